# Optimizing an MI355X kernel written in HIP

```python
import jax, jax.numpy as jnp
from jax import lax
import numpy as np

D_MODEL = 1024
BATCH = 32
SEQ = 2048
DEPTH = 4

CTX_LEN = 256
GRID_W = 64
HEAD_DIM = 64
BRANCH_WIDTH = 512
N_BRANCH = 3
CONV_WIDTH = BRANCH_WIDTH
CONV_K = 3
NA_HEADS = BRANCH_WIDTH // HEAD_DIM
NA_WIDTH = NA_HEADS * HEAD_DIM
NA_ROWS_MAX = 8
NA_COLS = 16
NA_QCOL_BLOCK = 16
NA_KCOL_BLOCK = 32
SW_Q_HEADS = BRANCH_WIDTH // HEAD_DIM
SW_KV_HEADS = 2
SW_Q_WIDTH = SW_Q_HEADS * HEAD_DIM
SW_KV_WIDTH = SW_KV_HEADS * HEAD_DIM
SW_WINDOW = 128
SW_BLOCK = 128
ROPE_BASE = 10000.0
ROPE_AXIS_FREQS = HEAD_DIM // 4
N_EXPERTS = 16
EXPERT_FF = 1024
CAPACITY_FACTOR = 2
RMS_EPS = 1e-6
NEG = -1e30
IN_SPLITS = [CONV_WIDTH] * 3 + [NA_WIDTH] * 3 + [SW_Q_WIDTH, SW_KV_WIDTH, SW_KV_WIDTH] + [D_MODEL] * N_BRANCH
IN_WIDTH = 3 * CONV_WIDTH + 3 * NA_WIDTH + SW_Q_WIDTH + 2 * SW_KV_WIDTH + N_BRANCH * D_MODEL

kernel_name = 'hybrid_dit_conv_natten_swa_ec_moe'


def rms_norm(x, g):
    xf = x.astype(jnp.float32)
    y = xf * lax.rsqrt(jnp.mean(xf * xf, axis=-1, keepdims=True) + RMS_EPS)
    return (y * g.astype(jnp.float32)).astype(x.dtype)


def modulate(h, shift, scale):
    return h * (1 + scale) + shift


def split_in(z):
    offs, acc = [], 0
    for s in IN_SPLITS[:-1]:
        acc += s
        offs.append(acc)
    return jnp.split(z, offs, axis=-1)


def heads(t, n):
    return t.reshape(t.shape[0], t.shape[1], n, HEAD_DIM)


def axial_rope(n_tokens):
    t = jnp.arange(n_tokens, dtype=jnp.int32)
    row = (t // GRID_W).astype(jnp.float32)
    col = (t % GRID_W).astype(jnp.float32)
    inv = ROPE_BASE ** (-jnp.arange(ROPE_AXIS_FREQS, dtype=jnp.float32) / ROPE_AXIS_FREQS)
    ang = jnp.concatenate([row[:, None] * inv, col[:, None] * inv], axis=-1)
    return jnp.cos(ang), jnp.sin(ang)


def apply_rope(x, cos, sin):
    xf = x.astype(jnp.float32)
    half = HEAD_DIM // 2
    x1, x2 = xf[..., :half], xf[..., half:]
    cs, sn = cos[None, :, None, :], sin[None, :, None, :]
    return jnp.concatenate([x1 * cs - x2 * sn, x1 * sn + x2 * cs], axis=-1).astype(x.dtype)


def short_conv(u, w):
    return lax.conv_general_dilated(u, w[:, None, :], window_strides=(1,),
                                    padding=((CONV_K // 2, CONV_K // 2),),
                                    dimension_numbers=('NWC', 'WIO', 'NWC'),
                                    feature_group_count=u.shape[-1])


def context_attention(q, k, v, sink):
    B, L, H, Dh = q.shape
    Hk = k.shape[2]
    G = H // Hk
    qg = q.reshape(B, L, Hk, G, Dh)
    s = jnp.einsum('bqkgd,blkd->bkgql', qg, k).astype(jnp.float32) * (Dh ** -0.5)
    if sink is not None:
        sk = jnp.broadcast_to(sink.astype(jnp.float32).reshape(Hk, G, 1, 1), (B, Hk, G, L, 1))
        s = jnp.concatenate([s, sk], axis=-1)
    p = jax.nn.softmax(s, axis=-1)[..., :L].astype(v.dtype)
    o = jnp.einsum('bkgql,blkd->bqkgd', p, v)
    return o.reshape(B, L, H * Dh)


def neighbourhood_attention(q, k, v, kc, vc, rpb):
    B, S, H, Dh = q.shape
    rows = S // GRID_W
    kr = min(NA_ROWS_MAX, rows)
    ncb = GRID_W // NA_QCOL_BLOCK
    scale = Dh ** -0.5
    qcols = np.arange(GRID_W).reshape(ncb, NA_QCOL_BLOCK)
    kstart = np.clip(np.arange(ncb) * NA_QCOL_BLOCK - NA_COLS // 2, 0, GRID_W - NA_KCOL_BLOCK)
    kcols = kstart[:, None] + np.arange(NA_KCOL_BLOCK)
    cstart = np.clip(qcols - NA_COLS // 2, 0, GRID_W - NA_COLS)
    col_ok = (kcols[:, None, :] >= cstart[..., None]) & (kcols[:, None, :] < cstart[..., None] + NA_COLS)
    dcol_idx = np.clip(kcols[:, None, :] - qcols[..., None] + NA_COLS - 1, 0, 2 * NA_COLS - 2)
    qg = q.reshape(B, rows, ncb, NA_QCOL_BLOCK, H, Dh)
    kg = k.reshape(B, rows, GRID_W, H, Dh)
    vg = v.reshape(B, rows, GRID_W, H, Dh)
    n_loc = kr * NA_KCOL_BLOCK

    def row_block(r):
        rs = jnp.clip(r - kr // 2, 0, rows - kr)
        kb = lax.dynamic_slice_in_dim(kg, rs, kr, axis=1)[:, :, kcols]
        vb = lax.dynamic_slice_in_dim(vg, rs, kr, axis=1)[:, :, kcols]
        qb = lax.dynamic_index_in_dim(qg, r, axis=1, keepdims=False)
        s_loc = jnp.einsum('bjqhd,brjkhd->bhjqrk', qb, kb).astype(jnp.float32) * scale
        dr_idx = rs + jnp.arange(kr) - r + NA_ROWS_MAX - 1
        bias = rpb[:, dr_idx[:, None, None, None], dcol_idx[None]]
        bias = bias.transpose(0, 2, 3, 1, 4).astype(jnp.float32)
        s_loc = jnp.where(col_ok[:, :, None, :], s_loc + bias[None], NEG)
        s_loc = s_loc.reshape(B, H, ncb, NA_QCOL_BLOCK, n_loc)
        s_ctx = jnp.einsum('bjqhd,blhd->bhjql', qb, kc).astype(jnp.float32) * scale
        p = jax.nn.softmax(jnp.concatenate([s_loc, s_ctx], axis=-1), axis=-1).astype(v.dtype)
        p_loc = p[..., :n_loc].reshape(B, H, ncb, NA_QCOL_BLOCK, kr, NA_KCOL_BLOCK)
        return (jnp.einsum('bhjqrk,brjkhd->bjqhd', p_loc, vb)
                + jnp.einsum('bhjql,blhd->bjqhd', p[..., n_loc:], vc))

    out = lax.map(row_block, jnp.arange(rows))
    return jnp.moveaxis(out, 0, 1).reshape(B, S, H * Dh)


def window_attention(q, k, v, kc, vc, sink):
    B, S, H, Dh = q.shape
    Hk = k.shape[2]
    G = H // Hk
    L = kc.shape[1]
    nb = S // SW_BLOCK
    span = SW_BLOCK + 2 * SW_WINDOW
    scale = Dh ** -0.5
    pad = ((0, 0), (SW_WINDOW, SW_WINDOW), (0, 0), (0, 0))
    kpad, vpad = jnp.pad(k, pad), jnp.pad(v, pad)
    qall = q.reshape(B, nb, SW_BLOCK, Hk, G, Dh)
    sk = jnp.broadcast_to(sink.astype(jnp.float32).reshape(Hk, G, 1, 1), (B, Hk, G, SW_BLOCK, 1))

    def block(n):
        start = n * SW_BLOCK
        kb = lax.dynamic_slice_in_dim(kpad, start, span, axis=1)
        vb = lax.dynamic_slice_in_dim(vpad, start, span, axis=1)
        qb = lax.dynamic_index_in_dim(qall, n, axis=1, keepdims=False)
        qpos = start + jnp.arange(SW_BLOCK)
        kpos = start - SW_WINDOW + jnp.arange(span)
        ok = (jnp.abs(qpos[:, None] - kpos[None, :]) <= SW_WINDOW) & (kpos[None, :] >= 0) & (kpos[None, :] < S)
        s_loc = jnp.einsum('bqkgd,blkd->bkgql', qb, kb).astype(jnp.float32) * scale
        s_loc = jnp.where(ok, s_loc, NEG)
        s_ctx = jnp.einsum('bqkgd,blkd->bkgql', qb, kc).astype(jnp.float32) * scale
        p = jax.nn.softmax(jnp.concatenate([s_loc, s_ctx, sk], axis=-1), axis=-1).astype(v.dtype)
        return (jnp.einsum('bkgql,blkd->bqkgd', p[..., :span], vb)
                + jnp.einsum('bkgql,blkd->bqkgd', p[..., span:span + L], vc))

    out = lax.map(block, jnp.arange(nb))
    return jnp.moveaxis(out, 0, 1).reshape(B, S, H * Dh)


def merge_branches(outs, gate_logits, w_branch, w_out):
    merged = jax.nn.sigmoid(gate_logits[0]) * (outs[0] @ w_branch[0])
    for i in range(1, N_BRANCH):
        merged = merged + jax.nn.sigmoid(gate_logits[i]) * (outs[i] @ w_branch[i])
    return merged @ w_out


def expert_choice_ffn(h, w_router, w_gate, w_up, w_down):
    B, N, D = h.shape
    cap = CAPACITY_FACTOR * N // N_EXPERTS
    aff = jax.nn.softmax((h @ w_router).astype(jnp.float32), axis=-1)
    gate, idx = lax.top_k(jnp.swapaxes(aff, 1, 2), cap)
    bidx = jnp.arange(B)[:, None, None]
    xe = h[bidx, idx]
    a = jnp.einsum('becd,edf->becf', xe, w_gate)
    u = jnp.einsum('becd,edf->becf', xe, w_up)
    ye = jnp.einsum('becf,efd->becd', jax.nn.silu(a) * u, w_down) * gate[..., None].astype(h.dtype)
    return jnp.zeros_like(h).at[bidx, idx].add(ye)


def setup_inputs(seed: int = 0) -> dict:
    key = jax.random.key(seed)
    ks = jax.random.split(key, 19)
    D = D_MODEL

    def nrm(k, shape, scale):
        return jax.random.normal(k, shape, jnp.float32) * scale

    return {
        'x': nrm(ks[0], (BATCH, SEQ, D), 1.0),
        'c': nrm(ks[1], (BATCH, D), 1.0),
        'ctx': nrm(ks[2], (BATCH, CTX_LEN, D), 1.0),
        'c_ctx': nrm(ks[3], (D,), 1.0),
        'w_ada': nrm(ks[4], (DEPTH, D, 6 * D), 0.5 * D ** -0.5),
        'b_ada': nrm(ks[5], (DEPTH, 6 * D), 0.02),
        'g_mix': 1.0 + nrm(ks[6], (DEPTH, D), 0.02),
        'w_in': nrm(ks[7], (DEPTH, D, IN_WIDTH), D ** -0.5),
        'conv_w': nrm(ks[8], (DEPTH, CONV_K, CONV_WIDTH), CONV_K ** -0.5),
        'na_rpb': nrm(ks[9], (DEPTH, NA_HEADS, 2 * NA_ROWS_MAX - 1, 2 * NA_COLS - 1), 0.1),
        'sw_sink': nrm(ks[10], (DEPTH, SW_Q_HEADS), 0.5),
        'w_branch': nrm(ks[11], (DEPTH, N_BRANCH, BRANCH_WIDTH, D), BRANCH_WIDTH ** -0.5),
        'w_out': nrm(ks[12], (DEPTH, D, D), D ** -0.5),
        'g_ffn': 1.0 + nrm(ks[13], (DEPTH, D), 0.02),
        'w_router': nrm(ks[14], (DEPTH, D, N_EXPERTS), D ** -0.5),
        'w_exp_gate': nrm(ks[15], (DEPTH, N_EXPERTS, D, EXPERT_FF), D ** -0.5),
        'w_exp_up': nrm(ks[16], (DEPTH, N_EXPERTS, D, EXPERT_FF), D ** -0.5),
        'w_exp_down': nrm(ks[17], (DEPTH, N_EXPERTS, EXPERT_FF, D), EXPERT_FF ** -0.5),
        'g_final': 1.0 + nrm(ks[18], (D,), 0.02),
    }


def reference(x, c, ctx, c_ctx, w_ada, b_ada, g_mix, w_in, conv_w, na_rpb, sw_sink, w_branch, w_out,
              g_ffn, w_router, w_exp_gate, w_exp_up, w_exp_down, g_final):
    S = x.shape[1]
    cos, sin = axial_rope(S)
    xc = ctx
    for l in range(DEPTH):
        last = l == DEPTH - 1
        mod = (jax.nn.silu(c) @ w_ada[l] + b_ada[l])[:, None, :]
        mod_c = (jax.nn.silu(c_ctx)[None] @ w_ada[l] + b_ada[l])[:, None, :]
        sh1, sc1, gt1, sh2, sc2, gt2 = jnp.split(mod, 6, axis=-1)
        csh1, csc1, cgt1, csh2, csc2, cgt2 = jnp.split(mod_c, 6, axis=-1)

        h = modulate(rms_norm(x, g_mix[l]), sh1, sc1)
        hc = modulate(rms_norm(xc, g_mix[l]), csh1, csc1)
        a_b, a_c, a_x, na_q, na_k, na_v, sw_q, sw_k, sw_v, ga, gb, gc = split_in(h @ w_in[l])
        ca_b, ca_c, ca_x, cna_q, cna_k, cna_v, csw_q, csw_k, csw_v, cga, cgb, cgc = split_in(hc @ w_in[l])
        kc_na, vc_na = heads(cna_k, NA_HEADS), heads(cna_v, NA_HEADS)
        kc_sw, vc_sw = heads(csw_k, SW_KV_HEADS), heads(csw_v, SW_KV_HEADS)

        o_a = a_b * short_conv(a_c * a_x, conv_w[l])
        o_b = neighbourhood_attention(heads(na_q, NA_HEADS), heads(na_k, NA_HEADS), heads(na_v, NA_HEADS),
                                      kc_na, vc_na, na_rpb[l])
        o_c = window_attention(apply_rope(heads(sw_q, SW_Q_HEADS), cos, sin),
                               apply_rope(heads(sw_k, SW_KV_HEADS), cos, sin),
                               heads(sw_v, SW_KV_HEADS), kc_sw, vc_sw, sw_sink[l])
        x = x + gt1 * merge_branches((o_a, o_b, o_c), (ga, gb, gc), w_branch[l], w_out[l])
        if not last:
            co_a = ca_b * short_conv(ca_c * ca_x, conv_w[l])
            co_b = context_attention(heads(cna_q, NA_HEADS), kc_na, vc_na, None)
            co_c = context_attention(heads(csw_q, SW_Q_HEADS), kc_sw, vc_sw, sw_sink[l])
            xc = xc + cgt1 * merge_branches((co_a, co_b, co_c), (cga, cgb, cgc), w_branch[l], w_out[l])

        x = x + gt2 * expert_choice_ffn(modulate(rms_norm(x, g_ffn[l]), sh2, sc2),
                                        w_router[l], w_exp_gate[l], w_exp_up[l], w_exp_down[l])
        if not last:
            xc = xc + cgt2 * expert_choice_ffn(modulate(rms_norm(xc, g_ffn[l]), csh2, csc2),
                                               w_router[l], w_exp_gate[l], w_exp_up[l], w_exp_down[l])
    return rms_norm(x, g_final)
```

```cpp
#include <hip/hip_runtime.h>
#include <cstdio>
#include <cstdint>

#ifndef MK_ONE_LAUNCH
#define MK_ONE_LAUNCH 1
#endif

#define GAS __attribute__((address_space(1)))
#define LAS __attribute__((address_space(3)))
typedef unsigned short bf16;
typedef short bf16x8 __attribute__((ext_vector_type(8)));
typedef float f32x4 __attribute__((ext_vector_type(4)));
typedef float f32x2 __attribute__((ext_vector_type(2)));
typedef unsigned u32x4 __attribute__((ext_vector_type(4)));
typedef unsigned u32x2 __attribute__((ext_vector_type(2)));

constexpr int D = 1024, NB = 32, SEQ = 2048, CTX = 256, DEPTH = 4, INW = 6912, NE = 16, FF = 1024;
constexpr int NCH = 2, BC = NB / NCH;
constexpr int LROWS = BC * SEQ, CTXALL = NB * CTX, RCMAX = LROWS + CTXALL;
constexpr int LT = LROWS / 256, CTT = CTXALL / 256;
__host__ __device__ constexpr int nrows_of(int ch) { return ch == 0 ? RCMAX : LROWS; }
constexpr int CAP_L = 2 * SEQ / NE, CAP_C = 2 * CTX / NE;
constexpr int SLOT_CT0 = BC * NE * CAP_L;
constexpr int NSLOTMAX = SLOT_CT0 + NE * NB * CAP_C;
constexpr int SLT = SLOT_CT0 / 256, SCT = NE * NB * CAP_C / 256;
constexpr float RMS_EPS = 1e-6f;
constexpr int Z_AB = 0, Z_AC = 512, Z_AX = 1024, Z_NQ = 1536, Z_NK = 2048, Z_NV = 2560, Z_SQ = 3072, Z_SK = 3584, Z_SV = 3712, Z_G = 3840;
constexpr int OW = 1536;
constexpr int ZW = Z_G;

constexpr size_t MiB = 1u << 20;
constexpr size_t WS_CTL = 0, CTL_ZERO_BYTES = 1 * MiB;
constexpr size_t WS_MODS = 1 * MiB;
constexpr size_t WS_ROPE = 5 * MiB;
constexpr size_t WS_AFFL = 6 * MiB;
constexpr size_t WS_AFFC = 10 * MiB;
constexpr size_t WS_GATEV = 11 * MiB;
constexpr size_t WS_SELTOK = 12 * MiB;
constexpr size_t WS_XC = 13 * MiB;
constexpr size_t WS_WIN = 45 * MiB;
constexpr size_t WS_WBR = 59 * MiB;
constexpr size_t WS_WOUT = 62 * MiB;
constexpr size_t WS_WUP = 64 * MiB;
constexpr size_t WS_WDN = 128 * MiB;
constexpr size_t WS_HBUF = 160 * MiB;
constexpr size_t WS_HBUF1 = 240 * MiB;
constexpr size_t WS_OBUF = 304 * MiB;
constexpr size_t WS_PART = 424 * MiB;
constexpr size_t WS_Z = 544 * MiB;
constexpr size_t WS_GB = 844 * MiB;
constexpr size_t WS_HMID = WS_OBUF;
constexpr size_t WS_YBUF = WS_OBUF + 288 * MiB;
constexpr size_t WS_DX0 = 1084 * MiB, WS_DX1 = 1164 * MiB;
constexpr size_t WS_TOKSLOT = 1228 * MiB;
constexpr size_t WS_END = 1234 * MiB;
static_assert((size_t)RCMAX * ZW * 2 == 300 * MiB && (size_t)LROWS * ZW * 2 == 240 * MiB && (size_t)NSLOTMAX * 1024 * 2 == 160 * MiB && (size_t)RCMAX * 1024 * 2 == 80 * MiB && (size_t)RCMAX * OW * 2 == 120 * MiB
              && (size_t)(RCMAX / 256) * 12 * 131072 == 240 * MiB && WS_YBUF + 288 * MiB <= WS_GB + 240 * MiB && WS_HBUF1 == WS_HBUF + (size_t)RCMAX * 1024 * 2, "ws map");
constexpr int PBT = NSLOTMAX / 256;
constexpr int CW_TMO = 0, CW_DIAG = 64, CW_BAR = 4096;

constexpr int RING_BYTES = 131072, LDSCTL_OFF = RING_BYTES, MISC_OFF = LDSCTL_OFF + 320, LDS_BYTES = 147456;
constexpr int NWAVES = 8, NTHR = 512;

__device__ __forceinline__ unsigned f2bf(float f) { unsigned u = __builtin_bit_cast(unsigned, f); return (u + 0x7fffu + ((u >> 16) & 1u)) >> 16; }
__device__ __forceinline__ unsigned pk2(float lo, float hi) { return f2bf(lo) | (f2bf(hi) << 16); }
__device__ __forceinline__ float bflo(unsigned u) { return __builtin_bit_cast(float, u << 16); }
__device__ __forceinline__ float bfhi(unsigned u) { return __builtin_bit_cast(float, u & 0xffff0000u); }
__device__ __forceinline__ void unpack8(const u32x4 u, float* f) { f[0] = bflo(u.x); f[1] = bfhi(u.x); f[2] = bflo(u.y); f[3] = bfhi(u.y); f[4] = bflo(u.z); f[5] = bfhi(u.z); f[6] = bflo(u.w); f[7] = bfhi(u.w); }
__device__ __forceinline__ float wave_sum(float v) {
#pragma unroll
    for (int o = 1; o < 64; o <<= 1) v += __shfl_xor(v, o);
    return v;
}
__device__ __forceinline__ float sigmoidf_(float x) { return __builtin_amdgcn_rcpf(1.0f + __builtin_amdgcn_exp2f(-1.4426950408889634f * x)); }
__device__ __forceinline__ int launder(int v) { asm volatile("" : "+v"(v)); return v; }
__device__ __forceinline__ int lane_id() { int l; asm volatile("v_mbcnt_lo_u32_b32 %0, -1, 0\n\tv_mbcnt_hi_u32_b32 %0, -1, %0" : "=v"(l)); return l; }
#define LDS_WAIT() asm volatile("s_waitcnt lgkmcnt(0)" ::: "memory")
#define VM_WAIT() asm volatile("s_waitcnt vmcnt(0)" ::: "memory")

namespace pg8 {
constexpr int BM = 256, BK = 64, HALF = 128, HTB = HALF * BK * 2, STAGE_BYTES = 8 * HTB, NXCD = 8, WGM = 8;
__host__ __device__ __forceinline__ int lds_byte(int r, int c) { const int st = (r >> 4) * 2 + (c >> 5), rr = r & 15, cc = c & 31, ob = rr * 64 + cc * 2; return st * 1024 + (ob ^ (((ob >> 9) & 1) << 5)); }
__host__ __device__ __forceinline__ void stage_rc(int b, int& R, int& C) { const int st = b / 1024, sb = b % 1024, swz = sb ^ (((sb >> 9) & 1) << 5); R = (st >> 1) * 16 + swz / 64; C = (st & 1) * 32 + (swz % 64) / 2; }
__host__ __device__ __forceinline__ int perm32(int rho) { const int n = rho >> 4, i = rho & 15; return 8 * (i >> 2) + 4 * n + (i & 3); }

struct Unit { int pm, pn, aux, pad; const char* A; const char* B; };

__device__ __forceinline__ bool tile_of(long L, int nM, int nN, int& pm, int& pn) {
    const int nwg = nM * nN; if (L >= nwg) return false;
    int wgid = (int)L; { const int q = nwg / NXCD, r = nwg % NXCD, xcd = wgid % NXCD, off = wgid / NXCD; wgid = (xcd < r ? xcd * (q + 1) : r * (q + 1) + (xcd - r) * q) + off; }
    const int nig = WGM * nN, gid = wgid / nig, fm = gid * WGM, gsz = (nM - fm) < WGM ? (nM - fm) : WGM;
    pm = fm + ((wgid % nig) % gsz); pn = (wgid % nig) / gsz; return true;
}

__device__ __forceinline__ unsigned cvt_pk_bf16(float lo, float hi) { unsigned r; asm volatile("v_cvt_pk_bf16_f32 %0, %1, %2" : "=v"(r) : "v"(lo), "v"(hi)); return r; }

template <class Epi, class Sched, bool ALIGN_EPI, bool SP2, int NSEG = 1, bool GATHER = false>
__device__ __forceinline__ void gemm_phase(LAS unsigned char* lds, const int lda_bytes, const int K, const Sched& S, const Epi& E, const int wid_in) {
    int wid = wid_in; asm volatile("" : "+s"(wid));
    int lane_ = lane_id(); asm volatile("" : "+v"(lane_));
    const int lane = lane_, tid = wid * 64 + lane, wr = wid >> 2, wc = wid & 3, fr = lane & 15, fq = lane >> 4;
    const int nt = K / BK;
    unsigned voffA[2], voffB[2]; int gR[2], gC[2];
#pragma unroll
    for (int i = 0; i < 2; ++i) { int R, C; stage_rc(tid * 16 + i * 8192, R, C); const int Rb = Epi::PERM ? ((R & ~31) + perm32(R & 31)) : R; gR[i] = R; gC[i] = C * 2;
        voffA[i] = (unsigned)(R * lda_bytes + C * 2); voffB[i] = (unsigned)(Rb * K + C) * 2u; }
    unsigned offc[2][2], offn[2][2]; int rawn[2][2];
    const size_t kstep = (size_t)(BK * 2);
    const size_t hstepA = (size_t)HALF * lda_bytes, hstepB = (size_t)HALF * K * 2;
    const unsigned ldsw = (unsigned)wid * 1024u;
    const int aoff = lds_byte(wr * 64 + fr, fq * 8), boff = lds_byte(wc * 32 + fr, fq * 8);
#define PG8_SA(b, h) (((b) * 2 + (h)) * HTB)
#define PG8_SB(b, h) ((4 + (b) * 2 + (h)) * HTB)
#define PG8_STAGE(bufoff, gbase, voff) do { _Pragma("unroll") for (int _i = 0; _i < 2; ++_i) \
        __builtin_amdgcn_global_load_lds((const unsigned*)((const char*)(gbase) + (voff)[_i]), (LAS unsigned*)(lds + (bufoff) + ldsw + _i * 8192), 16, 0, 0); } while (0)
#define PG8_STAGE_A(bufoff, kbase, h, nx) do { if constexpr (GATHER) { unsigned vs_[2]; vs_[0] = (nx) ? offn[h][0] : offc[h][0]; vs_[1] = (nx) ? offn[h][1] : offc[h][1]; PG8_STAGE(bufoff, (kbase), vs_); } \
        else { PG8_STAGE(bufoff, (kbase) + ((h) ? hstepA : (size_t)0), voffA); } } while (0)
#define PG8_LDA(dst, b, h) do { _Pragma("unroll") for (int m = 0; m < 4; ++m) _Pragma("unroll") for (int k = 0; k < 2; ++k) dst[m][k] = *(const LAS bf16x8*)(lds + PG8_SA(b, h) + aoff + m * 2048 + k * 1024); } while (0)
#define PG8_LDB(dst, b, h) do { _Pragma("unroll") for (int n = 0; n < 2; ++n) _Pragma("unroll") for (int k = 0; k < 2; ++k) dst[n][k] = *(const LAS bf16x8*)(lds + PG8_SB(b, h) + boff + n * 2048 + k * 1024); } while (0)
#define PG8_MMA(ai, bj, At, Bt) do { __builtin_amdgcn_s_setprio(1); _Pragma("unroll") for (int m = 0; m < 4; ++m) _Pragma("unroll") for (int n = 0; n < 2; ++n) _Pragma("unroll") for (int k = 0; k < 2; ++k) \
        acc[ai][bj][m][n] = __builtin_amdgcn_mfma_f32_16x16x32_bf16(Bt[n][k], At[m][k], acc[ai][bj][m][n], 0, 0, 0); __builtin_amdgcn_s_setprio(0); } while (0)
#define PG8_WAIT_V(n) asm volatile("s_waitcnt vmcnt(" #n ")" ::: "memory")
#define PG8_WAIT_L(n) asm volatile("s_waitcnt lgkmcnt(" #n ")" ::: "memory")
#define PG8_BAR __builtin_amdgcn_s_barrier()
#define PG8_SCHED __builtin_amdgcn_sched_barrier(0)
    Unit cur, nxt; int ui = 0;
    if (!S.next(0, cur)) return;
    f32x4 acc[2][2][4][2];
#pragma unroll
    for (int a = 0; a < 2; ++a)
#pragma unroll
        for (int b = 0; b < 2; ++b)
#pragma unroll
            for (int m = 0; m < 4; ++m)
#pragma unroll
                for (int n = 0; n < 2; ++n) acc[a][b][m][n] = (f32x4){0.f, 0.f, 0.f, 0.f};
    bf16x8 At[4][2], B0[2][2], B1[2][2];
    const char* cA = cur.A; const char* cB = cur.B;
    if constexpr (GATHER) {
#pragma unroll
        for (int h = 0; h < 2; ++h)
#pragma unroll
            for (int i = 0; i < 2; ++i) { offc[h][i] = (unsigned)S.gidx[cur.aux * 256 + h * 128 + gR[i]] * (unsigned)lda_bytes + (unsigned)gC[i]; offn[h][i] = offc[h][i]; }
    }
    if constexpr (SP2) {
        PG8_STAGE(PG8_SB(0, 0), cB, voffB); PG8_STAGE(PG8_SB(0, 1), cB + hstepB, voffB); PG8_STAGE_A(PG8_SA(0, 0), cA, 0, false); PG8_STAGE_A(PG8_SA(0, 1), cA, 1, false);
        if (wr == 1) PG8_BAR;
        PG8_WAIT_V(2); PG8_BAR;
        PG8_STAGE(PG8_SB(1, 0), cB + kstep, voffB); PG8_STAGE_A(PG8_SA(1, 0), cA + kstep, 0, false); PG8_STAGE(PG8_SB(1, 1), cB + hstepB + kstep, voffB);
        PG8_WAIT_V(6); PG8_BAR;
    } else {
        static_assert(SP2 || !GATHER, "GATHER is implemented for the SP2 loop only");
        PG8_STAGE(PG8_SB(0, 0), cB, voffB); PG8_STAGE(PG8_SA(0, 0), cA, voffA); PG8_STAGE(PG8_SB(0, 1), cB + hstepB, voffB); PG8_STAGE(PG8_SA(0, 1), cA + hstepA, voffA);
        if (wr == 1) PG8_BAR;
        PG8_WAIT_V(4); PG8_BAR;
        PG8_STAGE(PG8_SB(1, 0), cB + kstep, voffB); PG8_STAGE(PG8_SA(1, 0), cA + kstep, voffA); PG8_STAGE(PG8_SB(1, 1), cB + hstepB + kstep, voffB);
        PG8_WAIT_V(6); PG8_BAR;
    }
    for (;;) {
        const bool has_next = S.next(ui + 1, nxt);
        const char* nA = has_next ? nxt.A : cA; const char* nB = has_next ? nxt.B : cB;
        if constexpr (GATHER) {
            const int na_ = has_next ? nxt.aux : cur.aux;
#pragma unroll
            for (int h = 0; h < 2; ++h)
#pragma unroll
                for (int i = 0; i < 2; ++i) rawn[h][i] = S.gidx[na_ * 256 + h * 128 + gR[i]]; }
        for (int t = 0; t < nt; t += 2) {
            const bool last = (t == nt - 2);
            const char* a1 = cA + (size_t)(t + 1) * kstep;
            const char* a2 = last ? nA : cA + (size_t)(t + 2) * kstep; const char* b2 = last ? nB : cB + (size_t)(t + 2) * kstep;
            const char* a3 = a2 + kstep; const char* b3 = b2 + kstep;
            if constexpr (GATHER) { if (last && has_next) {
#pragma unroll
                for (int h = 0; h < 2; ++h)
#pragma unroll
                    for (int i = 0; i < 2; ++i) { int rw_ = rawn[h][i]; asm volatile("" : "+v"(rw_));
                        offn[h][i] = (unsigned)rw_ * (unsigned)lda_bytes + (unsigned)gC[i]; } } }
            if constexpr (NSEG > 1) { const int tseg = nt / NSEG; if (t > 0 && (t % tseg) == 0) E.mid(acc, cur, t / tseg, wr, wc, fr, fq); }
            if constexpr (SP2) {
            PG8_LDB(B0, 0, 0); PG8_LDB(B1, 0, 1); PG8_SCHED; PG8_LDA(At, 0, 0); PG8_STAGE_A(PG8_SA(1, 1), a1, 1, false);
            PG8_WAIT_V(8); PG8_WAIT_L(0); PG8_BAR; PG8_MMA(0, 0, At, B0); PG8_MMA(0, 1, At, B1); PG8_BAR; PG8_SCHED;
            PG8_LDA(At, 0, 1); PG8_STAGE(PG8_SB(0, 0), b2, voffB); PG8_STAGE(PG8_SB(0, 1), b2 + hstepB, voffB); PG8_STAGE_A(PG8_SA(0, 0), a2, 0, last);
            PG8_WAIT_V(8); PG8_WAIT_L(0); PG8_BAR; PG8_MMA(1, 0, At, B0); PG8_MMA(1, 1, At, B1); PG8_BAR; PG8_SCHED;
            PG8_LDB(B0, 1, 0); PG8_LDB(B1, 1, 1); PG8_SCHED; PG8_LDA(At, 1, 0); PG8_STAGE_A(PG8_SA(0, 1), a2, 1, last);
            PG8_WAIT_V(8); PG8_WAIT_L(0); PG8_BAR; PG8_MMA(0, 0, At, B0); PG8_MMA(0, 1, At, B1); PG8_BAR; PG8_SCHED;
            PG8_LDA(At, 1, 1); PG8_STAGE(PG8_SB(1, 0), b3, voffB); PG8_STAGE(PG8_SB(1, 1), b3 + hstepB, voffB); PG8_STAGE_A(PG8_SA(1, 0), a3, 0, last);
            PG8_WAIT_V(8); PG8_WAIT_L(0); PG8_BAR; PG8_MMA(1, 0, At, B0); PG8_MMA(1, 1, At, B1); PG8_BAR; PG8_SCHED;
            } else {
            PG8_LDB(B0, 0, 0); PG8_SCHED; PG8_LDA(At, 0, 0); PG8_STAGE(PG8_SA(1, 1), a1 + hstepA, voffA);
            PG8_WAIT_L(8); PG8_BAR; PG8_WAIT_L(0); PG8_MMA(0, 0, At, B0); PG8_BAR; PG8_SCHED;
            PG8_LDB(B1, 0, 1); PG8_STAGE(PG8_SB(0, 0), b2, voffB);
            PG8_BAR; PG8_WAIT_L(0); PG8_MMA(0, 1, At, B1); PG8_BAR;
            PG8_LDA(At, 0, 1); PG8_STAGE(PG8_SA(0, 0), a2, voffA);
            PG8_BAR; PG8_WAIT_L(0); PG8_MMA(1, 0, At, B0); PG8_BAR; PG8_SCHED;
            PG8_STAGE(PG8_SB(0, 1), b2 + hstepB, voffB);
            PG8_WAIT_V(6); PG8_BAR; PG8_MMA(1, 1, At, B1); PG8_BAR;
            PG8_LDB(B0, 1, 0); PG8_SCHED; PG8_LDA(At, 1, 0); PG8_STAGE(PG8_SA(0, 1), a2 + hstepA, voffA);
            PG8_WAIT_L(8); PG8_BAR; PG8_WAIT_L(0); PG8_MMA(0, 0, At, B0); PG8_BAR; PG8_SCHED;
            PG8_LDB(B1, 1, 1); PG8_STAGE(PG8_SB(1, 0), b3, voffB);
            PG8_BAR; PG8_WAIT_L(0); PG8_MMA(0, 1, At, B1); PG8_BAR;
            PG8_LDA(At, 1, 1); PG8_STAGE(PG8_SA(1, 0), a3, voffA);
            PG8_BAR; PG8_WAIT_L(0); PG8_MMA(1, 0, At, B0); PG8_BAR; PG8_SCHED;
            PG8_STAGE(PG8_SB(1, 1), b3 + hstepB, voffB);
            PG8_WAIT_V(6); PG8_BAR; PG8_MMA(1, 1, At, B1); PG8_BAR;
            }
        }
        if constexpr (ALIGN_EPI) { if (wr == 0) PG8_BAR; }
        E(acc, cur, wr, wc, fr, fq);
        if (!has_next) break;
#pragma unroll
        for (int a = 0; a < 2; ++a)
#pragma unroll
            for (int b = 0; b < 2; ++b)
#pragma unroll
                for (int m = 0; m < 4; ++m)
#pragma unroll
                    for (int n = 0; n < 2; ++n) acc[a][b][m][n] = (f32x4){0.f, 0.f, 0.f, 0.f};
        cur = nxt; cA = nA; cB = nB; ++ui;
        if constexpr (GATHER) {
#pragma unroll
            for (int h = 0; h < 2; ++h)
#pragma unroll
                for (int i = 0; i < 2; ++i) offc[h][i] = offn[h][i]; }
        if constexpr (ALIGN_EPI) { if (wr == 1) PG8_BAR; }
    }
    PG8_WAIT_V(0);
    if constexpr (!ALIGN_EPI) { if (wr == 0) PG8_BAR; }
    PG8_BAR;
#undef PG8_SA
#undef PG8_SB
#undef PG8_STAGE
#undef PG8_STAGE_A
#undef PG8_LDA
#undef PG8_LDB
#undef PG8_MMA
#undef PG8_WAIT_V
#undef PG8_WAIT_L
#undef PG8_BAR
#undef PG8_SCHED
}
}

#define XB_TMO      128
#define XB_XCNT(j)  (256  + 64 * (j))
#define XB_XSUB(j)  (1280 + 64 * (j))
#define XB_XGEN(j)  (2304 + 64 * (j))
#define XB_TOP      3328
#define XB_TOPGEN   3392
#define XCD_BAR_WORDS 3456
#define XB_SPIN_CAP (1u << 22)
__device__ __forceinline__ unsigned xb_ld(unsigned* p)              { return __hip_atomic_load(p, __ATOMIC_RELAXED, __HIP_MEMORY_SCOPE_AGENT); }
__device__ __forceinline__ unsigned xb_add(unsigned* p, unsigned v) { return __hip_atomic_fetch_add(p, v, __ATOMIC_RELAXED, __HIP_MEMORY_SCOPE_AGENT); }
__device__ __forceinline__ unsigned xb_xcc_id() { return (unsigned)__builtin_amdgcn_s_getreg((3 << 11) | 20) & 0xFu; }
#define XB_SPIN(cond, bar) do { unsigned _sp = 0; while (cond) { __builtin_amdgcn_s_sleep(1); \
    if ((++_sp & 255u) == 0u) { if (xb_ld(&(bar)[XB_TMO])) break; if (_sp > XB_SPIN_CAP) { atomicAdd(&(bar)[XB_TMO], 1u); break; } } } } while (0)
struct XcdBarrier { unsigned* bar; unsigned x; volatile LAS unsigned* st; };
__device__ __forceinline__ XcdBarrier xcd_barrier_post(unsigned* bar, volatile LAS unsigned* st) {
    XcdBarrier b; b.bar = bar; b.x = xb_xcc_id(); b.st = st;
    if (threadIdx.x == 0) (void)xb_add(&bar[XB_XCNT(b.x)], 1u);
    return b;
}
__device__ __forceinline__ void xcd_barrier_complete(unsigned* bar, unsigned x, unsigned& nloc, unsigned& nx) {
    const unsigned G = gridDim.x * gridDim.y * gridDim.z;
    unsigned sum, cnt, mine, sp = 0u;
    for (;;) {
        sum = 0u; cnt = 0u; mine = 0u;
#pragma unroll
        for (unsigned j = 0; j < 16; ++j) { const unsigned c = xb_ld(&bar[XB_XCNT(j)]); sum += c; cnt += (c > 0u) ? 1u : 0u; mine = (j == x) ? c : mine; }
        if (sum == G) break;
        __builtin_amdgcn_s_sleep(1);
        if ((++sp & 255u) == 0u) { if (xb_ld(&bar[XB_TMO])) break; if (sp > XB_SPIN_CAP) { atomicAdd(&bar[XB_TMO], 1u); break; } }
    }
    nloc = mine > 0u ? mine : 1u; nx = cnt > 0u ? cnt : 1u;
}
__device__ __forceinline__ void xcd_barrier(const XcdBarrier& b, const int wave) {
    asm volatile("s_waitcnt vmcnt(0)" ::: "memory");
    __syncthreads();
    if (wave == 0 && lane_id() == 0) {
        unsigned* bar = b.bar; asm volatile("" : "+s"(bar)); unsigned bx = b.x; asm volatile("" : "+s"(bx));
        __builtin_amdgcn_s_waitcnt(0);
        unsigned nloc = b.st[0], nx = b.st[1];
        if (nloc == 0u) { xcd_barrier_complete(bar, bx, nloc, nx); b.st[0] = nloc; b.st[1] = nx; }
        const unsigned old = xb_add(&bar[XB_XSUB(bx)], 1u);
        const unsigned gen = old / nloc;
        if (old + 1u == (gen + 1u) * nloc) {
            __builtin_amdgcn_fence(__ATOMIC_RELEASE, "agent");
            asm volatile("s_waitcnt vmcnt(0)" ::: "memory");
            const unsigned og = xb_add(&bar[XB_TOP], 1u);
            const unsigned tg = og / nx;
            if (og + 1u == (tg + 1u) * nx) xb_add(&bar[XB_TOPGEN], 1u);
            else XB_SPIN(xb_ld(&bar[XB_TOPGEN]) == tg, bar);
            __builtin_amdgcn_fence(__ATOMIC_ACQUIRE, "agent");
            xb_add(&bar[XB_XGEN(bx)], 1u);
            asm volatile("s_waitcnt vmcnt(0)" ::: "memory");
        } else {
            XB_SPIN(xb_ld(&bar[XB_XGEN(bx)]) == gen, bar);
            __builtin_amdgcn_fence(__ATOMIC_ACQUIRE, "agent");
            asm volatile("s_waitcnt vmcnt(0)" ::: "memory");
        }
    }
    __syncthreads();
}

struct Args {
    const float* in[19];
    float* out; unsigned char* ws;
    int ph_lo, ph_hi;
};
enum { I_X = 0, I_C, I_CTX, I_CCTX, I_WADA, I_BADA, I_GMIX, I_WIN, I_CONVW, I_RPB, I_SINK, I_WBR, I_WOUT, I_GFFN, I_WROUTER, I_WG, I_WU, I_WD, I_GFINAL };

struct Frame {
    unsigned char* lds;
    LAS unsigned char* ldsl;
    unsigned char* ws;
    int wave, vcu, G;
    float* out;
};

constexpr int PTR_OFF = MISC_OFF + 128;
__device__ __forceinline__ const float* inp(const Frame& F, int i) {
    const u32x2 v = *(const LAS u32x2*)(F.ldsl + PTR_OFF + 8 * i);
    const unsigned lo = __builtin_amdgcn_readfirstlane(v.x), hi = __builtin_amdgcn_readfirstlane(v.y);
    return (const float*)(((unsigned long long)hi << 32) | lo);
}
__device__ __forceinline__ float* xrow_dst(const Frame& F, int ch, int cr) {
    return cr < LROWS ? F.out + ((size_t)ch * LROWS + cr) * D : (float*)(F.ws + WS_XC) + (size_t)(cr - LROWS) * D;
}
__device__ __forceinline__ const float* xrow_src(const Frame& F, int l, int ch, int cr) {
    if (l > 0) return xrow_dst(F, ch, cr);
    return cr < LROWS ? inp(F, I_X) + ((size_t)ch * LROWS + cr) * D : inp(F, I_CTX) + (size_t)(cr - LROWS) * D;
}
__device__ __forceinline__ int mv_of(int ch, int cr) { return cr < LROWS ? ch * BC + cr / SEQ : NB; }
__device__ __forceinline__ const float* mod_ptr(const Frame& F, int l, int mv, int which) { return (const float*)(F.ws + WS_MODS) + ((size_t)(l * 33 + mv) * 6 + which) * D; }

__device__ __forceinline__ bf16* hbuf_of(const Frame& F, int ch) { return (bf16*)(F.ws + (ch == 0 ? WS_HBUF : WS_HBUF1)); }
__device__ __forceinline__ bf16* dx_of(const Frame& F, int ch) { return (bf16*)(F.ws + (ch == 0 ? WS_DX0 : WS_DX1)); }
__device__ __forceinline__ float* affl_of(const Frame& F, int ch) { return (float*)(F.ws + WS_AFFL) + (size_t)ch * BC * NE * SEQ; }
__device__ __forceinline__ int* tokslot_of(const Frame& F, int ch) { return (int*)(F.ws + WS_TOKSLOT) + (size_t)ch * RCMAX * NE; }
__device__ __forceinline__ void mods_phase(Frame& F) {
    const int lane = launder(lane_id()), tid = F.wave * 64 + lane; (void)tid; (void)lane;
    float* sl = (float*)F.lds;
    const float* c = inp(F, I_C); const float* cc = inp(F, I_CCTX);
    for (int item = F.vcu; item < DEPTH * 96; item += F.G) {
        const int l = item / 96, jb = item % 96, j = jb * 64 + lane;
        const float* W = inp(F, I_WADA) + (size_t)l * D * 6144;
        float acc[33];
#pragma unroll
        for (int m = 0; m < 33; ++m) acc[m] = 0.f;
        for (int kh = 0; kh < 2; ++kh) {
            __syncthreads();
            for (int i = tid; i < 512 * 33; i += NTHR) { const int k = i % 512, m = i / 512; const float v = (m < 32) ? c[(size_t)m * D + kh * 512 + k] : cc[kh * 512 + k]; sl[k * 36 + m] = v * sigmoidf_(v); }
            __syncthreads();
            for (int kk = 0; kk < 64; ++kk) {
                const int k = F.wave * 64 + kk; const float w = W[(size_t)(kh * 512 + k) * 6144 + j];
                const f32x4* s4 = (const f32x4*)(sl + k * 36);
#pragma unroll
                for (int q = 0; q < 8; ++q) { const f32x4 s = s4[q]; acc[4 * q] += s.x * w; acc[4 * q + 1] += s.y * w; acc[4 * q + 2] += s.z * w; acc[4 * q + 3] += s.w * w; }
                acc[32] += sl[k * 36 + 32] * w;
            }
        }
        __syncthreads();
        float* rd = (float*)F.lds;
#pragma unroll
        for (int m = 0; m < 33; ++m) rd[(F.wave * 33 + m) * 64 + lane] = acc[m];
        __syncthreads();
        for (int i = tid; i < 33 * 64; i += NTHR) { const int m = i / 64, jj = i % 64; float s = 0.f;
#pragma unroll
            for (int w = 0; w < 8; ++w) s += rd[(w * 33 + m) * 64 + jj];
            const int col = jb * 64 + jj;
            ((float*)(F.ws + WS_MODS))[(size_t)(l * 33 + m) * 6144 + col] = s + inp(F, I_BADA)[(size_t)l * 6144 + col]; }
    }
    __syncthreads();
    f32x2* tab = (f32x2*)(F.ws + WS_ROPE);
    for (int i = F.vcu * NTHR + tid; i < SEQ * 32; i += F.G * NTHR) {
        const int pos = i >> 5, fi = i & 31; const float inv = powf(10000.0f, -(float)(fi & 15) / 16.0f);
        const float ang = (fi < 16 ? (float)(pos / 64) : (float)(pos % 64)) * inv;
        tab[i] = (f32x2){cosf(ang), sinf(ang)};
    }
}

__device__ __forceinline__ void transpose_item(const float* W, int K, int N, bf16* WT, int k0, int n0, int orow0, float* scr, int lane, int ldo = 0, int kofs = 0) {
    if (ldo == 0) ldo = K;
    f32x4 v[8];
#pragma unroll
    for (int i = 0; i < 8; ++i) v[i] = *(const f32x4*)(W + (size_t)(k0 + 8 * i + (lane >> 3)) * N + n0 + 4 * (lane & 7));
#pragma unroll
    for (int i = 0; i < 8; ++i) *(f32x4*)(scr + (8 * i + (lane >> 3)) * 36 + 4 * (lane & 7)) = v[i];
    LDS_WAIT(); asm volatile("" ::: "memory");
    const int c = lane & 7;
#pragma unroll
    for (int j = 0; j < 4; ++j) { const int n = (lane >> 3) + 8 * j; const float* s = scr + (8 * c) * 36 + n;
        u32x4 o; o.x = pk2(s[0 * 36], s[1 * 36]); o.y = pk2(s[2 * 36], s[3 * 36]); o.z = pk2(s[4 * 36], s[5 * 36]); o.w = pk2(s[6 * 36], s[7 * 36]);
        *(u32x4*)(WT + (size_t)(orow0 + n) * ldo + kofs + k0 + 8 * c) = o; }
    LDS_WAIT(); asm volatile("" ::: "memory");
}
__device__ __forceinline__ void wconv_phase(Frame& F, int l) {
    const int lane = launder(lane_id()), tid = F.wave * 64 + lane; (void)tid; (void)lane;
    float* scr = (float*)(F.lds + F.wave * 16384);
    const int gw = F.vcu * NWAVES + F.wave, NGW = F.G * NWAVES;
    constexpr int I_IN = 16 * 216, I_BR = 3 * 8 * 32, I_OUT = 16 * 32, I_EX = 16 * 16 * 32;
    constexpr int NITEMS = I_IN + I_BR + I_OUT + 3 * I_EX;
    for (int it = gw; it < NITEMS; it += NGW) {
        int r = it;
        if (r < I_IN) { const int kb = r / 216, nb = r % 216; transpose_item(inp(F, I_WIN) + (size_t)l * D * INW, D, INW, (bf16*)(F.ws + WS_WIN), kb * 64, nb * 32, nb * 32, scr, lane); continue; } r -= I_IN;
        if (r < I_BR) { const int br = r / 256, q = r % 256, kb = q / 32, nb = q % 32;
            transpose_item(inp(F, I_WBR) + ((size_t)l * 3 + br) * 512 * D, 512, D, (bf16*)(F.ws + WS_WBR), kb * 64, nb * 32, nb * 32, scr, lane, 1536, br * 512); continue; } r -= I_BR;
        if (r < I_OUT) { const int kb = r / 32, nb = r % 32; transpose_item(inp(F, I_WOUT) + (size_t)l * D * D, D, D, (bf16*)(F.ws + WS_WOUT), kb * 64, nb * 32, nb * 32, scr, lane); continue; } r -= I_OUT;
        if (r < 2 * I_EX) { const int s = r / I_EX, q = r % I_EX, e = q / 512, q2 = q % 512, kb = q2 / 32, nb = q2 % 32, n0 = nb * 32;
            const float* W = inp(F, s ? I_WU : I_WG) + ((size_t)l * NE + e) * D * FF;
            transpose_item(W, D, FF, (bf16*)(F.ws + WS_WUP) + (size_t)e * 2048 * D, kb * 64, n0, 256 * (n0 / 128) + 128 * s + (n0 % 128), scr, lane); continue; } r -= 2 * I_EX;
        { const int e = r / 512, q2 = r % 512, kb = q2 / 32, nb = q2 % 32;
            transpose_item(inp(F, I_WD) + ((size_t)l * NE + e) * FF * D, FF, D, (bf16*)(F.ws + WS_WDN) + (size_t)e * D * FF, kb * 64, nb * 32, nb * 32, scr, lane); }
    }
}

__device__ __forceinline__ float xsel(bool c, float a, float b) { return c ? a : b; }
template <bool ROUTER>
__device__ __forceinline__ void norm_phase(Frame& F, int l, int ch, int nrows, bool dry = false) {
    const int lane = launder(lane_id()), tid = F.wave * 64 + lane; (void)tid; (void)lane;
    const int gw = F.vcu * NWAVES + F.wave, NGW = F.G * NWAVES;
    float* wr_l = (float*)F.lds;
    if (ROUTER) {
        const float* wr = inp(F, I_WROUTER) + (size_t)l * D * NE;
        for (int i = tid; i < D * NE; i += NTHR) { const int d = i >> 4, e = i & 15; wr_l[e * D + d] = wr[i]; }
        __syncthreads();
    }
    const float* gv = inp(F, ROUTER ? I_GFFN : I_GMIX) + (size_t)l * D;
    bf16* hb = dry ? (bf16*)(F.ws + WS_OBUF + 160 * MiB) : (bf16*)(F.ws + (ch == 0 ? WS_HBUF : WS_HBUF1));
    const bf16* dxb = dx_of(F, ch);
    f32x4 nx[2][4]; u32x2 nd[2][4];
#define NP_LOAD(c0) do { _Pragma("unroll") for (int rr_ = 0; rr_ < 2; ++rr_) { const float* xr_ = xrow_src(F, l, ch, (c0) + rr_); \
        _Pragma("unroll") for (int j_ = 0; j_ < 4; ++j_) { nx[rr_][j_] = *(const f32x4*)(xr_ + lane * 4 + 256 * j_); if (ROUTER) nd[rr_][j_] = *(const u32x2*)(dxb + (size_t)((c0) + rr_) * D + lane * 4 + 256 * j_); } } } while (0)
    const int rpw = (((nrows + NGW - 1) / NGW) + 1) & ~1, rbeg = gw * rpw, rend = (rbeg + rpw < nrows) ? rbeg + rpw : nrows;
    f32x4 gq[4], shq[4], scq[4]; int cmv = -1;
#pragma unroll
    for (int j = 0; j < 4; ++j) gq[j] = *(const f32x4*)(gv + lane * 4 + 256 * j);
    if (rbeg < rend) NP_LOAD(rbeg);
    for (int cr0 = rbeg; cr0 < rend; cr0 += 2) {
        f32x4 v[2][4]; u32x2 dv[2][4];
#pragma unroll
        for (int rr = 0; rr < 2; ++rr)
#pragma unroll
            for (int j = 0; j < 4; ++j) { v[rr][j] = nx[rr][j]; if (ROUTER) dv[rr][j] = nd[rr][j]; }
        if (cr0 + 2 < rend) NP_LOAD(cr0 + 2);
#pragma unroll
        for (int rr = 0; rr < 2; ++rr) {
            const int cr = cr0 + rr;
            const int mv = mv_of(ch, cr);
            if (mv != cmv) { cmv = mv; const float* sh = mod_ptr(F, l, mv, ROUTER ? 3 : 0); const float* sc = mod_ptr(F, l, mv, ROUTER ? 4 : 1);
#pragma unroll
                for (int j = 0; j < 4; ++j) { shq[j] = *(const f32x4*)(sh + lane * 4 + 256 * j); scq[j] = *(const f32x4*)(sc + lane * 4 + 256 * j); } }
            float ss = 0.f;
#pragma unroll
            for (int j = 0; j < 4; ++j) {
                if (ROUTER) {
                    const u32x2 dd = dv[rr][j];
                    v[rr][j].x += bflo(dd.x); v[rr][j].y += bfhi(dd.x); v[rr][j].z += bflo(dd.y); v[rr][j].w += bfhi(dd.y); }
                ss += (v[rr][j].x * v[rr][j].x + v[rr][j].y * v[rr][j].y) + (v[rr][j].z * v[rr][j].z + v[rr][j].w * v[rr][j].w); }
            const float rstd = 1.0f / sqrtf(wave_sum(ss) * (1.0f / D) + RMS_EPS);
#pragma unroll
            for (int j = 0; j < 4; ++j) {
                v[rr][j] = (v[rr][j] * rstd * gq[j]) * (scq[j] + 1.0f) + shq[j];
                u32x2 o; o.x = pk2(v[rr][j].x, v[rr][j].y); o.y = pk2(v[rr][j].z, v[rr][j].w);
                *(u32x2*)(hb + (size_t)cr * D + lane * 4 + 256 * j) = o;
            }
        }
#undef NP_LOAD
        if (ROUTER) {
            const bool b5 = lane & 32, b4 = lane & 16, b3 = lane & 8;
            float lg[2][2];
#pragma unroll
            for (int hf = 0; hf < 2; ++hf) {
                float a[2][8];
#pragma unroll
                for (int e = 0; e < 8; ++e) {
                    f32x4 w[4];
#pragma unroll
                    for (int j = 0; j < 4; ++j) w[j] = *(const f32x4*)(wr_l + (hf * 8 + e) * D + lane * 4 + 256 * j);
#pragma unroll
                    for (int rr = 0; rr < 2; ++rr) { float t = 0.f;
#pragma unroll
                        for (int j = 0; j < 4; ++j) t += (v[rr][j].x * w[j].x + v[rr][j].y * w[j].y) + (v[rr][j].z * w[j].z + v[rr][j].w * w[j].w);
                        a[rr][e] = t; }
                    if (e & 1) __builtin_amdgcn_sched_barrier(0);
                }
#pragma unroll
                for (int rr = 0; rr < 2; ++rr) {
                    float c[4], d2[2];
#pragma unroll
                    for (int i = 0; i < 4; ++i) { const float recv = __shfl_xor(xsel(b5, a[rr][i], a[rr][i + 4]), 32); c[i] = xsel(b5, a[rr][i + 4], a[rr][i]) + recv; }
#pragma unroll
                    for (int i = 0; i < 2; ++i) { const float recv = __shfl_xor(xsel(b4, c[i], c[i + 2]), 16); d2[i] = xsel(b4, c[i + 2], c[i]) + recv; }
                    float t = xsel(b3, d2[1], d2[0]) + __shfl_xor(xsel(b3, d2[0], d2[1]), 8);
                    t += __shfl_xor(t, 4); t += __shfl_xor(t, 2); t += __shfl_xor(t, 1);
                    lg[hf][rr] = t;
                }
                __builtin_amdgcn_sched_barrier(0);
            }
#pragma unroll
            for (int rr = 0; rr < 2; ++rr) {
                float m = fmaxf(lg[0][rr], lg[1][rr]);
#pragma unroll
                for (int o = 8; o < 64; o <<= 1) m = fmaxf(m, __shfl_xor(m, o));
                const float p0 = expf(lg[0][rr] - m), p1 = expf(lg[1][rr] - m); float s = p0 + p1;
#pragma unroll
                for (int o = 8; o < 64; o <<= 1) s += __shfl_xor(s, o);
                const float inv = 1.0f / s;
                const int cr = cr0 + rr, e = lane >> 3;
                if ((lane & 7) < 2 && !dry) {
                    const int ee = (lane & 1) ? e + 8 : e; const float mine = ((lane & 1) ? p1 : p0) * inv;
                    if (cr < LROWS) { const int bl = cr / SEQ, t = cr % SEQ; affl_of(F, ch)[(size_t)(bl * NE + ee) * SEQ + t] = mine; }
                    else { const int j = cr - LROWS, bl = j / CTX, t = j % CTX; ((float*)(F.ws + WS_AFFC))[(size_t)(bl * NE + ee) * CTX + t] = mine; }
                }
            }
        }
    }
}

__device__ __forceinline__ const bf16* zrow(const Frame& F, int cr) { return (const bf16*)(F.ws + WS_Z) + (size_t)cr * ZW; }

__device__ __forceinline__ void conv_phase(Frame& F, int l, int nrows) {
    const int lane = launder(lane_id()), tid = F.wave * 64 + lane; (void)tid; (void)lane;
    const int gw = F.vcu * NWAVES + F.wave, NGW = F.G * NWAVES;
    const float* cw = inp(F, I_CONVW) + (size_t)l * 3 * 512;
    float w[3][8];
#pragma unroll
    for (int k = 0; k < 3; ++k)
#pragma unroll
        for (int j = 0; j < 8; ++j) w[k][j] = cw[k * 512 + lane * 8 + j];
    bf16* ob = (bf16*)(F.ws + WS_OBUF);
    const int rpw = (nrows + NGW - 1) / NGW, rbeg = gw * rpw, rend = (rbeg + rpw < nrows) ? rbeg + rpw : nrows;
    if (rbeg >= rend) return;
#define CV_SEQ(cr_) ((cr_) < LROWS ? (cr_) / SEQ : 1024 + ((cr_) - LROWS) / CTX)
#define CV_LOADP(cr_, P) do { const bf16* zr_ = zrow(F, (cr_)); float c8_[8], x8_[8]; unpack8(*(const u32x4*)(zr_ + Z_AC + lane * 8), c8_); unpack8(*(const u32x4*)(zr_ + Z_AX + lane * 8), x8_); \
        _Pragma("unroll") for (int j_ = 0; j_ < 8; ++j_) (P)[j_] = c8_[j_] * x8_[j_]; } while (0)
    float pp[8], pc[8], pn[8];
#pragma unroll
    for (int j = 0; j < 8; ++j) pp[j] = 0.f;
    if (rbeg > 0 && CV_SEQ(rbeg - 1) == CV_SEQ(rbeg)) CV_LOADP(rbeg - 1, pp);
    CV_LOADP(rbeg, pc);
    for (int cr = rbeg; cr < rend; ++cr) {
        const bool hasn = cr + 1 < nrows, same = hasn && CV_SEQ(cr + 1) == CV_SEQ(cr);
#pragma unroll
        for (int j = 0; j < 8; ++j) pn[j] = 0.f;
        if (hasn) CV_LOADP(cr + 1, pn);
        float b8[8]; unpack8(*(const u32x4*)(zrow(F, cr) + Z_AB + lane * 8), b8);
        float acc[8];
#pragma unroll
        for (int j = 0; j < 8; ++j) acc[j] = w[0][j] * pp[j] + w[1][j] * pc[j] + (same ? w[2][j] * pn[j] : 0.f);
        u32x4 o; o.x = pk2(b8[0] * acc[0], b8[1] * acc[1]); o.y = pk2(b8[2] * acc[2], b8[3] * acc[3]); o.z = pk2(b8[4] * acc[4], b8[5] * acc[5]); o.w = pk2(b8[6] * acc[6], b8[7] * acc[7]);
        *(u32x4*)(ob + (size_t)cr * OW + lane * 8) = o;
#pragma unroll
        for (int j = 0; j < 8; ++j) { pp[j] = same ? pc[j] : 0.f; pc[j] = pn[j]; }
    }
#undef CV_SEQ
#undef CV_LOADP
}

struct NaiveState { unsigned q[32]; float o[64], m, l; };
__device__ __forceinline__ void load64(const bf16* p, float* f) {
#pragma unroll
    for (int i = 0; i < 8; ++i) unpack8(*(const u32x4*)(p + 8 * i), f + 8 * i);
}
__device__ __forceinline__ void rope64(float* x, const f32x2* tabrow) {
#pragma unroll
    for (int i = 0; i < 32; ++i) { const f32x2 cs = tabrow[i]; const float a = x[i], b = x[i + 32]; x[i] = a * cs.x - b * cs.y; x[i + 32] = a * cs.y + b * cs.x; }
}
__device__ __forceinline__ void naive_visit(NaiveState& st, const bf16* kp, const bf16* vp, float bias, bool valid, const f32x2* ropetab) {
    float s = 0.f;
#pragma unroll
    for (int c = 0; c < 4; ++c) {
        float a[8], b[8]; unpack8(*(const u32x4*)(kp + 8 * c), a); unpack8(*(const u32x4*)(kp + 32 + 8 * c), b);
        if (ropetab) {
#pragma unroll
            for (int i = 0; i < 8; ++i) { const f32x2 cs = ropetab[8 * c + i]; const float x1 = a[i], x2 = b[i]; a[i] = x1 * cs.x - x2 * cs.y; b[i] = x1 * cs.y + x2 * cs.x; }
        }
#pragma unroll
        for (int i = 0; i < 8; ++i) s += bflo(st.q[8 * c + i]) * a[i] + bfhi(st.q[8 * c + i]) * b[i];
    }
    s = valid ? s + bias : -1e30f;
    const float mn = fmaxf(st.m, s), alpha = __expf(st.m - mn), p = __expf(s - mn);
    st.m = mn; st.l = st.l * alpha + p;
#pragma unroll
    for (int c = 0; c < 8; ++c) { float v[8]; unpack8(*(const u32x4*)(vp + 8 * c), v);
#pragma unroll
        for (int i = 0; i < 8; ++i) st.o[8 * c + i] = st.o[8 * c + i] * alpha + p * v[i]; }
}
__device__ __forceinline__ void naive_attn_phase(Frame& F, int l, int ch, bool last, bf16* ob) {
    const int lane = launder(lane_id()), tid = F.wave * 64 + lane; (void)tid; (void)lane;
    const int n_lat = LROWS / 64, n_ctx = (last || ch != 0) ? 0 : CTXALL / 64;
    const int nunits = 2 * n_lat + 2 * n_ctx;
    const f32x2* tab = (const f32x2*)(F.ws + WS_ROPE);
    for (int u = F.vcu; u < nunits; u += F.G) {
        int type, blk;
        if (u < n_lat) { type = 0; blk = u; } else if (u < 2 * n_lat) { type = 1; blk = u - n_lat; } else if (u < 2 * n_lat + n_ctx) { type = 2; blk = u - 2 * n_lat; } else { type = 3; blk = u - 2 * n_lat - n_ctx; }
        const int h = F.wave;
        const int cr0 = (type < 2) ? blk * 64 : LROWS + blk * 64, cr = cr0 + lane;
        const int bl = (type < 2) ? ch * BC + cr0 / SEQ : (cr0 - LROWS) / CTX;
        const int t0 = (type < 2) ? cr0 % SEQ : (cr0 - LROWS) % CTX, t = t0 + lane;
        const int ctx0 = LROWS + bl * CTX;
        const bool sw = (type == 0 || type == 3);
        const int hk = sw ? h / 4 : h;
        const int qcol = (sw ? Z_SQ : Z_NQ) + 64 * h, kcol = (sw ? Z_SK : Z_NK) + 64 * hk, vcol = (sw ? Z_SV : Z_NV) + 64 * hk;
        NaiveState st;
        { float qf[64]; load64(zrow(F, cr) + qcol, qf);
          if (type == 0) rope64(qf, tab + (size_t)t * 32);
#pragma unroll
          for (int i = 0; i < 32; ++i) st.q[i] = pk2(qf[i] * 0.125f, qf[i + 32] * 0.125f);
#pragma unroll
          for (int i = 0; i < 64; ++i) st.o[i] = 0.f; }
        if (sw) { st.m = inp(F, I_SINK)[l * 8 + h]; st.l = 1.f; } else { st.m = -1e30f; st.l = 0.f; }
        const int lo = t0 - 128 < 0 ? 0 : t0 - 128, hi = t0 + 63 + 128 > SEQ - 1 ? SEQ - 1 : t0 + 63 + 128;
        const int r = t0 / 64, c = lane; int rs = r - 4; rs = rs < 0 ? 0 : (rs > 24 ? 24 : rs); int cs = c - 8; cs = cs < 0 ? 0 : (cs > 48 ? 48 : cs);
        const float* rpb = inp(F, I_RPB) + ((size_t)l * 8 + h) * 15 * 31;
        const int nloc = type == 0 ? hi - lo + 1 : (type == 1 ? 512 : 0);
#pragma unroll 1
        for (int idx = 0; idx < CTX + nloc; ++idx) {
            const bf16* zr; float bias = 0.f; bool valid = true; const f32x2* rt = nullptr;
            if (idx < CTX) zr = zrow(F, ctx0 + idx);
            else if (type == 0) { const int j = lo + idx - CTX, dlt = t - j; zr = zrow(F, cr0 - t0 + j); valid = dlt <= 128 && dlt >= -128; rt = tab + (size_t)j * 32; }
            else { const int q = idx - CTX, kr = rs + (q >> 6), kc = q & 63; zr = zrow(F, cr0 - t0 + kr * 64 + kc); valid = kc >= cs && kc < cs + 16;
                int dc = kc - c + 15; dc = dc < 0 ? 0 : (dc > 30 ? 30 : dc); bias = rpb[(kr - r + 7) * 31 + dc]; }
            naive_visit(st, zr + kcol, zr + vcol, bias, valid, rt);
        }
        const float inv = 1.0f / st.l;
        bf16* op = ob + (size_t)cr * OW + (sw ? 1024 : 512) + 64 * h;
#pragma unroll
        for (int i = 0; i < 8; ++i) { u32x4 o; o.x = pk2(st.o[8 * i] * inv, st.o[8 * i + 1] * inv); o.y = pk2(st.o[8 * i + 2] * inv, st.o[8 * i + 3] * inv); o.z = pk2(st.o[8 * i + 4] * inv, st.o[8 * i + 5] * inv); o.w = pk2(st.o[8 * i + 6] * inv, st.o[8 * i + 7] * inv);
            *(u32x4*)(op + 8 * i) = o; }
    }
}

typedef short s16x4 __attribute__((ext_vector_type(4)));
typedef float f32x16 __attribute__((ext_vector_type(16)));
typedef __bf16 bf16x2_t __attribute__((ext_vector_type(2)));
__device__ __forceinline__ unsigned cvtpk(float lo, float hi) { const f32x2 v = {lo, hi}; return __builtin_bit_cast(unsigned, __builtin_convertvector(v, bf16x2_t)); }
typedef short v4i16_t __attribute__((ext_vector_type(4)));
__device__ __forceinline__ s16x4 vtr(const LAS unsigned char* p) { return __builtin_bit_cast(s16x4, __builtin_amdgcn_ds_read_tr16_b64_v4i16((LAS v4i16_t*)p)); }
constexpr int AK_RS = 144, AV_RS = 192, AK_BYTES = 128 * AK_RS, AV_BYTES = 128 * AV_RS, ASTAGE = AK_BYTES + AV_BYTES, A_RPB_OFF = 2 * ASTAGE;
#define MFMA32(a, b, c) __builtin_amdgcn_mfma_f32_32x32x16_bf16((a), (b), (c), 0, 0, 0)
__device__ __forceinline__ float xlane32(float v) {
    const auto rr = __builtin_amdgcn_permlane32_swap(__builtin_bit_cast(unsigned, v), __builtin_bit_cast(unsigned, v), false, false);
    return __builtin_bit_cast(float, (lane_id() & 32) ? rr[0] : rr[1]);
}
__device__ __forceinline__ float max3f(float a, float b, float c) { return fmaxf(fmaxf(a, b), c); }
__device__ __forceinline__ float rowmax32(const f32x16& p0, const f32x16& p1) {
    float a = max3f(p0[0], p0[1], p1[0]), b = max3f(p0[2], p0[3], p1[1]); a = max3f(a, p1[2], p1[3]);
#pragma unroll
    for (int i = 4; i < 16; i += 4) { a = max3f(a, p0[i], p0[i + 1]); b = max3f(b, p0[i + 2], p0[i + 3]); a = max3f(a, p1[i], p1[i + 1]); b = max3f(b, p1[i + 2], p1[i + 3]); }
    const float m = fmaxf(a, b);
    const auto rr = __builtin_amdgcn_permlane32_swap(__builtin_bit_cast(unsigned, m), __builtin_bit_cast(unsigned, m), false, false);
    return fmaxf(__builtin_bit_cast(float, rr[0]), __builtin_bit_cast(float, rr[1]));
}
__device__ __forceinline__ void lds_read_k4(unsigned addr, bf16x8 (&ka)[4]) {
    asm volatile("ds_read_b128 %0, %4\n\tds_read_b128 %1, %4 offset:32\n\tds_read_b128 %2, %4 offset:64\n\tds_read_b128 %3, %4 offset:96\n\ts_waitcnt lgkmcnt(0)"
        : "=&v"(ka[0]), "=&v"(ka[1]), "=&v"(ka[2]), "=&v"(ka[3]) : "v"(addr) : "memory");
}
__device__ __forceinline__ void lds_read_k8(unsigned addr, bf16x8 (&ka)[4], bf16x8 (&kb)[4]) {
    asm volatile("ds_read_b128 %0, %8\n\tds_read_b128 %1, %8 offset:32\n\tds_read_b128 %2, %8 offset:64\n\tds_read_b128 %3, %8 offset:96\n\t"
                 "ds_read_b128 %4, %8 offset:4608\n\tds_read_b128 %5, %8 offset:4640\n\tds_read_b128 %6, %8 offset:4672\n\tds_read_b128 %7, %8 offset:4704\n\t"
                 "s_waitcnt lgkmcnt(0)"
        : "=&v"(ka[0]), "=&v"(ka[1]), "=&v"(ka[2]), "=&v"(ka[3]), "=&v"(kb[0]), "=&v"(kb[1]), "=&v"(kb[2]), "=&v"(kb[3]) : "v"(addr) : "memory");
}
constexpr int A_ROPE_OFF = A_RPB_OFF + 4096;
template <int VAR, int TY>
__device__ __forceinline__ void attn_units(Frame& F, int l, int ch, bool last, bf16* ob) {
    const int lane = launder(lane_id()), tid = F.wave * 64 + lane;
    const int wave = F.wave, r = lane & 31, hh = lane >> 5;
    const float LOG2E = 1.4426950408889634f;
    const f32x2* tab = (const f32x2*)(F.ws + WS_ROPE); (void)tab;
    float* rpbl = (float*)(F.lds + A_RPB_OFF);
    const int skey = tid >> 2, sc = tid & 3, sb = skey >> 6, srow = skey & 63;
    const int nNA = BC * 8 * 8, nSW = BC * 16 * 4, nCX = (last || ch != 0) ? 0 : NB * 8 * 2;
    const int ubeg = (TY == 1) ? 0 : (TY == 0 ? nNA : nNA + nSW), uend = (TY == 1) ? nNA : (TY == 0 ? nNA + nSW : nNA + nSW + nCX);
    for (int u = ubeg + F.vcu; u < uend; u += F.G) {
        int type, bl, h, rg = 0, n = 0;
        if (u < nNA) { type = 1; bl = u >> 6; rg = ((u >> 3) + (u >> 8)) & 7; h = u & 7; }
        else if (u < nNA + nSW) { const int v = u - nNA; type = 0; bl = v >> 6; n = ((v >> 2) + 4 * (v >> 8)) & 15; h = 4 * ((v >> 1) & 1) + 2 * (v & 1); }
        else { const int v = u - nNA - nSW; type = (v < NB * 8) ? 2 : 3; const int vv = v % (NB * 8); bl = vv >> 3; h = vv & 7; }
        if (TY != 2) type = TY;
        const bool sw = (type == 0 || type == 3);
        const int head = (type == 0) ? h + (wave >> 2) : h;
        const int jb = wave & 3;
        const int rq = 4 * rg + 2 * (wave >> 2) + (r >> 4), cq = 16 * jb + (r & 15);
        const int qrow = (type == 1) ? bl * SEQ + 64 * rq + cq : (type == 0) ? bl * SEQ + 128 * n + 32 * (wave & 3) + r : LROWS + bl * CTX + 32 * wave + r;
        const int qcol = (sw ? Z_SQ : Z_NQ) + 64 * head, kcol = sw ? Z_SK + 64 * (head >> 2) : Z_NK + 64 * head, vcol = sw ? Z_SV + 64 * (head >> 2) : Z_NV + 64 * head;
        const int ocol = (sw ? 1024 : 512) + 64 * head;
        const int ctx0 = LROWS + ((type < 2) ? ch * BC + bl : bl) * CTX;
        int nloc = 0, loc0 = 0;
        if (type == 0) { const int jlo = (n == 0) ? 2 : 0, jhi = (n == 15) ? 3 : 5; nloc = jhi - jlo + 1; loc0 = jlo; }
        else if (type == 1) { int a = 4 * rg - 4; a = a < 0 ? 0 : (a > 24 ? 24 : a); int b = 4 * rg - 1; b = b < 0 ? 0 : (b > 24 ? 24 : b); loc0 = a; nloc = b + 7 - a + 1; }
        const int nt = 4 + nloc;
        bf16x8 qf[4];
        {
            const bf16* qp = zrow(F, qrow) + qcol + 8 * hh;
            float q[4][8];
#pragma unroll
            for (int s4 = 0; s4 < 4; ++s4) unpack8(*(const u32x4*)(qp + 16 * s4), q[s4]);
            if (type == 0) {
                const int pos = qrow - bl * SEQ; const f32x2* rl = (const f32x2*)(F.lds + A_ROPE_OFF);
#pragma unroll
                for (int s4 = 0; s4 < 2; ++s4) { const f32x2* tr = rl + (s4 == 0 ? (pos >> 6) : 32 + (pos & 63)) * 16 + 8 * hh;
#pragma unroll
                    for (int j = 0; j < 8; ++j) { const f32x2 cs = tr[j]; const float x1 = q[s4][j], x2 = q[s4 + 2][j]; q[s4][j] = x1 * cs.x - x2 * cs.y; q[s4 + 2][j] = x1 * cs.y + x2 * cs.x; } }
            }
            const float qs = 0.125f * LOG2E;
#pragma unroll
            for (int s4 = 0; s4 < 4; ++s4) { u32x4 p; p.x = cvtpk(q[s4][0] * qs, q[s4][1] * qs); p.y = cvtpk(q[s4][2] * qs, q[s4][3] * qs); p.z = cvtpk(q[s4][4] * qs, q[s4][5] * qs); p.w = cvtpk(q[s4][6] * qs, q[s4][7] * qs);
                qf[s4] = __builtin_bit_cast(bf16x8, p); }
        }
        float m = 0.f, lsum = 0.f;
        if (sw) { m = inp(F, I_SINK)[l * 8 + head] * LOG2E; lsum = (hh == 0) ? 1.f : 0.f; }
        f32x16 o0, o1;
#pragma unroll
        for (int i = 0; i < 16; ++i) { o0[i] = 0.f; o1[i] = 0.f; }
        const int kst = (type == 1) ? (16 * jb - 8 < 0 ? 0 : (16 * jb - 8 > 32 ? 32 : 16 * jb - 8)) : 0;
        unsigned bixp[4] = {0u, 0u, 0u, 0u};
        {
            const int csq = cq - 8 < 0 ? 0 : (cq - 8 > 48 ? 48 : cq - 8);
#pragma unroll
            for (int i = 0; i < 16; ++i) { const int kc = kst + (i & 3) + 8 * (i >> 2) + 4 * hh; bixp[i >> 2] |= (unsigned)(((kc >= csq && kc <= csq + 15) ? kc - cq + 15 : 31) * 4) << (8 * (i & 3)); }
        }
#define BIX(i) ((bixp[(i) >> 2] >> (8 * ((i) & 3))) & 0xffu)
        const int rsl = rq - 4 < 0 ? 0 : (rq - 4 > 24 ? 24 : rq - 4);
        u32x4 gk0, gk1, gv0, gv1;
        bool grope = false; int gpos = 0;
#define A_TILE_ROW0(ti) ((ti) < 4 ? ctx0 + 64 * (ti) : (type == 0 ? bl * SEQ + 128 * n - 128 + 64 * (loc0 + (ti) - 4) : bl * SEQ + 64 * (loc0 + (ti) - 4)))
#define A_STAGE_LOAD(T) do { const int ti_ = 2 * (T) + sb; const int tic_ = ti_ < nt ? ti_ : nt - 1; const int row0_ = A_TILE_ROW0(tic_); const bf16* sp_ = zrow(F, row0_ + srow) + 8 * sc; \
            gk0 = *(const u32x4*)(sp_ + kcol); gk1 = *(const u32x4*)(sp_ + kcol + 32); gv0 = *(const u32x4*)(sp_ + vcol); gv1 = *(const u32x4*)(sp_ + vcol + 32); grope = (type == 0 && tic_ >= 4); gpos = row0_ - bl * SEQ + srow; } while (0)
#define A_STAGE_WRITE(st) do { unsigned char* dk_ = F.lds + (st) * ASTAGE + skey * AK_RS + 16 * sc; unsigned char* dv_ = F.lds + (st) * ASTAGE + AK_BYTES + skey * AV_RS + 16 * sc; \
            if (grope) { float a_[8], b_[8]; unpack8(gk0, a_); unpack8(gk1, b_); \
                const f32x4* rl_ = (const f32x4*)(F.lds + A_ROPE_OFF + ((sc < 2 ? (gpos >> 6) : 32 + (gpos & 63)) * 16 + 8 * (sc & 1)) * 8); \
                _Pragma("unroll") for (int j_ = 0; j_ < 4; ++j_) { const f32x4 rcj_ = rl_[j_]; const float c0_ = rcj_.x, s0_ = rcj_.y, c1_ = rcj_.z, s1_ = rcj_.w; \
                    const float x1_ = a_[2 * j_], x2_ = b_[2 * j_], y1_ = a_[2 * j_ + 1], y2_ = b_[2 * j_ + 1]; \
                    a_[2 * j_] = x1_ * c0_ - x2_ * s0_; b_[2 * j_] = x1_ * s0_ + x2_ * c0_; a_[2 * j_ + 1] = y1_ * c1_ - y2_ * s1_; b_[2 * j_ + 1] = y1_ * s1_ + y2_ * c1_; } \
                gk0.x = cvtpk(a_[0], a_[1]); gk0.y = cvtpk(a_[2], a_[3]); gk0.z = cvtpk(a_[4], a_[5]); gk0.w = cvtpk(a_[6], a_[7]); \
                gk1.x = cvtpk(b_[0], b_[1]); gk1.y = cvtpk(b_[2], b_[3]); gk1.z = cvtpk(b_[4], b_[5]); gk1.w = cvtpk(b_[6], b_[7]); } \
            *(u32x4*)dk_ = gk0; *(u32x4*)(dk_ + 64) = gk1; *(u32x4*)dv_ = gv0; *(u32x4*)(dv_ + 64) = gv1; } while (0)
#define A_QK(XV, kbase) do { bf16x8 k4_[4]; lds_read_k4((unsigned)(size_t)(kbase), k4_); _Pragma("unroll") for (int i_ = 0; i_ < 16; ++i_) (XV)[i_] = -m; \
            _Pragma("unroll") for (int s4_ = 0; s4_ < 4; ++s4_) (XV) = MFMA32(k4_[s4_], qf[s4_], (XV)); } while (0)
#define A_QK2(XA, XB, kbA) do { bf16x8 ka_[4], kb_[4]; lds_read_k8((unsigned)(size_t)(kbA), ka_, kb_); \
            _Pragma("unroll") for (int i_ = 0; i_ < 16; ++i_) { (XA)[i_] = -m; (XB)[i_] = -m; } \
            _Pragma("unroll") for (int s4_ = 0; s4_ < 4; ++s4_) { (XA) = MFMA32(ka_[s4_], qf[s4_], (XA)); (XB) = MFMA32(kb_[s4_], qf[s4_], (XB)); } } while (0)
#define A_NEG(XV) do { _Pragma("unroll") for (int i_ = 0; i_ < 16; ++i_) (XV)[i_] = -1e30f; } while (0)
#define A_PV(XV, vbase) do { _Pragma("unroll") for (int s2_ = 0; s2_ < 2; ++s2_) { \
            u32x4 p_; p_.x = cvtpk((XV)[8 * s2_], (XV)[8 * s2_ + 1]); p_.y = cvtpk((XV)[8 * s2_ + 2], (XV)[8 * s2_ + 3]); p_.z = cvtpk((XV)[8 * s2_ + 4], (XV)[8 * s2_ + 5]); p_.w = cvtpk((XV)[8 * s2_ + 6], (XV)[8 * s2_ + 7]); \
            const bf16x8 pf_ = __builtin_bit_cast(bf16x8, p_); const LAS unsigned char* vb_ = (vbase) + (16 * s2_) * AV_RS; \
            { const s16x4 lo_ = vtr(vb_), hi_ = vtr(vb_ + 8 * AV_RS); const bf16x8 va_ = __builtin_shufflevector(lo_, hi_, 0, 1, 2, 3, 4, 5, 6, 7); o0 = MFMA32(va_, pf_, o0); } \
            { const s16x4 lo_ = vtr(vb_ + 64), hi_ = vtr(vb_ + 8 * AV_RS + 64); const bf16x8 va_ = __builtin_shufflevector(lo_, hi_, 0, 1, 2, 3, 4, 5, 6, 7); o1 = MFMA32(va_, pf_, o1); } } } while (0)
        if (type == 1) { const float* rp = inp(F, I_RPB) + ((size_t)l * 8 + h) * 465;
            for (int i = tid; i < 17 * 32; i += NTHR) { const int tr = i >> 5, tc = i & 31; rpbl[i] = (tr >= 1 && tr <= 15 && tc < 31) ? rp[(tr - 1) * 31 + tc] * LOG2E : -1e30f; } }
        A_STAGE_LOAD(0); A_STAGE_WRITE(0);
        __syncthreads();
        const int qi = 32 * (wave & 3) + r;
        const LAS unsigned char* ldsl = F.ldsl;
        const int kro = r * AK_RS + 16 * hh;
        const int vro = (4 * hh + ((r & 15) >> 2)) * AV_RS + (16 * (r >> 4) + 4 * (r & 3)) * 2;
        const int krw = kro + kst * AK_RS, vrw = vro + kst * AV_RS;
        const int rqa = 4 * rg + 2 * (wave >> 2), rsa = rqa - 4 < 0 ? 0 : (rqa - 4 > 24 ? 24 : rqa - 4), rsb = rqa - 3 < 0 ? 0 : (rqa - 3 > 24 ? 24 : rqa - 3);
        const int nT = (nt + 1) >> 1;
#pragma unroll 1
        for (int T = 0; T < nT; ++T) {
            const int st = T & 1;
            if (VAR != 1) { if (T + 1 < nT) A_STAGE_LOAD(T + 1); }
            const LAS unsigned char* Kst = ldsl + st * ASTAGE; const LAS unsigned char* Vst = Kst + AK_BYTES;
            const bool vB = 2 * T + 1 < nt;
            const int jA = loc0 + 2 * T - 4, jB = jA + 1;
            if (VAR == 2) { } else
            if (T >= 2 && type == 1) {
                const bool nA = (jA >= rsa && jA <= rsb + 7), nB = vB && (jB >= rsa && jB <= rsb + 7);
                if (nA || nB) {
                    f32x16 x0, x1;
                    if (nA) { A_QK(x0, Kst + krw); const LAS unsigned char* tb = ldsl + A_RPB_OFF + ((jA >= rsl && jA <= rsl + 7) ? (jA - rq + 8) : 0) * 128;
#pragma unroll
                        for (int i = 0; i < 16; ++i) x0[i] += *(const LAS float*)(tb + BIX(i)); } else A_NEG(x0);
                    if (nB) { A_QK(x1, Kst + krw + 64 * AK_RS); const LAS unsigned char* tb = ldsl + A_RPB_OFF + ((jB >= rsl && jB <= rsl + 7) ? (jB - rq + 8) : 0) * 128;
#pragma unroll
                        for (int i = 0; i < 16; ++i) x1[i] += *(const LAS float*)(tb + BIX(i)); } else A_NEG(x1);
                    const float mt = rowmax32(x0, x1);
                    if (__any(mt > 8.0f)) {
                        const float dl = fmaxf(mt, 0.f), alpha = __builtin_amdgcn_exp2f(-dl);
                        m += dl; lsum *= alpha;
#pragma unroll
                        for (int i = 0; i < 16; ++i) { x0[i] -= dl; x1[i] -= dl; o0[i] *= alpha; o1[i] *= alpha; }
                    }
                    float ps = 0.f;
                    if (nA) {
#pragma unroll
                        for (int i = 0; i < 16; ++i) { x0[i] = __builtin_amdgcn_exp2f(x0[i]); ps += x0[i]; }
                        A_PV(x0, Vst + vrw); }
                    if (nB) {
#pragma unroll
                        for (int i = 0; i < 16; ++i) { x1[i] = __builtin_amdgcn_exp2f(x1[i]); ps += x1[i]; }
                        A_PV(x1, Vst + vrw + 64 * AV_RS); }
                    lsum += ps;
                }
            } else {
#pragma unroll
                for (int bi = 0; bi < 2; ++bi) {
                    if (bi == 1 && !vB) break;
                    const int j = jA + bi;
                    bool need = true, mask = false; int vlo = -1, vhi = 64;
                    if (T >= 2) { const int q0 = 32 * (wave & 3); need = (64 * j + 63 >= q0) && (64 * j <= q0 + 287); mask = !((64 * j >= q0 + 31) && (64 * j + 63 <= q0 + 256)); vlo = qi - 64 * j; vhi = qi + 256 - 64 * j; }
                    if (need) {
                        f32x16 x0, x1;
                        A_QK2(x0, x1, Kst + kro + bi * 64 * AK_RS);
                        if (mask) {
#pragma unroll
                            for (int i = 0; i < 16; ++i) { const int k0 = (i & 3) + 8 * (i >> 2) + 4 * hh, k1 = k0 + 32; x0[i] = (k0 >= vlo && k0 <= vhi) ? x0[i] : -1e30f; x1[i] = (k1 >= vlo && k1 <= vhi) ? x1[i] : -1e30f; }
                        }
                        const float mt = rowmax32(x0, x1);
                        const bool fst = !sw && T == 0 && bi == 0;
                        if (fst || __any(mt > 8.0f)) {
                            const float dl = fst ? mt : fmaxf(mt, 0.f), alpha = fst ? 1.f : __builtin_amdgcn_exp2f(-dl);
                            m += dl; lsum *= alpha;
#pragma unroll
                            for (int i = 0; i < 16; ++i) { x0[i] -= dl; x1[i] -= dl; o0[i] *= alpha; o1[i] *= alpha; }
                        }
                        float ps = 0.f;
#pragma unroll
                        for (int i = 0; i < 16; ++i) { x0[i] = __builtin_amdgcn_exp2f(x0[i]); ps += x0[i]; }
                        A_PV(x0, Vst + vro + bi * 64 * AV_RS);
#pragma unroll
                        for (int i = 0; i < 16; ++i) { x1[i] = __builtin_amdgcn_exp2f(x1[i]); ps += x1[i]; }
                        lsum += ps;
                        A_PV(x1, Vst + vro + (bi * 64 + 32) * AV_RS);
                    }
                }
            }
            if (VAR != 1) { if (T + 1 < nT) A_STAGE_WRITE(st ^ 1); }
            __syncthreads();
        }
#undef A_QK
#undef A_QK2
#undef A_NEG
#undef A_PV
#undef BIX
        const float inv = 1.0f / (lsum + __shfl_xor(lsum, 32));
        const int l2 = lane_id(), r2 = l2 & 31, h2 = l2 >> 5;
        const int rq2 = 4 * rg + 2 * (wave >> 2) + (r2 >> 4), cq2 = 16 * (wave & 3) + (r2 & 15);
        const int qrow2 = (type == 1) ? bl * SEQ + 64 * rq2 + cq2 : (type == 0) ? bl * SEQ + 128 * n + 32 * (wave & 3) + r2 : LROWS + bl * CTX + 32 * wave + r2;
        bf16* op = ob + (size_t)qrow2 * OW + ocol + 4 * h2;
#pragma unroll
        for (int g = 0; g < 4; ++g) {
            u32x2 w0, w1; w0.x = cvtpk(o0[4 * g] * inv, o0[4 * g + 1] * inv); w0.y = cvtpk(o0[4 * g + 2] * inv, o0[4 * g + 3] * inv);
            w1.x = cvtpk(o1[4 * g] * inv, o1[4 * g + 1] * inv); w1.y = cvtpk(o1[4 * g + 2] * inv, o1[4 * g + 3] * inv);
            *(u32x2*)(op + 8 * g) = w0; *(u32x2*)(op + 32 + 8 * g) = w1;
        }
    }
#undef A_TILE_ROW0
#undef A_STAGE_LOAD
#undef A_STAGE_WRITE
}
template <int VAR>
__device__ __forceinline__ void attn_phase(Frame& F, int l, int ch, bool last, bf16* ob) {
    { const int tid = F.wave * 64 + launder(lane_id()); const f32x2* tab = (const f32x2*)(F.ws + WS_ROPE);
      f32x2* rl = (f32x2*)(F.lds + A_ROPE_OFF); for (int i = tid; i < 96 * 16; i += NTHR) { const int a = i >> 4, f = i & 15; rl[i] = (a < 32) ? tab[(size_t)(a * 64) * 32 + f] : tab[(size_t)(a - 32) * 32 + 16 + f]; } }
    __syncthreads();
    attn_units<VAR, 1>(F, l, ch, last, ob);
    attn_units<VAR, 0>(F, l, ch, last, ob);
    attn_units<VAR, 2>(F, l, ch, last, ob);
}


template <int NPL>
__device__ __forceinline__ void topk_select_wave(const float* aff, int cap, int crbase, int ubase, int slot0, int e, int* tokslot, float* gatev, int* seltok, int lane) {
    unsigned v[NPL];
#pragma unroll
    for (int i = 0; i < NPL; i += 4) { const u32x4 t = *(const u32x4*)(aff + lane * NPL + i); v[i] = t.x; v[i + 1] = t.y; v[i + 2] = t.z; v[i + 3] = t.w; }
    unsigned T = 0u;
#pragma unroll 1
    for (int bit = 30; bit >= 0; --bit) {
        const unsigned cand = T | (1u << bit); int c = 0;
#pragma unroll
        for (int i = 0; i < NPL; ++i) c += (v[i] >= cand) ? 1 : 0;
#pragma unroll
        for (int o = 1; o < 64; o <<= 1) c += __shfl_xor(c, o);
        if (c >= cap) T = cand;
    }
    int ngt = 0, nti = 0;
#pragma unroll
    for (int i = 0; i < NPL; ++i) { ngt += (v[i] > T) ? 1 : 0; nti += (v[i] == T) ? 1 : 0; }
    int tot_gt = ngt;
#pragma unroll
    for (int o = 1; o < 64; o <<= 1) tot_gt += __shfl_xor(tot_gt, o);
    const int need = cap - tot_gt;
    int tinc = nti;
#pragma unroll
    for (int o = 1; o < 64; o <<= 1) { const int t = __shfl_up(tinc, o); if (lane >= o) tinc += t; }
    int tie_before = tinc - nti;
    unsigned selmask = 0u; int nsel = 0;
#pragma unroll
    for (int i = 0; i < NPL; ++i) { const bool tie = (v[i] == T); const bool sel = (v[i] > T) || (tie && tie_before < need); tie_before += tie ? 1 : 0; selmask |= sel ? (1u << i) : 0u; nsel += sel ? 1 : 0; }
    int sinc = nsel;
#pragma unroll
    for (int o = 1; o < 64; o <<= 1) { const int t = __shfl_up(sinc, o); if (lane >= o) sinc += t; }
    int pos = sinc - nsel;
#pragma unroll
    for (int i = 0; i < NPL; ++i) {
        const bool sel = (selmask >> i) & 1u; const int t = lane * NPL + i;
        tokslot[(size_t)(crbase + t) * NE + e] = sel ? pos : -1;
        if (sel) { seltok[slot0 + pos] = ubase + crbase + t; gatev[slot0 + pos] = __builtin_bit_cast(float, v[i]); ++pos; }
    }
}
__device__ __forceinline__ void topk_phase(Frame& F, bool last) {
    const int lane = launder(lane_id());
    int* gsel = (int*)(F.ws + WS_SELTOK);
    float* gatev = (float*)(F.ws + WS_GATEV);
    const bool cx = !last;
    for (int p = F.vcu; p < BC * NE; p += F.G) {
        const int bl = p / NE, e = p % NE;
        const int slotL = p * CAP_L, slotC0 = SLOT_CT0 + e * (NB * CAP_C) + bl * CAP_C, slotC1 = slotC0 + BC * CAP_C;
        if (F.wave == 0) topk_select_wave<32>(affl_of(F, 0) + (size_t)p * SEQ, CAP_L, bl * SEQ, 0, slotL, e, tokslot_of(F, 0), gatev, gsel, lane);
        else if (F.wave == 3) topk_select_wave<32>(affl_of(F, 1) + (size_t)p * SEQ, CAP_L, bl * SEQ, RCMAX, NSLOTMAX + slotL, e, tokslot_of(F, 1), gatev, gsel, lane);
        else if (F.wave == 1 && cx) topk_select_wave<4>((const float*)(F.ws + WS_AFFC) + (size_t)p * CTX, CAP_C, LROWS + bl * CTX, 0, slotC0, e, tokslot_of(F, 0), gatev, gsel, lane);
        else if (F.wave == 2 && cx) topk_select_wave<4>((const float*)(F.ws + WS_AFFC) + (size_t)(p + BC * NE) * CTX, CAP_C, LROWS + (bl + BC) * CTX, 0, slotC1, e, tokslot_of(F, 0), gatev, gsel, lane);
    }
}

__device__ __forceinline__ void combine_phase(Frame& F, int l, int ch, bool last, bool dry = false) {
    const int lane = launder(lane_id()), tid = F.wave * 64 + lane; (void)tid; (void)lane;
    const int gw = F.vcu * NWAVES + F.wave, NGW = F.G * NWAVES;
    const int nrows = last ? LROWS : nrows_of(ch);
    const bf16* yb = (const bf16*)(F.ws + WS_YBUF) + (size_t)ch * NSLOTMAX * D; const int* tokslot = tokslot_of(F, ch); const float* gatev = (const float*)(F.ws + WS_GATEV) + (size_t)ch * NSLOTMAX;
    int nslot = -1; f32x4 nxv[4]; u32x2 ndx[4]; const bf16* dxb = dx_of(F, ch);
#define CB_LOAD(c) do { nslot = (lane < 16) ? tokslot[(size_t)(c) * NE + lane] : -1; const float* xr_ = xrow_src(F, l, ch, (c)); \
        _Pragma("unroll") for (int j_ = 0; j_ < 4; ++j_) { nxv[j_] = *(const f32x4*)(xr_ + lane * 4 + 256 * j_); ndx[j_] = *(const u32x2*)(dxb + (size_t)(c) * D + lane * 4 + 256 * j_); } } while (0)
    const int rpw = (nrows + NGW - 1) / NGW, rbeg = gw * rpw, rend = (rbeg + rpw < nrows) ? rbeg + rpw : nrows;
    f32x4 gtq[4], shq[4], scq[4], gmq[4]; int cmv = -1;
#pragma unroll
    for (int j = 0; j < 4; ++j) gmq[j] = *(const f32x4*)((last ? inp(F, I_GFINAL) : inp(F, I_GMIX) + (size_t)(l + 1) * D) + lane * 4 + 256 * j);
    if (rbeg < rend) CB_LOAD(rbeg);
    for (int cr = rbeg; cr < rend; ++cr) {
        const bool lat = cr < LROWS; const int bl = lat ? cr / SEQ : (cr - LROWS) / CTX;
        { const int mv = mv_of(ch, cr); if (mv != cmv) { cmv = mv; const float* gt = mod_ptr(F, l, mv, 5); const float* sh = mod_ptr(F, last ? l : l + 1, mv, 0); const float* sc = mod_ptr(F, last ? l : l + 1, mv, 1);
#pragma unroll
            for (int j = 0; j < 4; ++j) { gtq[j] = *(const f32x4*)(gt + lane * 4 + 256 * j); shq[j] = *(const f32x4*)(sh + lane * 4 + 256 * j); scq[j] = *(const f32x4*)(sc + lane * 4 + 256 * j); } } }
        const int myslot = nslot; f32x4 v[4];
#pragma unroll
        for (int j = 0; j < 4; ++j) { v[j] = nxv[j]; v[j].x += bflo(ndx[j].x); v[j].y += bfhi(ndx[j].x); v[j].z += bflo(ndx[j].y); v[j].w += bfhi(ndx[j].y); }
        if (cr + 1 < rend) CB_LOAD(cr + 1);
        float acc[16];
#pragma unroll
        for (int i = 0; i < 16; ++i) acc[i] = 0.f;
        unsigned mask = (unsigned)__ballot(myslot >= 0) & 0xFFFFu;
        while (mask) {
            const int e0 = __builtin_ctz(mask); mask &= mask - 1;
            const bool two = mask != 0u; const int e1 = two ? __builtin_ctz(mask) : e0; if (two) mask &= mask - 1;
            const int p0 = __shfl(myslot, e0), p1 = __shfl(myslot, e1);
            const int s0 = lat ? (bl * NE + e0) * CAP_L + p0 : SLOT_CT0 + e0 * (NB * CAP_C) + bl * CAP_C + p0;
            const int s1 = lat ? (bl * NE + e1) * CAP_L + p1 : SLOT_CT0 + e1 * (NB * CAP_C) + bl * CAP_C + p1;
            u32x2 ua[4], ub[4]; const float ga = gatev[s0], gb = gatev[s1];
#pragma unroll
            for (int j = 0; j < 4; ++j) { ua[j] = *(const u32x2*)(yb + (size_t)s0 * D + lane * 4 + 256 * j); ub[j] = *(const u32x2*)(yb + (size_t)s1 * D + lane * 4 + 256 * j); }
#pragma unroll
            for (int j = 0; j < 4; ++j) { acc[4 * j] += ga * bflo(ua[j].x); acc[4 * j + 1] += ga * bfhi(ua[j].x); acc[4 * j + 2] += ga * bflo(ua[j].y); acc[4 * j + 3] += ga * bfhi(ua[j].y); }
            if (two) {
#pragma unroll
                for (int j = 0; j < 4; ++j) { acc[4 * j] += gb * bflo(ub[j].x); acc[4 * j + 1] += gb * bfhi(ub[j].x); acc[4 * j + 2] += gb * bflo(ub[j].y); acc[4 * j + 3] += gb * bfhi(ub[j].y); }
            }
        }
        float* xr = dry ? (float*)(F.ws + WS_OBUF) + (size_t)cr * D : xrow_dst(F, ch, cr);
        float ss = 0.f;
#pragma unroll
        for (int j = 0; j < 4; ++j) { const f32x4 g4 = gtq[j];
            v[j].x += g4.x * acc[4 * j]; v[j].y += g4.y * acc[4 * j + 1]; v[j].z += g4.z * acc[4 * j + 2]; v[j].w += g4.w * acc[4 * j + 3];
            ss += (v[j].x * v[j].x + v[j].y * v[j].y) + (v[j].z * v[j].z + v[j].w * v[j].w); }
        const float rstd = 1.0f / sqrtf(wave_sum(ss) * (1.0f / D) + RMS_EPS);
        if (!last) {
#pragma unroll
            for (int j = 0; j < 4; ++j) *(f32x4*)(xr + lane * 4 + 256 * j) = v[j];
            bf16* hb = dry ? (bf16*)(F.ws + WS_OBUF + 160 * MiB) : hbuf_of(F, ch);
#pragma unroll
            for (int j = 0; j < 4; ++j) {
                const f32x4 hv = (v[j] * rstd * gmq[j]) * (scq[j] + 1.0f) + shq[j];
                u32x2 o; o.x = pk2(hv.x, hv.y); o.y = pk2(hv.z, hv.w);
                *(u32x2*)(hb + (size_t)cr * D + lane * 4 + 256 * j) = o;
            }
            continue;
        }
        {
#pragma unroll
            for (int j = 0; j < 4; ++j) v[j] = v[j] * rstd * gmq[j];
#if defined(PROBE_ATTN)
            { const unsigned cn = __hip_atomic_load((unsigned*)(F.ws + WS_CTL) + CW_DIAG, __ATOMIC_RELAXED, __HIP_MEMORY_SCOPE_AGENT); const float sc = 1.0f + 0.02f * log2f(1.0f + (float)cn);
#pragma unroll
              for (int j = 0; j < 4; ++j) v[j] = v[j] * sc; }
#endif
        }
#pragma unroll
        for (int j = 0; j < 4; ++j) *(f32x4*)(xr + lane * 4 + 256 * j) = v[j];
    }
#undef CB_LOAD
}

using pg8::Unit; using pg8::cvt_pk_bf16;
struct SchedBase { int nM, nN, G, c, rep;
    __device__ __forceinline__ bool tile(int i, int& pm, int& pn, int& sub) const { sub = i % rep; return pg8::tile_of((long)(i / rep) * G + c, nM, nN, pm, pn); } };

struct SchedIn : SchedBase { const char* A; const char* B; int nMfull = 0, kvM = 0;
    __device__ __forceinline__ bool next(int i, Unit& u) const { int sub; u.aux = 0; u.pad = 0;
        if (!tile(i, u.pm, u.pn, sub)) {
            const long L = (long)(i / rep) * G + c - (long)nM * nN; if (kvM == 0 || L < 0 || L >= (long)kvM * 5) return false;
            const int q = (int)L % 5; u.pm = nM + (int)L / 5; u.pn = q < 4 ? 8 + q : 14; }
        u.A = A + (size_t)u.pm * 256 * D * 2; u.B = B + (size_t)u.pn * 256 * D * 2; return true; } };
__device__ __forceinline__ size_t gb_off(int pm, int g, int wr, int wc, int fr, int fq) { return ((size_t)(pm * 12 + g) * 131072) + (size_t)(((wr * 4 + wc) * 64 + fq * 16 + fr) * 16); }
struct EpiStoreBf16 { static constexpr bool PERM = true; bf16* O; int ldc; unsigned char* GB;
    __device__ __forceinline__ void operator()(const f32x4 (&acc)[2][2][4][2], const Unit& u, int wr, int wc, int fr, int fq) const {
        if (u.pn >= Z_G / 256) {
            unsigned char* gp = GB + gb_off(u.pm, u.pn - Z_G / 256, wr, wc, fr, fq);
#pragma unroll
            for (int ai = 0; ai < 2; ++ai)
#pragma unroll
                for (int m = 0; m < 4; ++m)
#pragma unroll
                    for (int bj = 0; bj < 2; ++bj) { f32x4 v0 = acc[ai][bj][m][0], v1 = acc[ai][bj][m][1];
#pragma unroll
                        for (int j = 0; j < 4; ++j) { v0[j] = fmaxf(sigmoidf_(v0[j]), 1e-30f); v1[j] = fmaxf(sigmoidf_(v1[j]), 1e-30f); }
                        u32x4 w; w.x = cvt_pk_bf16(v0[0], v0[1]); w.y = cvt_pk_bf16(v0[2], v0[3]); w.z = cvt_pk_bf16(v1[0], v1[1]); w.w = cvt_pk_bf16(v1[2], v1[3]);
                        __builtin_nontemporal_store(w, (u32x4*)(gp + ((ai * 4 + m) * 2 + bj) * 8192)); }
        } else {
            const int row0 = u.pm * 256 + wr * 64 + fr, col0 = u.pn * 256 + wc * 32 + 8 * fq;
#pragma unroll
            for (int ai = 0; ai < 2; ++ai)
#pragma unroll
                for (int m = 0; m < 4; ++m) { bf16* rowp = O + (size_t)(row0 + ai * 128 + m * 16) * ldc + col0;
#pragma unroll
                    for (int bj = 0; bj < 2; ++bj) { const f32x4 v0 = acc[ai][bj][m][0], v1 = acc[ai][bj][m][1];
                        u32x4 w; w.x = cvt_pk_bf16(v0[0], v0[1]); w.y = cvt_pk_bf16(v0[2], v0[3]); w.z = cvt_pk_bf16(v1[0], v1[1]); w.w = cvt_pk_bf16(v1[2], v1[3]);
                        __builtin_nontemporal_store(w, (u32x4*)(rowp + bj * 128)); } }
        }
    } };

struct SchedMerge : SchedBase { const char* A; const char* B;
    __device__ __forceinline__ bool next(int i, Unit& u) const { int sub; if (!tile(i, u.pm, u.pn, sub)) return false; u.aux = 0; u.pad = 0;
        u.A = A + (size_t)u.pm * 256 * OW * 2; u.B = B + (size_t)u.pn * 256 * 1536 * 2; return true; } };
__device__ __forceinline__ void gate_load8x2(const unsigned char* sbase, unsigned vo, u32x4 (&a)[8], u32x4 (&b)[8]) {
    unsigned t0, t1, t2, t3;
    asm volatile("v_add_u32 %[t0], 0, %[vo]\n\tglobal_load_dwordx4 %[a0], %[t0], %[sb]\n\t"
        "v_add_u32 %[t2], 524288, %[vo]\n\tglobal_load_dwordx4 %[b0], %[t2], %[sb]\n\t"
        "v_add_u32 %[t1], 8192, %[vo]\n\tglobal_load_dwordx4 %[a1], %[t1], %[sb]\n\t"
        "v_add_u32 %[t3], 532480, %[vo]\n\tglobal_load_dwordx4 %[b1], %[t3], %[sb]\n\t"
        "v_add_u32 %[t0], 16384, %[vo]\n\tglobal_load_dwordx4 %[a2], %[t0], %[sb]\n\t"
        "v_add_u32 %[t2], 540672, %[vo]\n\tglobal_load_dwordx4 %[b2], %[t2], %[sb]\n\t"
        "v_add_u32 %[t1], 24576, %[vo]\n\tglobal_load_dwordx4 %[a3], %[t1], %[sb]\n\t"
        "v_add_u32 %[t3], 548864, %[vo]\n\tglobal_load_dwordx4 %[b3], %[t3], %[sb]\n\t"
        "v_add_u32 %[t0], 32768, %[vo]\n\tglobal_load_dwordx4 %[a4], %[t0], %[sb]\n\t"
        "v_add_u32 %[t2], 557056, %[vo]\n\tglobal_load_dwordx4 %[b4], %[t2], %[sb]\n\t"
        "v_add_u32 %[t1], 40960, %[vo]\n\tglobal_load_dwordx4 %[a5], %[t1], %[sb]\n\t"
        "v_add_u32 %[t3], 565248, %[vo]\n\tglobal_load_dwordx4 %[b5], %[t3], %[sb]\n\t"
        "v_add_u32 %[t0], 49152, %[vo]\n\tglobal_load_dwordx4 %[a6], %[t0], %[sb]\n\t"
        "v_add_u32 %[t2], 573440, %[vo]\n\tglobal_load_dwordx4 %[b6], %[t2], %[sb]\n\t"
        "v_add_u32 %[t1], 57344, %[vo]\n\tglobal_load_dwordx4 %[a7], %[t1], %[sb]\n\t"
        "v_add_u32 %[t3], 581632, %[vo]\n\tglobal_load_dwordx4 %[b7], %[t3], %[sb]\n\t"
        "s_waitcnt vmcnt(0)"
        : [a0]"=&v"(a[0]), [a1]"=&v"(a[1]), [a2]"=&v"(a[2]), [a3]"=&v"(a[3]), [a4]"=&v"(a[4]), [a5]"=&v"(a[5]), [a6]"=&v"(a[6]), [a7]"=&v"(a[7]), [b0]"=&v"(b[0]), [b1]"=&v"(b[1]), [b2]"=&v"(b[2]), [b3]"=&v"(b[3]), [b4]"=&v"(b[4]), [b5]"=&v"(b[5]), [b6]"=&v"(b[6]), [b7]"=&v"(b[7]), [t0]"=&v"(t0), [t1]"=&v"(t1), [t2]"=&v"(t2), [t3]"=&v"(t3)
        : [vo]"v"(vo), [sb]"s"(sbase) : "memory");
}
__device__ __forceinline__ void gate_load16(const unsigned char* sbase, unsigned vo, u32x4 (&a)[16]) {
    unsigned t0, t1;
    asm volatile("v_add_u32 %[t0], 0, %[vo]\n\tglobal_load_dwordx4 %[a0], %[t0], %[sb]\n\t"
        "v_add_u32 %[t1], 8192, %[vo]\n\tglobal_load_dwordx4 %[a1], %[t1], %[sb]\n\t"
        "v_add_u32 %[t0], 16384, %[vo]\n\tglobal_load_dwordx4 %[a2], %[t0], %[sb]\n\t"
        "v_add_u32 %[t1], 24576, %[vo]\n\tglobal_load_dwordx4 %[a3], %[t1], %[sb]\n\t"
        "v_add_u32 %[t0], 32768, %[vo]\n\tglobal_load_dwordx4 %[a4], %[t0], %[sb]\n\t"
        "v_add_u32 %[t1], 40960, %[vo]\n\tglobal_load_dwordx4 %[a5], %[t1], %[sb]\n\t"
        "v_add_u32 %[t0], 49152, %[vo]\n\tglobal_load_dwordx4 %[a6], %[t0], %[sb]\n\t"
        "v_add_u32 %[t1], 57344, %[vo]\n\tglobal_load_dwordx4 %[a7], %[t1], %[sb]\n\t"
        "v_add_u32 %[t0], 65536, %[vo]\n\tglobal_load_dwordx4 %[a8], %[t0], %[sb]\n\t"
        "v_add_u32 %[t1], 73728, %[vo]\n\tglobal_load_dwordx4 %[a9], %[t1], %[sb]\n\t"
        "v_add_u32 %[t0], 81920, %[vo]\n\tglobal_load_dwordx4 %[a10], %[t0], %[sb]\n\t"
        "v_add_u32 %[t1], 90112, %[vo]\n\tglobal_load_dwordx4 %[a11], %[t1], %[sb]\n\t"
        "v_add_u32 %[t0], 98304, %[vo]\n\tglobal_load_dwordx4 %[a12], %[t0], %[sb]\n\t"
        "v_add_u32 %[t1], 106496, %[vo]\n\tglobal_load_dwordx4 %[a13], %[t1], %[sb]\n\t"
        "v_add_u32 %[t0], 114688, %[vo]\n\tglobal_load_dwordx4 %[a14], %[t0], %[sb]\n\t"
        "v_add_u32 %[t1], 122880, %[vo]\n\tglobal_load_dwordx4 %[a15], %[t1], %[sb]\n\t"
        "s_waitcnt vmcnt(0)"
        : [a0]"=&v"(a[0]), [a1]"=&v"(a[1]), [a2]"=&v"(a[2]), [a3]"=&v"(a[3]), [a4]"=&v"(a[4]), [a5]"=&v"(a[5]), [a6]"=&v"(a[6]), [a7]"=&v"(a[7]), [a8]"=&v"(a[8]), [a9]"=&v"(a[9]), [a10]"=&v"(a[10]), [a11]"=&v"(a[11]), [a12]"=&v"(a[12]), [a13]"=&v"(a[13]), [a14]"=&v"(a[14]), [a15]"=&v"(a[15]), [t0]"=&v"(t0), [t1]"=&v"(t1)
        : [vo]"v"(vo), [sb]"s"(sbase) : "memory");
}
struct EpiMerge { static constexpr bool PERM = true; const unsigned char* GB; bf16* O;
    __device__ __forceinline__ void mid(f32x4 (&acc)[2][2][4][2], const Unit& u, int seg, int wr, int wc, int fr, int fq) const {
        const unsigned char* tb = GB + (size_t)(u.pm * 12 + (seg - 1) * 4 + u.pn) * 131072;
        const unsigned vo = (unsigned)(((wr * 4 + wc) * 64 + fq * 16 + fr) * 16);
#pragma unroll
        for (int ai = 0; ai < 2; ++ai) {
            u32x4 a[8], b[8]; gate_load8x2(tb + ai * 65536, vo, a, b);
#pragma unroll
            for (int m = 0; m < 4; ++m)
#pragma unroll
                for (int bj = 0; bj < 2; ++bj) { float gpv[8], gnv[8]; unpack8(a[m * 2 + bj], gpv); unpack8(b[m * 2 + bj], gnv);
#pragma unroll
                    for (int j = 0; j < 4; ++j) { acc[ai][bj][m][0][j] *= gpv[j] * __builtin_amdgcn_rcpf(gnv[j]); acc[ai][bj][m][1][j] *= gpv[4 + j] * __builtin_amdgcn_rcpf(gnv[4 + j]); } }
        }
    }
    __device__ __forceinline__ void operator()(const f32x4 (&acc)[2][2][4][2], const Unit& u, int wr, int wc, int fr, int fq) const {
        const int row0 = u.pm * 256 + wr * 64 + fr, col0 = u.pn * 256 + wc * 32 + 8 * fq;
        const unsigned char* tb = GB + (size_t)(u.pm * 12 + 8 + u.pn) * 131072;
        const unsigned vo = (unsigned)(((wr * 4 + wc) * 64 + fq * 16 + fr) * 16);
        u32x4 g[16]; gate_load16(tb, vo, g);
#pragma unroll
        for (int ai = 0; ai < 2; ++ai)
#pragma unroll
            for (int m = 0; m < 4; ++m) { const size_t row = (size_t)(row0 + ai * 128 + m * 16);
#pragma unroll
                for (int bj = 0; bj < 2; ++bj) { const int col = col0 + bj * 128;
                    float g8[8]; unpack8(g[(ai * 4 + m) * 2 + bj], g8);
                    const f32x4 v0 = acc[ai][bj][m][0], v1 = acc[ai][bj][m][1];
                    u32x4 w; w.x = cvt_pk_bf16(v0[0] * g8[0], v0[1] * g8[1]); w.y = cvt_pk_bf16(v0[2] * g8[2], v0[3] * g8[3]); w.z = cvt_pk_bf16(v1[0] * g8[4], v1[1] * g8[5]); w.w = cvt_pk_bf16(v1[2] * g8[6], v1[3] * g8[7]);
                    *(u32x4*)(O + row * D + col) = w; } }
    } };

struct EpiOut { static constexpr bool PERM = true; const Frame* F; int l, ch; bf16* O;
    __device__ __forceinline__ void operator()(const f32x4 (&acc)[2][2][4][2], const Unit& u, int wr, int wc, int fr, int fq) const {
        const int cr0 = u.pm * 256; const float* gt = mod_ptr(*F, l, mv_of(ch, cr0), 2);
        const int row0 = cr0 + wr * 64 + fr, col0 = u.pn * 256 + wc * 32 + 8 * fq;
#pragma unroll
        for (int bj = 0; bj < 2; ++bj) { const f32x4 g0 = *(const f32x4*)(gt + col0 + bj * 128), g1 = *(const f32x4*)(gt + col0 + bj * 128 + 4);
#pragma unroll
            for (int ai = 0; ai < 2; ++ai)
#pragma unroll
                for (int m = 0; m < 4; ++m) { const f32x4 v0 = acc[ai][bj][m][0] * g0, v1 = acc[ai][bj][m][1] * g1;
                    u32x4 w; w.x = cvt_pk_bf16(v0[0], v0[1]); w.y = cvt_pk_bf16(v0[2], v0[3]); w.z = cvt_pk_bf16(v1[0], v1[1]); w.w = cvt_pk_bf16(v1[2], v1[3]);
                    *(u32x4*)(O + (size_t)(row0 + ai * 128 + m * 16) * D + col0 + bj * 128) = w; } }
    } };

__device__ __forceinline__ int expert_of_tile(int pm) { return pm < SLT ? pm % NE : (pm - SLT) / (NB * CAP_C / 256); }
__device__ __forceinline__ void ffn_tile(int t, bool last, int& c1, int& pml) {
    const int per = last ? 2 * BC : 2 * BC + NB * CAP_C / 256;
    const int e = t / per, k = t % per;
    if (k < BC) { c1 = 0; pml = k * NE + e; }
    else if (!last && k < BC + NB * CAP_C / 256) { c1 = 0; pml = SLT + e * (NB * CAP_C / 256) + (k - BC); }
    else { c1 = 1; pml = (k - (per - BC)) * NE + e; }
}
struct SchedUp : SchedBase { const char* A; const char* B; const int* gidx; int nM0;
    __device__ __forceinline__ bool next(int i, Unit& u) const { int sub; if (!tile(i, u.pm, u.pn, sub)) return false; u.pad = 0;
        int c1, pml; ffn_tile(u.pm, nM0 == SLT, c1, pml); u.aux = c1 * PBT + pml;
        u.A = A; u.B = B + ((size_t)expert_of_tile(pml) * 2048 + (size_t)u.pn * 256) * D * 2; return true; } };
struct EpiUp { static constexpr bool PERM = true; bf16* O;
    __device__ __forceinline__ void operator()(const f32x4 (&acc)[2][2][4][2], const Unit& u, int wr, int wc, int fr, int fq) const {
        const int row0 = u.aux * 256 + wr * 64 + fr, col0 = u.pn * 128 + wc * 32 + 8 * fq;
#pragma unroll
        for (int ai = 0; ai < 2; ++ai)
#pragma unroll
            for (int m = 0; m < 4; ++m) { float h[8];
#pragma unroll
                for (int n = 0; n < 2; ++n)
#pragma unroll
                    for (int j = 0; j < 4; ++j) { const float g = acc[ai][0][m][n][j], uu = acc[ai][1][m][n][j]; h[4 * n + j] = g * sigmoidf_(g) * uu; }
                u32x4 w; w.x = cvt_pk_bf16(h[0], h[1]); w.y = cvt_pk_bf16(h[2], h[3]); w.z = cvt_pk_bf16(h[4], h[5]); w.w = cvt_pk_bf16(h[6], h[7]);
                *(u32x4*)(O + (size_t)(row0 + ai * 128 + m * 16) * FF + col0) = w; }
    } };

struct SchedDown : SchedBase { const char* A; const char* B; int nM0;
    __device__ __forceinline__ bool next(int i, Unit& u) const { int sub; if (!tile(i, u.pm, u.pn, sub)) return false; u.pad = 0;
        int c1, pml; ffn_tile(nM - 1 - u.pm, nM0 == SLT, c1, pml); u.aux = c1 * PBT + pml;
        u.A = A + (size_t)u.aux * 256 * FF * 2; u.B = B + ((size_t)expert_of_tile(pml) * D + (size_t)u.pn * 256) * FF * 2; return true; } };
__device__ __forceinline__ void load8_rows_f32(const float* sbase, unsigned vo, float (&g)[8]) {
    asm volatile("global_load_dword %[g0], %[vo], %[sb]\n\tglobal_load_dword %[g1], %[vo], %[sb] offset:64\n\tglobal_load_dword %[g2], %[vo], %[sb] offset:128\n\tglobal_load_dword %[g3], %[vo], %[sb] offset:192\n\t"
                 "global_load_dword %[g4], %[vo], %[sb] offset:512\n\tglobal_load_dword %[g5], %[vo], %[sb] offset:576\n\tglobal_load_dword %[g6], %[vo], %[sb] offset:640\n\tglobal_load_dword %[g7], %[vo], %[sb] offset:704\n\t"
                 "s_waitcnt vmcnt(0)"
        : [g0]"=&v"(g[0]), [g1]"=&v"(g[1]), [g2]"=&v"(g[2]), [g3]"=&v"(g[3]), [g4]"=&v"(g[4]), [g5]"=&v"(g[5]), [g6]"=&v"(g[6]), [g7]"=&v"(g[7])
        : [vo]"v"(vo), [sb]"s"(sbase) : "memory");
}
struct EpiDown { static constexpr bool PERM = true; bf16* O; const float* gv;
    __device__ __forceinline__ void operator()(const f32x4 (&acc)[2][2][4][2], const Unit& u, int wr, int wc, int fr, int fq) const {
        const int row0 = u.aux * 256 + wr * 64 + fr, col0 = u.pn * 256 + wc * 32 + 8 * fq;
#pragma unroll
        for (int ai = 0; ai < 2; ++ai)
#pragma unroll
            for (int m = 0; m < 4; ++m) { const int row = row0 + ai * 128 + m * 16; const float g = 1.0f; bf16* rowp = O + (size_t)row * D + col0;
#pragma unroll
                for (int bj = 0; bj < 2; ++bj) { const f32x4 v0 = acc[ai][bj][m][0] * g, v1 = acc[ai][bj][m][1] * g;
                    u32x4 w; w.x = cvt_pk_bf16(v0[0], v0[1]); w.y = cvt_pk_bf16(v0[2], v0[3]); w.z = cvt_pk_bf16(v1[0], v1[1]); w.w = cvt_pk_bf16(v1[2], v1[3]);
                    *(u32x4*)(rowp + bj * 128) = w; } }
    } };

#if defined(PROBE_ATTN)
__device__ __forceinline__ void probe_compare(Frame& F, int nrows, const bf16* a, const bf16* b) {
    const int lane = launder(lane_id());
    const int gw = F.vcu * NWAVES + F.wave, NGW = F.G * NWAVES;
    unsigned cnt = 0;
    for (int cr = gw; cr < nrows; cr += NGW) {
#pragma unroll
        for (int j = 0; j < 2; ++j) { float x[8], y[8]; unpack8(*(const u32x4*)(a + (size_t)cr * OW + 512 + lane * 8 + 512 * j), x); unpack8(*(const u32x4*)(b + (size_t)cr * OW + 512 + lane * 8 + 512 * j), y);
#pragma unroll
            for (int i = 0; i < 8; ++i) { const float d = fabsf(x[i] - y[i]); cnt += (!(d <= 0.01f + 0.05f * fabsf(y[i]))) ? 1u : 0u; } }
    }
#pragma unroll
    for (int o = 1; o < 64; o <<= 1) cnt += __shfl_xor(cnt, o);
    if (lane == 0 && cnt) atomicAdd((unsigned*)(F.ws + WS_CTL) + CW_DIAG, cnt);
}
#endif

constexpr int SEQ_TOTAL = 2 + DEPTH * (NCH * 4 + 5);

__global__ void __launch_bounds__(NTHR, 2) fwd_kernel(Args args) {
    extern __shared__ __attribute__((aligned(16))) unsigned char lds[];
    Frame F;
    F.lds = lds; F.ldsl = (LAS unsigned char*)lds; F.ws = args.ws; F.out = args.out;
    F.wave = __builtin_amdgcn_readfirstlane(threadIdx.x >> 6);
    F.G = gridDim.x; { const int bx = blockIdx.x; F.vcu = (F.G % 8 == 0) ? (bx % 8) * (F.G / 8) + bx / 8 : bx; }
    volatile LAS unsigned* MISC = (volatile LAS unsigned*)(F.ldsl + MISC_OFF);
    for (int u = threadIdx.x; u < (LDS_BYTES - LDSCTL_OFF) / 4; u += NTHR) ((LAS unsigned*)(F.ldsl + LDSCTL_OFF))[u] = 0u;
    if (threadIdx.x < 19) *(LAS unsigned long long*)(F.ldsl + PTR_OFF + 8 * threadIdx.x) = (unsigned long long)args.in[threadIdx.x];
    __syncthreads();
    const int lo = args.ph_lo, hi = args.ph_hi;
    const bool multi = (hi - lo) > 1;
    XcdBarrier bar; bar.bar = (unsigned*)(F.ws + WS_CTL) + CW_BAR; bar.x = 0; bar.st = nullptr;
    if (multi) bar = xcd_barrier_post((unsigned*)(F.ws + WS_CTL) + CW_BAR, MISC + 8);
    int seq = 0;
#ifndef PHMASK
#define PHMASK 0xFFFF
#endif
#define EN(b) ((PHMASK >> (b)) & 1)
#ifndef REPMASK
#define REPMASK 0
#endif
#define REP(b) ((REPMASK >> (b)) & 1)
#define RUN(b, stmt) do { stmt; if (REP(b)) { __syncthreads(); stmt; } } while (0)
#define IN(k) (lo <= (k) && (k) < hi)
#define SEAM(k) do { if (IN(k) && IN((k) + 1)) xcd_barrier(bar, F.wave); } while (0)

    if (IN(seq)) { if (EN(0)) RUN(0, mods_phase(F)); if (EN(1)) RUN(1, wconv_phase(F, 0)); } SEAM(seq); ++seq;
    if (EN(2) && IN(seq)) { norm_phase<false>(F, 0, 0, nrows_of(0)); norm_phase<false>(F, 0, 1, nrows_of(1)); } SEAM(seq); ++seq;

    for (int l = 0; l < DEPTH; ++l) {
        const bool last = (l == DEPTH - 1);
        for (int ch = 0; ch < NCH; ++ch) {
            if (EN(3) && IN(seq)) {
                SchedIn S; S.nM = (last && ch == 0) ? LT : nrows_of(ch) / 256; S.kvM = (last && ch == 0) ? CTT : 0; S.nN = INW / 256; S.G = F.G; S.c = blockIdx.x; S.rep = 1; S.A = (const char*)hbuf_of(F, ch); S.B = (const char*)(F.ws + WS_WIN);
                EpiStoreBf16 E{(bf16*)(F.ws + WS_Z), ZW, F.ws + WS_GB};
                RUN(3, (pg8::gemm_phase<EpiStoreBf16, SchedIn, true, true>(F.ldsl, D * 2, D, S, E, F.wave)));
            } SEAM(seq); ++seq;
            if (IN(seq)) { if (EN(4)) RUN(4, conv_phase(F, l, last ? LROWS : nrows_of(ch)));
#if defined(ATTN_NAIVE)
                if (EN(5)) naive_attn_phase(F, l, ch, last, (bf16*)(F.ws + WS_OBUF));
#else
                if (EN(5)) attn_phase<0>(F, l, ch, last, (bf16*)(F.ws + WS_OBUF));
#if defined(PROBE_AVAR)
                __syncthreads(); attn_phase<PROBE_AVAR>(F, l, ch, last, (bf16*)(F.ws + WS_PART));
#endif
#endif
#if defined(PROBE_ATTN)
                naive_attn_phase(F, l, ch, last, (bf16*)(F.ws + WS_PART));
                xcd_barrier(bar, F.wave);
                probe_compare(F, last ? LROWS : nrows_of(ch), (const bf16*)(F.ws + WS_OBUF), (const bf16*)(F.ws + WS_PART));
#endif
            } SEAM(seq); ++seq;
            if (EN(6) && IN(seq)) {
                SchedMerge S; S.nM = (last ? LROWS : nrows_of(ch)) / 256; S.nN = D / 256; S.G = F.G; S.c = blockIdx.x; S.rep = 1; S.A = (const char*)(F.ws + WS_OBUF); S.B = (const char*)(F.ws + WS_WBR);
                EpiMerge E{(const unsigned char*)(F.ws + WS_GB), hbuf_of(F, ch)};
                RUN(6, (pg8::gemm_phase<EpiMerge, SchedMerge, true, true, 3>(F.ldsl, OW * 2, 1536, S, E, F.wave)));
#if defined(PROBE_NOHOOK)
                { __syncthreads(); EpiMerge E2{(const unsigned char*)(F.ws + WS_GB), (bf16*)(F.ws + WS_PART)}; pg8::gemm_phase<EpiMerge, SchedMerge, true, true, PROBE_NOHOOK>(F.ldsl, OW * 2, 1536, S, E2, F.wave); }
#endif
            } SEAM(seq); ++seq;
            if (EN(7) && IN(seq)) {
                SchedIn S; S.nM = (last ? LROWS : nrows_of(ch)) / 256; S.nN = D / 256; S.G = F.G; S.c = blockIdx.x; S.rep = 1; S.A = (const char*)hbuf_of(F, ch); S.B = (const char*)(F.ws + WS_WOUT);
                EpiOut E{&F, l, ch, dx_of(F, ch)};
                RUN(7, (pg8::gemm_phase<EpiOut, SchedIn, true, true>(F.ldsl, D * 2, D, S, E, F.wave)));
#if defined(PROBE_OUTK)
                { __syncthreads(); EpiOut E2{&F, l, ch, (bf16*)(F.ws + WS_PART)}; pg8::gemm_phase<EpiOut, SchedIn, true, true>(F.ldsl, D * 2, PROBE_OUTK, S, E2, F.wave); }
#endif
            } SEAM(seq); ++seq;
        }
        if (EN(8) && IN(seq)) {
            norm_phase<true>(F, l, 0, last ? LROWS : nrows_of(0)); __syncthreads(); norm_phase<true>(F, l, 1, LROWS);
            if (REP(8)) { __syncthreads(); norm_phase<true>(F, l, 0, last ? LROWS : nrows_of(0), true); __syncthreads(); norm_phase<true>(F, l, 1, LROWS, true); }
        } SEAM(seq); ++seq;
        if (EN(9) && IN(seq)) { topk_phase(F, last); } SEAM(seq); ++seq;
        if (EN(10) && IN(seq)) {
            SchedUp S; S.nM0 = last ? SLT : SLT + SCT; S.nM = S.nM0 + SLT; S.nN = 8; S.G = F.G; S.c = blockIdx.x; S.rep = 1; S.A = (const char*)(F.ws + WS_HBUF); S.B = (const char*)(F.ws + WS_WUP); S.gidx = (const int*)(F.ws + WS_SELTOK);
            EpiUp E{(bf16*)(F.ws + WS_HMID)};
            RUN(10, (pg8::gemm_phase<EpiUp, SchedUp, true, true, 1, true>(F.ldsl, D * 2, D, S, E, F.wave)));
        } SEAM(seq); ++seq;
        if (EN(11) && IN(seq)) {
            SchedDown S; S.nM0 = last ? SLT : SLT + SCT; S.nM = S.nM0 + SLT; S.nN = 4; S.G = F.G; S.c = blockIdx.x; S.rep = 1; S.A = (const char*)(F.ws + WS_HMID); S.B = (const char*)(F.ws + WS_WDN);
            EpiDown E{(bf16*)(F.ws + WS_YBUF), (const float*)(F.ws + WS_GATEV)};
            RUN(11, (pg8::gemm_phase<EpiDown, SchedDown, true, true>(F.ldsl, FF * 2, FF, S, E, F.wave)));
        } SEAM(seq); ++seq;
        if (IN(seq)) {
            if (EN(12)) { if (REP(12)) { combine_phase(F, l, 0, last, true); combine_phase(F, l, 1, last, true); } combine_phase(F, l, 0, last); combine_phase(F, l, 1, last); }
            if (!last && EN(1)) RUN(13, wconv_phase(F, l + 1));
        } SEAM(seq); ++seq;
    }
#undef IN
#undef SEAM
}

extern "C" void kernel_launch(void* const* d_in, const int* in_sizes, int n_in, void* d_out, int out_size, void* d_ws, size_t ws_size, hipStream_t stream) {
    static int grid = 0;
    if (grid == 0) {
        if (n_in != 19 || ws_size < WS_END) { fprintf(stderr, "kernel_launch: unexpected n_in %d / ws %zu (need %zu)\n", n_in, ws_size, (size_t)WS_END); grid = -1; return; }
        int dev = 0, cus = 0;
        if (hipGetDevice(&dev) != hipSuccess || hipDeviceGetAttribute(&cus, hipDeviceAttributeMultiprocessorCount, dev) != hipSuccess) { grid = -1; return; }
        if (hipFuncSetAttribute((const void*)fwd_kernel, hipFuncAttributeMaxDynamicSharedMemorySize, LDS_BYTES) != hipSuccess) { fprintf(stderr, "kernel_launch: hipFuncSetAttribute failed\n"); grid = -1; return; }
        int per_cu = 0;
        if (hipOccupancyMaxActiveBlocksPerMultiprocessor(&per_cu, (const void*)fwd_kernel, NTHR, LDS_BYTES) != hipSuccess || per_cu < 1) fprintf(stderr, "kernel_launch: occupancy query says %d\n", per_cu);
        (void)hipGetLastError();
        grid = cus;
    }
    if (grid < 0) return;
    (void)hipMemsetAsync((char*)d_ws + WS_CTL, 0, CTL_ZERO_BYTES, stream);
    Args a{};
    for (int i = 0; i < 19; ++i) a.in[i] = (const float*)d_in[i];
    a.out = (float*)d_out; a.ws = (unsigned char*)d_ws;
#if MK_ONE_LAUNCH
    a.ph_lo = 0; a.ph_hi = SEQ_TOTAL;
    hipLaunchKernelGGL(fwd_kernel, dim3(grid), dim3(NTHR), LDS_BYTES, stream, a);
#else
    for (int s = 0; s < SEQ_TOTAL; ++s) { a.ph_lo = s; a.ph_hi = s + 1; hipLaunchKernelGGL(fwd_kernel, dim3(grid), dim3(NTHR), LDS_BYTES, stream, a); }
#endif
}
```

```cpp
#include <hip/hip_runtime.h>
#include <cstdio>
#include <cstdint>

#ifndef MK_ONE_LAUNCH
#define MK_ONE_LAUNCH 1
#endif

#define GAS __attribute__((address_space(1)))
#define LAS __attribute__((address_space(3)))
typedef unsigned short bf16;
typedef short bf16x8 __attribute__((ext_vector_type(8)));
typedef float f32x4 __attribute__((ext_vector_type(4)));
typedef float f32x2 __attribute__((ext_vector_type(2)));
typedef unsigned u32x4 __attribute__((ext_vector_type(4)));
typedef unsigned u32x2 __attribute__((ext_vector_type(2)));

constexpr int D = 1024, NB = 32, SEQ = 2048, CTX = 256, DEPTH = 4, INW = 6912, NE = 16, FF = 1024;
constexpr int NCH = 2, BC = NB / NCH;
constexpr int LROWS = BC * SEQ, CTXALL = NB * CTX, RCMAX = LROWS + CTXALL;
constexpr int LT = LROWS / 256, CTT = CTXALL / 256;
__host__ __device__ constexpr int nrows_of(int ch) { return ch == 0 ? RCMAX : LROWS; }
constexpr int CAP_L = 2 * SEQ / NE, CAP_C = 2 * CTX / NE;
constexpr int SLOT_CT0 = BC * NE * CAP_L;
constexpr int NSLOTMAX = SLOT_CT0 + NE * NB * CAP_C;
constexpr int SLT = SLOT_CT0 / 256, SCT = NE * NB * CAP_C / 256;
constexpr float RMS_EPS = 1e-6f;
constexpr int Z_AB = 0, Z_AC = 512, Z_AX = 1024, Z_NQ = 1536, Z_NK = 2048, Z_NV = 2560, Z_SQ = 3072, Z_SK = 3584, Z_SV = 3712, Z_G = 3840;
constexpr int OW = 1536;
constexpr int ZW = Z_G;

constexpr size_t MiB = 1u << 20;
constexpr size_t WS_CTL = 0, CTL_ZERO_BYTES = 1 * MiB;
constexpr size_t WS_MODS = 1 * MiB;
constexpr size_t WS_ROPE = 5 * MiB;
constexpr size_t WS_AFFL = 6 * MiB;
constexpr size_t WS_AFFC = 10 * MiB;
constexpr size_t WS_GATEV = 11 * MiB;
constexpr size_t WS_SELTOK = 12 * MiB;
constexpr size_t WS_XC = 13 * MiB;
constexpr size_t WS_WIN = 45 * MiB;
constexpr size_t WS_WBR = 59 * MiB;
constexpr size_t WS_WOUT = 62 * MiB;
constexpr size_t WS_WUP = 64 * MiB;
constexpr size_t WS_WDN = 128 * MiB;
constexpr size_t WS_HBUF = 160 * MiB;
constexpr size_t WS_HBUF1 = 240 * MiB;
constexpr size_t WS_OBUF = 304 * MiB;
constexpr size_t WS_PART = 424 * MiB;
constexpr size_t WS_Z = 544 * MiB;
constexpr size_t WS_GB = 844 * MiB;
constexpr size_t WS_HMID = WS_OBUF;
constexpr size_t WS_YBUF = WS_OBUF + 288 * MiB;
constexpr size_t WS_DX0 = 1084 * MiB, WS_DX1 = 1164 * MiB;
constexpr size_t WS_TOKSLOT = 1228 * MiB;
constexpr size_t WS_END = 1234 * MiB;
static_assert((size_t)RCMAX * ZW * 2 == 300 * MiB && (size_t)LROWS * ZW * 2 == 240 * MiB && (size_t)NSLOTMAX * 1024 * 2 == 160 * MiB && (size_t)RCMAX * 1024 * 2 == 80 * MiB && (size_t)RCMAX * OW * 2 == 120 * MiB
              && (size_t)(RCMAX / 256) * 12 * 131072 == 240 * MiB && WS_YBUF + 288 * MiB <= WS_GB + 240 * MiB && WS_HBUF1 == WS_HBUF + (size_t)RCMAX * 1024 * 2, "ws map");
constexpr int PBT = NSLOTMAX / 256;
constexpr int CW_TMO = 0, CW_DIAG = 64, CW_BAR = 4096;

constexpr int RING_BYTES = 131072, LDSCTL_OFF = RING_BYTES, MISC_OFF = LDSCTL_OFF + 320, LDS_BYTES = 147456;
constexpr int NWAVES = 8, NTHR = 512;

__device__ __forceinline__ unsigned f2bf(float f) { unsigned u = __builtin_bit_cast(unsigned, f); return (u + 0x7fffu + ((u >> 16) & 1u)) >> 16; }
__device__ __forceinline__ unsigned pk2(float lo, float hi) { return f2bf(lo) | (f2bf(hi) << 16); }
__device__ __forceinline__ float bflo(unsigned u) { return __builtin_bit_cast(float, u << 16); }
__device__ __forceinline__ float bfhi(unsigned u) { return __builtin_bit_cast(float, u & 0xffff0000u); }
__device__ __forceinline__ void unpack8(const u32x4 u, float* f) { f[0] = bflo(u.x); f[1] = bfhi(u.x); f[2] = bflo(u.y); f[3] = bfhi(u.y); f[4] = bflo(u.z); f[5] = bfhi(u.z); f[6] = bflo(u.w); f[7] = bfhi(u.w); }
__device__ __forceinline__ float wave_sum(float v) {
#pragma unroll
    for (int o = 1; o < 64; o <<= 1) v += __shfl_xor(v, o);
    return v;
}
__device__ __forceinline__ float sigmoidf_(float x) { return __builtin_amdgcn_rcpf(1.0f + __builtin_amdgcn_exp2f(-1.4426950408889634f * x)); }
__device__ __forceinline__ int launder(int v) { asm volatile("" : "+v"(v)); return v; }
__device__ __forceinline__ int lane_id() { int l; asm volatile("v_mbcnt_lo_u32_b32 %0, -1, 0\n\tv_mbcnt_hi_u32_b32 %0, -1, %0" : "=v"(l)); return l; }
#define LDS_WAIT() asm volatile("s_waitcnt lgkmcnt(0)" ::: "memory")
#define VM_WAIT() asm volatile("s_waitcnt vmcnt(0)" ::: "memory")

namespace pg8 {
constexpr int BM = 256, BK = 64, HALF = 128, HTB = HALF * BK * 2, STAGE_BYTES = 8 * HTB, NXCD = 8, WGM = 8;
__host__ __device__ __forceinline__ int lds_byte(int r, int c) { const int st = (r >> 4) * 2 + (c >> 5), rr = r & 15, cc = c & 31, ob = rr * 64 + cc * 2; return st * 1024 + (ob ^ (((ob >> 9) & 1) << 5)); }
__host__ __device__ __forceinline__ void stage_rc(int b, int& R, int& C) { const int st = b / 1024, sb = b % 1024, swz = sb ^ (((sb >> 9) & 1) << 5); R = (st >> 1) * 16 + swz / 64; C = (st & 1) * 32 + (swz % 64) / 2; }
__host__ __device__ __forceinline__ int perm32(int rho) { const int n = rho >> 4, i = rho & 15; return 8 * (i >> 2) + 4 * n + (i & 3); }

struct Unit { int pm, pn, aux, pad; const char* A; const char* B; };

__device__ __forceinline__ bool tile_of(long L, int nM, int nN, int& pm, int& pn) {
    const int nwg = nM * nN; if (L >= nwg) return false;
    int wgid = (int)L; { const int q = nwg / NXCD, r = nwg % NXCD, xcd = wgid % NXCD, off = wgid / NXCD; wgid = (xcd < r ? xcd * (q + 1) : r * (q + 1) + (xcd - r) * q) + off; }
    const int nig = WGM * nN, gid = wgid / nig, fm = gid * WGM, gsz = (nM - fm) < WGM ? (nM - fm) : WGM;
    pm = fm + ((wgid % nig) % gsz); pn = (wgid % nig) / gsz; return true;
}

__device__ __forceinline__ unsigned cvt_pk_bf16(float lo, float hi) { unsigned r; asm volatile("v_cvt_pk_bf16_f32 %0, %1, %2" : "=v"(r) : "v"(lo), "v"(hi)); return r; }

template <class Epi, class Sched, bool ALIGN_EPI, bool SP2, int NSEG = 1, bool GATHER = false>
__device__ __forceinline__ void gemm_phase(LAS unsigned char* lds, const int lda_bytes, const int K, const Sched& S, const Epi& E, const int wid_in) {
    int wid = wid_in; asm volatile("" : "+s"(wid));
    int lane_ = lane_id(); asm volatile("" : "+v"(lane_));
    const int lane = lane_, tid = wid * 64 + lane, wr = wid >> 2, wc = wid & 3, fr = lane & 15, fq = lane >> 4;
    const int nt = K / BK;
    unsigned voffA[2], voffB[2]; int gR[2], gC[2];
#pragma unroll
    for (int i = 0; i < 2; ++i) { int R, C; stage_rc(tid * 16 + i * 8192, R, C); const int Rb = Epi::PERM ? ((R & ~31) + perm32(R & 31)) : R; gR[i] = R; gC[i] = C * 2;
        voffA[i] = (unsigned)(R * lda_bytes + C * 2); voffB[i] = (unsigned)(Rb * K + C) * 2u; }
    unsigned offc[2][2], offn[2][2]; int rawn[2][2];
    const size_t kstep = (size_t)(BK * 2);
    const size_t hstepA = (size_t)HALF * lda_bytes, hstepB = (size_t)HALF * K * 2;
    const unsigned ldsw = (unsigned)wid * 1024u;
    const int aoff = lds_byte(wr * 64 + fr, fq * 8), boff = lds_byte(wc * 32 + fr, fq * 8);
#define PG8_SA(b, h) (((b) * 2 + (h)) * HTB)
#define PG8_SB(b, h) ((4 + (b) * 2 + (h)) * HTB)
#define PG8_STAGE(bufoff, gbase, voff) do { _Pragma("unroll") for (int _i = 0; _i < 2; ++_i) \
        __builtin_amdgcn_global_load_lds((const unsigned*)((const char*)(gbase) + (voff)[_i]), (LAS unsigned*)(lds + (bufoff) + ldsw + _i * 8192), 16, 0, 0); } while (0)
#define PG8_STAGE_A(bufoff, kbase, h, nx) do { if constexpr (GATHER) { unsigned vs_[2]; vs_[0] = (nx) ? offn[h][0] : offc[h][0]; vs_[1] = (nx) ? offn[h][1] : offc[h][1]; PG8_STAGE(bufoff, (kbase), vs_); } \
        else { PG8_STAGE(bufoff, (kbase) + ((h) ? hstepA : (size_t)0), voffA); } } while (0)
#define PG8_LDA(dst, b, h) do { _Pragma("unroll") for (int m = 0; m < 4; ++m) _Pragma("unroll") for (int k = 0; k < 2; ++k) dst[m][k] = *(const LAS bf16x8*)(lds + PG8_SA(b, h) + aoff + m * 2048 + k * 1024); } while (0)
#define PG8_LDB(dst, b, h) do { _Pragma("unroll") for (int n = 0; n < 2; ++n) _Pragma("unroll") for (int k = 0; k < 2; ++k) dst[n][k] = *(const LAS bf16x8*)(lds + PG8_SB(b, h) + boff + n * 2048 + k * 1024); } while (0)
#define PG8_MMA(ai, bj, At, Bt) do { __builtin_amdgcn_s_setprio(1); _Pragma("unroll") for (int m = 0; m < 4; ++m) _Pragma("unroll") for (int n = 0; n < 2; ++n) _Pragma("unroll") for (int k = 0; k < 2; ++k) \
        acc[ai][bj][m][n] = __builtin_amdgcn_mfma_f32_16x16x32_bf16(Bt[n][k], At[m][k], acc[ai][bj][m][n], 0, 0, 0); __builtin_amdgcn_s_setprio(0); } while (0)
#define PG8_WAIT_V(n) asm volatile("s_waitcnt vmcnt(" #n ")" ::: "memory")
#define PG8_WAIT_L(n) asm volatile("s_waitcnt lgkmcnt(" #n ")" ::: "memory")
#define PG8_BAR __builtin_amdgcn_s_barrier()
#define PG8_SCHED __builtin_amdgcn_sched_barrier(0)
    Unit cur, nxt; int ui = 0;
    if (!S.next(0, cur)) return;
    f32x4 acc[2][2][4][2];
#pragma unroll
    for (int a = 0; a < 2; ++a)
#pragma unroll
        for (int b = 0; b < 2; ++b)
#pragma unroll
            for (int m = 0; m < 4; ++m)
#pragma unroll
                for (int n = 0; n < 2; ++n) acc[a][b][m][n] = (f32x4){0.f, 0.f, 0.f, 0.f};
    bf16x8 At[4][2], B0[2][2], B1[2][2];
    const char* cA = cur.A; const char* cB = cur.B;
    if constexpr (GATHER) {
#pragma unroll
        for (int h = 0; h < 2; ++h)
#pragma unroll
            for (int i = 0; i < 2; ++i) { offc[h][i] = (unsigned)S.gidx[cur.aux * 256 + h * 128 + gR[i]] * (unsigned)lda_bytes + (unsigned)gC[i]; offn[h][i] = offc[h][i]; }
    }
    if constexpr (SP2) {
        PG8_STAGE(PG8_SB(0, 0), cB, voffB); PG8_STAGE(PG8_SB(0, 1), cB + hstepB, voffB); PG8_STAGE_A(PG8_SA(0, 0), cA, 0, false); PG8_STAGE_A(PG8_SA(0, 1), cA, 1, false);
        if (wr == 1) PG8_BAR;
        PG8_WAIT_V(2); PG8_BAR;
        PG8_STAGE(PG8_SB(1, 0), cB + kstep, voffB); PG8_STAGE_A(PG8_SA(1, 0), cA + kstep, 0, false); PG8_STAGE(PG8_SB(1, 1), cB + hstepB + kstep, voffB);
        PG8_WAIT_V(6); PG8_BAR;
    } else {
        static_assert(SP2 || !GATHER, "GATHER is implemented for the SP2 loop only");
        PG8_STAGE(PG8_SB(0, 0), cB, voffB); PG8_STAGE(PG8_SA(0, 0), cA, voffA); PG8_STAGE(PG8_SB(0, 1), cB + hstepB, voffB); PG8_STAGE(PG8_SA(0, 1), cA + hstepA, voffA);
        if (wr == 1) PG8_BAR;
        PG8_WAIT_V(4); PG8_BAR;
        PG8_STAGE(PG8_SB(1, 0), cB + kstep, voffB); PG8_STAGE(PG8_SA(1, 0), cA + kstep, voffA); PG8_STAGE(PG8_SB(1, 1), cB + hstepB + kstep, voffB);
        PG8_WAIT_V(6); PG8_BAR;
    }
    for (;;) {
        const bool has_next = S.next(ui + 1, nxt);
        const char* nA = has_next ? nxt.A : cA; const char* nB = has_next ? nxt.B : cB;
        if constexpr (GATHER) {
            const int na_ = has_next ? nxt.aux : cur.aux;
#pragma unroll
            for (int h = 0; h < 2; ++h)
#pragma unroll
                for (int i = 0; i < 2; ++i) rawn[h][i] = S.gidx[na_ * 256 + h * 128 + gR[i]]; }
        for (int t = 0; t < nt; t += 2) {
            const bool last = (t == nt - 2);
            const char* a1 = cA + (size_t)(t + 1) * kstep;
            const char* a2 = last ? nA : cA + (size_t)(t + 2) * kstep; const char* b2 = last ? nB : cB + (size_t)(t + 2) * kstep;
            const char* a3 = a2 + kstep; const char* b3 = b2 + kstep;
            if constexpr (GATHER) { if (last && has_next) {
#pragma unroll
                for (int h = 0; h < 2; ++h)
#pragma unroll
                    for (int i = 0; i < 2; ++i) { int rw_ = rawn[h][i]; asm volatile("" : "+v"(rw_));
                        offn[h][i] = (unsigned)rw_ * (unsigned)lda_bytes + (unsigned)gC[i]; } } }
            if constexpr (NSEG > 1) { const int tseg = nt / NSEG; if (t > 0 && (t % tseg) == 0) E.mid(acc, cur, t / tseg, wr, wc, fr, fq); }
            if constexpr (SP2) {
            PG8_LDB(B0, 0, 0); PG8_LDB(B1, 0, 1); PG8_SCHED; PG8_LDA(At, 0, 0); PG8_STAGE_A(PG8_SA(1, 1), a1, 1, false);
            PG8_WAIT_V(8); PG8_WAIT_L(0); PG8_BAR; PG8_MMA(0, 0, At, B0); PG8_MMA(0, 1, At, B1); PG8_BAR; PG8_SCHED;
            PG8_LDA(At, 0, 1); PG8_STAGE(PG8_SB(0, 0), b2, voffB); PG8_STAGE(PG8_SB(0, 1), b2 + hstepB, voffB); PG8_STAGE_A(PG8_SA(0, 0), a2, 0, last);
            PG8_WAIT_V(8); PG8_WAIT_L(0); PG8_BAR; PG8_MMA(1, 0, At, B0); PG8_MMA(1, 1, At, B1); PG8_BAR; PG8_SCHED;
            PG8_LDB(B0, 1, 0); PG8_LDB(B1, 1, 1); PG8_SCHED; PG8_LDA(At, 1, 0); PG8_STAGE_A(PG8_SA(0, 1), a2, 1, last);
            PG8_WAIT_V(8); PG8_WAIT_L(0); PG8_BAR; PG8_MMA(0, 0, At, B0); PG8_MMA(0, 1, At, B1); PG8_BAR; PG8_SCHED;
            PG8_LDA(At, 1, 1); PG8_STAGE(PG8_SB(1, 0), b3, voffB); PG8_STAGE(PG8_SB(1, 1), b3 + hstepB, voffB); PG8_STAGE_A(PG8_SA(1, 0), a3, 0, last);
            PG8_WAIT_V(8); PG8_WAIT_L(0); PG8_BAR; PG8_MMA(1, 0, At, B0); PG8_MMA(1, 1, At, B1); PG8_BAR; PG8_SCHED;
            } else {
            PG8_LDB(B0, 0, 0); PG8_SCHED; PG8_LDA(At, 0, 0); PG8_STAGE(PG8_SA(1, 1), a1 + hstepA, voffA);
            PG8_WAIT_L(8); PG8_BAR; PG8_WAIT_L(0); PG8_MMA(0, 0, At, B0); PG8_BAR; PG8_SCHED;
            PG8_LDB(B1, 0, 1); PG8_STAGE(PG8_SB(0, 0), b2, voffB);
            PG8_BAR; PG8_WAIT_L(0); PG8_MMA(0, 1, At, B1); PG8_BAR;
            PG8_LDA(At, 0, 1); PG8_STAGE(PG8_SA(0, 0), a2, voffA);
            PG8_BAR; PG8_WAIT_L(0); PG8_MMA(1, 0, At, B0); PG8_BAR; PG8_SCHED;
            PG8_STAGE(PG8_SB(0, 1), b2 + hstepB, voffB);
            PG8_WAIT_V(6); PG8_BAR; PG8_MMA(1, 1, At, B1); PG8_BAR;
            PG8_LDB(B0, 1, 0); PG8_SCHED; PG8_LDA(At, 1, 0); PG8_STAGE(PG8_SA(0, 1), a2 + hstepA, voffA);
            PG8_WAIT_L(8); PG8_BAR; PG8_WAIT_L(0); PG8_MMA(0, 0, At, B0); PG8_BAR; PG8_SCHED;
            PG8_LDB(B1, 1, 1); PG8_STAGE(PG8_SB(1, 0), b3, voffB);
            PG8_BAR; PG8_WAIT_L(0); PG8_MMA(0, 1, At, B1); PG8_BAR;
            PG8_LDA(At, 1, 1); PG8_STAGE(PG8_SA(1, 0), a3, voffA);
            PG8_BAR; PG8_WAIT_L(0); PG8_MMA(1, 0, At, B0); PG8_BAR; PG8_SCHED;
            PG8_STAGE(PG8_SB(1, 1), b3 + hstepB, voffB);
            PG8_WAIT_V(6); PG8_BAR; PG8_MMA(1, 1, At, B1); PG8_BAR;
            }
        }
        if constexpr (ALIGN_EPI) { if (wr == 0) PG8_BAR; }
        E(acc, cur, wr, wc, fr, fq);
        if (!has_next) break;
#pragma unroll
        for (int a = 0; a < 2; ++a)
#pragma unroll
            for (int b = 0; b < 2; ++b)
#pragma unroll
                for (int m = 0; m < 4; ++m)
#pragma unroll
                    for (int n = 0; n < 2; ++n) acc[a][b][m][n] = (f32x4){0.f, 0.f, 0.f, 0.f};
        cur = nxt; cA = nA; cB = nB; ++ui;
        if constexpr (GATHER) {
#pragma unroll
            for (int h = 0; h < 2; ++h)
#pragma unroll
                for (int i = 0; i < 2; ++i) offc[h][i] = offn[h][i]; }
        if constexpr (ALIGN_EPI) { if (wr == 1) PG8_BAR; }
    }
    PG8_WAIT_V(0);
    if constexpr (!ALIGN_EPI) { if (wr == 0) PG8_BAR; }
    PG8_BAR;
#undef PG8_SA
#undef PG8_SB
#undef PG8_STAGE
#undef PG8_STAGE_A
#undef PG8_LDA
#undef PG8_LDB
#undef PG8_MMA
#undef PG8_WAIT_V
#undef PG8_WAIT_L
#undef PG8_BAR
#undef PG8_SCHED
}
}

#define XB_TMO      128
#define XB_XCNT(j)  (256  + 64 * (j))
#define XB_XSUB(j)  (1280 + 64 * (j))
#define XB_XGEN(j)  (2304 + 64 * (j))
#define XB_TOP      3328
#define XB_TOPGEN   3392
#define XCD_BAR_WORDS 3456
#define XB_SPIN_CAP (1u << 22)
__device__ __forceinline__ unsigned xb_ld(unsigned* p)              { return __hip_atomic_load(p, __ATOMIC_RELAXED, __HIP_MEMORY_SCOPE_AGENT); }
__device__ __forceinline__ unsigned xb_add(unsigned* p, unsigned v) { return __hip_atomic_fetch_add(p, v, __ATOMIC_RELAXED, __HIP_MEMORY_SCOPE_AGENT); }
__device__ __forceinline__ unsigned xb_xcc_id() { return (unsigned)__builtin_amdgcn_s_getreg((3 << 11) | 20) & 0xFu; }
#define XB_SPIN(cond, bar) do { unsigned _sp = 0; while (cond) { __builtin_amdgcn_s_sleep(1); \
    if ((++_sp & 255u) == 0u) { if (xb_ld(&(bar)[XB_TMO])) break; if (_sp > XB_SPIN_CAP) { atomicAdd(&(bar)[XB_TMO], 1u); break; } } } } while (0)
struct XcdBarrier { unsigned* bar; unsigned x; volatile LAS unsigned* st; };
__device__ __forceinline__ XcdBarrier xcd_barrier_post(unsigned* bar, volatile LAS unsigned* st) {
    XcdBarrier b; b.bar = bar; b.x = xb_xcc_id(); b.st = st;
    if (threadIdx.x == 0) (void)xb_add(&bar[XB_XCNT(b.x)], 1u);
    return b;
}
__device__ __forceinline__ void xcd_barrier_complete(unsigned* bar, unsigned x, unsigned& nloc, unsigned& nx) {
    const unsigned G = gridDim.x * gridDim.y * gridDim.z;
    unsigned sum, cnt, mine, sp = 0u;
    for (;;) {
        sum = 0u; cnt = 0u; mine = 0u;
#pragma unroll
        for (unsigned j = 0; j < 16; ++j) { const unsigned c = xb_ld(&bar[XB_XCNT(j)]); sum += c; cnt += (c > 0u) ? 1u : 0u; mine = (j == x) ? c : mine; }
        if (sum == G) break;
        __builtin_amdgcn_s_sleep(1);
        if ((++sp & 255u) == 0u) { if (xb_ld(&bar[XB_TMO])) break; if (sp > XB_SPIN_CAP) { atomicAdd(&bar[XB_TMO], 1u); break; } }
    }
    nloc = mine > 0u ? mine : 1u; nx = cnt > 0u ? cnt : 1u;
}
__device__ __forceinline__ void xcd_barrier(const XcdBarrier& b, const int wave) {
    asm volatile("s_waitcnt vmcnt(0)" ::: "memory");
    __syncthreads();
    if (wave == 0 && lane_id() == 0) {
        unsigned* bar = b.bar; asm volatile("" : "+s"(bar)); unsigned bx = b.x; asm volatile("" : "+s"(bx));
        __builtin_amdgcn_s_waitcnt(0);
        unsigned nloc = b.st[0], nx = b.st[1];
        if (nloc == 0u) { xcd_barrier_complete(bar, bx, nloc, nx); b.st[0] = nloc; b.st[1] = nx; }
        const unsigned old = xb_add(&bar[XB_XSUB(bx)], 1u);
        const unsigned gen = old / nloc;
        if (old + 1u == (gen + 1u) * nloc) {
            __builtin_amdgcn_fence(__ATOMIC_RELEASE, "agent");
            asm volatile("s_waitcnt vmcnt(0)" ::: "memory");
            const unsigned og = xb_add(&bar[XB_TOP], 1u);
            const unsigned tg = og / nx;
            if (og + 1u == (tg + 1u) * nx) xb_add(&bar[XB_TOPGEN], 1u);
            else XB_SPIN(xb_ld(&bar[XB_TOPGEN]) == tg, bar);
            __builtin_amdgcn_fence(__ATOMIC_ACQUIRE, "agent");
            xb_add(&bar[XB_XGEN(bx)], 1u);
            asm volatile("s_waitcnt vmcnt(0)" ::: "memory");
        } else {
            XB_SPIN(xb_ld(&bar[XB_XGEN(bx)]) == gen, bar);
            __builtin_amdgcn_fence(__ATOMIC_ACQUIRE, "agent");
            asm volatile("s_waitcnt vmcnt(0)" ::: "memory");
        }
    }
    __syncthreads();
}

struct Args {
    const float* in[19];
    float* out; unsigned char* ws;
    int ph_lo, ph_hi;
};
enum { I_X = 0, I_C, I_CTX, I_CCTX, I_WADA, I_BADA, I_GMIX, I_WIN, I_CONVW, I_RPB, I_SINK, I_WBR, I_WOUT, I_GFFN, I_WROUTER, I_WG, I_WU, I_WD, I_GFINAL };

struct Frame {
    unsigned char* lds;
    LAS unsigned char* ldsl;
    unsigned char* ws;
    int wave, vcu, G;
    float* out;
};

constexpr int PTR_OFF = MISC_OFF + 128;
__device__ __forceinline__ const float* inp(const Frame& F, int i) {
    const u32x2 v = *(const LAS u32x2*)(F.ldsl + PTR_OFF + 8 * i);
    const unsigned lo = __builtin_amdgcn_readfirstlane(v.x), hi = __builtin_amdgcn_readfirstlane(v.y);
    return (const float*)(((unsigned long long)hi << 32) | lo);
}
__device__ __forceinline__ float* xrow_dst(const Frame& F, int ch, int cr) {
    return cr < LROWS ? F.out + ((size_t)ch * LROWS + cr) * D : (float*)(F.ws + WS_XC) + (size_t)(cr - LROWS) * D;
}
__device__ __forceinline__ const float* xrow_src(const Frame& F, int l, int ch, int cr) {
    if (l > 0) return xrow_dst(F, ch, cr);
    return cr < LROWS ? inp(F, I_X) + ((size_t)ch * LROWS + cr) * D : inp(F, I_CTX) + (size_t)(cr - LROWS) * D;
}
__device__ __forceinline__ int mv_of(int ch, int cr) { return cr < LROWS ? ch * BC + cr / SEQ : NB; }
__device__ __forceinline__ const float* mod_ptr(const Frame& F, int l, int mv, int which) { return (const float*)(F.ws + WS_MODS) + ((size_t)(l * 33 + mv) * 6 + which) * D; }

__device__ __forceinline__ bf16* hbuf_of(const Frame& F, int ch) { return (bf16*)(F.ws + (ch == 0 ? WS_HBUF : WS_HBUF1)); }
__device__ __forceinline__ bf16* dx_of(const Frame& F, int ch) { return (bf16*)(F.ws + (ch == 0 ? WS_DX0 : WS_DX1)); }
__device__ __forceinline__ float* affl_of(const Frame& F, int ch) { return (float*)(F.ws + WS_AFFL) + (size_t)ch * BC * NE * SEQ; }
__device__ __forceinline__ int* tokslot_of(const Frame& F, int ch) { return (int*)(F.ws + WS_TOKSLOT) + (size_t)ch * RCMAX * NE; }
__device__ __forceinline__ void mods_phase(Frame& F) {
    const int lane = launder(lane_id()), tid = F.wave * 64 + lane; (void)tid; (void)lane;
    float* sl = (float*)F.lds;
    const float* c = inp(F, I_C); const float* cc = inp(F, I_CCTX);
    for (int item = F.vcu; item < DEPTH * 96; item += F.G) {
        const int l = item / 96, jb = item % 96, j = jb * 64 + lane;
        const float* W = inp(F, I_WADA) + (size_t)l * D * 6144;
        float acc[33];
#pragma unroll
        for (int m = 0; m < 33; ++m) acc[m] = 0.f;
        for (int kh = 0; kh < 2; ++kh) {
            __syncthreads();
            for (int i = tid; i < 512 * 33; i += NTHR) { const int k = i % 512, m = i / 512; const float v = (m < 32) ? c[(size_t)m * D + kh * 512 + k] : cc[kh * 512 + k]; sl[k * 36 + m] = v * sigmoidf_(v); }
            __syncthreads();
            for (int kk = 0; kk < 64; ++kk) {
                const int k = F.wave * 64 + kk; const float w = W[(size_t)(kh * 512 + k) * 6144 + j];
                const f32x4* s4 = (const f32x4*)(sl + k * 36);
#pragma unroll
                for (int q = 0; q < 8; ++q) { const f32x4 s = s4[q]; acc[4 * q] += s.x * w; acc[4 * q + 1] += s.y * w; acc[4 * q + 2] += s.z * w; acc[4 * q + 3] += s.w * w; }
                acc[32] += sl[k * 36 + 32] * w;
            }
        }
        __syncthreads();
        float* rd = (float*)F.lds;
#pragma unroll
        for (int m = 0; m < 33; ++m) rd[(F.wave * 33 + m) * 64 + lane] = acc[m];
        __syncthreads();
        for (int i = tid; i < 33 * 64; i += NTHR) { const int m = i / 64, jj = i % 64; float s = 0.f;
#pragma unroll
            for (int w = 0; w < 8; ++w) s += rd[(w * 33 + m) * 64 + jj];
            const int col = jb * 64 + jj;
            ((float*)(F.ws + WS_MODS))[(size_t)(l * 33 + m) * 6144 + col] = s + inp(F, I_BADA)[(size_t)l * 6144 + col]; }
    }
    __syncthreads();
    f32x2* tab = (f32x2*)(F.ws + WS_ROPE);
    for (int i = F.vcu * NTHR + tid; i < SEQ * 32; i += F.G * NTHR) {
        const int pos = i >> 5, fi = i & 31; const float inv = powf(10000.0f, -(float)(fi & 15) / 16.0f);
        const float ang = (fi < 16 ? (float)(pos / 64) : (float)(pos % 64)) * inv;
        tab[i] = (f32x2){cosf(ang), sinf(ang)};
    }
}

__device__ __forceinline__ void transpose_item(const float* W, int K, int N, bf16* WT, int k0, int n0, int orow0, float* scr, int lane, int ldo = 0, int kofs = 0) {
    if (ldo == 0) ldo = K;
    f32x4 v[8];
#pragma unroll
    for (int i = 0; i < 8; ++i) v[i] = *(const f32x4*)(W + (size_t)(k0 + 8 * i + (lane >> 3)) * N + n0 + 4 * (lane & 7));
#pragma unroll
    for (int i = 0; i < 8; ++i) *(f32x4*)(scr + (8 * i + (lane >> 3)) * 36 + 4 * (lane & 7)) = v[i];
    LDS_WAIT(); asm volatile("" ::: "memory");
    const int c = lane & 7;
#pragma unroll
    for (int j = 0; j < 4; ++j) { const int n = (lane >> 3) + 8 * j; const float* s = scr + (8 * c) * 36 + n;
        u32x4 o; o.x = pk2(s[0 * 36], s[1 * 36]); o.y = pk2(s[2 * 36], s[3 * 36]); o.z = pk2(s[4 * 36], s[5 * 36]); o.w = pk2(s[6 * 36], s[7 * 36]);
        *(u32x4*)(WT + (size_t)(orow0 + n) * ldo + kofs + k0 + 8 * c) = o; }
    LDS_WAIT(); asm volatile("" ::: "memory");
}
__device__ __forceinline__ void wconv_phase(Frame& F, int l) {
    const int lane = launder(lane_id()), tid = F.wave * 64 + lane; (void)tid; (void)lane;
    float* scr = (float*)(F.lds + F.wave * 16384);
    const int gw = F.vcu * NWAVES + F.wave, NGW = F.G * NWAVES;
    constexpr int I_IN = 16 * 216, I_BR = 3 * 8 * 32, I_OUT = 16 * 32, I_EX = 16 * 16 * 32;
    constexpr int NITEMS = I_IN + I_BR + I_OUT + 3 * I_EX;
    for (int it = gw; it < NITEMS; it += NGW) {
        int r = it;
        if (r < I_IN) { const int kb = r / 216, nb = r % 216; transpose_item(inp(F, I_WIN) + (size_t)l * D * INW, D, INW, (bf16*)(F.ws + WS_WIN), kb * 64, nb * 32, nb * 32, scr, lane); continue; } r -= I_IN;
        if (r < I_BR) { const int br = r / 256, q = r % 256, kb = q / 32, nb = q % 32;
            transpose_item(inp(F, I_WBR) + ((size_t)l * 3 + br) * 512 * D, 512, D, (bf16*)(F.ws + WS_WBR), kb * 64, nb * 32, nb * 32, scr, lane, 1536, br * 512); continue; } r -= I_BR;
        if (r < I_OUT) { const int kb = r / 32, nb = r % 32; transpose_item(inp(F, I_WOUT) + (size_t)l * D * D, D, D, (bf16*)(F.ws + WS_WOUT), kb * 64, nb * 32, nb * 32, scr, lane); continue; } r -= I_OUT;
        if (r < 2 * I_EX) { const int s = r / I_EX, q = r % I_EX, e = q / 512, q2 = q % 512, kb = q2 / 32, nb = q2 % 32, n0 = nb * 32;
            const float* W = inp(F, s ? I_WU : I_WG) + ((size_t)l * NE + e) * D * FF;
            transpose_item(W, D, FF, (bf16*)(F.ws + WS_WUP) + (size_t)e * 2048 * D, kb * 64, n0, 256 * (n0 / 128) + 128 * s + (n0 % 128), scr, lane); continue; } r -= 2 * I_EX;
        { const int e = r / 512, q2 = r % 512, kb = q2 / 32, nb = q2 % 32;
            transpose_item(inp(F, I_WD) + ((size_t)l * NE + e) * FF * D, FF, D, (bf16*)(F.ws + WS_WDN) + (size_t)e * D * FF, kb * 64, nb * 32, nb * 32, scr, lane); }
    }
}

__device__ __forceinline__ float xsel(bool c, float a, float b) { return c ? a : b; }
template <bool ROUTER>
__device__ __forceinline__ void norm_phase(Frame& F, int l, int ch, int nrows, bool dry = false) {
    const int lane = launder(lane_id()), tid = F.wave * 64 + lane; (void)tid; (void)lane;
    const int gw = F.vcu * NWAVES + F.wave, NGW = F.G * NWAVES;
    float* wr_l = (float*)F.lds;
    if (ROUTER) {
        const float* wr = inp(F, I_WROUTER) + (size_t)l * D * NE;
        for (int i = tid; i < D * NE; i += NTHR) { const int d = i >> 4, e = i & 15; wr_l[e * D + d] = wr[i]; }
        __syncthreads();
    }
    const float* gv = inp(F, ROUTER ? I_GFFN : I_GMIX) + (size_t)l * D;
    bf16* hb = dry ? (bf16*)(F.ws + WS_OBUF + 160 * MiB) : (bf16*)(F.ws + (ch == 0 ? WS_HBUF : WS_HBUF1));
    const bf16* dxb = dx_of(F, ch);
    f32x4 nx[2][4]; u32x2 nd[2][4];
#define NP_LOAD(c0) do { _Pragma("unroll") for (int rr_ = 0; rr_ < 2; ++rr_) { const float* xr_ = xrow_src(F, l, ch, (c0) + rr_); \
        _Pragma("unroll") for (int j_ = 0; j_ < 4; ++j_) { nx[rr_][j_] = *(const f32x4*)(xr_ + lane * 4 + 256 * j_); if (ROUTER) nd[rr_][j_] = *(const u32x2*)(dxb + (size_t)((c0) + rr_) * D + lane * 4 + 256 * j_); } } } while (0)
    const int rpw = (((nrows + NGW - 1) / NGW) + 1) & ~1, rbeg = gw * rpw, rend = (rbeg + rpw < nrows) ? rbeg + rpw : nrows;
    f32x4 gq[4], shq[4], scq[4]; int cmv = -1;
#pragma unroll
    for (int j = 0; j < 4; ++j) gq[j] = *(const f32x4*)(gv + lane * 4 + 256 * j);
    if (rbeg < rend) NP_LOAD(rbeg);
    for (int cr0 = rbeg; cr0 < rend; cr0 += 2) {
        f32x4 v[2][4]; u32x2 dv[2][4];
#pragma unroll
        for (int rr = 0; rr < 2; ++rr)
#pragma unroll
            for (int j = 0; j < 4; ++j) { v[rr][j] = nx[rr][j]; if (ROUTER) dv[rr][j] = nd[rr][j]; }
        if (cr0 + 2 < rend) NP_LOAD(cr0 + 2);
#pragma unroll
        for (int rr = 0; rr < 2; ++rr) {
            const int cr = cr0 + rr;
            const int mv = mv_of(ch, cr);
            if (mv != cmv) { cmv = mv; const float* sh = mod_ptr(F, l, mv, ROUTER ? 3 : 0); const float* sc = mod_ptr(F, l, mv, ROUTER ? 4 : 1);
#pragma unroll
                for (int j = 0; j < 4; ++j) { shq[j] = *(const f32x4*)(sh + lane * 4 + 256 * j); scq[j] = *(const f32x4*)(sc + lane * 4 + 256 * j); } }
            float ss = 0.f;
#pragma unroll
            for (int j = 0; j < 4; ++j) {
                if (ROUTER) {
                    const u32x2 dd = dv[rr][j];
                    v[rr][j].x += bflo(dd.x); v[rr][j].y += bfhi(dd.x); v[rr][j].z += bflo(dd.y); v[rr][j].w += bfhi(dd.y); }
                ss += (v[rr][j].x * v[rr][j].x + v[rr][j].y * v[rr][j].y) + (v[rr][j].z * v[rr][j].z + v[rr][j].w * v[rr][j].w); }
            const float rstd = 1.0f / sqrtf(wave_sum(ss) * (1.0f / D) + RMS_EPS);
#pragma unroll
            for (int j = 0; j < 4; ++j) {
                v[rr][j] = (v[rr][j] * rstd * gq[j]) * (scq[j] + 1.0f) + shq[j];
                u32x2 o; o.x = pk2(v[rr][j].x, v[rr][j].y); o.y = pk2(v[rr][j].z, v[rr][j].w);
                *(u32x2*)(hb + (size_t)cr * D + lane * 4 + 256 * j) = o;
            }
        }
#undef NP_LOAD
        if (ROUTER) {
            const bool b5 = lane & 32, b4 = lane & 16, b3 = lane & 8;
            float lg[2][2];
#pragma unroll
            for (int hf = 0; hf < 2; ++hf) {
                float a[2][8];
#pragma unroll
                for (int e = 0; e < 8; ++e) {
                    f32x4 w[4];
#pragma unroll
                    for (int j = 0; j < 4; ++j) w[j] = *(const f32x4*)(wr_l + (hf * 8 + e) * D + lane * 4 + 256 * j);
#pragma unroll
                    for (int rr = 0; rr < 2; ++rr) { float t = 0.f;
#pragma unroll
                        for (int j = 0; j < 4; ++j) t += (v[rr][j].x * w[j].x + v[rr][j].y * w[j].y) + (v[rr][j].z * w[j].z + v[rr][j].w * w[j].w);
                        a[rr][e] = t; }
                    if (e & 1) __builtin_amdgcn_sched_barrier(0);
                }
#pragma unroll
                for (int rr = 0; rr < 2; ++rr) {
                    float c[4], d2[2];
#pragma unroll
                    for (int i = 0; i < 4; ++i) { const float recv = __shfl_xor(xsel(b5, a[rr][i], a[rr][i + 4]), 32); c[i] = xsel(b5, a[rr][i + 4], a[rr][i]) + recv; }
#pragma unroll
                    for (int i = 0; i < 2; ++i) { const float recv = __shfl_xor(xsel(b4, c[i], c[i + 2]), 16); d2[i] = xsel(b4, c[i + 2], c[i]) + recv; }
                    float t = xsel(b3, d2[1], d2[0]) + __shfl_xor(xsel(b3, d2[0], d2[1]), 8);
                    t += __shfl_xor(t, 4); t += __shfl_xor(t, 2); t += __shfl_xor(t, 1);
                    lg[hf][rr] = t;
                }
                __builtin_amdgcn_sched_barrier(0);
            }
#pragma unroll
            for (int rr = 0; rr < 2; ++rr) {
                float m = fmaxf(lg[0][rr], lg[1][rr]);
#pragma unroll
                for (int o = 8; o < 64; o <<= 1) m = fmaxf(m, __shfl_xor(m, o));
                const float p0 = expf(lg[0][rr] - m), p1 = expf(lg[1][rr] - m); float s = p0 + p1;
#pragma unroll
                for (int o = 8; o < 64; o <<= 1) s += __shfl_xor(s, o);
                const float inv = 1.0f / s;
                const int cr = cr0 + rr, e = lane >> 3;
                if ((lane & 7) < 2 && !dry) {
                    const int ee = (lane & 1) ? e + 8 : e; const float mine = ((lane & 1) ? p1 : p0) * inv;
                    if (cr < LROWS) { const int bl = cr / SEQ, t = cr % SEQ; affl_of(F, ch)[(size_t)(bl * NE + ee) * SEQ + t] = mine; }
                    else { const int j = cr - LROWS, bl = j / CTX, t = j % CTX; ((float*)(F.ws + WS_AFFC))[(size_t)(bl * NE + ee) * CTX + t] = mine; }
                }
            }
        }
    }
}

__device__ __forceinline__ const bf16* zrow(const Frame& F, int cr) { return (const bf16*)(F.ws + WS_Z) + (size_t)cr * ZW; }

__device__ __forceinline__ void conv_phase(Frame& F, int l, int nrows) {
    const int lane = launder(lane_id()), tid = F.wave * 64 + lane; (void)tid; (void)lane;
    const int gw = F.vcu * NWAVES + F.wave, NGW = F.G * NWAVES;
    const float* cw = inp(F, I_CONVW) + (size_t)l * 3 * 512;
    float w[3][8];
#pragma unroll
    for (int k = 0; k < 3; ++k)
#pragma unroll
        for (int j = 0; j < 8; ++j) w[k][j] = cw[k * 512 + lane * 8 + j];
    bf16* ob = (bf16*)(F.ws + WS_OBUF);
    const int rpw = (nrows + NGW - 1) / NGW, rbeg = gw * rpw, rend = (rbeg + rpw < nrows) ? rbeg + rpw : nrows;
    if (rbeg >= rend) return;
#define CV_SEQ(cr_) ((cr_) < LROWS ? (cr_) / SEQ : 1024 + ((cr_) - LROWS) / CTX)
#define CV_LOADP(cr_, P) do { const bf16* zr_ = zrow(F, (cr_)); float c8_[8], x8_[8]; unpack8(*(const u32x4*)(zr_ + Z_AC + lane * 8), c8_); unpack8(*(const u32x4*)(zr_ + Z_AX + lane * 8), x8_); \
        _Pragma("unroll") for (int j_ = 0; j_ < 8; ++j_) (P)[j_] = c8_[j_] * x8_[j_]; } while (0)
    float pp[8], pc[8], pn[8];
#pragma unroll
    for (int j = 0; j < 8; ++j) pp[j] = 0.f;
    if (rbeg > 0 && CV_SEQ(rbeg - 1) == CV_SEQ(rbeg)) CV_LOADP(rbeg - 1, pp);
    CV_LOADP(rbeg, pc);
    for (int cr = rbeg; cr < rend; ++cr) {
        const bool hasn = cr + 1 < nrows, same = hasn && CV_SEQ(cr + 1) == CV_SEQ(cr);
#pragma unroll
        for (int j = 0; j < 8; ++j) pn[j] = 0.f;
        if (hasn) CV_LOADP(cr + 1, pn);
        float b8[8]; unpack8(*(const u32x4*)(zrow(F, cr) + Z_AB + lane * 8), b8);
        float acc[8];
#pragma unroll
        for (int j = 0; j < 8; ++j) acc[j] = w[0][j] * pp[j] + w[1][j] * pc[j] + (same ? w[2][j] * pn[j] : 0.f);
        u32x4 o; o.x = pk2(b8[0] * acc[0], b8[1] * acc[1]); o.y = pk2(b8[2] * acc[2], b8[3] * acc[3]); o.z = pk2(b8[4] * acc[4], b8[5] * acc[5]); o.w = pk2(b8[6] * acc[6], b8[7] * acc[7]);
        *(u32x4*)(ob + (size_t)cr * OW + lane * 8) = o;
#pragma unroll
        for (int j = 0; j < 8; ++j) { pp[j] = same ? pc[j] : 0.f; pc[j] = pn[j]; }
    }
#undef CV_SEQ
#undef CV_LOADP
}

struct NaiveState { unsigned q[32]; float o[64], m, l; };
__device__ __forceinline__ void load64(const bf16* p, float* f) {
#pragma unroll
    for (int i = 0; i < 8; ++i) unpack8(*(const u32x4*)(p + 8 * i), f + 8 * i);
}
__device__ __forceinline__ void rope64(float* x, const f32x2* tabrow) {
#pragma unroll
    for (int i = 0; i < 32; ++i) { const f32x2 cs = tabrow[i]; const float a = x[i], b = x[i + 32]; x[i] = a * cs.x - b * cs.y; x[i + 32] = a * cs.y + b * cs.x; }
}
__device__ __forceinline__ void naive_visit(NaiveState& st, const bf16* kp, const bf16* vp, float bias, bool valid, const f32x2* ropetab) {
    float s = 0.f;
#pragma unroll
    for (int c = 0; c < 4; ++c) {
        float a[8], b[8]; unpack8(*(const u32x4*)(kp + 8 * c), a); unpack8(*(const u32x4*)(kp + 32 + 8 * c), b);
        if (ropetab) {
#pragma unroll
            for (int i = 0; i < 8; ++i) { const f32x2 cs = ropetab[8 * c + i]; const float x1 = a[i], x2 = b[i]; a[i] = x1 * cs.x - x2 * cs.y; b[i] = x1 * cs.y + x2 * cs.x; }
        }
#pragma unroll
        for (int i = 0; i < 8; ++i) s += bflo(st.q[8 * c + i]) * a[i] + bfhi(st.q[8 * c + i]) * b[i];
    }
    s = valid ? s + bias : -1e30f;
    const float mn = fmaxf(st.m, s), alpha = __expf(st.m - mn), p = __expf(s - mn);
    st.m = mn; st.l = st.l * alpha + p;
#pragma unroll
    for (int c = 0; c < 8; ++c) { float v[8]; unpack8(*(const u32x4*)(vp + 8 * c), v);
#pragma unroll
        for (int i = 0; i < 8; ++i) st.o[8 * c + i] = st.o[8 * c + i] * alpha + p * v[i]; }
}
__device__ __forceinline__ void naive_attn_phase(Frame& F, int l, int ch, bool last, bf16* ob) {
    const int lane = launder(lane_id()), tid = F.wave * 64 + lane; (void)tid; (void)lane;
    const int n_lat = LROWS / 64, n_ctx = (last || ch != 0) ? 0 : CTXALL / 64;
    const int nunits = 2 * n_lat + 2 * n_ctx;
    const f32x2* tab = (const f32x2*)(F.ws + WS_ROPE);
    for (int u = F.vcu; u < nunits; u += F.G) {
        int type, blk;
        if (u < n_lat) { type = 0; blk = u; } else if (u < 2 * n_lat) { type = 1; blk = u - n_lat; } else if (u < 2 * n_lat + n_ctx) { type = 2; blk = u - 2 * n_lat; } else { type = 3; blk = u - 2 * n_lat - n_ctx; }
        const int h = F.wave;
        const int cr0 = (type < 2) ? blk * 64 : LROWS + blk * 64, cr = cr0 + lane;
        const int bl = (type < 2) ? ch * BC + cr0 / SEQ : (cr0 - LROWS) / CTX;
        const int t0 = (type < 2) ? cr0 % SEQ : (cr0 - LROWS) % CTX, t = t0 + lane;
        const int ctx0 = LROWS + bl * CTX;
        const bool sw = (type == 0 || type == 3);
        const int hk = sw ? h / 4 : h;
        const int qcol = (sw ? Z_SQ : Z_NQ) + 64 * h, kcol = (sw ? Z_SK : Z_NK) + 64 * hk, vcol = (sw ? Z_SV : Z_NV) + 64 * hk;
        NaiveState st;
        { float qf[64]; load64(zrow(F, cr) + qcol, qf);
          if (type == 0) rope64(qf, tab + (size_t)t * 32);
#pragma unroll
          for (int i = 0; i < 32; ++i) st.q[i] = pk2(qf[i] * 0.125f, qf[i + 32] * 0.125f);
#pragma unroll
          for (int i = 0; i < 64; ++i) st.o[i] = 0.f; }
        if (sw) { st.m = inp(F, I_SINK)[l * 8 + h]; st.l = 1.f; } else { st.m = -1e30f; st.l = 0.f; }
        const int lo = t0 - 128 < 0 ? 0 : t0 - 128, hi = t0 + 63 + 128 > SEQ - 1 ? SEQ - 1 : t0 + 63 + 128;
        const int r = t0 / 64, c = lane; int rs = r - 4; rs = rs < 0 ? 0 : (rs > 24 ? 24 : rs); int cs = c - 8; cs = cs < 0 ? 0 : (cs > 48 ? 48 : cs);
        const float* rpb = inp(F, I_RPB) + ((size_t)l * 8 + h) * 15 * 31;
        const int nloc = type == 0 ? hi - lo + 1 : (type == 1 ? 512 : 0);
#pragma unroll 1
        for (int idx = 0; idx < CTX + nloc; ++idx) {
            const bf16* zr; float bias = 0.f; bool valid = true; const f32x2* rt = nullptr;
            if (idx < CTX) zr = zrow(F, ctx0 + idx);
            else if (type == 0) { const int j = lo + idx - CTX, dlt = t - j; zr = zrow(F, cr0 - t0 + j); valid = dlt <= 128 && dlt >= -128; rt = tab + (size_t)j * 32; }
            else { const int q = idx - CTX, kr = rs + (q >> 6), kc = q & 63; zr = zrow(F, cr0 - t0 + kr * 64 + kc); valid = kc >= cs && kc < cs + 16;
                int dc = kc - c + 15; dc = dc < 0 ? 0 : (dc > 30 ? 30 : dc); bias = rpb[(kr - r + 7) * 31 + dc]; }
            naive_visit(st, zr + kcol, zr + vcol, bias, valid, rt);
        }
        const float inv = 1.0f / st.l;
        bf16* op = ob + (size_t)cr * OW + (sw ? 1024 : 512) + 64 * h;
#pragma unroll
        for (int i = 0; i < 8; ++i) { u32x4 o; o.x = pk2(st.o[8 * i] * inv, st.o[8 * i + 1] * inv); o.y = pk2(st.o[8 * i + 2] * inv, st.o[8 * i + 3] * inv); o.z = pk2(st.o[8 * i + 4] * inv, st.o[8 * i + 5] * inv); o.w = pk2(st.o[8 * i + 6] * inv, st.o[8 * i + 7] * inv);
            *(u32x4*)(op + 8 * i) = o; }
    }
}

typedef short s16x4 __attribute__((ext_vector_type(4)));
typedef float f32x16 __attribute__((ext_vector_type(16)));
typedef __bf16 bf16x2_t __attribute__((ext_vector_type(2)));
__device__ __forceinline__ unsigned cvtpk(float lo, float hi) { const f32x2 v = {lo, hi}; return __builtin_bit_cast(unsigned, __builtin_convertvector(v, bf16x2_t)); }
typedef short v4i16_t __attribute__((ext_vector_type(4)));
__device__ __forceinline__ s16x4 vtr(const LAS unsigned char* p) { return __builtin_bit_cast(s16x4, __builtin_amdgcn_ds_read_tr16_b64_v4i16((LAS v4i16_t*)p)); }
constexpr int AK_RS = 144, AV_RS = 192, AK_BYTES = 128 * AK_RS, AV_BYTES = 128 * AV_RS, ASTAGE = AK_BYTES + AV_BYTES, A_RPB_OFF = 2 * ASTAGE;
#define MFMA32(a, b, c) __builtin_amdgcn_mfma_f32_32x32x16_bf16((a), (b), (c), 0, 0, 0)
__device__ __forceinline__ float xlane32(float v) {
    const auto rr = __builtin_amdgcn_permlane32_swap(__builtin_bit_cast(unsigned, v), __builtin_bit_cast(unsigned, v), false, false);
    return __builtin_bit_cast(float, (lane_id() & 32) ? rr[0] : rr[1]);
}
__device__ __forceinline__ float max3f(float a, float b, float c) { return fmaxf(fmaxf(a, b), c); }
__device__ __forceinline__ float rowmax32(const f32x16& p0, const f32x16& p1) {
    float a = max3f(p0[0], p0[1], p1[0]), b = max3f(p0[2], p0[3], p1[1]); a = max3f(a, p1[2], p1[3]);
#pragma unroll
    for (int i = 4; i < 16; i += 4) { a = max3f(a, p0[i], p0[i + 1]); b = max3f(b, p0[i + 2], p0[i + 3]); a = max3f(a, p1[i], p1[i + 1]); b = max3f(b, p1[i + 2], p1[i + 3]); }
    const float m = fmaxf(a, b);
    const auto rr = __builtin_amdgcn_permlane32_swap(__builtin_bit_cast(unsigned, m), __builtin_bit_cast(unsigned, m), false, false);
    return fmaxf(__builtin_bit_cast(float, rr[0]), __builtin_bit_cast(float, rr[1]));
}
__device__ __forceinline__ void lds_read_vt8(unsigned addr, s16x4 (&t)[8]) {
    asm volatile("ds_read_b64_tr_b16 %0, %8\n\tds_read_b64_tr_b16 %1, %8 offset:1536\n\tds_read_b64_tr_b16 %2, %8 offset:64\n\tds_read_b64_tr_b16 %3, %8 offset:1600\n\t"
                 "ds_read_b64_tr_b16 %4, %8 offset:3072\n\tds_read_b64_tr_b16 %5, %8 offset:4608\n\tds_read_b64_tr_b16 %6, %8 offset:3136\n\tds_read_b64_tr_b16 %7, %8 offset:4672\n\t"
                 "s_waitcnt lgkmcnt(0)"
        : "=&v"(t[0]), "=&v"(t[1]), "=&v"(t[2]), "=&v"(t[3]), "=&v"(t[4]), "=&v"(t[5]), "=&v"(t[6]), "=&v"(t[7]) : "v"(addr) : "memory");
}
static_assert(16 * 192 == 3072 && 8 * 192 == 1536, "lds_read_vt8 offsets assume AV_RS = 192");
__device__ __forceinline__ void lds_read_k4(unsigned addr, bf16x8 (&ka)[4]) {
    asm volatile("ds_read_b128 %0, %4\n\tds_read_b128 %1, %4 offset:32\n\tds_read_b128 %2, %4 offset:64\n\tds_read_b128 %3, %4 offset:96\n\ts_waitcnt lgkmcnt(0)"
        : "=&v"(ka[0]), "=&v"(ka[1]), "=&v"(ka[2]), "=&v"(ka[3]) : "v"(addr) : "memory");
}
__device__ __forceinline__ void lds_read_k8(unsigned addr, bf16x8 (&ka)[4], bf16x8 (&kb)[4]) {
    asm volatile("ds_read_b128 %0, %8\n\tds_read_b128 %1, %8 offset:32\n\tds_read_b128 %2, %8 offset:64\n\tds_read_b128 %3, %8 offset:96\n\t"
                 "ds_read_b128 %4, %8 offset:4608\n\tds_read_b128 %5, %8 offset:4640\n\tds_read_b128 %6, %8 offset:4672\n\tds_read_b128 %7, %8 offset:4704\n\t"
                 "s_waitcnt lgkmcnt(0)"
        : "=&v"(ka[0]), "=&v"(ka[1]), "=&v"(ka[2]), "=&v"(ka[3]), "=&v"(kb[0]), "=&v"(kb[1]), "=&v"(kb[2]), "=&v"(kb[3]) : "v"(addr) : "memory");
}
constexpr int A_ROPE_OFF = A_RPB_OFF + 4096;
template <int VAR, int TY>
__device__ __forceinline__ void attn_units(Frame& F, int l, int ch, bool last, bf16* ob) {
    const int lane = launder(lane_id()), tid = F.wave * 64 + lane;
    const int wave = F.wave, r = lane & 31, hh = lane >> 5;
    const float LOG2E = 1.4426950408889634f;
    const f32x2* tab = (const f32x2*)(F.ws + WS_ROPE); (void)tab;
    float* rpbl = (float*)(F.lds + A_RPB_OFF);
    const int skey = tid >> 2, sc = tid & 3, sb = skey >> 6, srow = skey & 63;
    const int nNA = BC * 8 * 8, nSW = BC * 16 * 4, nCX = (last || ch != 0) ? 0 : NB * 8 * 2;
    const int ubeg = (TY == 1) ? 0 : (TY == 0 ? nNA : nNA + nSW), uend = (TY == 1) ? nNA : (TY == 0 ? nNA + nSW : nNA + nSW + nCX);
    for (int u = ubeg + F.vcu; u < uend; u += F.G) {
        int type, bl, h, rg = 0, n = 0;
        if (u < nNA) { type = 1; bl = u >> 6; rg = ((u >> 3) + (u >> 8)) & 7; h = u & 7; }
        else if (u < nNA + nSW) { const int v = u - nNA; type = 0; bl = v >> 6; n = ((v >> 2) + 4 * (v >> 8)) & 15; h = 4 * ((v >> 1) & 1) + 2 * (v & 1); }
        else { const int v = u - nNA - nSW; type = (v < NB * 8) ? 2 : 3; const int vv = v % (NB * 8); bl = vv >> 3; h = vv & 7; }
        if (TY != 2) type = TY;
        const bool sw = (type == 0 || type == 3);
        const int head = (type == 0) ? h + (wave >> 2) : h;
        const int jb = wave & 3;
        const int rq = 4 * rg + 2 * (wave >> 2) + (r >> 4), cq = 16 * jb + (r & 15);
        const int qrow = (type == 1) ? bl * SEQ + 64 * rq + cq : (type == 0) ? bl * SEQ + 128 * n + 32 * (wave & 3) + r : LROWS + bl * CTX + 32 * wave + r;
        const int qcol = (sw ? Z_SQ : Z_NQ) + 64 * head, kcol = sw ? Z_SK + 64 * (head >> 2) : Z_NK + 64 * head, vcol = sw ? Z_SV + 64 * (head >> 2) : Z_NV + 64 * head;
        const int ocol = (sw ? 1024 : 512) + 64 * head;
        const int ctx0 = LROWS + ((type < 2) ? ch * BC + bl : bl) * CTX;
        int nloc = 0, loc0 = 0;
        if (type == 0) { const int jlo = (n == 0) ? 2 : 0, jhi = (n == 15) ? 3 : 5; nloc = jhi - jlo + 1; loc0 = jlo; }
        else if (type == 1) { int a = 4 * rg - 4; a = a < 0 ? 0 : (a > 24 ? 24 : a); int b = 4 * rg - 1; b = b < 0 ? 0 : (b > 24 ? 24 : b); loc0 = a; nloc = b + 7 - a + 1; }
        const int nt = 4 + nloc;
        bf16x8 qf[4];
        {
            const bf16* qp = zrow(F, qrow) + qcol + 8 * hh;
            float q[4][8];
#pragma unroll
            for (int s4 = 0; s4 < 4; ++s4) unpack8(*(const u32x4*)(qp + 16 * s4), q[s4]);
            if (type == 0) {
                const int pos = qrow - bl * SEQ; const f32x2* rl = (const f32x2*)(F.lds + A_ROPE_OFF);
#pragma unroll
                for (int s4 = 0; s4 < 2; ++s4) { const f32x2* tr = rl + (s4 == 0 ? (pos >> 6) : 32 + (pos & 63)) * 16 + 8 * hh;
#pragma unroll
                    for (int j = 0; j < 8; ++j) { const f32x2 cs = tr[j]; const float x1 = q[s4][j], x2 = q[s4 + 2][j]; q[s4][j] = x1 * cs.x - x2 * cs.y; q[s4 + 2][j] = x1 * cs.y + x2 * cs.x; } }
            }
            const float qs = 0.125f * LOG2E;
#pragma unroll
            for (int s4 = 0; s4 < 4; ++s4) { u32x4 p; p.x = cvtpk(q[s4][0] * qs, q[s4][1] * qs); p.y = cvtpk(q[s4][2] * qs, q[s4][3] * qs); p.z = cvtpk(q[s4][4] * qs, q[s4][5] * qs); p.w = cvtpk(q[s4][6] * qs, q[s4][7] * qs);
                qf[s4] = __builtin_bit_cast(bf16x8, p); }
        }
        float m = 0.f, lsum = 0.f;
        if (sw) { m = inp(F, I_SINK)[l * 8 + head] * LOG2E; lsum = (hh == 0) ? 1.f : 0.f; }
        f32x16 o0, o1;
#pragma unroll
        for (int i = 0; i < 16; ++i) { o0[i] = 0.f; o1[i] = 0.f; }
        const int kst = (type == 1) ? (16 * jb - 8 < 0 ? 0 : (16 * jb - 8 > 32 ? 32 : 16 * jb - 8)) : 0;
        unsigned bixp[4] = {0u, 0u, 0u, 0u};
        {
            const int csq = cq - 8 < 0 ? 0 : (cq - 8 > 48 ? 48 : cq - 8);
#pragma unroll
            for (int i = 0; i < 16; ++i) { const int kc = kst + (i & 3) + 8 * (i >> 2) + 4 * hh; bixp[i >> 2] |= (unsigned)(((kc >= csq && kc <= csq + 15) ? kc - cq + 15 : 31) * 4) << (8 * (i & 3)); }
        }
#define BIX(i) ((bixp[(i) >> 2] >> (8 * ((i) & 3))) & 0xffu)
        const int rsl = rq - 4 < 0 ? 0 : (rq - 4 > 24 ? 24 : rq - 4);
        u32x4 gk0, gk1, gv0, gv1;
        bool grope = false; int gpos = 0;
#define A_TILE_ROW0(ti) ((ti) < 4 ? ctx0 + 64 * (ti) : (type == 0 ? bl * SEQ + 128 * n - 128 + 64 * (loc0 + (ti) - 4) : bl * SEQ + 64 * (loc0 + (ti) - 4)))
#define A_STAGE_LOAD(T) do { const int ti_ = 2 * (T) + sb; const int tic_ = ti_ < nt ? ti_ : nt - 1; const int row0_ = A_TILE_ROW0(tic_); const bf16* sp_ = zrow(F, row0_ + srow) + 8 * sc; \
            gk0 = *(const u32x4*)(sp_ + kcol); gk1 = *(const u32x4*)(sp_ + kcol + 32); gv0 = *(const u32x4*)(sp_ + vcol); gv1 = *(const u32x4*)(sp_ + vcol + 32); grope = (type == 0 && tic_ >= 4); gpos = row0_ - bl * SEQ + srow; } while (0)
#define A_STAGE_WRITE(st) do { unsigned char* dk_ = F.lds + (st) * ASTAGE + skey * AK_RS + 16 * sc; unsigned char* dv_ = F.lds + (st) * ASTAGE + AK_BYTES + skey * AV_RS + 16 * sc; \
            if (grope) { float a_[8], b_[8]; unpack8(gk0, a_); unpack8(gk1, b_); \
                const f32x4* rl_ = (const f32x4*)(F.lds + A_ROPE_OFF + ((sc < 2 ? (gpos >> 6) : 32 + (gpos & 63)) * 16 + 8 * (sc & 1)) * 8); \
                _Pragma("unroll") for (int j_ = 0; j_ < 4; ++j_) { const f32x4 rcj_ = rl_[j_]; const float c0_ = rcj_.x, s0_ = rcj_.y, c1_ = rcj_.z, s1_ = rcj_.w; \
                    const float x1_ = a_[2 * j_], x2_ = b_[2 * j_], y1_ = a_[2 * j_ + 1], y2_ = b_[2 * j_ + 1]; \
                    a_[2 * j_] = x1_ * c0_ - x2_ * s0_; b_[2 * j_] = x1_ * s0_ + x2_ * c0_; a_[2 * j_ + 1] = y1_ * c1_ - y2_ * s1_; b_[2 * j_ + 1] = y1_ * s1_ + y2_ * c1_; } \
                gk0.x = cvtpk(a_[0], a_[1]); gk0.y = cvtpk(a_[2], a_[3]); gk0.z = cvtpk(a_[4], a_[5]); gk0.w = cvtpk(a_[6], a_[7]); \
                gk1.x = cvtpk(b_[0], b_[1]); gk1.y = cvtpk(b_[2], b_[3]); gk1.z = cvtpk(b_[4], b_[5]); gk1.w = cvtpk(b_[6], b_[7]); } \
            *(u32x4*)dk_ = gk0; *(u32x4*)(dk_ + 64) = gk1; *(u32x4*)dv_ = gv0; *(u32x4*)(dv_ + 64) = gv1; } while (0)
#define A_QK(XV, kbase) do { bf16x8 k4_[4]; lds_read_k4((unsigned)(size_t)(kbase), k4_); _Pragma("unroll") for (int i_ = 0; i_ < 16; ++i_) (XV)[i_] = -m; \
            _Pragma("unroll") for (int s4_ = 0; s4_ < 4; ++s4_) (XV) = MFMA32(k4_[s4_], qf[s4_], (XV)); } while (0)
#define A_QK2(XA, XB, kbA) do { bf16x8 ka_[4], kb_[4]; lds_read_k8((unsigned)(size_t)(kbA), ka_, kb_); \
            _Pragma("unroll") for (int i_ = 0; i_ < 16; ++i_) { (XA)[i_] = -m; (XB)[i_] = -m; } \
            _Pragma("unroll") for (int s4_ = 0; s4_ < 4; ++s4_) { (XA) = MFMA32(ka_[s4_], qf[s4_], (XA)); (XB) = MFMA32(kb_[s4_], qf[s4_], (XB)); } } while (0)
#define A_NEG(XV) do { _Pragma("unroll") for (int i_ = 0; i_ < 16; ++i_) (XV)[i_] = -1e30f; } while (0)
#define A_PV(XV, vbase) do { u32x4 pa_, pb_; \
            pa_.x = cvtpk((XV)[0], (XV)[1]); pa_.y = cvtpk((XV)[2], (XV)[3]); pa_.z = cvtpk((XV)[4], (XV)[5]); pa_.w = cvtpk((XV)[6], (XV)[7]); \
            pb_.x = cvtpk((XV)[8], (XV)[9]); pb_.y = cvtpk((XV)[10], (XV)[11]); pb_.z = cvtpk((XV)[12], (XV)[13]); pb_.w = cvtpk((XV)[14], (XV)[15]); \
            s16x4 t_[8]; lds_read_vt8((unsigned)(size_t)(vbase), t_); \
            const bf16x8 pfa_ = __builtin_bit_cast(bf16x8, pa_), pfb_ = __builtin_bit_cast(bf16x8, pb_); \
            o0 = MFMA32(__builtin_shufflevector(t_[0], t_[1], 0, 1, 2, 3, 4, 5, 6, 7), pfa_, o0); o1 = MFMA32(__builtin_shufflevector(t_[2], t_[3], 0, 1, 2, 3, 4, 5, 6, 7), pfa_, o1); \
            o0 = MFMA32(__builtin_shufflevector(t_[4], t_[5], 0, 1, 2, 3, 4, 5, 6, 7), pfb_, o0); o1 = MFMA32(__builtin_shufflevector(t_[6], t_[7], 0, 1, 2, 3, 4, 5, 6, 7), pfb_, o1); } while (0)
        if (type == 1) { const float* rp = inp(F, I_RPB) + ((size_t)l * 8 + h) * 465;
            for (int i = tid; i < 17 * 32; i += NTHR) { const int tr = i >> 5, tc = i & 31; rpbl[i] = (tr >= 1 && tr <= 15 && tc < 31) ? rp[(tr - 1) * 31 + tc] * LOG2E : -1e30f; } }
        A_STAGE_LOAD(0); A_STAGE_WRITE(0);
        __syncthreads();
        const int qi = 32 * (wave & 3) + r;
        const LAS unsigned char* ldsl = F.ldsl;
        const int kro = r * AK_RS + 16 * hh;
        const int vro = (4 * hh + ((r & 15) >> 2)) * AV_RS + (16 * (r >> 4) + 4 * (r & 3)) * 2;
        const int krw = kro + kst * AK_RS, vrw = vro + kst * AV_RS;
        const int rqa = 4 * rg + 2 * (wave >> 2), rsa = rqa - 4 < 0 ? 0 : (rqa - 4 > 24 ? 24 : rqa - 4), rsb = rqa - 3 < 0 ? 0 : (rqa - 3 > 24 ? 24 : rqa - 3);
        const int nT = (nt + 1) >> 1;
#pragma unroll 1
        for (int T = 0; T < nT; ++T) {
            const int st = T & 1;
            if (VAR != 1) { if (T + 1 < nT) A_STAGE_LOAD(T + 1); }
            const LAS unsigned char* Kst = ldsl + st * ASTAGE; const LAS unsigned char* Vst = Kst + AK_BYTES;
            const bool vB = 2 * T + 1 < nt;
            const int jA = loc0 + 2 * T - 4, jB = jA + 1;
            if (VAR == 2) { } else
            if (T >= 2 && type == 1) {
                const bool nA = (jA >= rsa && jA <= rsb + 7), nB = vB && (jB >= rsa && jB <= rsb + 7);
                if (nA || nB) {
                    f32x16 x0, x1;
                    if (nA) { A_QK(x0, Kst + krw); const LAS unsigned char* tb = ldsl + A_RPB_OFF + ((jA >= rsl && jA <= rsl + 7) ? (jA - rq + 8) : 0) * 128;
#pragma unroll
                        for (int i = 0; i < 16; ++i) x0[i] += *(const LAS float*)(tb + BIX(i)); } else A_NEG(x0);
                    if (nB) { A_QK(x1, Kst + krw + 64 * AK_RS); const LAS unsigned char* tb = ldsl + A_RPB_OFF + ((jB >= rsl && jB <= rsl + 7) ? (jB - rq + 8) : 0) * 128;
#pragma unroll
                        for (int i = 0; i < 16; ++i) x1[i] += *(const LAS float*)(tb + BIX(i)); } else A_NEG(x1);
                    const float mt = rowmax32(x0, x1);
                    if (__any(mt > 8.0f)) {
                        const float dl = fmaxf(mt, 0.f), alpha = __builtin_amdgcn_exp2f(-dl);
                        m += dl; lsum *= alpha;
#pragma unroll
                        for (int i = 0; i < 16; ++i) { x0[i] -= dl; x1[i] -= dl; o0[i] *= alpha; o1[i] *= alpha; }
                    }
                    float ps = 0.f;
                    if (nA) {
#pragma unroll
                        for (int i = 0; i < 16; ++i) { x0[i] = __builtin_amdgcn_exp2f(x0[i]); ps += x0[i]; }
                        A_PV(x0, Vst + vrw); }
                    if (nB) {
#pragma unroll
                        for (int i = 0; i < 16; ++i) { x1[i] = __builtin_amdgcn_exp2f(x1[i]); ps += x1[i]; }
                        A_PV(x1, Vst + vrw + 64 * AV_RS); }
                    lsum += ps;
                }
            } else {
#pragma unroll
                for (int bi = 0; bi < 2; ++bi) {
                    if (bi == 1 && !vB) break;
                    const int j = jA + bi;
                    bool need = true, mask = false; int vlo = -1, vhi = 64;
                    if (T >= 2) { const int q0 = 32 * (wave & 3); need = (64 * j + 63 >= q0) && (64 * j <= q0 + 287); mask = !((64 * j >= q0 + 31) && (64 * j + 63 <= q0 + 256)); vlo = qi - 64 * j; vhi = qi + 256 - 64 * j; }
                    if (need) {
                        f32x16 x0, x1;
                        A_QK2(x0, x1, Kst + kro + bi * 64 * AK_RS);
                        if (mask) {
#pragma unroll
                            for (int i = 0; i < 16; ++i) { const int k0 = (i & 3) + 8 * (i >> 2) + 4 * hh, k1 = k0 + 32; x0[i] = (k0 >= vlo && k0 <= vhi) ? x0[i] : -1e30f; x1[i] = (k1 >= vlo && k1 <= vhi) ? x1[i] : -1e30f; }
                        }
                        const float mt = rowmax32(x0, x1);
                        const bool fst = !sw && T == 0 && bi == 0;
                        if (fst || __any(mt > 8.0f)) {
                            const float dl = fst ? mt : fmaxf(mt, 0.f), alpha = fst ? 1.f : __builtin_amdgcn_exp2f(-dl);
                            m += dl; lsum *= alpha;
#pragma unroll
                            for (int i = 0; i < 16; ++i) { x0[i] -= dl; x1[i] -= dl; o0[i] *= alpha; o1[i] *= alpha; }
                        }
                        float ps = 0.f;
#pragma unroll
                        for (int i = 0; i < 16; ++i) { x0[i] = __builtin_amdgcn_exp2f(x0[i]); ps += x0[i]; }
                        A_PV(x0, Vst + vro + bi * 64 * AV_RS);
#pragma unroll
                        for (int i = 0; i < 16; ++i) { x1[i] = __builtin_amdgcn_exp2f(x1[i]); ps += x1[i]; }
                        lsum += ps;
                        A_PV(x1, Vst + vro + (bi * 64 + 32) * AV_RS);
                    }
                }
            }
            if (VAR != 1) { if (T + 1 < nT) A_STAGE_WRITE(st ^ 1); }
            __syncthreads();
        }
#undef A_QK
#undef A_QK2
#undef A_NEG
#undef A_PV
#undef BIX
        const float inv = 1.0f / (lsum + __shfl_xor(lsum, 32));
        const int l2 = lane_id(), r2 = l2 & 31, h2 = l2 >> 5;
        const int rq2 = 4 * rg + 2 * (wave >> 2) + (r2 >> 4), cq2 = 16 * (wave & 3) + (r2 & 15);
        const int qrow2 = (type == 1) ? bl * SEQ + 64 * rq2 + cq2 : (type == 0) ? bl * SEQ + 128 * n + 32 * (wave & 3) + r2 : LROWS + bl * CTX + 32 * wave + r2;
        bf16* op = ob + (size_t)qrow2 * OW + ocol + 4 * h2;
#pragma unroll
        for (int g = 0; g < 4; ++g) {
            u32x2 w0, w1; w0.x = cvtpk(o0[4 * g] * inv, o0[4 * g + 1] * inv); w0.y = cvtpk(o0[4 * g + 2] * inv, o0[4 * g + 3] * inv);
            w1.x = cvtpk(o1[4 * g] * inv, o1[4 * g + 1] * inv); w1.y = cvtpk(o1[4 * g + 2] * inv, o1[4 * g + 3] * inv);
            *(u32x2*)(op + 8 * g) = w0; *(u32x2*)(op + 32 + 8 * g) = w1;
        }
    }
#undef A_TILE_ROW0
#undef A_STAGE_LOAD
#undef A_STAGE_WRITE
}
template <int VAR>
__device__ __forceinline__ void attn_phase(Frame& F, int l, int ch, bool last, bf16* ob) {
    { const int tid = F.wave * 64 + launder(lane_id()); const f32x2* tab = (const f32x2*)(F.ws + WS_ROPE);
      f32x2* rl = (f32x2*)(F.lds + A_ROPE_OFF); for (int i = tid; i < 96 * 16; i += NTHR) { const int a = i >> 4, f = i & 15; rl[i] = (a < 32) ? tab[(size_t)(a * 64) * 32 + f] : tab[(size_t)(a - 32) * 32 + 16 + f]; } }
    __syncthreads();
    attn_units<VAR, 1>(F, l, ch, last, ob);
    attn_units<VAR, 0>(F, l, ch, last, ob);
    attn_units<VAR, 2>(F, l, ch, last, ob);
}


template <int NPL>
__device__ __forceinline__ void topk_select_wave(const float* aff, int cap, int crbase, int ubase, int slot0, int e, int* tokslot, float* gatev, int* seltok, int lane) {
    unsigned v[NPL];
#pragma unroll
    for (int i = 0; i < NPL; i += 4) { const u32x4 t = *(const u32x4*)(aff + lane * NPL + i); v[i] = t.x; v[i + 1] = t.y; v[i + 2] = t.z; v[i + 3] = t.w; }
    unsigned T = 0u;
#pragma unroll 1
    for (int bit = 30; bit >= 0; --bit) {
        const unsigned cand = T | (1u << bit); int c = 0;
#pragma unroll
        for (int i = 0; i < NPL; ++i) c += (v[i] >= cand) ? 1 : 0;
#pragma unroll
        for (int o = 1; o < 64; o <<= 1) c += __shfl_xor(c, o);
        if (c >= cap) T = cand;
    }
    int ngt = 0, nti = 0;
#pragma unroll
    for (int i = 0; i < NPL; ++i) { ngt += (v[i] > T) ? 1 : 0; nti += (v[i] == T) ? 1 : 0; }
    int tot_gt = ngt;
#pragma unroll
    for (int o = 1; o < 64; o <<= 1) tot_gt += __shfl_xor(tot_gt, o);
    const int need = cap - tot_gt;
    int tinc = nti;
#pragma unroll
    for (int o = 1; o < 64; o <<= 1) { const int t = __shfl_up(tinc, o); if (lane >= o) tinc += t; }
    int tie_before = tinc - nti;
    unsigned selmask = 0u; int nsel = 0;
#pragma unroll
    for (int i = 0; i < NPL; ++i) { const bool tie = (v[i] == T); const bool sel = (v[i] > T) || (tie && tie_before < need); tie_before += tie ? 1 : 0; selmask |= sel ? (1u << i) : 0u; nsel += sel ? 1 : 0; }
    int sinc = nsel;
#pragma unroll
    for (int o = 1; o < 64; o <<= 1) { const int t = __shfl_up(sinc, o); if (lane >= o) sinc += t; }
    int pos = sinc - nsel;
#pragma unroll
    for (int i = 0; i < NPL; ++i) {
        const bool sel = (selmask >> i) & 1u; const int t = lane * NPL + i;
        tokslot[(size_t)(crbase + t) * NE + e] = sel ? pos : -1;
        if (sel) { seltok[slot0 + pos] = ubase + crbase + t; gatev[slot0 + pos] = __builtin_bit_cast(float, v[i]); ++pos; }
    }
}
__device__ __forceinline__ void topk_phase(Frame& F, bool last) {
    const int lane = launder(lane_id());
    int* gsel = (int*)(F.ws + WS_SELTOK);
    float* gatev = (float*)(F.ws + WS_GATEV);
    const bool cx = !last;
    for (int p = F.vcu; p < BC * NE; p += F.G) {
        const int bl = p / NE, e = p % NE;
        const int slotL = p * CAP_L, slotC0 = SLOT_CT0 + e * (NB * CAP_C) + bl * CAP_C, slotC1 = slotC0 + BC * CAP_C;
        if (F.wave == 0) topk_select_wave<32>(affl_of(F, 0) + (size_t)p * SEQ, CAP_L, bl * SEQ, 0, slotL, e, tokslot_of(F, 0), gatev, gsel, lane);
        else if (F.wave == 3) topk_select_wave<32>(affl_of(F, 1) + (size_t)p * SEQ, CAP_L, bl * SEQ, RCMAX, NSLOTMAX + slotL, e, tokslot_of(F, 1), gatev, gsel, lane);
        else if (F.wave == 1 && cx) topk_select_wave<4>((const float*)(F.ws + WS_AFFC) + (size_t)p * CTX, CAP_C, LROWS + bl * CTX, 0, slotC0, e, tokslot_of(F, 0), gatev, gsel, lane);
        else if (F.wave == 2 && cx) topk_select_wave<4>((const float*)(F.ws + WS_AFFC) + (size_t)(p + BC * NE) * CTX, CAP_C, LROWS + (bl + BC) * CTX, 0, slotC1, e, tokslot_of(F, 0), gatev, gsel, lane);
    }
}

__device__ __forceinline__ void combine_phase(Frame& F, int l, int ch, bool last, bool dry = false) {
    const int lane = launder(lane_id()), tid = F.wave * 64 + lane; (void)tid; (void)lane;
    const int gw = F.vcu * NWAVES + F.wave, NGW = F.G * NWAVES;
    const int nrows = last ? LROWS : nrows_of(ch);
    const bf16* yb = (const bf16*)(F.ws + WS_YBUF) + (size_t)ch * NSLOTMAX * D; const int* tokslot = tokslot_of(F, ch); const float* gatev = (const float*)(F.ws + WS_GATEV) + (size_t)ch * NSLOTMAX;
    int nslot = -1; f32x4 nxv[4]; u32x2 ndx[4]; const bf16* dxb = dx_of(F, ch);
#define CB_LOAD(c) do { nslot = (lane < 16) ? tokslot[(size_t)(c) * NE + lane] : -1; const float* xr_ = xrow_src(F, l, ch, (c)); \
        _Pragma("unroll") for (int j_ = 0; j_ < 4; ++j_) { nxv[j_] = *(const f32x4*)(xr_ + lane * 4 + 256 * j_); ndx[j_] = *(const u32x2*)(dxb + (size_t)(c) * D + lane * 4 + 256 * j_); } } while (0)
    const int rpw = (nrows + NGW - 1) / NGW, rbeg = gw * rpw, rend = (rbeg + rpw < nrows) ? rbeg + rpw : nrows;
    f32x4 gtq[4], shq[4], scq[4], gmq[4]; int cmv = -1;
#pragma unroll
    for (int j = 0; j < 4; ++j) gmq[j] = *(const f32x4*)((last ? inp(F, I_GFINAL) : inp(F, I_GMIX) + (size_t)(l + 1) * D) + lane * 4 + 256 * j);
    if (rbeg < rend) CB_LOAD(rbeg);
    for (int cr = rbeg; cr < rend; ++cr) {
        const bool lat = cr < LROWS; const int bl = lat ? cr / SEQ : (cr - LROWS) / CTX;
        { const int mv = mv_of(ch, cr); if (mv != cmv) { cmv = mv; const float* gt = mod_ptr(F, l, mv, 5); const float* sh = mod_ptr(F, last ? l : l + 1, mv, 0); const float* sc = mod_ptr(F, last ? l : l + 1, mv, 1);
#pragma unroll
            for (int j = 0; j < 4; ++j) { gtq[j] = *(const f32x4*)(gt + lane * 4 + 256 * j); shq[j] = *(const f32x4*)(sh + lane * 4 + 256 * j); scq[j] = *(const f32x4*)(sc + lane * 4 + 256 * j); } } }
        const int myslot = nslot; f32x4 v[4];
#pragma unroll
        for (int j = 0; j < 4; ++j) { v[j] = nxv[j]; v[j].x += bflo(ndx[j].x); v[j].y += bfhi(ndx[j].x); v[j].z += bflo(ndx[j].y); v[j].w += bfhi(ndx[j].y); }
        if (cr + 1 < rend) CB_LOAD(cr + 1);
        float acc[16];
#pragma unroll
        for (int i = 0; i < 16; ++i) acc[i] = 0.f;
        unsigned mask = (unsigned)__ballot(myslot >= 0) & 0xFFFFu;
        while (mask) {
            const int e0 = __builtin_ctz(mask); mask &= mask - 1;
            const bool two = mask != 0u; const int e1 = two ? __builtin_ctz(mask) : e0; if (two) mask &= mask - 1;
            const int p0 = __shfl(myslot, e0), p1 = __shfl(myslot, e1);
            const int s0 = lat ? (bl * NE + e0) * CAP_L + p0 : SLOT_CT0 + e0 * (NB * CAP_C) + bl * CAP_C + p0;
            const int s1 = lat ? (bl * NE + e1) * CAP_L + p1 : SLOT_CT0 + e1 * (NB * CAP_C) + bl * CAP_C + p1;
            u32x2 ua[4], ub[4]; const float ga = gatev[s0], gb = gatev[s1];
#pragma unroll
            for (int j = 0; j < 4; ++j) { ua[j] = *(const u32x2*)(yb + (size_t)s0 * D + lane * 4 + 256 * j); ub[j] = *(const u32x2*)(yb + (size_t)s1 * D + lane * 4 + 256 * j); }
#pragma unroll
            for (int j = 0; j < 4; ++j) { acc[4 * j] += ga * bflo(ua[j].x); acc[4 * j + 1] += ga * bfhi(ua[j].x); acc[4 * j + 2] += ga * bflo(ua[j].y); acc[4 * j + 3] += ga * bfhi(ua[j].y); }
            if (two) {
#pragma unroll
                for (int j = 0; j < 4; ++j) { acc[4 * j] += gb * bflo(ub[j].x); acc[4 * j + 1] += gb * bfhi(ub[j].x); acc[4 * j + 2] += gb * bflo(ub[j].y); acc[4 * j + 3] += gb * bfhi(ub[j].y); }
            }
        }
        float* xr = dry ? (float*)(F.ws + WS_OBUF) + (size_t)cr * D : xrow_dst(F, ch, cr);
        float ss = 0.f;
#pragma unroll
        for (int j = 0; j < 4; ++j) { const f32x4 g4 = gtq[j];
            v[j].x += g4.x * acc[4 * j]; v[j].y += g4.y * acc[4 * j + 1]; v[j].z += g4.z * acc[4 * j + 2]; v[j].w += g4.w * acc[4 * j + 3];
            ss += (v[j].x * v[j].x + v[j].y * v[j].y) + (v[j].z * v[j].z + v[j].w * v[j].w); }
        const float rstd = 1.0f / sqrtf(wave_sum(ss) * (1.0f / D) + RMS_EPS);
        if (!last) {
#pragma unroll
            for (int j = 0; j < 4; ++j) *(f32x4*)(xr + lane * 4 + 256 * j) = v[j];
            bf16* hb = dry ? (bf16*)(F.ws + WS_OBUF + 160 * MiB) : hbuf_of(F, ch);
#pragma unroll
            for (int j = 0; j < 4; ++j) {
                const f32x4 hv = (v[j] * rstd * gmq[j]) * (scq[j] + 1.0f) + shq[j];
                u32x2 o; o.x = pk2(hv.x, hv.y); o.y = pk2(hv.z, hv.w);
                *(u32x2*)(hb + (size_t)cr * D + lane * 4 + 256 * j) = o;
            }
            continue;
        }
        {
#pragma unroll
            for (int j = 0; j < 4; ++j) v[j] = v[j] * rstd * gmq[j];
#if defined(PROBE_ATTN)
            { const unsigned cn = __hip_atomic_load((unsigned*)(F.ws + WS_CTL) + CW_DIAG, __ATOMIC_RELAXED, __HIP_MEMORY_SCOPE_AGENT); const float sc = 1.0f + 0.02f * log2f(1.0f + (float)cn);
#pragma unroll
              for (int j = 0; j < 4; ++j) v[j] = v[j] * sc; }
#endif
        }
#pragma unroll
        for (int j = 0; j < 4; ++j) *(f32x4*)(xr + lane * 4 + 256 * j) = v[j];
    }
#undef CB_LOAD
}

using pg8::Unit; using pg8::cvt_pk_bf16;
struct SchedBase { int nM, nN, G, c, rep;
    __device__ __forceinline__ bool tile(int i, int& pm, int& pn, int& sub) const { sub = i % rep; return pg8::tile_of((long)(i / rep) * G + c, nM, nN, pm, pn); } };

struct SchedIn : SchedBase { const char* A; const char* B; int nMfull = 0, kvM = 0;
    __device__ __forceinline__ bool next(int i, Unit& u) const { int sub; u.aux = 0; u.pad = 0;
        if (!tile(i, u.pm, u.pn, sub)) {
            const long L = (long)(i / rep) * G + c - (long)nM * nN; if (kvM == 0 || L < 0 || L >= (long)kvM * 5) return false;
            const int q = (int)L % 5; u.pm = nM + (int)L / 5; u.pn = q < 4 ? 8 + q : 14; }
        u.A = A + (size_t)u.pm * 256 * D * 2; u.B = B + (size_t)u.pn * 256 * D * 2; return true; } };
__device__ __forceinline__ size_t gb_off(int pm, int g, int wr, int wc, int fr, int fq) { return ((size_t)(pm * 12 + g) * 131072) + (size_t)(((wr * 4 + wc) * 64 + fq * 16 + fr) * 16); }
struct EpiStoreBf16 { static constexpr bool PERM = true; bf16* O; int ldc; unsigned char* GB;
    __device__ __forceinline__ void operator()(const f32x4 (&acc)[2][2][4][2], const Unit& u, int wr, int wc, int fr, int fq) const {
        if (u.pn >= Z_G / 256) {
            unsigned char* gp = GB + gb_off(u.pm, u.pn - Z_G / 256, wr, wc, fr, fq);
#pragma unroll
            for (int ai = 0; ai < 2; ++ai)
#pragma unroll
                for (int m = 0; m < 4; ++m)
#pragma unroll
                    for (int bj = 0; bj < 2; ++bj) { f32x4 v0 = acc[ai][bj][m][0], v1 = acc[ai][bj][m][1];
#pragma unroll
                        for (int j = 0; j < 4; ++j) { v0[j] = fmaxf(sigmoidf_(v0[j]), 1e-30f); v1[j] = fmaxf(sigmoidf_(v1[j]), 1e-30f); }
                        u32x4 w; w.x = cvt_pk_bf16(v0[0], v0[1]); w.y = cvt_pk_bf16(v0[2], v0[3]); w.z = cvt_pk_bf16(v1[0], v1[1]); w.w = cvt_pk_bf16(v1[2], v1[3]);
                        __builtin_nontemporal_store(w, (u32x4*)(gp + ((ai * 4 + m) * 2 + bj) * 8192)); }
        } else {
            const int row0 = u.pm * 256 + wr * 64 + fr, col0 = u.pn * 256 + wc * 32 + 8 * fq;
#pragma unroll
            for (int ai = 0; ai < 2; ++ai)
#pragma unroll
                for (int m = 0; m < 4; ++m) { bf16* rowp = O + (size_t)(row0 + ai * 128 + m * 16) * ldc + col0;
#pragma unroll
                    for (int bj = 0; bj < 2; ++bj) { const f32x4 v0 = acc[ai][bj][m][0], v1 = acc[ai][bj][m][1];
                        u32x4 w; w.x = cvt_pk_bf16(v0[0], v0[1]); w.y = cvt_pk_bf16(v0[2], v0[3]); w.z = cvt_pk_bf16(v1[0], v1[1]); w.w = cvt_pk_bf16(v1[2], v1[3]);
                        __builtin_nontemporal_store(w, (u32x4*)(rowp + bj * 128)); } }
        }
    } };

struct SchedMerge : SchedBase { const char* A; const char* B;
    __device__ __forceinline__ bool next(int i, Unit& u) const { int sub; if (!tile(i, u.pm, u.pn, sub)) return false; u.aux = 0; u.pad = 0;
        u.A = A + (size_t)u.pm * 256 * OW * 2; u.B = B + (size_t)u.pn * 256 * 1536 * 2; return true; } };
__device__ __forceinline__ void gate_load8x2(const unsigned char* sbase, unsigned vo, u32x4 (&a)[8], u32x4 (&b)[8]) {
    unsigned t0, t1, t2, t3;
    asm volatile("v_add_u32 %[t0], 0, %[vo]\n\tglobal_load_dwordx4 %[a0], %[t0], %[sb]\n\t"
        "v_add_u32 %[t2], 524288, %[vo]\n\tglobal_load_dwordx4 %[b0], %[t2], %[sb]\n\t"
        "v_add_u32 %[t1], 8192, %[vo]\n\tglobal_load_dwordx4 %[a1], %[t1], %[sb]\n\t"
        "v_add_u32 %[t3], 532480, %[vo]\n\tglobal_load_dwordx4 %[b1], %[t3], %[sb]\n\t"
        "v_add_u32 %[t0], 16384, %[vo]\n\tglobal_load_dwordx4 %[a2], %[t0], %[sb]\n\t"
        "v_add_u32 %[t2], 540672, %[vo]\n\tglobal_load_dwordx4 %[b2], %[t2], %[sb]\n\t"
        "v_add_u32 %[t1], 24576, %[vo]\n\tglobal_load_dwordx4 %[a3], %[t1], %[sb]\n\t"
        "v_add_u32 %[t3], 548864, %[vo]\n\tglobal_load_dwordx4 %[b3], %[t3], %[sb]\n\t"
        "v_add_u32 %[t0], 32768, %[vo]\n\tglobal_load_dwordx4 %[a4], %[t0], %[sb]\n\t"
        "v_add_u32 %[t2], 557056, %[vo]\n\tglobal_load_dwordx4 %[b4], %[t2], %[sb]\n\t"
        "v_add_u32 %[t1], 40960, %[vo]\n\tglobal_load_dwordx4 %[a5], %[t1], %[sb]\n\t"
        "v_add_u32 %[t3], 565248, %[vo]\n\tglobal_load_dwordx4 %[b5], %[t3], %[sb]\n\t"
        "v_add_u32 %[t0], 49152, %[vo]\n\tglobal_load_dwordx4 %[a6], %[t0], %[sb]\n\t"
        "v_add_u32 %[t2], 573440, %[vo]\n\tglobal_load_dwordx4 %[b6], %[t2], %[sb]\n\t"
        "v_add_u32 %[t1], 57344, %[vo]\n\tglobal_load_dwordx4 %[a7], %[t1], %[sb]\n\t"
        "v_add_u32 %[t3], 581632, %[vo]\n\tglobal_load_dwordx4 %[b7], %[t3], %[sb]\n\t"
        "s_waitcnt vmcnt(0)"
        : [a0]"=&v"(a[0]), [a1]"=&v"(a[1]), [a2]"=&v"(a[2]), [a3]"=&v"(a[3]), [a4]"=&v"(a[4]), [a5]"=&v"(a[5]), [a6]"=&v"(a[6]), [a7]"=&v"(a[7]), [b0]"=&v"(b[0]), [b1]"=&v"(b[1]), [b2]"=&v"(b[2]), [b3]"=&v"(b[3]), [b4]"=&v"(b[4]), [b5]"=&v"(b[5]), [b6]"=&v"(b[6]), [b7]"=&v"(b[7]), [t0]"=&v"(t0), [t1]"=&v"(t1), [t2]"=&v"(t2), [t3]"=&v"(t3)
        : [vo]"v"(vo), [sb]"s"(sbase) : "memory");
}
__device__ __forceinline__ void gate_load16(const unsigned char* sbase, unsigned vo, u32x4 (&a)[16]) {
    unsigned t0, t1;
    asm volatile("v_add_u32 %[t0], 0, %[vo]\n\tglobal_load_dwordx4 %[a0], %[t0], %[sb]\n\t"
        "v_add_u32 %[t1], 8192, %[vo]\n\tglobal_load_dwordx4 %[a1], %[t1], %[sb]\n\t"
        "v_add_u32 %[t0], 16384, %[vo]\n\tglobal_load_dwordx4 %[a2], %[t0], %[sb]\n\t"
        "v_add_u32 %[t1], 24576, %[vo]\n\tglobal_load_dwordx4 %[a3], %[t1], %[sb]\n\t"
        "v_add_u32 %[t0], 32768, %[vo]\n\tglobal_load_dwordx4 %[a4], %[t0], %[sb]\n\t"
        "v_add_u32 %[t1], 40960, %[vo]\n\tglobal_load_dwordx4 %[a5], %[t1], %[sb]\n\t"
        "v_add_u32 %[t0], 49152, %[vo]\n\tglobal_load_dwordx4 %[a6], %[t0], %[sb]\n\t"
        "v_add_u32 %[t1], 57344, %[vo]\n\tglobal_load_dwordx4 %[a7], %[t1], %[sb]\n\t"
        "v_add_u32 %[t0], 65536, %[vo]\n\tglobal_load_dwordx4 %[a8], %[t0], %[sb]\n\t"
        "v_add_u32 %[t1], 73728, %[vo]\n\tglobal_load_dwordx4 %[a9], %[t1], %[sb]\n\t"
        "v_add_u32 %[t0], 81920, %[vo]\n\tglobal_load_dwordx4 %[a10], %[t0], %[sb]\n\t"
        "v_add_u32 %[t1], 90112, %[vo]\n\tglobal_load_dwordx4 %[a11], %[t1], %[sb]\n\t"
        "v_add_u32 %[t0], 98304, %[vo]\n\tglobal_load_dwordx4 %[a12], %[t0], %[sb]\n\t"
        "v_add_u32 %[t1], 106496, %[vo]\n\tglobal_load_dwordx4 %[a13], %[t1], %[sb]\n\t"
        "v_add_u32 %[t0], 114688, %[vo]\n\tglobal_load_dwordx4 %[a14], %[t0], %[sb]\n\t"
        "v_add_u32 %[t1], 122880, %[vo]\n\tglobal_load_dwordx4 %[a15], %[t1], %[sb]\n\t"
        "s_waitcnt vmcnt(0)"
        : [a0]"=&v"(a[0]), [a1]"=&v"(a[1]), [a2]"=&v"(a[2]), [a3]"=&v"(a[3]), [a4]"=&v"(a[4]), [a5]"=&v"(a[5]), [a6]"=&v"(a[6]), [a7]"=&v"(a[7]), [a8]"=&v"(a[8]), [a9]"=&v"(a[9]), [a10]"=&v"(a[10]), [a11]"=&v"(a[11]), [a12]"=&v"(a[12]), [a13]"=&v"(a[13]), [a14]"=&v"(a[14]), [a15]"=&v"(a[15]), [t0]"=&v"(t0), [t1]"=&v"(t1)
        : [vo]"v"(vo), [sb]"s"(sbase) : "memory");
}
struct EpiMerge { static constexpr bool PERM = true; const unsigned char* GB; bf16* O;
    __device__ __forceinline__ void mid(f32x4 (&acc)[2][2][4][2], const Unit& u, int seg, int wr, int wc, int fr, int fq) const {
        const unsigned char* tb = GB + (size_t)(u.pm * 12 + (seg - 1) * 4 + u.pn) * 131072;
        const unsigned vo = (unsigned)(((wr * 4 + wc) * 64 + fq * 16 + fr) * 16);
#pragma unroll
        for (int ai = 0; ai < 2; ++ai) {
            u32x4 a[8], b[8]; gate_load8x2(tb + ai * 65536, vo, a, b);
#pragma unroll
            for (int m = 0; m < 4; ++m)
#pragma unroll
                for (int bj = 0; bj < 2; ++bj) { float gpv[8], gnv[8]; unpack8(a[m * 2 + bj], gpv); unpack8(b[m * 2 + bj], gnv);
#pragma unroll
                    for (int j = 0; j < 4; ++j) { acc[ai][bj][m][0][j] *= gpv[j] * __builtin_amdgcn_rcpf(gnv[j]); acc[ai][bj][m][1][j] *= gpv[4 + j] * __builtin_amdgcn_rcpf(gnv[4 + j]); } }
        }
    }
    __device__ __forceinline__ void operator()(const f32x4 (&acc)[2][2][4][2], const Unit& u, int wr, int wc, int fr, int fq) const {
        const int row0 = u.pm * 256 + wr * 64 + fr, col0 = u.pn * 256 + wc * 32 + 8 * fq;
        const unsigned char* tb = GB + (size_t)(u.pm * 12 + 8 + u.pn) * 131072;
        const unsigned vo = (unsigned)(((wr * 4 + wc) * 64 + fq * 16 + fr) * 16);
        u32x4 g[16]; gate_load16(tb, vo, g);
#pragma unroll
        for (int ai = 0; ai < 2; ++ai)
#pragma unroll
            for (int m = 0; m < 4; ++m) { const size_t row = (size_t)(row0 + ai * 128 + m * 16);
#pragma unroll
                for (int bj = 0; bj < 2; ++bj) { const int col = col0 + bj * 128;
                    float g8[8]; unpack8(g[(ai * 4 + m) * 2 + bj], g8);
                    const f32x4 v0 = acc[ai][bj][m][0], v1 = acc[ai][bj][m][1];
                    u32x4 w; w.x = cvt_pk_bf16(v0[0] * g8[0], v0[1] * g8[1]); w.y = cvt_pk_bf16(v0[2] * g8[2], v0[3] * g8[3]); w.z = cvt_pk_bf16(v1[0] * g8[4], v1[1] * g8[5]); w.w = cvt_pk_bf16(v1[2] * g8[6], v1[3] * g8[7]);
                    *(u32x4*)(O + row * D + col) = w; } }
    } };

struct EpiOut { static constexpr bool PERM = true; const Frame* F; int l, ch; bf16* O;
    __device__ __forceinline__ void operator()(const f32x4 (&acc)[2][2][4][2], const Unit& u, int wr, int wc, int fr, int fq) const {
        const int cr0 = u.pm * 256; const float* gt = mod_ptr(*F, l, mv_of(ch, cr0), 2);
        const int row0 = cr0 + wr * 64 + fr, col0 = u.pn * 256 + wc * 32 + 8 * fq;
#pragma unroll
        for (int bj = 0; bj < 2; ++bj) { const f32x4 g0 = *(const f32x4*)(gt + col0 + bj * 128), g1 = *(const f32x4*)(gt + col0 + bj * 128 + 4);
#pragma unroll
            for (int ai = 0; ai < 2; ++ai)
#pragma unroll
                for (int m = 0; m < 4; ++m) { const f32x4 v0 = acc[ai][bj][m][0] * g0, v1 = acc[ai][bj][m][1] * g1;
                    u32x4 w; w.x = cvt_pk_bf16(v0[0], v0[1]); w.y = cvt_pk_bf16(v0[2], v0[3]); w.z = cvt_pk_bf16(v1[0], v1[1]); w.w = cvt_pk_bf16(v1[2], v1[3]);
                    *(u32x4*)(O + (size_t)(row0 + ai * 128 + m * 16) * D + col0 + bj * 128) = w; } }
    } };

__device__ __forceinline__ int expert_of_tile(int pm) { return pm < SLT ? pm % NE : (pm - SLT) / (NB * CAP_C / 256); }
__device__ __forceinline__ void ffn_tile(int t, bool last, int& c1, int& pml) {
    const int per = last ? 2 * BC : 2 * BC + NB * CAP_C / 256;
    const int e = t / per, k = t % per;
    if (k < BC) { c1 = 0; pml = k * NE + e; }
    else if (!last && k < BC + NB * CAP_C / 256) { c1 = 0; pml = SLT + e * (NB * CAP_C / 256) + (k - BC); }
    else { c1 = 1; pml = (k - (per - BC)) * NE + e; }
}
struct SchedUp : SchedBase { const char* A; const char* B; const int* gidx; int nM0;
    __device__ __forceinline__ bool next(int i, Unit& u) const { int sub; if (!tile(i, u.pm, u.pn, sub)) return false; u.pad = 0;
        int c1, pml; ffn_tile(u.pm, nM0 == SLT, c1, pml); u.aux = c1 * PBT + pml;
        u.A = A; u.B = B + ((size_t)expert_of_tile(pml) * 2048 + (size_t)u.pn * 256) * D * 2; return true; } };
struct EpiUp { static constexpr bool PERM = true; bf16* O;
    __device__ __forceinline__ void operator()(const f32x4 (&acc)[2][2][4][2], const Unit& u, int wr, int wc, int fr, int fq) const {
        const int row0 = u.aux * 256 + wr * 64 + fr, col0 = u.pn * 128 + wc * 32 + 8 * fq;
#pragma unroll
        for (int ai = 0; ai < 2; ++ai)
#pragma unroll
            for (int m = 0; m < 4; ++m) { float h[8];
#pragma unroll
                for (int n = 0; n < 2; ++n)
#pragma unroll
                    for (int j = 0; j < 4; ++j) { const float g = acc[ai][0][m][n][j], uu = acc[ai][1][m][n][j]; h[4 * n + j] = g * sigmoidf_(g) * uu; }
                u32x4 w; w.x = cvt_pk_bf16(h[0], h[1]); w.y = cvt_pk_bf16(h[2], h[3]); w.z = cvt_pk_bf16(h[4], h[5]); w.w = cvt_pk_bf16(h[6], h[7]);
                *(u32x4*)(O + (size_t)(row0 + ai * 128 + m * 16) * FF + col0) = w; }
    } };

struct SchedDown : SchedBase { const char* A; const char* B; int nM0;
    __device__ __forceinline__ bool next(int i, Unit& u) const { int sub; if (!tile(i, u.pm, u.pn, sub)) return false; u.pad = 0;
        int c1, pml; ffn_tile(nM - 1 - u.pm, nM0 == SLT, c1, pml); u.aux = c1 * PBT + pml;
        u.A = A + (size_t)u.aux * 256 * FF * 2; u.B = B + ((size_t)expert_of_tile(pml) * D + (size_t)u.pn * 256) * FF * 2; return true; } };
__device__ __forceinline__ void load8_rows_f32(const float* sbase, unsigned vo, float (&g)[8]) {
    asm volatile("global_load_dword %[g0], %[vo], %[sb]\n\tglobal_load_dword %[g1], %[vo], %[sb] offset:64\n\tglobal_load_dword %[g2], %[vo], %[sb] offset:128\n\tglobal_load_dword %[g3], %[vo], %[sb] offset:192\n\t"
                 "global_load_dword %[g4], %[vo], %[sb] offset:512\n\tglobal_load_dword %[g5], %[vo], %[sb] offset:576\n\tglobal_load_dword %[g6], %[vo], %[sb] offset:640\n\tglobal_load_dword %[g7], %[vo], %[sb] offset:704\n\t"
                 "s_waitcnt vmcnt(0)"
        : [g0]"=&v"(g[0]), [g1]"=&v"(g[1]), [g2]"=&v"(g[2]), [g3]"=&v"(g[3]), [g4]"=&v"(g[4]), [g5]"=&v"(g[5]), [g6]"=&v"(g[6]), [g7]"=&v"(g[7])
        : [vo]"v"(vo), [sb]"s"(sbase) : "memory");
}
struct EpiDown { static constexpr bool PERM = true; bf16* O; const float* gv;
    __device__ __forceinline__ void operator()(const f32x4 (&acc)[2][2][4][2], const Unit& u, int wr, int wc, int fr, int fq) const {
        const int row0 = u.aux * 256 + wr * 64 + fr, col0 = u.pn * 256 + wc * 32 + 8 * fq;
#pragma unroll
        for (int ai = 0; ai < 2; ++ai)
#pragma unroll
            for (int m = 0; m < 4; ++m) { const int row = row0 + ai * 128 + m * 16; const float g = 1.0f; bf16* rowp = O + (size_t)row * D + col0;
#pragma unroll
                for (int bj = 0; bj < 2; ++bj) { const f32x4 v0 = acc[ai][bj][m][0] * g, v1 = acc[ai][bj][m][1] * g;
                    u32x4 w; w.x = cvt_pk_bf16(v0[0], v0[1]); w.y = cvt_pk_bf16(v0[2], v0[3]); w.z = cvt_pk_bf16(v1[0], v1[1]); w.w = cvt_pk_bf16(v1[2], v1[3]);
                    *(u32x4*)(rowp + bj * 128) = w; } }
    } };

#if defined(PROBE_ATTN)
__device__ __forceinline__ void probe_compare(Frame& F, int nrows, const bf16* a, const bf16* b) {
    const int lane = launder(lane_id());
    const int gw = F.vcu * NWAVES + F.wave, NGW = F.G * NWAVES;
    unsigned cnt = 0;
    for (int cr = gw; cr < nrows; cr += NGW) {
#pragma unroll
        for (int j = 0; j < 2; ++j) { float x[8], y[8]; unpack8(*(const u32x4*)(a + (size_t)cr * OW + 512 + lane * 8 + 512 * j), x); unpack8(*(const u32x4*)(b + (size_t)cr * OW + 512 + lane * 8 + 512 * j), y);
#pragma unroll
            for (int i = 0; i < 8; ++i) { const float d = fabsf(x[i] - y[i]); cnt += (!(d <= 0.01f + 0.05f * fabsf(y[i]))) ? 1u : 0u; } }
    }
#pragma unroll
    for (int o = 1; o < 64; o <<= 1) cnt += __shfl_xor(cnt, o);
    if (lane == 0 && cnt) atomicAdd((unsigned*)(F.ws + WS_CTL) + CW_DIAG, cnt);
}
#endif

constexpr int SEQ_TOTAL = 2 + DEPTH * (NCH * 4 + 5);

__global__ void __launch_bounds__(NTHR, 2) fwd_kernel(Args args) {
    extern __shared__ __attribute__((aligned(16))) unsigned char lds[];
    Frame F;
    F.lds = lds; F.ldsl = (LAS unsigned char*)lds; F.ws = args.ws; F.out = args.out;
    F.wave = __builtin_amdgcn_readfirstlane(threadIdx.x >> 6);
    F.G = gridDim.x; { const int bx = blockIdx.x; F.vcu = (F.G % 8 == 0) ? (bx % 8) * (F.G / 8) + bx / 8 : bx; }
    volatile LAS unsigned* MISC = (volatile LAS unsigned*)(F.ldsl + MISC_OFF);
    for (int u = threadIdx.x; u < (LDS_BYTES - LDSCTL_OFF) / 4; u += NTHR) ((LAS unsigned*)(F.ldsl + LDSCTL_OFF))[u] = 0u;
    if (threadIdx.x < 19) *(LAS unsigned long long*)(F.ldsl + PTR_OFF + 8 * threadIdx.x) = (unsigned long long)args.in[threadIdx.x];
    __syncthreads();
    const int lo = args.ph_lo, hi = args.ph_hi;
    const bool multi = (hi - lo) > 1;
    XcdBarrier bar; bar.bar = (unsigned*)(F.ws + WS_CTL) + CW_BAR; bar.x = 0; bar.st = nullptr;
    if (multi) bar = xcd_barrier_post((unsigned*)(F.ws + WS_CTL) + CW_BAR, MISC + 8);
    int seq = 0;
#ifndef PHMASK
#define PHMASK 0xFFFF
#endif
#define EN(b) ((PHMASK >> (b)) & 1)
#ifndef REPMASK
#define REPMASK 0
#endif
#define REP(b) ((REPMASK >> (b)) & 1)
#define RUN(b, stmt) do { stmt; if (REP(b)) { __syncthreads(); stmt; } } while (0)
#define IN(k) (lo <= (k) && (k) < hi)
#define SEAM(k) do { if (IN(k) && IN((k) + 1)) xcd_barrier(bar, F.wave); } while (0)

    if (IN(seq)) { if (EN(0)) RUN(0, mods_phase(F)); if (EN(1)) RUN(1, wconv_phase(F, 0)); } SEAM(seq); ++seq;
    if (EN(2) && IN(seq)) { norm_phase<false>(F, 0, 0, nrows_of(0)); norm_phase<false>(F, 0, 1, nrows_of(1)); } SEAM(seq); ++seq;

    for (int l = 0; l < DEPTH; ++l) {
        const bool last = (l == DEPTH - 1);
        for (int ch = 0; ch < NCH; ++ch) {
            if (EN(3) && IN(seq)) {
                SchedIn S; S.nM = (last && ch == 0) ? LT : nrows_of(ch) / 256; S.kvM = (last && ch == 0) ? CTT : 0; S.nN = INW / 256; S.G = F.G; S.c = blockIdx.x; S.rep = 1; S.A = (const char*)hbuf_of(F, ch); S.B = (const char*)(F.ws + WS_WIN);
                EpiStoreBf16 E{(bf16*)(F.ws + WS_Z), ZW, F.ws + WS_GB};
                RUN(3, (pg8::gemm_phase<EpiStoreBf16, SchedIn, true, true>(F.ldsl, D * 2, D, S, E, F.wave)));
            } SEAM(seq); ++seq;
            if (IN(seq)) { if (EN(4)) RUN(4, conv_phase(F, l, last ? LROWS : nrows_of(ch)));
#if defined(ATTN_NAIVE)
                if (EN(5)) naive_attn_phase(F, l, ch, last, (bf16*)(F.ws + WS_OBUF));
#else
                if (EN(5)) attn_phase<0>(F, l, ch, last, (bf16*)(F.ws + WS_OBUF));
#if defined(PROBE_AVAR)
                __syncthreads(); attn_phase<PROBE_AVAR>(F, l, ch, last, (bf16*)(F.ws + WS_PART));
#endif
#endif
#if defined(PROBE_ATTN)
                naive_attn_phase(F, l, ch, last, (bf16*)(F.ws + WS_PART));
                xcd_barrier(bar, F.wave);
                probe_compare(F, last ? LROWS : nrows_of(ch), (const bf16*)(F.ws + WS_OBUF), (const bf16*)(F.ws + WS_PART));
#endif
            } SEAM(seq); ++seq;
            if (EN(6) && IN(seq)) {
                SchedMerge S; S.nM = (last ? LROWS : nrows_of(ch)) / 256; S.nN = D / 256; S.G = F.G; S.c = blockIdx.x; S.rep = 1; S.A = (const char*)(F.ws + WS_OBUF); S.B = (const char*)(F.ws + WS_WBR);
                EpiMerge E{(const unsigned char*)(F.ws + WS_GB), hbuf_of(F, ch)};
                RUN(6, (pg8::gemm_phase<EpiMerge, SchedMerge, true, true, 3>(F.ldsl, OW * 2, 1536, S, E, F.wave)));
#if defined(PROBE_NOHOOK)
                { __syncthreads(); EpiMerge E2{(const unsigned char*)(F.ws + WS_GB), (bf16*)(F.ws + WS_PART)}; pg8::gemm_phase<EpiMerge, SchedMerge, true, true, PROBE_NOHOOK>(F.ldsl, OW * 2, 1536, S, E2, F.wave); }
#endif
            } SEAM(seq); ++seq;
            if (EN(7) && IN(seq)) {
                SchedIn S; S.nM = (last ? LROWS : nrows_of(ch)) / 256; S.nN = D / 256; S.G = F.G; S.c = blockIdx.x; S.rep = 1; S.A = (const char*)hbuf_of(F, ch); S.B = (const char*)(F.ws + WS_WOUT);
                EpiOut E{&F, l, ch, dx_of(F, ch)};
                RUN(7, (pg8::gemm_phase<EpiOut, SchedIn, true, true>(F.ldsl, D * 2, D, S, E, F.wave)));
#if defined(PROBE_OUTK)
                { __syncthreads(); EpiOut E2{&F, l, ch, (bf16*)(F.ws + WS_PART)}; pg8::gemm_phase<EpiOut, SchedIn, true, true>(F.ldsl, D * 2, PROBE_OUTK, S, E2, F.wave); }
#endif
            } SEAM(seq); ++seq;
        }
        if (EN(8) && IN(seq)) {
            norm_phase<true>(F, l, 0, last ? LROWS : nrows_of(0)); __syncthreads(); norm_phase<true>(F, l, 1, LROWS);
            if (REP(8)) { __syncthreads(); norm_phase<true>(F, l, 0, last ? LROWS : nrows_of(0), true); __syncthreads(); norm_phase<true>(F, l, 1, LROWS, true); }
        } SEAM(seq); ++seq;
        if (EN(9) && IN(seq)) { topk_phase(F, last); } SEAM(seq); ++seq;
        if (EN(10) && IN(seq)) {
            SchedUp S; S.nM0 = last ? SLT : SLT + SCT; S.nM = S.nM0 + SLT; S.nN = 8; S.G = F.G; S.c = blockIdx.x; S.rep = 1; S.A = (const char*)(F.ws + WS_HBUF); S.B = (const char*)(F.ws + WS_WUP); S.gidx = (const int*)(F.ws + WS_SELTOK);
            EpiUp E{(bf16*)(F.ws + WS_HMID)};
            RUN(10, (pg8::gemm_phase<EpiUp, SchedUp, true, true, 1, true>(F.ldsl, D * 2, D, S, E, F.wave)));
        } SEAM(seq); ++seq;
        if (EN(11) && IN(seq)) {
            SchedDown S; S.nM0 = last ? SLT : SLT + SCT; S.nM = S.nM0 + SLT; S.nN = 4; S.G = F.G; S.c = blockIdx.x; S.rep = 1; S.A = (const char*)(F.ws + WS_HMID); S.B = (const char*)(F.ws + WS_WDN);
            EpiDown E{(bf16*)(F.ws + WS_YBUF), (const float*)(F.ws + WS_GATEV)};
            RUN(11, (pg8::gemm_phase<EpiDown, SchedDown, true, true>(F.ldsl, FF * 2, FF, S, E, F.wave)));
        } SEAM(seq); ++seq;
        if (IN(seq)) {
            if (EN(12)) { if (REP(12)) { combine_phase(F, l, 0, last, true); combine_phase(F, l, 1, last, true); } combine_phase(F, l, 0, last); combine_phase(F, l, 1, last); }
            if (!last && EN(1)) RUN(13, wconv_phase(F, l + 1));
        } SEAM(seq); ++seq;
    }
#undef IN
#undef SEAM
}

extern "C" void kernel_launch(void* const* d_in, const int* in_sizes, int n_in, void* d_out, int out_size, void* d_ws, size_t ws_size, hipStream_t stream) {
    static int grid = 0;
    if (grid == 0) {
        if (n_in != 19 || ws_size < WS_END) { fprintf(stderr, "kernel_launch: unexpected n_in %d / ws %zu (need %zu)\n", n_in, ws_size, (size_t)WS_END); grid = -1; return; }
        int dev = 0, cus = 0;
        if (hipGetDevice(&dev) != hipSuccess || hipDeviceGetAttribute(&cus, hipDeviceAttributeMultiprocessorCount, dev) != hipSuccess) { grid = -1; return; }
        if (hipFuncSetAttribute((const void*)fwd_kernel, hipFuncAttributeMaxDynamicSharedMemorySize, LDS_BYTES) != hipSuccess) { fprintf(stderr, "kernel_launch: hipFuncSetAttribute failed\n"); grid = -1; return; }
        int per_cu = 0;
        if (hipOccupancyMaxActiveBlocksPerMultiprocessor(&per_cu, (const void*)fwd_kernel, NTHR, LDS_BYTES) != hipSuccess || per_cu < 1) fprintf(stderr, "kernel_launch: occupancy query says %d\n", per_cu);
        (void)hipGetLastError();
        grid = cus;
    }
    if (grid < 0) return;
    (void)hipMemsetAsync((char*)d_ws + WS_CTL, 0, CTL_ZERO_BYTES, stream);
    Args a{};
    for (int i = 0; i < 19; ++i) a.in[i] = (const float*)d_in[i];
    a.out = (float*)d_out; a.ws = (unsigned char*)d_ws;
#if MK_ONE_LAUNCH
    a.ph_lo = 0; a.ph_hi = SEQ_TOTAL;
    hipLaunchKernelGGL(fwd_kernel, dim3(grid), dim3(NTHR), LDS_BYTES, stream, a);
#else
    for (int s = 0; s < SEQ_TOTAL; ++s) { a.ph_lo = s; a.ph_hi = s + 1; hipLaunchKernelGGL(fwd_kernel, dim3(grid), dim3(NTHR), LDS_BYTES, stream, a); }
#endif
}
```

```cpp
#include <hip/hip_runtime.h>
#include <cstdio>
#include <cstdint>

#ifndef MK_ONE_LAUNCH
#define MK_ONE_LAUNCH 1
#endif

#define GAS __attribute__((address_space(1)))
#define LAS __attribute__((address_space(3)))
typedef unsigned short bf16;
typedef short bf16x8 __attribute__((ext_vector_type(8)));
typedef float f32x4 __attribute__((ext_vector_type(4)));
typedef float f32x2 __attribute__((ext_vector_type(2)));
typedef unsigned u32x4 __attribute__((ext_vector_type(4)));
typedef unsigned u32x2 __attribute__((ext_vector_type(2)));

constexpr int D = 1024, NB = 32, SEQ = 2048, CTX = 256, DEPTH = 4, INW = 6912, NE = 16, FF = 1024;
constexpr int NCH = 2, BC = NB / NCH;
constexpr int LROWS = BC * SEQ, CTXALL = NB * CTX, RCMAX = LROWS + CTXALL;
constexpr int LT = LROWS / 256, CTT = CTXALL / 256;
__host__ __device__ constexpr int nrows_of(int ch) { return ch == 0 ? RCMAX : LROWS; }
constexpr int CAP_L = 2 * SEQ / NE, CAP_C = 2 * CTX / NE;
constexpr int SLOT_CT0 = BC * NE * CAP_L;
constexpr int NSLOTMAX = SLOT_CT0 + NE * NB * CAP_C;
constexpr int SLT = SLOT_CT0 / 256, SCT = NE * NB * CAP_C / 256;
constexpr float RMS_EPS = 1e-6f;
constexpr int Z_AB = 0, Z_AC = 512, Z_AX = 1024, Z_NQ = 1536, Z_NK = 2048, Z_NV = 2560, Z_SQ = 3072, Z_SK = 3584, Z_SV = 3712, Z_G = 3840;
constexpr int OW = 1536;
constexpr int ZW = Z_G;

constexpr size_t MiB = 1u << 20;
constexpr size_t WS_CTL = 0, CTL_ZERO_BYTES = 1 * MiB;
constexpr size_t WS_MODS = 1 * MiB;
constexpr size_t WS_ROPE = 5 * MiB;
constexpr size_t WS_AFFL = 6 * MiB;
constexpr size_t WS_AFFC = 10 * MiB;
constexpr size_t WS_GATEV = 11 * MiB;
constexpr size_t WS_SELTOK = 12 * MiB;
constexpr size_t WS_XC = 13 * MiB;
constexpr size_t WS_WIN = 45 * MiB;
constexpr size_t WS_WBR = 59 * MiB;
constexpr size_t WS_WOUT = 62 * MiB;
constexpr size_t WS_WUP = 64 * MiB;
constexpr size_t WS_WDN = 128 * MiB;
constexpr size_t WS_HBUF = 160 * MiB;
constexpr size_t WS_HBUF1 = 240 * MiB;
constexpr size_t WS_OBUF = 304 * MiB;
constexpr size_t WS_PART = 424 * MiB;
constexpr size_t WS_Z = 544 * MiB;
constexpr size_t WS_GB = 844 * MiB;
constexpr size_t WS_HMID = WS_OBUF;
constexpr size_t WS_YBUF = WS_OBUF + 288 * MiB;
constexpr size_t WS_DX0 = 1084 * MiB, WS_DX1 = 1164 * MiB;
constexpr size_t WS_TOKSLOT = 1228 * MiB;
constexpr size_t WS_END = 1234 * MiB;
static_assert((size_t)RCMAX * ZW * 2 == 300 * MiB && (size_t)LROWS * ZW * 2 == 240 * MiB && (size_t)NSLOTMAX * 1024 * 2 == 160 * MiB && (size_t)RCMAX * 1024 * 2 == 80 * MiB && (size_t)RCMAX * OW * 2 == 120 * MiB
              && (size_t)(RCMAX / 256) * 12 * 131072 == 240 * MiB && WS_YBUF + 288 * MiB <= WS_GB + 240 * MiB && WS_HBUF1 == WS_HBUF + (size_t)RCMAX * 1024 * 2, "ws map");
constexpr int PBT = NSLOTMAX / 256;
constexpr int CW_TMO = 0, CW_DIAG = 64, CW_BAR = 4096;

constexpr int RING_BYTES = 131072, LDSCTL_OFF = RING_BYTES, MISC_OFF = LDSCTL_OFF + 320, LDS_BYTES = 147456;
constexpr int NWAVES = 8, NTHR = 512;

__device__ __forceinline__ unsigned f2bf(float f) { unsigned u = __builtin_bit_cast(unsigned, f); return (u + 0x7fffu + ((u >> 16) & 1u)) >> 16; }
__device__ __forceinline__ unsigned pk2(float lo, float hi) { return f2bf(lo) | (f2bf(hi) << 16); }
__device__ __forceinline__ float bflo(unsigned u) { return __builtin_bit_cast(float, u << 16); }
__device__ __forceinline__ float bfhi(unsigned u) { return __builtin_bit_cast(float, u & 0xffff0000u); }
__device__ __forceinline__ void unpack8(const u32x4 u, float* f) { f[0] = bflo(u.x); f[1] = bfhi(u.x); f[2] = bflo(u.y); f[3] = bfhi(u.y); f[4] = bflo(u.z); f[5] = bfhi(u.z); f[6] = bflo(u.w); f[7] = bfhi(u.w); }
__device__ __forceinline__ float wave_sum(float v) {
#pragma unroll
    for (int o = 1; o < 64; o <<= 1) v += __shfl_xor(v, o);
    return v;
}
__device__ __forceinline__ float sigmoidf_(float x) { return __builtin_amdgcn_rcpf(1.0f + __builtin_amdgcn_exp2f(-1.4426950408889634f * x)); }
__device__ __forceinline__ int launder(int v) { asm volatile("" : "+v"(v)); return v; }
__device__ __forceinline__ int lane_id() { int l; asm volatile("v_mbcnt_lo_u32_b32 %0, -1, 0\n\tv_mbcnt_hi_u32_b32 %0, -1, %0" : "=v"(l)); return l; }
#define LDS_WAIT() asm volatile("s_waitcnt lgkmcnt(0)" ::: "memory")
#define VM_WAIT() asm volatile("s_waitcnt vmcnt(0)" ::: "memory")

namespace pg8 {
constexpr int BM = 256, BK = 64, HALF = 128, HTB = HALF * BK * 2, STAGE_BYTES = 8 * HTB, NXCD = 8, WGM = 8;
__host__ __device__ __forceinline__ int lds_byte(int r, int c) { const int st = (r >> 4) * 2 + (c >> 5), rr = r & 15, cc = c & 31, ob = rr * 64 + cc * 2; return st * 1024 + (ob ^ (((ob >> 9) & 1) << 5)); }
__host__ __device__ __forceinline__ void stage_rc(int b, int& R, int& C) { const int st = b / 1024, sb = b % 1024, swz = sb ^ (((sb >> 9) & 1) << 5); R = (st >> 1) * 16 + swz / 64; C = (st & 1) * 32 + (swz % 64) / 2; }
__host__ __device__ __forceinline__ int perm32(int rho) { const int n = rho >> 4, i = rho & 15; return 8 * (i >> 2) + 4 * n + (i & 3); }

struct Unit { int pm, pn, aux, pad; const char* A; const char* B; };

__device__ __forceinline__ bool tile_of(long L, int nM, int nN, int& pm, int& pn) {
    const int nwg = nM * nN; if (L >= nwg) return false;
    int wgid = (int)L; { const int q = nwg / NXCD, r = nwg % NXCD, xcd = wgid % NXCD, off = wgid / NXCD; wgid = (xcd < r ? xcd * (q + 1) : r * (q + 1) + (xcd - r) * q) + off; }
    const int nig = WGM * nN, gid = wgid / nig, fm = gid * WGM, gsz = (nM - fm) < WGM ? (nM - fm) : WGM;
    pm = fm + ((wgid % nig) % gsz); pn = (wgid % nig) / gsz; return true;
}

__device__ __forceinline__ unsigned cvt_pk_bf16(float lo, float hi) { unsigned r; asm volatile("v_cvt_pk_bf16_f32 %0, %1, %2" : "=v"(r) : "v"(lo), "v"(hi)); return r; }

template <class Epi, class Sched, bool ALIGN_EPI, bool SP2, int NSEG = 1, bool GATHER = false>
__device__ __forceinline__ void gemm_phase(LAS unsigned char* lds, const int lda_bytes, const int K, const Sched& S, const Epi& E, const int wid_in) {
    int wid = wid_in; asm volatile("" : "+s"(wid));
    int lane_ = lane_id(); asm volatile("" : "+v"(lane_));
    const int lane = lane_, tid = wid * 64 + lane, wr = wid >> 2, wc = wid & 3, fr = lane & 15, fq = lane >> 4;
    const int nt = K / BK;
    unsigned voffA[2], voffB[2]; int gR[2], gC[2];
#pragma unroll
    for (int i = 0; i < 2; ++i) { int R, C; stage_rc(tid * 16 + i * 8192, R, C); const int Rb = Epi::PERM ? ((R & ~31) + perm32(R & 31)) : R; gR[i] = R; gC[i] = C * 2;
        voffA[i] = (unsigned)(R * lda_bytes + C * 2); voffB[i] = (unsigned)(Rb * K + C) * 2u; }
    unsigned offc[2][2], offn[2][2]; int rawn[2][2];
    const size_t kstep = (size_t)(BK * 2);
    const size_t hstepA = (size_t)HALF * lda_bytes, hstepB = (size_t)HALF * K * 2;
    const unsigned ldsw = (unsigned)wid * 1024u;
    const int aoff = lds_byte(wr * 64 + fr, fq * 8), boff = lds_byte(wc * 32 + fr, fq * 8);
#define PG8_SA(b, h) (((b) * 2 + (h)) * HTB)
#define PG8_SB(b, h) ((4 + (b) * 2 + (h)) * HTB)
#define PG8_STAGE(bufoff, gbase, voff) do { _Pragma("unroll") for (int _i = 0; _i < 2; ++_i) \
        __builtin_amdgcn_global_load_lds((const unsigned*)((const char*)(gbase) + (voff)[_i]), (LAS unsigned*)(lds + (bufoff) + ldsw + _i * 8192), 16, 0, 0); } while (0)
#define PG8_STAGE_A(bufoff, kbase, h, nx) do { if constexpr (GATHER) { unsigned vs_[2]; vs_[0] = (nx) ? offn[h][0] : offc[h][0]; vs_[1] = (nx) ? offn[h][1] : offc[h][1]; PG8_STAGE(bufoff, (kbase), vs_); } \
        else { PG8_STAGE(bufoff, (kbase) + ((h) ? hstepA : (size_t)0), voffA); } } while (0)
#define PG8_LDA(dst, b, h) do { _Pragma("unroll") for (int m = 0; m < 4; ++m) _Pragma("unroll") for (int k = 0; k < 2; ++k) dst[m][k] = *(const LAS bf16x8*)(lds + PG8_SA(b, h) + aoff + m * 2048 + k * 1024); } while (0)
#define PG8_LDB(dst, b, h) do { _Pragma("unroll") for (int n = 0; n < 2; ++n) _Pragma("unroll") for (int k = 0; k < 2; ++k) dst[n][k] = *(const LAS bf16x8*)(lds + PG8_SB(b, h) + boff + n * 2048 + k * 1024); } while (0)
#define PG8_MMA(ai, bj, At, Bt) do { __builtin_amdgcn_s_setprio(1); _Pragma("unroll") for (int m = 0; m < 4; ++m) _Pragma("unroll") for (int n = 0; n < 2; ++n) _Pragma("unroll") for (int k = 0; k < 2; ++k) \
        acc[ai][bj][m][n] = __builtin_amdgcn_mfma_f32_16x16x32_bf16(Bt[n][k], At[m][k], acc[ai][bj][m][n], 0, 0, 0); __builtin_amdgcn_s_setprio(0); } while (0)
#define PG8_WAIT_V(n) asm volatile("s_waitcnt vmcnt(" #n ")" ::: "memory")
#define PG8_WAIT_L(n) asm volatile("s_waitcnt lgkmcnt(" #n ")" ::: "memory")
#define PG8_BAR __builtin_amdgcn_s_barrier()
#define PG8_SCHED __builtin_amdgcn_sched_barrier(0)
    Unit cur, nxt; int ui = 0;
    if (!S.next(0, cur)) return;
    f32x4 acc[2][2][4][2];
#pragma unroll
    for (int a = 0; a < 2; ++a)
#pragma unroll
        for (int b = 0; b < 2; ++b)
#pragma unroll
            for (int m = 0; m < 4; ++m)
#pragma unroll
                for (int n = 0; n < 2; ++n) acc[a][b][m][n] = (f32x4){0.f, 0.f, 0.f, 0.f};
    bf16x8 At[4][2], B0[2][2], B1[2][2];
    const char* cA = cur.A; const char* cB = cur.B;
    if constexpr (GATHER) {
#pragma unroll
        for (int h = 0; h < 2; ++h)
#pragma unroll
            for (int i = 0; i < 2; ++i) { offc[h][i] = (unsigned)S.gidx[cur.aux * 256 + h * 128 + gR[i]] * (unsigned)lda_bytes + (unsigned)gC[i]; offn[h][i] = offc[h][i]; }
    }
    if constexpr (SP2) {
        PG8_STAGE(PG8_SB(0, 0), cB, voffB); PG8_STAGE(PG8_SB(0, 1), cB + hstepB, voffB); PG8_STAGE_A(PG8_SA(0, 0), cA, 0, false); PG8_STAGE_A(PG8_SA(0, 1), cA, 1, false);
        if (wr == 1) PG8_BAR;
        PG8_WAIT_V(2); PG8_BAR;
        PG8_STAGE(PG8_SB(1, 0), cB + kstep, voffB); PG8_STAGE_A(PG8_SA(1, 0), cA + kstep, 0, false); PG8_STAGE(PG8_SB(1, 1), cB + hstepB + kstep, voffB);
        PG8_WAIT_V(6); PG8_BAR;
    } else {
        static_assert(SP2 || !GATHER, "GATHER is implemented for the SP2 loop only");
        PG8_STAGE(PG8_SB(0, 0), cB, voffB); PG8_STAGE(PG8_SA(0, 0), cA, voffA); PG8_STAGE(PG8_SB(0, 1), cB + hstepB, voffB); PG8_STAGE(PG8_SA(0, 1), cA + hstepA, voffA);
        if (wr == 1) PG8_BAR;
        PG8_WAIT_V(4); PG8_BAR;
        PG8_STAGE(PG8_SB(1, 0), cB + kstep, voffB); PG8_STAGE(PG8_SA(1, 0), cA + kstep, voffA); PG8_STAGE(PG8_SB(1, 1), cB + hstepB + kstep, voffB);
        PG8_WAIT_V(6); PG8_BAR;
    }
    for (;;) {
        const bool has_next = S.next(ui + 1, nxt);
        const char* nA = has_next ? nxt.A : cA; const char* nB = has_next ? nxt.B : cB;
        if constexpr (GATHER) {
            const int na_ = has_next ? nxt.aux : cur.aux;
#pragma unroll
            for (int h = 0; h < 2; ++h)
#pragma unroll
                for (int i = 0; i < 2; ++i) rawn[h][i] = S.gidx[na_ * 256 + h * 128 + gR[i]]; }
        for (int t = 0; t < nt; t += 2) {
            const bool last = (t == nt - 2);
            const char* a1 = cA + (size_t)(t + 1) * kstep;
            const char* a2 = last ? nA : cA + (size_t)(t + 2) * kstep; const char* b2 = last ? nB : cB + (size_t)(t + 2) * kstep;
            const char* a3 = a2 + kstep; const char* b3 = b2 + kstep;
            if constexpr (GATHER) { if (last && has_next) {
#pragma unroll
                for (int h = 0; h < 2; ++h)
#pragma unroll
                    for (int i = 0; i < 2; ++i) { int rw_ = rawn[h][i]; asm volatile("" : "+v"(rw_));
                        offn[h][i] = (unsigned)rw_ * (unsigned)lda_bytes + (unsigned)gC[i]; } } }
            if constexpr (NSEG > 1) { const int tseg = nt / NSEG; if (t > 0 && (t % tseg) == 0) E.mid(acc, cur, t / tseg, wr, wc, fr, fq); }
            if constexpr (SP2) {
            PG8_LDB(B0, 0, 0); PG8_LDB(B1, 0, 1); PG8_SCHED; PG8_LDA(At, 0, 0); PG8_STAGE_A(PG8_SA(1, 1), a1, 1, false);
            PG8_WAIT_V(8); PG8_WAIT_L(0); PG8_BAR; PG8_MMA(0, 0, At, B0); PG8_MMA(0, 1, At, B1); PG8_BAR; PG8_SCHED;
            PG8_LDA(At, 0, 1); PG8_STAGE(PG8_SB(0, 0), b2, voffB); PG8_STAGE(PG8_SB(0, 1), b2 + hstepB, voffB); PG8_STAGE_A(PG8_SA(0, 0), a2, 0, last);
            PG8_WAIT_V(8); PG8_WAIT_L(0); PG8_BAR; PG8_MMA(1, 0, At, B0); PG8_MMA(1, 1, At, B1); PG8_BAR; PG8_SCHED;
            PG8_LDB(B0, 1, 0); PG8_LDB(B1, 1, 1); PG8_SCHED; PG8_LDA(At, 1, 0); PG8_STAGE_A(PG8_SA(0, 1), a2, 1, last);
            PG8_WAIT_V(8); PG8_WAIT_L(0); PG8_BAR; PG8_MMA(0, 0, At, B0); PG8_MMA(0, 1, At, B1); PG8_BAR; PG8_SCHED;
            PG8_LDA(At, 1, 1); PG8_STAGE(PG8_SB(1, 0), b3, voffB); PG8_STAGE(PG8_SB(1, 1), b3 + hstepB, voffB); PG8_STAGE_A(PG8_SA(1, 0), a3, 0, last);
            PG8_WAIT_V(8); PG8_WAIT_L(0); PG8_BAR; PG8_MMA(1, 0, At, B0); PG8_MMA(1, 1, At, B1); PG8_BAR; PG8_SCHED;
            } else {
            PG8_LDB(B0, 0, 0); PG8_SCHED; PG8_LDA(At, 0, 0); PG8_STAGE(PG8_SA(1, 1), a1 + hstepA, voffA);
            PG8_WAIT_L(8); PG8_BAR; PG8_WAIT_L(0); PG8_MMA(0, 0, At, B0); PG8_BAR; PG8_SCHED;
            PG8_LDB(B1, 0, 1); PG8_STAGE(PG8_SB(0, 0), b2, voffB);
            PG8_BAR; PG8_WAIT_L(0); PG8_MMA(0, 1, At, B1); PG8_BAR;
            PG8_LDA(At, 0, 1); PG8_STAGE(PG8_SA(0, 0), a2, voffA);
            PG8_BAR; PG8_WAIT_L(0); PG8_MMA(1, 0, At, B0); PG8_BAR; PG8_SCHED;
            PG8_STAGE(PG8_SB(0, 1), b2 + hstepB, voffB);
            PG8_WAIT_V(6); PG8_BAR; PG8_MMA(1, 1, At, B1); PG8_BAR;
            PG8_LDB(B0, 1, 0); PG8_SCHED; PG8_LDA(At, 1, 0); PG8_STAGE(PG8_SA(0, 1), a2 + hstepA, voffA);
            PG8_WAIT_L(8); PG8_BAR; PG8_WAIT_L(0); PG8_MMA(0, 0, At, B0); PG8_BAR; PG8_SCHED;
            PG8_LDB(B1, 1, 1); PG8_STAGE(PG8_SB(1, 0), b3, voffB);
            PG8_BAR; PG8_WAIT_L(0); PG8_MMA(0, 1, At, B1); PG8_BAR;
            PG8_LDA(At, 1, 1); PG8_STAGE(PG8_SA(1, 0), a3, voffA);
            PG8_BAR; PG8_WAIT_L(0); PG8_MMA(1, 0, At, B0); PG8_BAR; PG8_SCHED;
            PG8_STAGE(PG8_SB(1, 1), b3 + hstepB, voffB);
            PG8_WAIT_V(6); PG8_BAR; PG8_MMA(1, 1, At, B1); PG8_BAR;
            }
        }
        if constexpr (ALIGN_EPI) { if (wr == 0) PG8_BAR; }
        E(acc, cur, wr, wc, fr, fq);
        if (!has_next) break;
#pragma unroll
        for (int a = 0; a < 2; ++a)
#pragma unroll
            for (int b = 0; b < 2; ++b)
#pragma unroll
                for (int m = 0; m < 4; ++m)
#pragma unroll
                    for (int n = 0; n < 2; ++n) acc[a][b][m][n] = (f32x4){0.f, 0.f, 0.f, 0.f};
        cur = nxt; cA = nA; cB = nB; ++ui;
        if constexpr (GATHER) {
#pragma unroll
            for (int h = 0; h < 2; ++h)
#pragma unroll
                for (int i = 0; i < 2; ++i) offc[h][i] = offn[h][i]; }
        if constexpr (ALIGN_EPI) { if (wr == 1) PG8_BAR; }
    }
    PG8_WAIT_V(0);
    if constexpr (!ALIGN_EPI) { if (wr == 0) PG8_BAR; }
    PG8_BAR;
#undef PG8_SA
#undef PG8_SB
#undef PG8_STAGE
#undef PG8_STAGE_A
#undef PG8_LDA
#undef PG8_LDB
#undef PG8_MMA
#undef PG8_WAIT_V
#undef PG8_WAIT_L
#undef PG8_BAR
#undef PG8_SCHED
}
}

#define XB_TMO      128
#define XB_XCNT(j)  (256  + 64 * (j))
#define XB_XSUB(j)  (1280 + 64 * (j))
#define XB_XGEN(j)  (2304 + 64 * (j))
#define XB_TOP      3328
#define XB_TOPGEN   3392
#define XCD_BAR_WORDS 3456
#define XB_SPIN_CAP (1u << 22)
__device__ __forceinline__ unsigned xb_ld(unsigned* p)              { return __hip_atomic_load(p, __ATOMIC_RELAXED, __HIP_MEMORY_SCOPE_AGENT); }
__device__ __forceinline__ unsigned xb_add(unsigned* p, unsigned v) { return __hip_atomic_fetch_add(p, v, __ATOMIC_RELAXED, __HIP_MEMORY_SCOPE_AGENT); }
__device__ __forceinline__ unsigned xb_xcc_id() { return (unsigned)__builtin_amdgcn_s_getreg((3 << 11) | 20) & 0xFu; }
#define XB_SPIN(cond, bar) do { unsigned _sp = 0; while (cond) { __builtin_amdgcn_s_sleep(1); \
    if ((++_sp & 255u) == 0u) { if (xb_ld(&(bar)[XB_TMO])) break; if (_sp > XB_SPIN_CAP) { atomicAdd(&(bar)[XB_TMO], 1u); break; } } } } while (0)
struct XcdBarrier { unsigned* bar; unsigned x; volatile LAS unsigned* st; };
__device__ __forceinline__ XcdBarrier xcd_barrier_post(unsigned* bar, volatile LAS unsigned* st) {
    XcdBarrier b; b.bar = bar; b.x = xb_xcc_id(); b.st = st;
    if (threadIdx.x == 0) (void)xb_add(&bar[XB_XCNT(b.x)], 1u);
    return b;
}
__device__ __forceinline__ void xcd_barrier_complete(unsigned* bar, unsigned x, unsigned& nloc, unsigned& nx) {
    const unsigned G = gridDim.x * gridDim.y * gridDim.z;
    unsigned sum, cnt, mine, sp = 0u;
    for (;;) {
        sum = 0u; cnt = 0u; mine = 0u;
#pragma unroll
        for (unsigned j = 0; j < 16; ++j) { const unsigned c = xb_ld(&bar[XB_XCNT(j)]); sum += c; cnt += (c > 0u) ? 1u : 0u; mine = (j == x) ? c : mine; }
        if (sum == G) break;
        __builtin_amdgcn_s_sleep(1);
        if ((++sp & 255u) == 0u) { if (xb_ld(&bar[XB_TMO])) break; if (sp > XB_SPIN_CAP) { atomicAdd(&bar[XB_TMO], 1u); break; } }
    }
    nloc = mine > 0u ? mine : 1u; nx = cnt > 0u ? cnt : 1u;
}
__device__ __forceinline__ void xcd_barrier(const XcdBarrier& b, const int wave) {
    asm volatile("s_waitcnt vmcnt(0)" ::: "memory");
    __syncthreads();
    if (wave == 0 && lane_id() == 0) {
        unsigned* bar = b.bar; asm volatile("" : "+s"(bar)); unsigned bx = b.x; asm volatile("" : "+s"(bx));
        __builtin_amdgcn_s_waitcnt(0);
        unsigned nloc = b.st[0], nx = b.st[1];
        if (nloc == 0u) { xcd_barrier_complete(bar, bx, nloc, nx); b.st[0] = nloc; b.st[1] = nx; }
        const unsigned old = xb_add(&bar[XB_XSUB(bx)], 1u);
        const unsigned gen = old / nloc;
        if (old + 1u == (gen + 1u) * nloc) {
            __builtin_amdgcn_fence(__ATOMIC_RELEASE, "agent");
            asm volatile("s_waitcnt vmcnt(0)" ::: "memory");
            const unsigned og = xb_add(&bar[XB_TOP], 1u);
            const unsigned tg = og / nx;
            if (og + 1u == (tg + 1u) * nx) xb_add(&bar[XB_TOPGEN], 1u);
            else XB_SPIN(xb_ld(&bar[XB_TOPGEN]) == tg, bar);
            __builtin_amdgcn_fence(__ATOMIC_ACQUIRE, "agent");
            xb_add(&bar[XB_XGEN(bx)], 1u);
            asm volatile("s_waitcnt vmcnt(0)" ::: "memory");
        } else {
            XB_SPIN(xb_ld(&bar[XB_XGEN(bx)]) == gen, bar);
            __builtin_amdgcn_fence(__ATOMIC_ACQUIRE, "agent");
            asm volatile("s_waitcnt vmcnt(0)" ::: "memory");
        }
    }
    __syncthreads();
}

struct Args {
    const float* in[19];
    float* out; unsigned char* ws;
    int ph_lo, ph_hi;
};
enum { I_X = 0, I_C, I_CTX, I_CCTX, I_WADA, I_BADA, I_GMIX, I_WIN, I_CONVW, I_RPB, I_SINK, I_WBR, I_WOUT, I_GFFN, I_WROUTER, I_WG, I_WU, I_WD, I_GFINAL };

struct Frame {
    unsigned char* lds;
    LAS unsigned char* ldsl;
    unsigned char* ws;
    int wave, vcu, G;
    float* out;
};

constexpr int PTR_OFF = MISC_OFF + 128;
__device__ __forceinline__ const float* inp(const Frame& F, int i) {
    const u32x2 v = *(const LAS u32x2*)(F.ldsl + PTR_OFF + 8 * i);
    const unsigned lo = __builtin_amdgcn_readfirstlane(v.x), hi = __builtin_amdgcn_readfirstlane(v.y);
    return (const float*)(((unsigned long long)hi << 32) | lo);
}
__device__ __forceinline__ float* xrow_dst(const Frame& F, int ch, int cr) {
    return cr < LROWS ? F.out + ((size_t)ch * LROWS + cr) * D : (float*)(F.ws + WS_XC) + (size_t)(cr - LROWS) * D;
}
__device__ __forceinline__ const float* xrow_src(const Frame& F, int l, int ch, int cr) {
    if (l > 0) return xrow_dst(F, ch, cr);
    return cr < LROWS ? inp(F, I_X) + ((size_t)ch * LROWS + cr) * D : inp(F, I_CTX) + (size_t)(cr - LROWS) * D;
}
__device__ __forceinline__ int mv_of(int ch, int cr) { return cr < LROWS ? ch * BC + cr / SEQ : NB; }
__device__ __forceinline__ const float* mod_ptr(const Frame& F, int l, int mv, int which) { return (const float*)(F.ws + WS_MODS) + ((size_t)(l * 33 + mv) * 6 + which) * D; }

__device__ __forceinline__ bf16* hbuf_of(const Frame& F, int ch) { return (bf16*)(F.ws + (ch == 0 ? WS_HBUF : WS_HBUF1)); }
__device__ __forceinline__ bf16* dx_of(const Frame& F, int ch) { return (bf16*)(F.ws + (ch == 0 ? WS_DX0 : WS_DX1)); }
__device__ __forceinline__ float* affl_of(const Frame& F, int ch) { return (float*)(F.ws + WS_AFFL) + (size_t)ch * BC * NE * SEQ; }
__device__ __forceinline__ int* tokslot_of(const Frame& F, int ch) { return (int*)(F.ws + WS_TOKSLOT) + (size_t)ch * RCMAX * NE; }
__device__ __forceinline__ void mods_phase(Frame& F) {
    const int lane = launder(lane_id()), tid = F.wave * 64 + lane; (void)tid; (void)lane;
    float* sl = (float*)F.lds;
    const float* c = inp(F, I_C); const float* cc = inp(F, I_CCTX);
    for (int item = F.vcu; item < DEPTH * 96; item += F.G) {
        const int l = item / 96, jb = item % 96, j = jb * 64 + lane;
        const float* W = inp(F, I_WADA) + (size_t)l * D * 6144;
        float acc[33];
#pragma unroll
        for (int m = 0; m < 33; ++m) acc[m] = 0.f;
        for (int kh = 0; kh < 2; ++kh) {
            __syncthreads();
            for (int i = tid; i < 512 * 33; i += NTHR) { const int k = i % 512, m = i / 512; const float v = (m < 32) ? c[(size_t)m * D + kh * 512 + k] : cc[kh * 512 + k]; sl[k * 36 + m] = v * sigmoidf_(v); }
            __syncthreads();
            for (int kk0 = 0; kk0 < 64; kk0 += 8) {
                float w8[8];
#pragma unroll
                for (int u8 = 0; u8 < 8; ++u8) w8[u8] = W[(size_t)(kh * 512 + F.wave * 64 + kk0 + u8) * 6144 + j];
#pragma unroll
                for (int u8 = 0; u8 < 8; ++u8) { const int k = F.wave * 64 + kk0 + u8; const float w = w8[u8];
                    const f32x4* s4 = (const f32x4*)(sl + k * 36);
#pragma unroll
                    for (int q = 0; q < 8; ++q) { const f32x4 s = s4[q]; acc[4 * q] += s.x * w; acc[4 * q + 1] += s.y * w; acc[4 * q + 2] += s.z * w; acc[4 * q + 3] += s.w * w; }
                    acc[32] += sl[k * 36 + 32] * w; }
            }
        }
        __syncthreads();
        float* rd = (float*)F.lds;
#pragma unroll
        for (int m = 0; m < 33; ++m) rd[(F.wave * 33 + m) * 64 + lane] = acc[m];
        __syncthreads();
        for (int i = tid; i < 33 * 64; i += NTHR) { const int m = i / 64, jj = i % 64; float s = 0.f;
#pragma unroll
            for (int w = 0; w < 8; ++w) s += rd[(w * 33 + m) * 64 + jj];
            const int col = jb * 64 + jj;
            ((float*)(F.ws + WS_MODS))[(size_t)(l * 33 + m) * 6144 + col] = s + inp(F, I_BADA)[(size_t)l * 6144 + col]; }
    }
    __syncthreads();
    f32x2* tab = (f32x2*)(F.ws + WS_ROPE);
    for (int i = F.vcu * NTHR + tid; i < SEQ * 32; i += F.G * NTHR) {
        const int pos = i >> 5, fi = i & 31; const float inv = powf(10000.0f, -(float)(fi & 15) / 16.0f);
        const float ang = (fi < 16 ? (float)(pos / 64) : (float)(pos % 64)) * inv;
        tab[i] = (f32x2){cosf(ang), sinf(ang)};
    }
}

__device__ __forceinline__ void transpose_item(const float* W, int K, int N, bf16* WT, int k0, int n0, int orow0, float* scr, int lane, int ldo = 0, int kofs = 0) {
    if (ldo == 0) ldo = K;
    f32x4 v[8];
#pragma unroll
    for (int i = 0; i < 8; ++i) v[i] = *(const f32x4*)(W + (size_t)(k0 + 8 * i + (lane >> 3)) * N + n0 + 4 * (lane & 7));
#pragma unroll
    for (int i = 0; i < 8; ++i) *(f32x4*)(scr + (8 * i + (lane >> 3)) * 36 + 4 * (lane & 7)) = v[i];
    LDS_WAIT(); asm volatile("" ::: "memory");
    const int c = lane & 7;
#pragma unroll
    for (int j = 0; j < 4; ++j) { const int n = (lane >> 3) + 8 * j; const float* s = scr + (8 * c) * 36 + n;
        u32x4 o; o.x = pk2(s[0 * 36], s[1 * 36]); o.y = pk2(s[2 * 36], s[3 * 36]); o.z = pk2(s[4 * 36], s[5 * 36]); o.w = pk2(s[6 * 36], s[7 * 36]);
        *(u32x4*)(WT + (size_t)(orow0 + n) * ldo + kofs + k0 + 8 * c) = o; }
    LDS_WAIT(); asm volatile("" ::: "memory");
}
__device__ __forceinline__ void wconv_phase(Frame& F, int l) {
    const int lane = launder(lane_id()), tid = F.wave * 64 + lane; (void)tid; (void)lane;
    float* scr = (float*)(F.lds + F.wave * 16384);
    const int gw = F.vcu * NWAVES + F.wave, NGW = F.G * NWAVES;
    constexpr int I_IN = 16 * 216, I_BR = 3 * 8 * 32, I_OUT = 16 * 32, I_EX = 16 * 16 * 32;
    constexpr int NITEMS = I_IN + I_BR + I_OUT + 3 * I_EX;
    for (int it = gw; it < NITEMS; it += NGW) {
        int r = it;
        if (r < I_IN) { const int kb = r / 216, nb = r % 216; transpose_item(inp(F, I_WIN) + (size_t)l * D * INW, D, INW, (bf16*)(F.ws + WS_WIN), kb * 64, nb * 32, nb * 32, scr, lane); continue; } r -= I_IN;
        if (r < I_BR) { const int br = r / 256, q = r % 256, kb = q / 32, nb = q % 32;
            transpose_item(inp(F, I_WBR) + ((size_t)l * 3 + br) * 512 * D, 512, D, (bf16*)(F.ws + WS_WBR), kb * 64, nb * 32, nb * 32, scr, lane, 1536, br * 512); continue; } r -= I_BR;
        if (r < I_OUT) { const int kb = r / 32, nb = r % 32; transpose_item(inp(F, I_WOUT) + (size_t)l * D * D, D, D, (bf16*)(F.ws + WS_WOUT), kb * 64, nb * 32, nb * 32, scr, lane); continue; } r -= I_OUT;
        if (r < 2 * I_EX) { const int s = r / I_EX, q = r % I_EX, e = q / 512, q2 = q % 512, kb = q2 / 32, nb = q2 % 32, n0 = nb * 32;
            const float* W = inp(F, s ? I_WU : I_WG) + ((size_t)l * NE + e) * D * FF;
            transpose_item(W, D, FF, (bf16*)(F.ws + WS_WUP) + (size_t)e * 2048 * D, kb * 64, n0, 256 * (n0 / 128) + 128 * s + (n0 % 128), scr, lane); continue; } r -= 2 * I_EX;
        { const int e = r / 512, q2 = r % 512, kb = q2 / 32, nb = q2 % 32;
            transpose_item(inp(F, I_WD) + ((size_t)l * NE + e) * FF * D, FF, D, (bf16*)(F.ws + WS_WDN) + (size_t)e * D * FF, kb * 64, nb * 32, nb * 32, scr, lane); }
    }
}

__device__ __forceinline__ float xsel(bool c, float a, float b) { return c ? a : b; }
template <bool ROUTER>
__device__ __forceinline__ void norm_phase(Frame& F, int l, int ch, int nrows, bool dry = false) {
    const int lane = launder(lane_id()), tid = F.wave * 64 + lane; (void)tid; (void)lane;
    const int gw = F.vcu * NWAVES + F.wave, NGW = F.G * NWAVES;
    float* wr_l = (float*)F.lds;
    if (ROUTER) {
        const float* wr = inp(F, I_WROUTER) + (size_t)l * D * NE;
        for (int i = tid; i < D * NE; i += NTHR) { const int d = i >> 4, e = i & 15; wr_l[e * D + d] = wr[i]; }
        __syncthreads();
    }
    const float* gv = inp(F, ROUTER ? I_GFFN : I_GMIX) + (size_t)l * D;
    bf16* hb = dry ? (bf16*)(F.ws + WS_OBUF + 160 * MiB) : (bf16*)(F.ws + (ch == 0 ? WS_HBUF : WS_HBUF1));
    const bf16* dxb = dx_of(F, ch);
    f32x4 nx[2][4]; u32x2 nd[2][4];
#define NP_LOAD(c0) do { _Pragma("unroll") for (int rr_ = 0; rr_ < 2; ++rr_) { const float* xr_ = xrow_src(F, l, ch, (c0) + rr_); \
        _Pragma("unroll") for (int j_ = 0; j_ < 4; ++j_) { nx[rr_][j_] = *(const f32x4*)(xr_ + lane * 4 + 256 * j_); if (ROUTER) nd[rr_][j_] = *(const u32x2*)(dxb + (size_t)((c0) + rr_) * D + lane * 4 + 256 * j_); } } } while (0)
    const int rpw = (((nrows + NGW - 1) / NGW) + 1) & ~1, rbeg = gw * rpw, rend = (rbeg + rpw < nrows) ? rbeg + rpw : nrows;
    f32x4 gq[4], shq[4], scq[4]; int cmv = -1;
#pragma unroll
    for (int j = 0; j < 4; ++j) gq[j] = *(const f32x4*)(gv + lane * 4 + 256 * j);
    if (rbeg < rend) NP_LOAD(rbeg);
    for (int cr0 = rbeg; cr0 < rend; cr0 += 2) {
        f32x4 v[2][4]; u32x2 dv[2][4];
#pragma unroll
        for (int rr = 0; rr < 2; ++rr)
#pragma unroll
            for (int j = 0; j < 4; ++j) { v[rr][j] = nx[rr][j]; if (ROUTER) dv[rr][j] = nd[rr][j]; }
        if (cr0 + 2 < rend) NP_LOAD(cr0 + 2);
#pragma unroll
        for (int rr = 0; rr < 2; ++rr) {
            const int cr = cr0 + rr;
            const int mv = mv_of(ch, cr);
            if (mv != cmv) { cmv = mv; const float* sh = mod_ptr(F, l, mv, ROUTER ? 3 : 0); const float* sc = mod_ptr(F, l, mv, ROUTER ? 4 : 1);
#pragma unroll
                for (int j = 0; j < 4; ++j) { shq[j] = *(const f32x4*)(sh + lane * 4 + 256 * j); scq[j] = *(const f32x4*)(sc + lane * 4 + 256 * j); } }
            float ss = 0.f;
#pragma unroll
            for (int j = 0; j < 4; ++j) {
                if (ROUTER) {
                    const u32x2 dd = dv[rr][j];
                    v[rr][j].x += bflo(dd.x); v[rr][j].y += bfhi(dd.x); v[rr][j].z += bflo(dd.y); v[rr][j].w += bfhi(dd.y); }
                ss += (v[rr][j].x * v[rr][j].x + v[rr][j].y * v[rr][j].y) + (v[rr][j].z * v[rr][j].z + v[rr][j].w * v[rr][j].w); }
            const float rstd = 1.0f / sqrtf(wave_sum(ss) * (1.0f / D) + RMS_EPS);
#pragma unroll
            for (int j = 0; j < 4; ++j) {
                v[rr][j] = (v[rr][j] * rstd * gq[j]) * (scq[j] + 1.0f) + shq[j];
                u32x2 o; o.x = pk2(v[rr][j].x, v[rr][j].y); o.y = pk2(v[rr][j].z, v[rr][j].w);
                *(u32x2*)(hb + (size_t)cr * D + lane * 4 + 256 * j) = o;
            }
        }
#undef NP_LOAD
        if (ROUTER) {
            const bool b5 = lane & 32, b4 = lane & 16, b3 = lane & 8;
            float lg[2][2];
#pragma unroll
            for (int hf = 0; hf < 2; ++hf) {
                float a[2][8];
#pragma unroll
                for (int e = 0; e < 8; ++e) {
                    f32x4 w[4];
#pragma unroll
                    for (int j = 0; j < 4; ++j) w[j] = *(const f32x4*)(wr_l + (hf * 8 + e) * D + lane * 4 + 256 * j);
#pragma unroll
                    for (int rr = 0; rr < 2; ++rr) { float t = 0.f;
#pragma unroll
                        for (int j = 0; j < 4; ++j) t += (v[rr][j].x * w[j].x + v[rr][j].y * w[j].y) + (v[rr][j].z * w[j].z + v[rr][j].w * w[j].w);
                        a[rr][e] = t; }
                    if (e & 1) __builtin_amdgcn_sched_barrier(0);
                }
#pragma unroll
                for (int rr = 0; rr < 2; ++rr) {
                    float c[4], d2[2];
#pragma unroll
                    for (int i = 0; i < 4; ++i) { const float recv = __shfl_xor(xsel(b5, a[rr][i], a[rr][i + 4]), 32); c[i] = xsel(b5, a[rr][i + 4], a[rr][i]) + recv; }
#pragma unroll
                    for (int i = 0; i < 2; ++i) { const float recv = __shfl_xor(xsel(b4, c[i], c[i + 2]), 16); d2[i] = xsel(b4, c[i + 2], c[i]) + recv; }
                    float t = xsel(b3, d2[1], d2[0]) + __shfl_xor(xsel(b3, d2[0], d2[1]), 8);
                    t += __shfl_xor(t, 4); t += __shfl_xor(t, 2); t += __shfl_xor(t, 1);
                    lg[hf][rr] = t;
                }
                __builtin_amdgcn_sched_barrier(0);
            }
#pragma unroll
            for (int rr = 0; rr < 2; ++rr) {
                float m = fmaxf(lg[0][rr], lg[1][rr]);
#pragma unroll
                for (int o = 8; o < 64; o <<= 1) m = fmaxf(m, __shfl_xor(m, o));
                const float p0 = expf(lg[0][rr] - m), p1 = expf(lg[1][rr] - m); float s = p0 + p1;
#pragma unroll
                for (int o = 8; o < 64; o <<= 1) s += __shfl_xor(s, o);
                const float inv = 1.0f / s;
                const int cr = cr0 + rr, e = lane >> 3;
                if ((lane & 7) < 2 && !dry) {
                    const int ee = (lane & 1) ? e + 8 : e; const float mine = ((lane & 1) ? p1 : p0) * inv;
                    if (cr < LROWS) { const int bl = cr / SEQ, t = cr % SEQ; affl_of(F, ch)[(size_t)(bl * NE + ee) * SEQ + t] = mine; }
                    else { const int j = cr - LROWS, bl = j / CTX, t = j % CTX; ((float*)(F.ws + WS_AFFC))[(size_t)(bl * NE + ee) * CTX + t] = mine; }
                }
            }
        }
    }
}

__device__ __forceinline__ const bf16* zrow(const Frame& F, int cr) { return (const bf16*)(F.ws + WS_Z) + (size_t)cr * ZW; }

__device__ __forceinline__ void conv_phase(Frame& F, int l, int nrows) {
    const int lane = launder(lane_id()), tid = F.wave * 64 + lane; (void)tid; (void)lane;
    const int gw = F.vcu * NWAVES + F.wave, NGW = F.G * NWAVES;
    const float* cw = inp(F, I_CONVW) + (size_t)l * 3 * 512;
    float w[3][8];
#pragma unroll
    for (int k = 0; k < 3; ++k)
#pragma unroll
        for (int j = 0; j < 8; ++j) w[k][j] = cw[k * 512 + lane * 8 + j];
    bf16* ob = (bf16*)(F.ws + WS_OBUF);
    const int rpw = (nrows + NGW - 1) / NGW, rbeg = gw * rpw, rend = (rbeg + rpw < nrows) ? rbeg + rpw : nrows;
    if (rbeg >= rend) return;
#define CV_SEQ(cr_) ((cr_) < LROWS ? (cr_) / SEQ : 1024 + ((cr_) - LROWS) / CTX)
#define CV_LOADP(cr_, P) do { const bf16* zr_ = zrow(F, (cr_)); float c8_[8], x8_[8]; unpack8(*(const u32x4*)(zr_ + Z_AC + lane * 8), c8_); unpack8(*(const u32x4*)(zr_ + Z_AX + lane * 8), x8_); \
        _Pragma("unroll") for (int j_ = 0; j_ < 8; ++j_) (P)[j_] = c8_[j_] * x8_[j_]; } while (0)
    float pp[8], pc[8], pn[8];
#pragma unroll
    for (int j = 0; j < 8; ++j) pp[j] = 0.f;
    if (rbeg > 0 && CV_SEQ(rbeg - 1) == CV_SEQ(rbeg)) CV_LOADP(rbeg - 1, pp);
    CV_LOADP(rbeg, pc);
    for (int cr = rbeg; cr < rend; ++cr) {
        const bool hasn = cr + 1 < nrows, same = hasn && CV_SEQ(cr + 1) == CV_SEQ(cr);
#pragma unroll
        for (int j = 0; j < 8; ++j) pn[j] = 0.f;
        if (hasn) CV_LOADP(cr + 1, pn);
        float b8[8]; unpack8(*(const u32x4*)(zrow(F, cr) + Z_AB + lane * 8), b8);
        float acc[8];
#pragma unroll
        for (int j = 0; j < 8; ++j) acc[j] = w[0][j] * pp[j] + w[1][j] * pc[j] + (same ? w[2][j] * pn[j] : 0.f);
        u32x4 o; o.x = pk2(b8[0] * acc[0], b8[1] * acc[1]); o.y = pk2(b8[2] * acc[2], b8[3] * acc[3]); o.z = pk2(b8[4] * acc[4], b8[5] * acc[5]); o.w = pk2(b8[6] * acc[6], b8[7] * acc[7]);
        *(u32x4*)(ob + (size_t)cr * OW + lane * 8) = o;
#pragma unroll
        for (int j = 0; j < 8; ++j) { pp[j] = same ? pc[j] : 0.f; pc[j] = pn[j]; }
    }
#undef CV_SEQ
#undef CV_LOADP
}

struct NaiveState { unsigned q[32]; float o[64], m, l; };
__device__ __forceinline__ void load64(const bf16* p, float* f) {
#pragma unroll
    for (int i = 0; i < 8; ++i) unpack8(*(const u32x4*)(p + 8 * i), f + 8 * i);
}
__device__ __forceinline__ void rope64(float* x, const f32x2* tabrow) {
#pragma unroll
    for (int i = 0; i < 32; ++i) { const f32x2 cs = tabrow[i]; const float a = x[i], b = x[i + 32]; x[i] = a * cs.x - b * cs.y; x[i + 32] = a * cs.y + b * cs.x; }
}
__device__ __forceinline__ void naive_visit(NaiveState& st, const bf16* kp, const bf16* vp, float bias, bool valid, const f32x2* ropetab) {
    float s = 0.f;
#pragma unroll
    for (int c = 0; c < 4; ++c) {
        float a[8], b[8]; unpack8(*(const u32x4*)(kp + 8 * c), a); unpack8(*(const u32x4*)(kp + 32 + 8 * c), b);
        if (ropetab) {
#pragma unroll
            for (int i = 0; i < 8; ++i) { const f32x2 cs = ropetab[8 * c + i]; const float x1 = a[i], x2 = b[i]; a[i] = x1 * cs.x - x2 * cs.y; b[i] = x1 * cs.y + x2 * cs.x; }
        }
#pragma unroll
        for (int i = 0; i < 8; ++i) s += bflo(st.q[8 * c + i]) * a[i] + bfhi(st.q[8 * c + i]) * b[i];
    }
    s = valid ? s + bias : -1e30f;
    const float mn = fmaxf(st.m, s), alpha = __expf(st.m - mn), p = __expf(s - mn);
    st.m = mn; st.l = st.l * alpha + p;
#pragma unroll
    for (int c = 0; c < 8; ++c) { float v[8]; unpack8(*(const u32x4*)(vp + 8 * c), v);
#pragma unroll
        for (int i = 0; i < 8; ++i) st.o[8 * c + i] = st.o[8 * c + i] * alpha + p * v[i]; }
}
__device__ __forceinline__ void naive_attn_phase(Frame& F, int l, int ch, bool last, bf16* ob) {
    const int lane = launder(lane_id()), tid = F.wave * 64 + lane; (void)tid; (void)lane;
    const int n_lat = LROWS / 64, n_ctx = (last || ch != 0) ? 0 : CTXALL / 64;
    const int nunits = 2 * n_lat + 2 * n_ctx;
    const f32x2* tab = (const f32x2*)(F.ws + WS_ROPE);
    for (int u = F.vcu; u < nunits; u += F.G) {
        int type, blk;
        if (u < n_lat) { type = 0; blk = u; } else if (u < 2 * n_lat) { type = 1; blk = u - n_lat; } else if (u < 2 * n_lat + n_ctx) { type = 2; blk = u - 2 * n_lat; } else { type = 3; blk = u - 2 * n_lat - n_ctx; }
        const int h = F.wave;
        const int cr0 = (type < 2) ? blk * 64 : LROWS + blk * 64, cr = cr0 + lane;
        const int bl = (type < 2) ? ch * BC + cr0 / SEQ : (cr0 - LROWS) / CTX;
        const int t0 = (type < 2) ? cr0 % SEQ : (cr0 - LROWS) % CTX, t = t0 + lane;
        const int ctx0 = LROWS + bl * CTX;
        const bool sw = (type == 0 || type == 3);
        const int hk = sw ? h / 4 : h;
        const int qcol = (sw ? Z_SQ : Z_NQ) + 64 * h, kcol = (sw ? Z_SK : Z_NK) + 64 * hk, vcol = (sw ? Z_SV : Z_NV) + 64 * hk;
        NaiveState st;
        { float qf[64]; load64(zrow(F, cr) + qcol, qf);
          if (type == 0) rope64(qf, tab + (size_t)t * 32);
#pragma unroll
          for (int i = 0; i < 32; ++i) st.q[i] = pk2(qf[i] * 0.125f, qf[i + 32] * 0.125f);
#pragma unroll
          for (int i = 0; i < 64; ++i) st.o[i] = 0.f; }
        if (sw) { st.m = inp(F, I_SINK)[l * 8 + h]; st.l = 1.f; } else { st.m = -1e30f; st.l = 0.f; }
        const int lo = t0 - 128 < 0 ? 0 : t0 - 128, hi = t0 + 63 + 128 > SEQ - 1 ? SEQ - 1 : t0 + 63 + 128;
        const int r = t0 / 64, c = lane; int rs = r - 4; rs = rs < 0 ? 0 : (rs > 24 ? 24 : rs); int cs = c - 8; cs = cs < 0 ? 0 : (cs > 48 ? 48 : cs);
        const float* rpb = inp(F, I_RPB) + ((size_t)l * 8 + h) * 15 * 31;
        const int nloc = type == 0 ? hi - lo + 1 : (type == 1 ? 512 : 0);
#pragma unroll 1
        for (int idx = 0; idx < CTX + nloc; ++idx) {
            const bf16* zr; float bias = 0.f; bool valid = true; const f32x2* rt = nullptr;
            if (idx < CTX) zr = zrow(F, ctx0 + idx);
            else if (type == 0) { const int j = lo + idx - CTX, dlt = t - j; zr = zrow(F, cr0 - t0 + j); valid = dlt <= 128 && dlt >= -128; rt = tab + (size_t)j * 32; }
            else { const int q = idx - CTX, kr = rs + (q >> 6), kc = q & 63; zr = zrow(F, cr0 - t0 + kr * 64 + kc); valid = kc >= cs && kc < cs + 16;
                int dc = kc - c + 15; dc = dc < 0 ? 0 : (dc > 30 ? 30 : dc); bias = rpb[(kr - r + 7) * 31 + dc]; }
            naive_visit(st, zr + kcol, zr + vcol, bias, valid, rt);
        }
        const float inv = 1.0f / st.l;
        bf16* op = ob + (size_t)cr * OW + (sw ? 1024 : 512) + 64 * h;
#pragma unroll
        for (int i = 0; i < 8; ++i) { u32x4 o; o.x = pk2(st.o[8 * i] * inv, st.o[8 * i + 1] * inv); o.y = pk2(st.o[8 * i + 2] * inv, st.o[8 * i + 3] * inv); o.z = pk2(st.o[8 * i + 4] * inv, st.o[8 * i + 5] * inv); o.w = pk2(st.o[8 * i + 6] * inv, st.o[8 * i + 7] * inv);
            *(u32x4*)(op + 8 * i) = o; }
    }
}

typedef short s16x4 __attribute__((ext_vector_type(4)));
typedef float f32x16 __attribute__((ext_vector_type(16)));
typedef __bf16 bf16x2_t __attribute__((ext_vector_type(2)));
__device__ __forceinline__ unsigned cvtpk(float lo, float hi) { const f32x2 v = {lo, hi}; return __builtin_bit_cast(unsigned, __builtin_convertvector(v, bf16x2_t)); }
typedef short v4i16_t __attribute__((ext_vector_type(4)));
__device__ __forceinline__ s16x4 vtr(const LAS unsigned char* p) { return __builtin_bit_cast(s16x4, __builtin_amdgcn_ds_read_tr16_b64_v4i16((LAS v4i16_t*)p)); }
constexpr int AK_RS = 144, AV_RS = 192, AK_BYTES = 128 * AK_RS, AV_BYTES = 128 * AV_RS, ASTAGE = AK_BYTES + AV_BYTES, A_RPB_OFF = 2 * ASTAGE;
#define MFMA32(a, b, c) __builtin_amdgcn_mfma_f32_32x32x16_bf16((a), (b), (c), 0, 0, 0)
__device__ __forceinline__ float xlane32(float v) {
    const auto rr = __builtin_amdgcn_permlane32_swap(__builtin_bit_cast(unsigned, v), __builtin_bit_cast(unsigned, v), false, false);
    return __builtin_bit_cast(float, (lane_id() & 32) ? rr[0] : rr[1]);
}
__device__ __forceinline__ float max3f(float a, float b, float c) { return fmaxf(fmaxf(a, b), c); }
__device__ __forceinline__ float rowmax32(const f32x16& p0, const f32x16& p1) {
    float a = max3f(p0[0], p0[1], p1[0]), b = max3f(p0[2], p0[3], p1[1]); a = max3f(a, p1[2], p1[3]);
#pragma unroll
    for (int i = 4; i < 16; i += 4) { a = max3f(a, p0[i], p0[i + 1]); b = max3f(b, p0[i + 2], p0[i + 3]); a = max3f(a, p1[i], p1[i + 1]); b = max3f(b, p1[i + 2], p1[i + 3]); }
    const float m = fmaxf(a, b);
    const auto rr = __builtin_amdgcn_permlane32_swap(__builtin_bit_cast(unsigned, m), __builtin_bit_cast(unsigned, m), false, false);
    return fmaxf(__builtin_bit_cast(float, rr[0]), __builtin_bit_cast(float, rr[1]));
}
__device__ __forceinline__ void lds_read_vt8(unsigned addr, s16x4 (&t)[8]) {
    asm volatile("ds_read_b64_tr_b16 %0, %8\n\tds_read_b64_tr_b16 %1, %8 offset:1536\n\tds_read_b64_tr_b16 %2, %8 offset:64\n\tds_read_b64_tr_b16 %3, %8 offset:1600\n\t"
                 "ds_read_b64_tr_b16 %4, %8 offset:3072\n\tds_read_b64_tr_b16 %5, %8 offset:4608\n\tds_read_b64_tr_b16 %6, %8 offset:3136\n\tds_read_b64_tr_b16 %7, %8 offset:4672\n\t"
                 "s_waitcnt lgkmcnt(0)"
        : "=&v"(t[0]), "=&v"(t[1]), "=&v"(t[2]), "=&v"(t[3]), "=&v"(t[4]), "=&v"(t[5]), "=&v"(t[6]), "=&v"(t[7]) : "v"(addr) : "memory");
}
static_assert(16 * 192 == 3072 && 8 * 192 == 1536, "lds_read_vt8 offsets assume AV_RS = 192");
__device__ __forceinline__ void lds_read_k4(unsigned addr, bf16x8 (&ka)[4]) {
    asm volatile("ds_read_b128 %0, %4\n\tds_read_b128 %1, %4 offset:32\n\tds_read_b128 %2, %4 offset:64\n\tds_read_b128 %3, %4 offset:96\n\ts_waitcnt lgkmcnt(0)"
        : "=&v"(ka[0]), "=&v"(ka[1]), "=&v"(ka[2]), "=&v"(ka[3]) : "v"(addr) : "memory");
}
__device__ __forceinline__ void lds_read_k8(unsigned addr, bf16x8 (&ka)[4], bf16x8 (&kb)[4]) {
    asm volatile("ds_read_b128 %0, %8\n\tds_read_b128 %1, %8 offset:32\n\tds_read_b128 %2, %8 offset:64\n\tds_read_b128 %3, %8 offset:96\n\t"
                 "ds_read_b128 %4, %8 offset:4608\n\tds_read_b128 %5, %8 offset:4640\n\tds_read_b128 %6, %8 offset:4672\n\tds_read_b128 %7, %8 offset:4704\n\t"
                 "s_waitcnt lgkmcnt(0)"
        : "=&v"(ka[0]), "=&v"(ka[1]), "=&v"(ka[2]), "=&v"(ka[3]), "=&v"(kb[0]), "=&v"(kb[1]), "=&v"(kb[2]), "=&v"(kb[3]) : "v"(addr) : "memory");
}
constexpr int A_ROPE_OFF = A_RPB_OFF + 4096;
template <int VAR, int TY>
__device__ __forceinline__ void attn_units(Frame& F, int l, int ch, bool last, bf16* ob) {
    const int lane = launder(lane_id()), tid = F.wave * 64 + lane;
    const int wave = F.wave, r = lane & 31, hh = lane >> 5;
    const float LOG2E = 1.4426950408889634f;
    const f32x2* tab = (const f32x2*)(F.ws + WS_ROPE); (void)tab;
    float* rpbl = (float*)(F.lds + A_RPB_OFF);
    const int skey = tid >> 2, sc = tid & 3, sb = skey >> 6, srow = skey & 63;
    const int nNA = BC * 8 * 8, nSW = BC * 16 * 4, nCX = (last || ch != 0) ? 0 : NB * 8 * 2;
    const int ubeg = (TY == 1) ? 0 : (TY == 0 ? nNA : nNA + nSW), uend = (TY == 1) ? nNA : (TY == 0 ? nNA + nSW : nNA + nSW + nCX);
    for (int u = ubeg + F.vcu; u < uend; u += F.G) {
        int type, bl, h, rg = 0, n = 0;
        if (u < nNA) { type = 1; bl = u >> 6; rg = ((u >> 3) + (u >> 8)) & 7; h = u & 7; }
        else if (u < nNA + nSW) { const int v = u - nNA; type = 0; bl = v >> 6; n = ((v >> 2) + 4 * (v >> 8)) & 15; h = 4 * ((v >> 1) & 1) + 2 * (v & 1); }
        else { const int v = u - nNA - nSW; type = (v < NB * 8) ? 2 : 3; const int vv = v % (NB * 8); bl = vv >> 3; h = vv & 7; }
        if (TY != 2) type = TY;
        const bool sw = (type == 0 || type == 3);
        const int head = (type == 0) ? h + (wave >> 2) : h;
        const int jb = wave & 3;
        const int rq = 4 * rg + 2 * (wave >> 2) + (r >> 4), cq = 16 * jb + (r & 15);
        const int qrow = (type == 1) ? bl * SEQ + 64 * rq + cq : (type == 0) ? bl * SEQ + 128 * n + 32 * (wave & 3) + r : LROWS + bl * CTX + 32 * wave + r;
        const int qcol = (sw ? Z_SQ : Z_NQ) + 64 * head, kcol = sw ? Z_SK + 64 * (head >> 2) : Z_NK + 64 * head, vcol = sw ? Z_SV + 64 * (head >> 2) : Z_NV + 64 * head;
        const int ocol = (sw ? 1024 : 512) + 64 * head;
        const int ctx0 = LROWS + ((type < 2) ? ch * BC + bl : bl) * CTX;
        int nloc = 0, loc0 = 0;
        if (type == 0) { const int jlo = (n == 0) ? 2 : 0, jhi = (n == 15) ? 3 : 5; nloc = jhi - jlo + 1; loc0 = jlo; }
        else if (type == 1) { int a = 4 * rg - 4; a = a < 0 ? 0 : (a > 24 ? 24 : a); int b = 4 * rg - 1; b = b < 0 ? 0 : (b > 24 ? 24 : b); loc0 = a; nloc = b + 7 - a + 1; }
        const int nt = 4 + nloc;
        bf16x8 qf[4];
        {
            const bf16* qp = zrow(F, qrow) + qcol + 8 * hh;
            float q[4][8];
#pragma unroll
            for (int s4 = 0; s4 < 4; ++s4) unpack8(*(const u32x4*)(qp + 16 * s4), q[s4]);
            if (type == 0) {
                const int pos = qrow - bl * SEQ; const f32x2* rl = (const f32x2*)(F.lds + A_ROPE_OFF);
#pragma unroll
                for (int s4 = 0; s4 < 2; ++s4) { const f32x2* tr = rl + (s4 == 0 ? (pos >> 6) : 32 + (pos & 63)) * 16 + 8 * hh;
#pragma unroll
                    for (int j = 0; j < 8; ++j) { const f32x2 cs = tr[j]; const float x1 = q[s4][j], x2 = q[s4 + 2][j]; q[s4][j] = x1 * cs.x - x2 * cs.y; q[s4 + 2][j] = x1 * cs.y + x2 * cs.x; } }
            }
            const float qs = 0.125f * LOG2E;
#pragma unroll
            for (int s4 = 0; s4 < 4; ++s4) { u32x4 p; p.x = cvtpk(q[s4][0] * qs, q[s4][1] * qs); p.y = cvtpk(q[s4][2] * qs, q[s4][3] * qs); p.z = cvtpk(q[s4][4] * qs, q[s4][5] * qs); p.w = cvtpk(q[s4][6] * qs, q[s4][7] * qs);
                qf[s4] = __builtin_bit_cast(bf16x8, p); }
        }
        float m = 0.f, lsum = 0.f;
        if (sw) { m = inp(F, I_SINK)[l * 8 + head] * LOG2E; lsum = (hh == 0) ? 1.f : 0.f; }
        f32x16 o0, o1;
#pragma unroll
        for (int i = 0; i < 16; ++i) { o0[i] = 0.f; o1[i] = 0.f; }
        const int kst = (type == 1) ? (16 * jb - 8 < 0 ? 0 : (16 * jb - 8 > 32 ? 32 : 16 * jb - 8)) : 0;
        unsigned bixp[4] = {0u, 0u, 0u, 0u};
        {
            const int csq = cq - 8 < 0 ? 0 : (cq - 8 > 48 ? 48 : cq - 8);
#pragma unroll
            for (int i = 0; i < 16; ++i) { const int kc = kst + (i & 3) + 8 * (i >> 2) + 4 * hh; bixp[i >> 2] |= (unsigned)(((kc >= csq && kc <= csq + 15) ? kc - cq + 15 : 31) * 4) << (8 * (i & 3)); }
        }
#define BIX(i) ((bixp[(i) >> 2] >> (8 * ((i) & 3))) & 0xffu)
        const int rsl = rq - 4 < 0 ? 0 : (rq - 4 > 24 ? 24 : rq - 4);
        u32x4 gk0, gk1, gv0, gv1;
        bool grope = false; int gpos = 0;
#define A_TILE_ROW0(ti) ((ti) < 4 ? ctx0 + 64 * (ti) : (type == 0 ? bl * SEQ + 128 * n - 128 + 64 * (loc0 + (ti) - 4) : bl * SEQ + 64 * (loc0 + (ti) - 4)))
#define A_STAGE_LOAD(T) do { const int ti_ = 2 * (T) + sb; const int tic_ = ti_ < nt ? ti_ : nt - 1; const int row0_ = A_TILE_ROW0(tic_); const bf16* sp_ = zrow(F, row0_ + srow) + 8 * sc; \
            gk0 = *(const u32x4*)(sp_ + kcol); gk1 = *(const u32x4*)(sp_ + kcol + 32); gv0 = *(const u32x4*)(sp_ + vcol); gv1 = *(const u32x4*)(sp_ + vcol + 32); grope = (type == 0 && tic_ >= 4); gpos = row0_ - bl * SEQ + srow; } while (0)
#define A_STAGE_WRITE(st) do { unsigned char* dk_ = F.lds + (st) * ASTAGE + skey * AK_RS + 16 * sc; unsigned char* dv_ = F.lds + (st) * ASTAGE + AK_BYTES + skey * AV_RS + 16 * sc; \
            if (grope) { float a_[8], b_[8]; unpack8(gk0, a_); unpack8(gk1, b_); \
                const f32x4* rl_ = (const f32x4*)(F.lds + A_ROPE_OFF + ((sc < 2 ? (gpos >> 6) : 32 + (gpos & 63)) * 16 + 8 * (sc & 1)) * 8); \
                _Pragma("unroll") for (int j_ = 0; j_ < 4; ++j_) { const f32x4 rcj_ = rl_[j_]; const float c0_ = rcj_.x, s0_ = rcj_.y, c1_ = rcj_.z, s1_ = rcj_.w; \
                    const float x1_ = a_[2 * j_], x2_ = b_[2 * j_], y1_ = a_[2 * j_ + 1], y2_ = b_[2 * j_ + 1]; \
                    a_[2 * j_] = x1_ * c0_ - x2_ * s0_; b_[2 * j_] = x1_ * s0_ + x2_ * c0_; a_[2 * j_ + 1] = y1_ * c1_ - y2_ * s1_; b_[2 * j_ + 1] = y1_ * s1_ + y2_ * c1_; } \
                gk0.x = cvtpk(a_[0], a_[1]); gk0.y = cvtpk(a_[2], a_[3]); gk0.z = cvtpk(a_[4], a_[5]); gk0.w = cvtpk(a_[6], a_[7]); \
                gk1.x = cvtpk(b_[0], b_[1]); gk1.y = cvtpk(b_[2], b_[3]); gk1.z = cvtpk(b_[4], b_[5]); gk1.w = cvtpk(b_[6], b_[7]); } \
            *(u32x4*)dk_ = gk0; *(u32x4*)(dk_ + 64) = gk1; *(u32x4*)dv_ = gv0; *(u32x4*)(dv_ + 64) = gv1; } while (0)
#define A_QK(XV, kbase) do { bf16x8 k4_[4]; lds_read_k4((unsigned)(size_t)(kbase), k4_); _Pragma("unroll") for (int i_ = 0; i_ < 16; ++i_) (XV)[i_] = -m; \
            _Pragma("unroll") for (int s4_ = 0; s4_ < 4; ++s4_) (XV) = MFMA32(k4_[s4_], qf[s4_], (XV)); } while (0)
#define A_QK2(XA, XB, kbA) do { bf16x8 ka_[4], kb_[4]; lds_read_k8((unsigned)(size_t)(kbA), ka_, kb_); \
            _Pragma("unroll") for (int i_ = 0; i_ < 16; ++i_) { (XA)[i_] = -m; (XB)[i_] = -m; } \
            _Pragma("unroll") for (int s4_ = 0; s4_ < 4; ++s4_) { (XA) = MFMA32(ka_[s4_], qf[s4_], (XA)); (XB) = MFMA32(kb_[s4_], qf[s4_], (XB)); } } while (0)
#define A_NEG(XV) do { _Pragma("unroll") for (int i_ = 0; i_ < 16; ++i_) (XV)[i_] = -1e30f; } while (0)
#define A_PV(XV, vbase) do { u32x4 pa_, pb_; \
            pa_.x = cvtpk((XV)[0], (XV)[1]); pa_.y = cvtpk((XV)[2], (XV)[3]); pa_.z = cvtpk((XV)[4], (XV)[5]); pa_.w = cvtpk((XV)[6], (XV)[7]); \
            pb_.x = cvtpk((XV)[8], (XV)[9]); pb_.y = cvtpk((XV)[10], (XV)[11]); pb_.z = cvtpk((XV)[12], (XV)[13]); pb_.w = cvtpk((XV)[14], (XV)[15]); \
            s16x4 t_[8]; lds_read_vt8((unsigned)(size_t)(vbase), t_); \
            const bf16x8 pfa_ = __builtin_bit_cast(bf16x8, pa_), pfb_ = __builtin_bit_cast(bf16x8, pb_); \
            o0 = MFMA32(__builtin_shufflevector(t_[0], t_[1], 0, 1, 2, 3, 4, 5, 6, 7), pfa_, o0); o1 = MFMA32(__builtin_shufflevector(t_[2], t_[3], 0, 1, 2, 3, 4, 5, 6, 7), pfa_, o1); \
            o0 = MFMA32(__builtin_shufflevector(t_[4], t_[5], 0, 1, 2, 3, 4, 5, 6, 7), pfb_, o0); o1 = MFMA32(__builtin_shufflevector(t_[6], t_[7], 0, 1, 2, 3, 4, 5, 6, 7), pfb_, o1); } while (0)
        if (type == 1) { const float* rp = inp(F, I_RPB) + ((size_t)l * 8 + h) * 465;
            for (int i = tid; i < 17 * 32; i += NTHR) { const int tr = i >> 5, tc = i & 31; rpbl[i] = (tr >= 1 && tr <= 15 && tc < 31) ? rp[(tr - 1) * 31 + tc] * LOG2E : -1e30f; } }
        A_STAGE_LOAD(0); A_STAGE_WRITE(0);
        __syncthreads();
        const int qi = 32 * (wave & 3) + r;
        const LAS unsigned char* ldsl = F.ldsl;
        const int kro = r * AK_RS + 16 * hh;
        const int vro = (4 * hh + ((r & 15) >> 2)) * AV_RS + (16 * (r >> 4) + 4 * (r & 3)) * 2;
        const int krw = kro + kst * AK_RS, vrw = vro + kst * AV_RS;
        const int rqa = 4 * rg + 2 * (wave >> 2), rsa = rqa - 4 < 0 ? 0 : (rqa - 4 > 24 ? 24 : rqa - 4), rsb = rqa - 3 < 0 ? 0 : (rqa - 3 > 24 ? 24 : rqa - 3);
        const int nT = (nt + 1) >> 1;
#pragma unroll 1
        for (int T = 0; T < nT; ++T) {
            const int st = T & 1;
            if (VAR != 1) { if (T + 1 < nT) A_STAGE_LOAD(T + 1); }
            const LAS unsigned char* Kst = ldsl + st * ASTAGE; const LAS unsigned char* Vst = Kst + AK_BYTES;
            const bool vB = 2 * T + 1 < nt;
            const int jA = loc0 + 2 * T - 4, jB = jA + 1;
            if (VAR == 2) { } else
            if (T >= 2 && type == 1) {
                const bool nA = (jA >= rsa && jA <= rsb + 7), nB = vB && (jB >= rsa && jB <= rsb + 7);
                if (nA || nB) {
                    f32x16 x0, x1;
                    if (nA) { A_QK(x0, Kst + krw); const LAS unsigned char* tb = ldsl + A_RPB_OFF + ((jA >= rsl && jA <= rsl + 7) ? (jA - rq + 8) : 0) * 128;
#pragma unroll
                        for (int i = 0; i < 16; ++i) x0[i] += *(const LAS float*)(tb + BIX(i)); } else A_NEG(x0);
                    if (nB) { A_QK(x1, Kst + krw + 64 * AK_RS); const LAS unsigned char* tb = ldsl + A_RPB_OFF + ((jB >= rsl && jB <= rsl + 7) ? (jB - rq + 8) : 0) * 128;
#pragma unroll
                        for (int i = 0; i < 16; ++i) x1[i] += *(const LAS float*)(tb + BIX(i)); } else A_NEG(x1);
                    const float mt = rowmax32(x0, x1);
                    if (__any(mt > 8.0f)) {
                        const float dl = fmaxf(mt, 0.f), alpha = __builtin_amdgcn_exp2f(-dl);
                        m += dl; lsum *= alpha;
#pragma unroll
                        for (int i = 0; i < 16; ++i) { x0[i] -= dl; x1[i] -= dl; o0[i] *= alpha; o1[i] *= alpha; }
                    }
                    float ps = 0.f;
                    if (nA) {
#pragma unroll
                        for (int i = 0; i < 16; ++i) { x0[i] = __builtin_amdgcn_exp2f(x0[i]); ps += x0[i]; }
                        A_PV(x0, Vst + vrw); }
                    if (nB) {
#pragma unroll
                        for (int i = 0; i < 16; ++i) { x1[i] = __builtin_amdgcn_exp2f(x1[i]); ps += x1[i]; }
                        A_PV(x1, Vst + vrw + 64 * AV_RS); }
                    lsum += ps;
                }
            } else {
#pragma unroll
                for (int bi = 0; bi < 2; ++bi) {
                    if (bi == 1 && !vB) break;
                    const int j = jA + bi;
                    bool need = true, mask = false; int vlo = -1, vhi = 64;
                    if (T >= 2) { const int q0 = 32 * (wave & 3); need = (64 * j + 63 >= q0) && (64 * j <= q0 + 287); mask = !((64 * j >= q0 + 31) && (64 * j + 63 <= q0 + 256)); vlo = qi - 64 * j; vhi = qi + 256 - 64 * j; }
                    if (need) {
                        f32x16 x0, x1;
                        A_QK2(x0, x1, Kst + kro + bi * 64 * AK_RS);
                        if (mask) {
#pragma unroll
                            for (int i = 0; i < 16; ++i) { const int k0 = (i & 3) + 8 * (i >> 2) + 4 * hh, k1 = k0 + 32; x0[i] = (k0 >= vlo && k0 <= vhi) ? x0[i] : -1e30f; x1[i] = (k1 >= vlo && k1 <= vhi) ? x1[i] : -1e30f; }
                        }
                        const float mt = rowmax32(x0, x1);
                        const bool fst = !sw && T == 0 && bi == 0;
                        if (fst || __any(mt > 8.0f)) {
                            const float dl = fst ? mt : fmaxf(mt, 0.f), alpha = fst ? 1.f : __builtin_amdgcn_exp2f(-dl);
                            m += dl; lsum *= alpha;
#pragma unroll
                            for (int i = 0; i < 16; ++i) { x0[i] -= dl; x1[i] -= dl; o0[i] *= alpha; o1[i] *= alpha; }
                        }
                        float ps = 0.f;
#pragma unroll
                        for (int i = 0; i < 16; ++i) { x0[i] = __builtin_amdgcn_exp2f(x0[i]); ps += x0[i]; }
                        A_PV(x0, Vst + vro + bi * 64 * AV_RS);
#pragma unroll
                        for (int i = 0; i < 16; ++i) { x1[i] = __builtin_amdgcn_exp2f(x1[i]); ps += x1[i]; }
                        lsum += ps;
                        A_PV(x1, Vst + vro + (bi * 64 + 32) * AV_RS);
                    }
                }
            }
            if (VAR != 1) { if (T + 1 < nT) A_STAGE_WRITE(st ^ 1); }
            __syncthreads();
        }
#undef A_QK
#undef A_QK2
#undef A_NEG
#undef A_PV
#undef BIX
        const float inv = 1.0f / (lsum + __shfl_xor(lsum, 32));
        const int l2 = lane_id(), r2 = l2 & 31, h2 = l2 >> 5;
        const int rq2 = 4 * rg + 2 * (wave >> 2) + (r2 >> 4), cq2 = 16 * (wave & 3) + (r2 & 15);
        const int qrow2 = (type == 1) ? bl * SEQ + 64 * rq2 + cq2 : (type == 0) ? bl * SEQ + 128 * n + 32 * (wave & 3) + r2 : LROWS + bl * CTX + 32 * wave + r2;
        bf16* op = ob + (size_t)qrow2 * OW + ocol + 4 * h2;
#pragma unroll
        for (int g = 0; g < 4; ++g) {
            u32x2 w0, w1; w0.x = cvtpk(o0[4 * g] * inv, o0[4 * g + 1] * inv); w0.y = cvtpk(o0[4 * g + 2] * inv, o0[4 * g + 3] * inv);
            w1.x = cvtpk(o1[4 * g] * inv, o1[4 * g + 1] * inv); w1.y = cvtpk(o1[4 * g + 2] * inv, o1[4 * g + 3] * inv);
            *(u32x2*)(op + 8 * g) = w0; *(u32x2*)(op + 32 + 8 * g) = w1;
        }
    }
#undef A_TILE_ROW0
#undef A_STAGE_LOAD
#undef A_STAGE_WRITE
}
template <int VAR>
__device__ __forceinline__ void attn_phase(Frame& F, int l, int ch, bool last, bf16* ob) {
    { const int tid = F.wave * 64 + launder(lane_id()); const f32x2* tab = (const f32x2*)(F.ws + WS_ROPE);
      f32x2* rl = (f32x2*)(F.lds + A_ROPE_OFF); for (int i = tid; i < 96 * 16; i += NTHR) { const int a = i >> 4, f = i & 15; rl[i] = (a < 32) ? tab[(size_t)(a * 64) * 32 + f] : tab[(size_t)(a - 32) * 32 + 16 + f]; } }
    __syncthreads();
    attn_units<VAR, 1>(F, l, ch, last, ob);
    attn_units<VAR, 0>(F, l, ch, last, ob);
    attn_units<VAR, 2>(F, l, ch, last, ob);
}


template <int NPL>
__device__ __forceinline__ void topk_select_wave(const float* aff, int cap, int crbase, int ubase, int slot0, int e, int* tokslot, float* gatev, int* seltok, int lane) {
    unsigned v[NPL];
#pragma unroll
    for (int i = 0; i < NPL; i += 4) { const u32x4 t = *(const u32x4*)(aff + lane * NPL + i); v[i] = t.x; v[i + 1] = t.y; v[i + 2] = t.z; v[i + 3] = t.w; }
    unsigned T = 0u;
#pragma unroll 1
    for (int bit = 30; bit >= 0; --bit) {
        const unsigned cand = T | (1u << bit); int c = 0;
#pragma unroll
        for (int i = 0; i < NPL; ++i) c += (v[i] >= cand) ? 1 : 0;
#pragma unroll
        for (int o = 1; o < 64; o <<= 1) c += __shfl_xor(c, o);
        if (c >= cap) T = cand;
    }
    int ngt = 0, nti = 0;
#pragma unroll
    for (int i = 0; i < NPL; ++i) { ngt += (v[i] > T) ? 1 : 0; nti += (v[i] == T) ? 1 : 0; }
    int tot_gt = ngt;
#pragma unroll
    for (int o = 1; o < 64; o <<= 1) tot_gt += __shfl_xor(tot_gt, o);
    const int need = cap - tot_gt;
    int tinc = nti;
#pragma unroll
    for (int o = 1; o < 64; o <<= 1) { const int t = __shfl_up(tinc, o); if (lane >= o) tinc += t; }
    int tie_before = tinc - nti;
    unsigned selmask = 0u; int nsel = 0;
#pragma unroll
    for (int i = 0; i < NPL; ++i) { const bool tie = (v[i] == T); const bool sel = (v[i] > T) || (tie && tie_before < need); tie_before += tie ? 1 : 0; selmask |= sel ? (1u << i) : 0u; nsel += sel ? 1 : 0; }
    int sinc = nsel;
#pragma unroll
    for (int o = 1; o < 64; o <<= 1) { const int t = __shfl_up(sinc, o); if (lane >= o) sinc += t; }
    int pos = sinc - nsel;
#pragma unroll
    for (int i = 0; i < NPL; ++i) {
        const bool sel = (selmask >> i) & 1u; const int t = lane * NPL + i;
        tokslot[(size_t)(crbase + t) * NE + e] = sel ? pos : -1;
        if (sel) { seltok[slot0 + pos] = ubase + crbase + t; gatev[slot0 + pos] = __builtin_bit_cast(float, v[i]); ++pos; }
    }
}
__device__ __forceinline__ void topk_phase(Frame& F, bool last) {
    const int lane = launder(lane_id());
    int* gsel = (int*)(F.ws + WS_SELTOK);
    float* gatev = (float*)(F.ws + WS_GATEV);
    const bool cx = !last;
    for (int p = F.vcu; p < BC * NE; p += F.G) {
        const int bl = p / NE, e = p % NE;
        const int slotL = p * CAP_L, slotC0 = SLOT_CT0 + e * (NB * CAP_C) + bl * CAP_C, slotC1 = slotC0 + BC * CAP_C;
        if (F.wave == 0) topk_select_wave<32>(affl_of(F, 0) + (size_t)p * SEQ, CAP_L, bl * SEQ, 0, slotL, e, tokslot_of(F, 0), gatev, gsel, lane);
        else if (F.wave == 3) topk_select_wave<32>(affl_of(F, 1) + (size_t)p * SEQ, CAP_L, bl * SEQ, RCMAX, NSLOTMAX + slotL, e, tokslot_of(F, 1), gatev, gsel, lane);
        else if (F.wave == 1 && cx) topk_select_wave<4>((const float*)(F.ws + WS_AFFC) + (size_t)p * CTX, CAP_C, LROWS + bl * CTX, 0, slotC0, e, tokslot_of(F, 0), gatev, gsel, lane);
        else if (F.wave == 2 && cx) topk_select_wave<4>((const float*)(F.ws + WS_AFFC) + (size_t)(p + BC * NE) * CTX, CAP_C, LROWS + (bl + BC) * CTX, 0, slotC1, e, tokslot_of(F, 0), gatev, gsel, lane);
    }
}

__device__ __forceinline__ void combine_phase(Frame& F, int l, int ch, bool last, bool dry = false) {
    const int lane = launder(lane_id()), tid = F.wave * 64 + lane; (void)tid; (void)lane;
    const int gw = F.vcu * NWAVES + F.wave, NGW = F.G * NWAVES;
    const int nrows = last ? LROWS : nrows_of(ch);
    const bf16* yb = (const bf16*)(F.ws + WS_YBUF) + (size_t)ch * NSLOTMAX * D; const int* tokslot = tokslot_of(F, ch); const float* gatev = (const float*)(F.ws + WS_GATEV) + (size_t)ch * NSLOTMAX;
    int nslot = -1; f32x4 nxv[4]; u32x2 ndx[4]; const bf16* dxb = dx_of(F, ch);
#define CB_LOAD(c) do { nslot = (lane < 16) ? tokslot[(size_t)(c) * NE + lane] : -1; const float* xr_ = xrow_src(F, l, ch, (c)); \
        _Pragma("unroll") for (int j_ = 0; j_ < 4; ++j_) { nxv[j_] = *(const f32x4*)(xr_ + lane * 4 + 256 * j_); ndx[j_] = *(const u32x2*)(dxb + (size_t)(c) * D + lane * 4 + 256 * j_); } } while (0)
    const int rpw = (nrows + NGW - 1) / NGW, rbeg = gw * rpw, rend = (rbeg + rpw < nrows) ? rbeg + rpw : nrows;
    f32x4 gtq[4], shq[4], scq[4], gmq[4]; int cmv = -1;
#pragma unroll
    for (int j = 0; j < 4; ++j) gmq[j] = *(const f32x4*)((last ? inp(F, I_GFINAL) : inp(F, I_GMIX) + (size_t)(l + 1) * D) + lane * 4 + 256 * j);
    if (rbeg < rend) CB_LOAD(rbeg);
    for (int cr = rbeg; cr < rend; ++cr) {
        const bool lat = cr < LROWS; const int bl = lat ? cr / SEQ : (cr - LROWS) / CTX;
        { const int mv = mv_of(ch, cr); if (mv != cmv) { cmv = mv; const float* gt = mod_ptr(F, l, mv, 5); const float* sh = mod_ptr(F, last ? l : l + 1, mv, 0); const float* sc = mod_ptr(F, last ? l : l + 1, mv, 1);
#pragma unroll
            for (int j = 0; j < 4; ++j) { gtq[j] = *(const f32x4*)(gt + lane * 4 + 256 * j); shq[j] = *(const f32x4*)(sh + lane * 4 + 256 * j); scq[j] = *(const f32x4*)(sc + lane * 4 + 256 * j); } } }
        const int myslot = nslot; f32x4 v[4];
#pragma unroll
        for (int j = 0; j < 4; ++j) { v[j] = nxv[j]; v[j].x += bflo(ndx[j].x); v[j].y += bfhi(ndx[j].x); v[j].z += bflo(ndx[j].y); v[j].w += bfhi(ndx[j].y); }
        if (cr + 1 < rend) CB_LOAD(cr + 1);
        float acc[16];
#pragma unroll
        for (int i = 0; i < 16; ++i) acc[i] = 0.f;
        unsigned mask = (unsigned)__ballot(myslot >= 0) & 0xFFFFu;
        while (mask) {
            const int e0 = __builtin_ctz(mask); mask &= mask - 1;
            const bool two = mask != 0u; const int e1 = two ? __builtin_ctz(mask) : e0; if (two) mask &= mask - 1;
            const int p0 = __shfl(myslot, e0), p1 = __shfl(myslot, e1);
            const int s0 = lat ? (bl * NE + e0) * CAP_L + p0 : SLOT_CT0 + e0 * (NB * CAP_C) + bl * CAP_C + p0;
            const int s1 = lat ? (bl * NE + e1) * CAP_L + p1 : SLOT_CT0 + e1 * (NB * CAP_C) + bl * CAP_C + p1;
            u32x2 ua[4], ub[4]; const float ga = gatev[s0], gb = gatev[s1];
#pragma unroll
            for (int j = 0; j < 4; ++j) { ua[j] = *(const u32x2*)(yb + (size_t)s0 * D + lane * 4 + 256 * j); ub[j] = *(const u32x2*)(yb + (size_t)s1 * D + lane * 4 + 256 * j); }
#pragma unroll
            for (int j = 0; j < 4; ++j) { acc[4 * j] += ga * bflo(ua[j].x); acc[4 * j + 1] += ga * bfhi(ua[j].x); acc[4 * j + 2] += ga * bflo(ua[j].y); acc[4 * j + 3] += ga * bfhi(ua[j].y); }
            if (two) {
#pragma unroll
                for (int j = 0; j < 4; ++j) { acc[4 * j] += gb * bflo(ub[j].x); acc[4 * j + 1] += gb * bfhi(ub[j].x); acc[4 * j + 2] += gb * bflo(ub[j].y); acc[4 * j + 3] += gb * bfhi(ub[j].y); }
            }
        }
        float* xr = dry ? (float*)(F.ws + WS_OBUF) + (size_t)cr * D : xrow_dst(F, ch, cr);
        float ss = 0.f;
#pragma unroll
        for (int j = 0; j < 4; ++j) { const f32x4 g4 = gtq[j];
            v[j].x += g4.x * acc[4 * j]; v[j].y += g4.y * acc[4 * j + 1]; v[j].z += g4.z * acc[4 * j + 2]; v[j].w += g4.w * acc[4 * j + 3];
            ss += (v[j].x * v[j].x + v[j].y * v[j].y) + (v[j].z * v[j].z + v[j].w * v[j].w); }
        const float rstd = 1.0f / sqrtf(wave_sum(ss) * (1.0f / D) + RMS_EPS);
        if (!last) {
#pragma unroll
            for (int j = 0; j < 4; ++j) *(f32x4*)(xr + lane * 4 + 256 * j) = v[j];
            bf16* hb = dry ? (bf16*)(F.ws + WS_OBUF + 160 * MiB) : hbuf_of(F, ch);
#pragma unroll
            for (int j = 0; j < 4; ++j) {
                const f32x4 hv = (v[j] * rstd * gmq[j]) * (scq[j] + 1.0f) + shq[j];
                u32x2 o; o.x = pk2(hv.x, hv.y); o.y = pk2(hv.z, hv.w);
                *(u32x2*)(hb + (size_t)cr * D + lane * 4 + 256 * j) = o;
            }
            continue;
        }
        {
#pragma unroll
            for (int j = 0; j < 4; ++j) v[j] = v[j] * rstd * gmq[j];
#if defined(PROBE_ATTN)
            { const unsigned cn = __hip_atomic_load((unsigned*)(F.ws + WS_CTL) + CW_DIAG, __ATOMIC_RELAXED, __HIP_MEMORY_SCOPE_AGENT); const float sc = 1.0f + 0.02f * log2f(1.0f + (float)cn);
#pragma unroll
              for (int j = 0; j < 4; ++j) v[j] = v[j] * sc; }
#endif
        }
#pragma unroll
        for (int j = 0; j < 4; ++j) *(f32x4*)(xr + lane * 4 + 256 * j) = v[j];
    }
#undef CB_LOAD
}

using pg8::Unit; using pg8::cvt_pk_bf16;
struct SchedBase { int nM, nN, G, c, rep;
    __device__ __forceinline__ bool tile(int i, int& pm, int& pn, int& sub) const { sub = i % rep; return pg8::tile_of((long)(i / rep) * G + c, nM, nN, pm, pn); } };

struct SchedIn : SchedBase { const char* A; const char* B; int nMfull = 0, kvM = 0;
    __device__ __forceinline__ bool next(int i, Unit& u) const { int sub; u.aux = 0; u.pad = 0;
        if (!tile(i, u.pm, u.pn, sub)) {
            const long L = (long)(i / rep) * G + c - (long)nM * nN; if (kvM == 0 || L < 0 || L >= (long)kvM * 5) return false;
            const int q = (int)L % 5; u.pm = nM + (int)L / 5; u.pn = q < 4 ? 8 + q : 14; }
        u.A = A + (size_t)u.pm * 256 * D * 2; u.B = B + (size_t)u.pn * 256 * D * 2; return true; } };
__device__ __forceinline__ size_t gb_off(int pm, int g, int wr, int wc, int fr, int fq) { return ((size_t)(pm * 12 + g) * 131072) + (size_t)(((wr * 4 + wc) * 64 + fq * 16 + fr) * 16); }
struct EpiStoreBf16 { static constexpr bool PERM = true; bf16* O; int ldc; unsigned char* GB;
    __device__ __forceinline__ void operator()(const f32x4 (&acc)[2][2][4][2], const Unit& u, int wr, int wc, int fr, int fq) const {
        if (u.pn >= Z_G / 256) {
            unsigned char* gp = GB + gb_off(u.pm, u.pn - Z_G / 256, wr, wc, fr, fq);
#pragma unroll
            for (int ai = 0; ai < 2; ++ai)
#pragma unroll
                for (int m = 0; m < 4; ++m)
#pragma unroll
                    for (int bj = 0; bj < 2; ++bj) { f32x4 v0 = acc[ai][bj][m][0], v1 = acc[ai][bj][m][1];
#pragma unroll
                        for (int j = 0; j < 4; ++j) { v0[j] = fmaxf(sigmoidf_(v0[j]), 1e-30f); v1[j] = fmaxf(sigmoidf_(v1[j]), 1e-30f); }
                        u32x4 w; w.x = cvt_pk_bf16(v0[0], v0[1]); w.y = cvt_pk_bf16(v0[2], v0[3]); w.z = cvt_pk_bf16(v1[0], v1[1]); w.w = cvt_pk_bf16(v1[2], v1[3]);
                        __builtin_nontemporal_store(w, (u32x4*)(gp + ((ai * 4 + m) * 2 + bj) * 8192)); }
        } else {
            const int row0 = u.pm * 256 + wr * 64 + fr, col0 = u.pn * 256 + wc * 32 + 8 * fq;
#pragma unroll
            for (int ai = 0; ai < 2; ++ai)
#pragma unroll
                for (int m = 0; m < 4; ++m) { bf16* rowp = O + (size_t)(row0 + ai * 128 + m * 16) * ldc + col0;
#pragma unroll
                    for (int bj = 0; bj < 2; ++bj) { const f32x4 v0 = acc[ai][bj][m][0], v1 = acc[ai][bj][m][1];
                        u32x4 w; w.x = cvt_pk_bf16(v0[0], v0[1]); w.y = cvt_pk_bf16(v0[2], v0[3]); w.z = cvt_pk_bf16(v1[0], v1[1]); w.w = cvt_pk_bf16(v1[2], v1[3]);
                        __builtin_nontemporal_store(w, (u32x4*)(rowp + bj * 128)); } }
        }
    } };

struct SchedMerge : SchedBase { const char* A; const char* B;
    __device__ __forceinline__ bool next(int i, Unit& u) const { int sub; if (!tile(i, u.pm, u.pn, sub)) return false; u.aux = 0; u.pad = 0;
        u.A = A + (size_t)u.pm * 256 * OW * 2; u.B = B + (size_t)u.pn * 256 * 1536 * 2; return true; } };
__device__ __forceinline__ void gate_load8x2(const unsigned char* sbase, unsigned vo, u32x4 (&a)[8], u32x4 (&b)[8]) {
    unsigned t0, t1, t2, t3;
    asm volatile("v_add_u32 %[t0], 0, %[vo]\n\tglobal_load_dwordx4 %[a0], %[t0], %[sb]\n\t"
        "v_add_u32 %[t2], 524288, %[vo]\n\tglobal_load_dwordx4 %[b0], %[t2], %[sb]\n\t"
        "v_add_u32 %[t1], 8192, %[vo]\n\tglobal_load_dwordx4 %[a1], %[t1], %[sb]\n\t"
        "v_add_u32 %[t3], 532480, %[vo]\n\tglobal_load_dwordx4 %[b1], %[t3], %[sb]\n\t"
        "v_add_u32 %[t0], 16384, %[vo]\n\tglobal_load_dwordx4 %[a2], %[t0], %[sb]\n\t"
        "v_add_u32 %[t2], 540672, %[vo]\n\tglobal_load_dwordx4 %[b2], %[t2], %[sb]\n\t"
        "v_add_u32 %[t1], 24576, %[vo]\n\tglobal_load_dwordx4 %[a3], %[t1], %[sb]\n\t"
        "v_add_u32 %[t3], 548864, %[vo]\n\tglobal_load_dwordx4 %[b3], %[t3], %[sb]\n\t"
        "v_add_u32 %[t0], 32768, %[vo]\n\tglobal_load_dwordx4 %[a4], %[t0], %[sb]\n\t"
        "v_add_u32 %[t2], 557056, %[vo]\n\tglobal_load_dwordx4 %[b4], %[t2], %[sb]\n\t"
        "v_add_u32 %[t1], 40960, %[vo]\n\tglobal_load_dwordx4 %[a5], %[t1], %[sb]\n\t"
        "v_add_u32 %[t3], 565248, %[vo]\n\tglobal_load_dwordx4 %[b5], %[t3], %[sb]\n\t"
        "v_add_u32 %[t0], 49152, %[vo]\n\tglobal_load_dwordx4 %[a6], %[t0], %[sb]\n\t"
        "v_add_u32 %[t2], 573440, %[vo]\n\tglobal_load_dwordx4 %[b6], %[t2], %[sb]\n\t"
        "v_add_u32 %[t1], 57344, %[vo]\n\tglobal_load_dwordx4 %[a7], %[t1], %[sb]\n\t"
        "v_add_u32 %[t3], 581632, %[vo]\n\tglobal_load_dwordx4 %[b7], %[t3], %[sb]\n\t"
        "s_waitcnt vmcnt(0)"
        : [a0]"=&v"(a[0]), [a1]"=&v"(a[1]), [a2]"=&v"(a[2]), [a3]"=&v"(a[3]), [a4]"=&v"(a[4]), [a5]"=&v"(a[5]), [a6]"=&v"(a[6]), [a7]"=&v"(a[7]), [b0]"=&v"(b[0]), [b1]"=&v"(b[1]), [b2]"=&v"(b[2]), [b3]"=&v"(b[3]), [b4]"=&v"(b[4]), [b5]"=&v"(b[5]), [b6]"=&v"(b[6]), [b7]"=&v"(b[7]), [t0]"=&v"(t0), [t1]"=&v"(t1), [t2]"=&v"(t2), [t3]"=&v"(t3)
        : [vo]"v"(vo), [sb]"s"(sbase) : "memory");
}
__device__ __forceinline__ void gate_load16(const unsigned char* sbase, unsigned vo, u32x4 (&a)[16]) {
    unsigned t0, t1;
    asm volatile("v_add_u32 %[t0], 0, %[vo]\n\tglobal_load_dwordx4 %[a0], %[t0], %[sb]\n\t"
        "v_add_u32 %[t1], 8192, %[vo]\n\tglobal_load_dwordx4 %[a1], %[t1], %[sb]\n\t"
        "v_add_u32 %[t0], 16384, %[vo]\n\tglobal_load_dwordx4 %[a2], %[t0], %[sb]\n\t"
        "v_add_u32 %[t1], 24576, %[vo]\n\tglobal_load_dwordx4 %[a3], %[t1], %[sb]\n\t"
        "v_add_u32 %[t0], 32768, %[vo]\n\tglobal_load_dwordx4 %[a4], %[t0], %[sb]\n\t"
        "v_add_u32 %[t1], 40960, %[vo]\n\tglobal_load_dwordx4 %[a5], %[t1], %[sb]\n\t"
        "v_add_u32 %[t0], 49152, %[vo]\n\tglobal_load_dwordx4 %[a6], %[t0], %[sb]\n\t"
        "v_add_u32 %[t1], 57344, %[vo]\n\tglobal_load_dwordx4 %[a7], %[t1], %[sb]\n\t"
        "v_add_u32 %[t0], 65536, %[vo]\n\tglobal_load_dwordx4 %[a8], %[t0], %[sb]\n\t"
        "v_add_u32 %[t1], 73728, %[vo]\n\tglobal_load_dwordx4 %[a9], %[t1], %[sb]\n\t"
        "v_add_u32 %[t0], 81920, %[vo]\n\tglobal_load_dwordx4 %[a10], %[t0], %[sb]\n\t"
        "v_add_u32 %[t1], 90112, %[vo]\n\tglobal_load_dwordx4 %[a11], %[t1], %[sb]\n\t"
        "v_add_u32 %[t0], 98304, %[vo]\n\tglobal_load_dwordx4 %[a12], %[t0], %[sb]\n\t"
        "v_add_u32 %[t1], 106496, %[vo]\n\tglobal_load_dwordx4 %[a13], %[t1], %[sb]\n\t"
        "v_add_u32 %[t0], 114688, %[vo]\n\tglobal_load_dwordx4 %[a14], %[t0], %[sb]\n\t"
        "v_add_u32 %[t1], 122880, %[vo]\n\tglobal_load_dwordx4 %[a15], %[t1], %[sb]\n\t"
        "s_waitcnt vmcnt(0)"
        : [a0]"=&v"(a[0]), [a1]"=&v"(a[1]), [a2]"=&v"(a[2]), [a3]"=&v"(a[3]), [a4]"=&v"(a[4]), [a5]"=&v"(a[5]), [a6]"=&v"(a[6]), [a7]"=&v"(a[7]), [a8]"=&v"(a[8]), [a9]"=&v"(a[9]), [a10]"=&v"(a[10]), [a11]"=&v"(a[11]), [a12]"=&v"(a[12]), [a13]"=&v"(a[13]), [a14]"=&v"(a[14]), [a15]"=&v"(a[15]), [t0]"=&v"(t0), [t1]"=&v"(t1)
        : [vo]"v"(vo), [sb]"s"(sbase) : "memory");
}
struct EpiMerge { static constexpr bool PERM = true; const unsigned char* GB; bf16* O;
    __device__ __forceinline__ void mid(f32x4 (&acc)[2][2][4][2], const Unit& u, int seg, int wr, int wc, int fr, int fq) const {
        const unsigned char* tb = GB + (size_t)(u.pm * 12 + (seg - 1) * 4 + u.pn) * 131072;
        const unsigned vo = (unsigned)(((wr * 4 + wc) * 64 + fq * 16 + fr) * 16);
#pragma unroll
        for (int ai = 0; ai < 2; ++ai) {
            u32x4 a[8], b[8]; gate_load8x2(tb + ai * 65536, vo, a, b);
#pragma unroll
            for (int m = 0; m < 4; ++m)
#pragma unroll
                for (int bj = 0; bj < 2; ++bj) { float gpv[8], gnv[8]; unpack8(a[m * 2 + bj], gpv); unpack8(b[m * 2 + bj], gnv);
#pragma unroll
                    for (int j = 0; j < 4; ++j) { acc[ai][bj][m][0][j] *= gpv[j] * __builtin_amdgcn_rcpf(gnv[j]); acc[ai][bj][m][1][j] *= gpv[4 + j] * __builtin_amdgcn_rcpf(gnv[4 + j]); } }
        }
    }
    __device__ __forceinline__ void operator()(const f32x4 (&acc)[2][2][4][2], const Unit& u, int wr, int wc, int fr, int fq) const {
        const int row0 = u.pm * 256 + wr * 64 + fr, col0 = u.pn * 256 + wc * 32 + 8 * fq;
        const unsigned char* tb = GB + (size_t)(u.pm * 12 + 8 + u.pn) * 131072;
        const unsigned vo = (unsigned)(((wr * 4 + wc) * 64 + fq * 16 + fr) * 16);
        u32x4 g[16]; gate_load16(tb, vo, g);
#pragma unroll
        for (int ai = 0; ai < 2; ++ai)
#pragma unroll
            for (int m = 0; m < 4; ++m) { const size_t row = (size_t)(row0 + ai * 128 + m * 16);
#pragma unroll
                for (int bj = 0; bj < 2; ++bj) { const int col = col0 + bj * 128;
                    float g8[8]; unpack8(g[(ai * 4 + m) * 2 + bj], g8);
                    const f32x4 v0 = acc[ai][bj][m][0], v1 = acc[ai][bj][m][1];
                    u32x4 w; w.x = cvt_pk_bf16(v0[0] * g8[0], v0[1] * g8[1]); w.y = cvt_pk_bf16(v0[2] * g8[2], v0[3] * g8[3]); w.z = cvt_pk_bf16(v1[0] * g8[4], v1[1] * g8[5]); w.w = cvt_pk_bf16(v1[2] * g8[6], v1[3] * g8[7]);
                    *(u32x4*)(O + row * D + col) = w; } }
    } };

struct EpiOut { static constexpr bool PERM = true; const Frame* F; int l, ch; bf16* O;
    __device__ __forceinline__ void operator()(const f32x4 (&acc)[2][2][4][2], const Unit& u, int wr, int wc, int fr, int fq) const {
        const int cr0 = u.pm * 256; const float* gt = mod_ptr(*F, l, mv_of(ch, cr0), 2);
        const int row0 = cr0 + wr * 64 + fr, col0 = u.pn * 256 + wc * 32 + 8 * fq;
#pragma unroll
        for (int bj = 0; bj < 2; ++bj) { const f32x4 g0 = *(const f32x4*)(gt + col0 + bj * 128), g1 = *(const f32x4*)(gt + col0 + bj * 128 + 4);
#pragma unroll
            for (int ai = 0; ai < 2; ++ai)
#pragma unroll
                for (int m = 0; m < 4; ++m) { const f32x4 v0 = acc[ai][bj][m][0] * g0, v1 = acc[ai][bj][m][1] * g1;
                    u32x4 w; w.x = cvt_pk_bf16(v0[0], v0[1]); w.y = cvt_pk_bf16(v0[2], v0[3]); w.z = cvt_pk_bf16(v1[0], v1[1]); w.w = cvt_pk_bf16(v1[2], v1[3]);
                    *(u32x4*)(O + (size_t)(row0 + ai * 128 + m * 16) * D + col0 + bj * 128) = w; } }
    } };

__device__ __forceinline__ int expert_of_tile(int pm) { return pm < SLT ? pm % NE : (pm - SLT) / (NB * CAP_C / 256); }
__device__ __forceinline__ void ffn_tile(int t, bool last, int& c1, int& pml) {
    const int per = last ? 2 * BC : 2 * BC + NB * CAP_C / 256;
    const int e = t / per, k = t % per;
    if (k < BC) { c1 = 0; pml = k * NE + e; }
    else if (!last && k < BC + NB * CAP_C / 256) { c1 = 0; pml = SLT + e * (NB * CAP_C / 256) + (k - BC); }
    else { c1 = 1; pml = (k - (per - BC)) * NE + e; }
}
struct SchedUp : SchedBase { const char* A; const char* B; const int* gidx; int nM0;
    __device__ __forceinline__ bool next(int i, Unit& u) const { int sub; if (!tile(i, u.pm, u.pn, sub)) return false; u.pad = 0;
        int c1, pml; ffn_tile(u.pm, nM0 == SLT, c1, pml); u.aux = c1 * PBT + pml;
        u.A = A; u.B = B + ((size_t)expert_of_tile(pml) * 2048 + (size_t)u.pn * 256) * D * 2; return true; } };
struct EpiUp { static constexpr bool PERM = true; bf16* O;
    __device__ __forceinline__ void operator()(const f32x4 (&acc)[2][2][4][2], const Unit& u, int wr, int wc, int fr, int fq) const {
        const int row0 = u.aux * 256 + wr * 64 + fr, col0 = u.pn * 128 + wc * 32 + 8 * fq;
#pragma unroll
        for (int ai = 0; ai < 2; ++ai)
#pragma unroll
            for (int m = 0; m < 4; ++m) { float h[8];
#pragma unroll
                for (int n = 0; n < 2; ++n)
#pragma unroll
                    for (int j = 0; j < 4; ++j) { const float g = acc[ai][0][m][n][j], uu = acc[ai][1][m][n][j]; h[4 * n + j] = g * sigmoidf_(g) * uu; }
                u32x4 w; w.x = cvt_pk_bf16(h[0], h[1]); w.y = cvt_pk_bf16(h[2], h[3]); w.z = cvt_pk_bf16(h[4], h[5]); w.w = cvt_pk_bf16(h[6], h[7]);
                *(u32x4*)(O + (size_t)(row0 + ai * 128 + m * 16) * FF + col0) = w; }
    } };

struct SchedDown : SchedBase { const char* A; const char* B; int nM0;
    __device__ __forceinline__ bool next(int i, Unit& u) const { int sub; if (!tile(i, u.pm, u.pn, sub)) return false; u.pad = 0;
        int c1, pml; ffn_tile(nM - 1 - u.pm, nM0 == SLT, c1, pml); u.aux = c1 * PBT + pml;
        u.A = A + (size_t)u.aux * 256 * FF * 2; u.B = B + ((size_t)expert_of_tile(pml) * D + (size_t)u.pn * 256) * FF * 2; return true; } };
__device__ __forceinline__ void load8_rows_f32(const float* sbase, unsigned vo, float (&g)[8]) {
    asm volatile("global_load_dword %[g0], %[vo], %[sb]\n\tglobal_load_dword %[g1], %[vo], %[sb] offset:64\n\tglobal_load_dword %[g2], %[vo], %[sb] offset:128\n\tglobal_load_dword %[g3], %[vo], %[sb] offset:192\n\t"
                 "global_load_dword %[g4], %[vo], %[sb] offset:512\n\tglobal_load_dword %[g5], %[vo], %[sb] offset:576\n\tglobal_load_dword %[g6], %[vo], %[sb] offset:640\n\tglobal_load_dword %[g7], %[vo], %[sb] offset:704\n\t"
                 "s_waitcnt vmcnt(0)"
        : [g0]"=&v"(g[0]), [g1]"=&v"(g[1]), [g2]"=&v"(g[2]), [g3]"=&v"(g[3]), [g4]"=&v"(g[4]), [g5]"=&v"(g[5]), [g6]"=&v"(g[6]), [g7]"=&v"(g[7])
        : [vo]"v"(vo), [sb]"s"(sbase) : "memory");
}
struct EpiDown { static constexpr bool PERM = true; bf16* O; const float* gv;
    __device__ __forceinline__ void operator()(const f32x4 (&acc)[2][2][4][2], const Unit& u, int wr, int wc, int fr, int fq) const {
        const int row0 = u.aux * 256 + wr * 64 + fr, col0 = u.pn * 256 + wc * 32 + 8 * fq;
#pragma unroll
        for (int ai = 0; ai < 2; ++ai)
#pragma unroll
            for (int m = 0; m < 4; ++m) { const int row = row0 + ai * 128 + m * 16; const float g = 1.0f; bf16* rowp = O + (size_t)row * D + col0;
#pragma unroll
                for (int bj = 0; bj < 2; ++bj) { const f32x4 v0 = acc[ai][bj][m][0] * g, v1 = acc[ai][bj][m][1] * g;
                    u32x4 w; w.x = cvt_pk_bf16(v0[0], v0[1]); w.y = cvt_pk_bf16(v0[2], v0[3]); w.z = cvt_pk_bf16(v1[0], v1[1]); w.w = cvt_pk_bf16(v1[2], v1[3]);
                    *(u32x4*)(rowp + bj * 128) = w; } }
    } };

#if defined(PROBE_ATTN)
__device__ __forceinline__ void probe_compare(Frame& F, int nrows, const bf16* a, const bf16* b) {
    const int lane = launder(lane_id());
    const int gw = F.vcu * NWAVES + F.wave, NGW = F.G * NWAVES;
    unsigned cnt = 0;
    for (int cr = gw; cr < nrows; cr += NGW) {
#pragma unroll
        for (int j = 0; j < 2; ++j) { float x[8], y[8]; unpack8(*(const u32x4*)(a + (size_t)cr * OW + 512 + lane * 8 + 512 * j), x); unpack8(*(const u32x4*)(b + (size_t)cr * OW + 512 + lane * 8 + 512 * j), y);
#pragma unroll
            for (int i = 0; i < 8; ++i) { const float d = fabsf(x[i] - y[i]); cnt += (!(d <= 0.01f + 0.05f * fabsf(y[i]))) ? 1u : 0u; } }
    }
#pragma unroll
    for (int o = 1; o < 64; o <<= 1) cnt += __shfl_xor(cnt, o);
    if (lane == 0 && cnt) atomicAdd((unsigned*)(F.ws + WS_CTL) + CW_DIAG, cnt);
}
#endif

constexpr int SEQ_TOTAL = 2 + DEPTH * (NCH * 4 + 5);

__global__ void __launch_bounds__(NTHR, 2) fwd_kernel(Args args) {
    extern __shared__ __attribute__((aligned(16))) unsigned char lds[];
    Frame F;
    F.lds = lds; F.ldsl = (LAS unsigned char*)lds; F.ws = args.ws; F.out = args.out;
    F.wave = __builtin_amdgcn_readfirstlane(threadIdx.x >> 6);
    F.G = gridDim.x; { const int bx = blockIdx.x; F.vcu = (F.G % 8 == 0) ? (bx % 8) * (F.G / 8) + bx / 8 : bx; }
    volatile LAS unsigned* MISC = (volatile LAS unsigned*)(F.ldsl + MISC_OFF);
    for (int u = threadIdx.x; u < (LDS_BYTES - LDSCTL_OFF) / 4; u += NTHR) ((LAS unsigned*)(F.ldsl + LDSCTL_OFF))[u] = 0u;
    if (threadIdx.x < 19) *(LAS unsigned long long*)(F.ldsl + PTR_OFF + 8 * threadIdx.x) = (unsigned long long)args.in[threadIdx.x];
    __syncthreads();
    const int lo = args.ph_lo, hi = args.ph_hi;
    const bool multi = (hi - lo) > 1;
    XcdBarrier bar; bar.bar = (unsigned*)(F.ws + WS_CTL) + CW_BAR; bar.x = 0; bar.st = nullptr;
    if (multi) bar = xcd_barrier_post((unsigned*)(F.ws + WS_CTL) + CW_BAR, MISC + 8);
    int seq = 0;
#ifndef PHMASK
#define PHMASK 0xFFFF
#endif
#define EN(b) ((PHMASK >> (b)) & 1)
#ifndef REPMASK
#define REPMASK 0
#endif
#define REP(b) ((REPMASK >> (b)) & 1)
#define RUN(b, stmt) do { stmt; if (REP(b)) { __syncthreads(); stmt; } } while (0)
#define IN(k) (lo <= (k) && (k) < hi)
#define SEAM(k) do { if (IN(k) && IN((k) + 1)) xcd_barrier(bar, F.wave); } while (0)

    if (IN(seq)) { if (EN(0)) RUN(0, mods_phase(F)); if (EN(1)) RUN(1, wconv_phase(F, 0)); } SEAM(seq); ++seq;
    if (EN(2) && IN(seq)) { norm_phase<false>(F, 0, 0, nrows_of(0)); norm_phase<false>(F, 0, 1, nrows_of(1)); } SEAM(seq); ++seq;

    for (int l = 0; l < DEPTH; ++l) {
        const bool last = (l == DEPTH - 1);
        for (int ch = 0; ch < NCH; ++ch) {
            if (EN(3) && IN(seq)) {
                SchedIn S; S.nM = (last && ch == 0) ? LT : nrows_of(ch) / 256; S.kvM = (last && ch == 0) ? CTT : 0; S.nN = INW / 256; S.G = F.G; S.c = blockIdx.x; S.rep = 1; S.A = (const char*)hbuf_of(F, ch); S.B = (const char*)(F.ws + WS_WIN);
                EpiStoreBf16 E{(bf16*)(F.ws + WS_Z), ZW, F.ws + WS_GB};
                RUN(3, (pg8::gemm_phase<EpiStoreBf16, SchedIn, true, true>(F.ldsl, D * 2, D, S, E, F.wave)));
            } SEAM(seq); ++seq;
            if (IN(seq)) { if (EN(4)) RUN(4, conv_phase(F, l, last ? LROWS : nrows_of(ch)));
#if defined(ATTN_NAIVE)
                if (EN(5)) naive_attn_phase(F, l, ch, last, (bf16*)(F.ws + WS_OBUF));
#else
                if (EN(5)) attn_phase<0>(F, l, ch, last, (bf16*)(F.ws + WS_OBUF));
#if defined(PROBE_AVAR)
                __syncthreads(); attn_phase<PROBE_AVAR>(F, l, ch, last, (bf16*)(F.ws + WS_PART));
#endif
#endif
#if defined(PROBE_ATTN)
                naive_attn_phase(F, l, ch, last, (bf16*)(F.ws + WS_PART));
                xcd_barrier(bar, F.wave);
                probe_compare(F, last ? LROWS : nrows_of(ch), (const bf16*)(F.ws + WS_OBUF), (const bf16*)(F.ws + WS_PART));
#endif
            } SEAM(seq); ++seq;
            if (EN(6) && IN(seq)) {
                SchedMerge S; S.nM = (last ? LROWS : nrows_of(ch)) / 256; S.nN = D / 256; S.G = F.G; S.c = blockIdx.x; S.rep = 1; S.A = (const char*)(F.ws + WS_OBUF); S.B = (const char*)(F.ws + WS_WBR);
                EpiMerge E{(const unsigned char*)(F.ws + WS_GB), hbuf_of(F, ch)};
                RUN(6, (pg8::gemm_phase<EpiMerge, SchedMerge, true, true, 3>(F.ldsl, OW * 2, 1536, S, E, F.wave)));
#if defined(PROBE_NOHOOK)
                { __syncthreads(); EpiMerge E2{(const unsigned char*)(F.ws + WS_GB), (bf16*)(F.ws + WS_PART)}; pg8::gemm_phase<EpiMerge, SchedMerge, true, true, PROBE_NOHOOK>(F.ldsl, OW * 2, 1536, S, E2, F.wave); }
#endif
            } SEAM(seq); ++seq;
            if (EN(7) && IN(seq)) {
                SchedIn S; S.nM = (last ? LROWS : nrows_of(ch)) / 256; S.nN = D / 256; S.G = F.G; S.c = blockIdx.x; S.rep = 1; S.A = (const char*)hbuf_of(F, ch); S.B = (const char*)(F.ws + WS_WOUT);
                EpiOut E{&F, l, ch, dx_of(F, ch)};
                RUN(7, (pg8::gemm_phase<EpiOut, SchedIn, true, true>(F.ldsl, D * 2, D, S, E, F.wave)));
#if defined(PROBE_OUTK)
                { __syncthreads(); EpiOut E2{&F, l, ch, (bf16*)(F.ws + WS_PART)}; pg8::gemm_phase<EpiOut, SchedIn, true, true>(F.ldsl, D * 2, PROBE_OUTK, S, E2, F.wave); }
#endif
            } SEAM(seq); ++seq;
        }
        if (EN(8) && IN(seq)) {
            norm_phase<true>(F, l, 0, last ? LROWS : nrows_of(0)); __syncthreads(); norm_phase<true>(F, l, 1, LROWS);
            if (REP(8)) { __syncthreads(); norm_phase<true>(F, l, 0, last ? LROWS : nrows_of(0), true); __syncthreads(); norm_phase<true>(F, l, 1, LROWS, true); }
        } SEAM(seq); ++seq;
        if (EN(9) && IN(seq)) { topk_phase(F, last); } SEAM(seq); ++seq;
        if (EN(10) && IN(seq)) {
            SchedUp S; S.nM0 = last ? SLT : SLT + SCT; S.nM = S.nM0 + SLT; S.nN = 8; S.G = F.G; S.c = blockIdx.x; S.rep = 1; S.A = (const char*)(F.ws + WS_HBUF); S.B = (const char*)(F.ws + WS_WUP); S.gidx = (const int*)(F.ws + WS_SELTOK);
            EpiUp E{(bf16*)(F.ws + WS_HMID)};
            RUN(10, (pg8::gemm_phase<EpiUp, SchedUp, true, true, 1, true>(F.ldsl, D * 2, D, S, E, F.wave)));
        } SEAM(seq); ++seq;
        if (EN(11) && IN(seq)) {
            SchedDown S; S.nM0 = last ? SLT : SLT + SCT; S.nM = S.nM0 + SLT; S.nN = 4; S.G = F.G; S.c = blockIdx.x; S.rep = 1; S.A = (const char*)(F.ws + WS_HMID); S.B = (const char*)(F.ws + WS_WDN);
            EpiDown E{(bf16*)(F.ws + WS_YBUF), (const float*)(F.ws + WS_GATEV)};
            RUN(11, (pg8::gemm_phase<EpiDown, SchedDown, true, true>(F.ldsl, FF * 2, FF, S, E, F.wave)));
        } SEAM(seq); ++seq;
        if (IN(seq)) {
            if (EN(12)) { if (REP(12)) { combine_phase(F, l, 0, last, true); combine_phase(F, l, 1, last, true); } combine_phase(F, l, 0, last); combine_phase(F, l, 1, last); }
            if (!last && EN(1)) RUN(13, wconv_phase(F, l + 1));
        } SEAM(seq); ++seq;
    }
#undef IN
#undef SEAM
}

extern "C" void kernel_launch(void* const* d_in, const int* in_sizes, int n_in, void* d_out, int out_size, void* d_ws, size_t ws_size, hipStream_t stream) {
    static int grid = 0;
    if (grid == 0) {
        if (n_in != 19 || ws_size < WS_END) { fprintf(stderr, "kernel_launch: unexpected n_in %d / ws %zu (need %zu)\n", n_in, ws_size, (size_t)WS_END); grid = -1; return; }
        int dev = 0, cus = 0;
        if (hipGetDevice(&dev) != hipSuccess || hipDeviceGetAttribute(&cus, hipDeviceAttributeMultiprocessorCount, dev) != hipSuccess) { grid = -1; return; }
        if (hipFuncSetAttribute((const void*)fwd_kernel, hipFuncAttributeMaxDynamicSharedMemorySize, LDS_BYTES) != hipSuccess) { fprintf(stderr, "kernel_launch: hipFuncSetAttribute failed\n"); grid = -1; return; }
        int per_cu = 0;
        if (hipOccupancyMaxActiveBlocksPerMultiprocessor(&per_cu, (const void*)fwd_kernel, NTHR, LDS_BYTES) != hipSuccess || per_cu < 1) fprintf(stderr, "kernel_launch: occupancy query says %d\n", per_cu);
        (void)hipGetLastError();
        grid = cus;
    }
    if (grid < 0) return;
    (void)hipMemsetAsync((char*)d_ws + WS_CTL, 0, CTL_ZERO_BYTES, stream);
    Args a{};
    for (int i = 0; i < 19; ++i) a.in[i] = (const float*)d_in[i];
    a.out = (float*)d_out; a.ws = (unsigned char*)d_ws;
#if MK_ONE_LAUNCH
    a.ph_lo = 0; a.ph_hi = SEQ_TOTAL;
    hipLaunchKernelGGL(fwd_kernel, dim3(grid), dim3(NTHR), LDS_BYTES, stream, a);
#else
    for (int s = 0; s < SEQ_TOTAL; ++s) { a.ph_lo = s; a.ph_hi = s + 1; hipLaunchKernelGGL(fwd_kernel, dim3(grid), dim3(NTHR), LDS_BYTES, stream, a); }
#endif
}
```

```cpp
#include <hip/hip_runtime.h>
#include <cstdio>
#include <cstdint>

#ifndef MK_ONE_LAUNCH
#define MK_ONE_LAUNCH 1
#endif

#define GAS __attribute__((address_space(1)))
#define LAS __attribute__((address_space(3)))
typedef unsigned short bf16;
typedef short bf16x8 __attribute__((ext_vector_type(8)));
typedef float f32x4 __attribute__((ext_vector_type(4)));
typedef float f32x2 __attribute__((ext_vector_type(2)));
typedef unsigned u32x4 __attribute__((ext_vector_type(4)));
typedef unsigned u32x2 __attribute__((ext_vector_type(2)));

constexpr int D = 1024, NB = 32, SEQ = 2048, CTX = 256, DEPTH = 4, INW = 6912, NE = 16, FF = 1024;
constexpr int NCH = 2, BC = NB / NCH;
constexpr int LROWS = BC * SEQ, CTXALL = NB * CTX, RCMAX = LROWS + CTXALL;
constexpr int LT = LROWS / 256, CTT = CTXALL / 256;
__host__ __device__ constexpr int nrows_of(int ch) { return ch == 0 ? RCMAX : LROWS; }
constexpr int CAP_L = 2 * SEQ / NE, CAP_C = 2 * CTX / NE;
constexpr int SLOT_CT0 = BC * NE * CAP_L;
constexpr int NSLOTMAX = SLOT_CT0 + NE * NB * CAP_C;
constexpr int SLT = SLOT_CT0 / 256, SCT = NE * NB * CAP_C / 256;
constexpr float RMS_EPS = 1e-6f;
constexpr int Z_AB = 0, Z_AC = 512, Z_AX = 1024, Z_NQ = 1536, Z_NK = 2048, Z_NV = 2560, Z_SQ = 3072, Z_SK = 3584, Z_SV = 3712, Z_G = 3840;
constexpr int OW = 1536;
constexpr int ZW = Z_G;

constexpr size_t MiB = 1u << 20;
constexpr size_t WS_CTL = 0, CTL_ZERO_BYTES = 1 * MiB;
constexpr size_t WS_MODS = 1 * MiB;
constexpr size_t WS_ROPE = 5 * MiB;
constexpr size_t WS_AFFL = 6 * MiB;
constexpr size_t WS_AFFC = 10 * MiB;
constexpr size_t WS_GATEV = 11 * MiB;
constexpr size_t WS_SELTOK = 12 * MiB;
constexpr size_t WS_XC = 13 * MiB;
constexpr size_t WS_WIN = 45 * MiB;
constexpr size_t WS_WBR = 59 * MiB;
constexpr size_t WS_WOUT = 62 * MiB;
constexpr size_t WS_WUP = 64 * MiB;
constexpr size_t WS_WDN = 128 * MiB;
constexpr size_t WS_HBUF = 160 * MiB;
constexpr size_t WS_HBUF1 = 240 * MiB;
constexpr size_t WS_OBUF = 304 * MiB;
constexpr size_t WS_PART = 424 * MiB;
constexpr size_t WS_Z = 544 * MiB;
constexpr size_t WS_GB = 844 * MiB;
constexpr size_t WS_HMID = WS_OBUF;
constexpr size_t WS_YBUF = WS_OBUF + 288 * MiB;
constexpr size_t WS_DX0 = 1084 * MiB, WS_DX1 = 1164 * MiB;
constexpr size_t WS_TOKSLOT = 1228 * MiB;
constexpr size_t WS_END = 1234 * MiB;
static_assert((size_t)RCMAX * ZW * 2 == 300 * MiB && (size_t)LROWS * ZW * 2 == 240 * MiB && (size_t)NSLOTMAX * 1024 * 2 == 160 * MiB && (size_t)RCMAX * 1024 * 2 == 80 * MiB && (size_t)RCMAX * OW * 2 == 120 * MiB
              && (size_t)(RCMAX / 256) * 12 * 131072 == 240 * MiB && WS_YBUF + 288 * MiB <= WS_GB + 240 * MiB && WS_HBUF1 == WS_HBUF + (size_t)RCMAX * 1024 * 2, "ws map");
constexpr int PBT = NSLOTMAX / 256;
constexpr int CW_TMO = 0, CW_DIAG = 64, CW_BAR = 4096;

constexpr int RING_BYTES = 131072, LDSCTL_OFF = RING_BYTES, MISC_OFF = LDSCTL_OFF + 320, LDS_BYTES = 147456;
constexpr int NWAVES = 8, NTHR = 512;

__device__ __forceinline__ unsigned f2bf(float f) { unsigned u = __builtin_bit_cast(unsigned, f); return (u + 0x7fffu + ((u >> 16) & 1u)) >> 16; }
__device__ __forceinline__ unsigned pk2(float lo, float hi) { return f2bf(lo) | (f2bf(hi) << 16); }
__device__ __forceinline__ float bflo(unsigned u) { return __builtin_bit_cast(float, u << 16); }
__device__ __forceinline__ float bfhi(unsigned u) { return __builtin_bit_cast(float, u & 0xffff0000u); }
__device__ __forceinline__ void unpack8(const u32x4 u, float* f) { f[0] = bflo(u.x); f[1] = bfhi(u.x); f[2] = bflo(u.y); f[3] = bfhi(u.y); f[4] = bflo(u.z); f[5] = bfhi(u.z); f[6] = bflo(u.w); f[7] = bfhi(u.w); }
__device__ __forceinline__ float wave_sum(float v) {
#pragma unroll
    for (int o = 1; o < 64; o <<= 1) v += __shfl_xor(v, o);
    return v;
}
__device__ __forceinline__ float sigmoidf_(float x) { return __builtin_amdgcn_rcpf(1.0f + __builtin_amdgcn_exp2f(-1.4426950408889634f * x)); }
__device__ __forceinline__ int launder(int v) { asm volatile("" : "+v"(v)); return v; }
__device__ __forceinline__ int lane_id() { int l; asm volatile("v_mbcnt_lo_u32_b32 %0, -1, 0\n\tv_mbcnt_hi_u32_b32 %0, -1, %0" : "=v"(l)); return l; }
#define LDS_WAIT() asm volatile("s_waitcnt lgkmcnt(0)" ::: "memory")
#define VM_WAIT() asm volatile("s_waitcnt vmcnt(0)" ::: "memory")

namespace pg8 {
constexpr int BM = 256, BK = 64, HALF = 128, HTB = HALF * BK * 2, STAGE_BYTES = 8 * HTB, NXCD = 8, WGM = 8;
__host__ __device__ __forceinline__ int lds_byte(int r, int c) { const int st = (r >> 4) * 2 + (c >> 5), rr = r & 15, cc = c & 31, ob = rr * 64 + cc * 2; return st * 1024 + (ob ^ (((ob >> 9) & 1) << 5)); }
__host__ __device__ __forceinline__ void stage_rc(int b, int& R, int& C) { const int st = b / 1024, sb = b % 1024, swz = sb ^ (((sb >> 9) & 1) << 5); R = (st >> 1) * 16 + swz / 64; C = (st & 1) * 32 + (swz % 64) / 2; }
__host__ __device__ __forceinline__ int perm32(int rho) { const int n = rho >> 4, i = rho & 15; return 8 * (i >> 2) + 4 * n + (i & 3); }

struct Unit { int pm, pn, aux, pad; const char* A; const char* B; };

__device__ __forceinline__ bool tile_of(long L, int nM, int nN, int& pm, int& pn) {
    const int nwg = nM * nN; if (L >= nwg) return false;
    int wgid = (int)L; { const int q = nwg / NXCD, r = nwg % NXCD, xcd = wgid % NXCD, off = wgid / NXCD; wgid = (xcd < r ? xcd * (q + 1) : r * (q + 1) + (xcd - r) * q) + off; }
    const int nig = WGM * nN, gid = wgid / nig, fm = gid * WGM, gsz = (nM - fm) < WGM ? (nM - fm) : WGM;
    pm = fm + ((wgid % nig) % gsz); pn = (wgid % nig) / gsz; return true;
}

__device__ __forceinline__ unsigned cvt_pk_bf16(float lo, float hi) { unsigned r; asm volatile("v_cvt_pk_bf16_f32 %0, %1, %2" : "=v"(r) : "v"(lo), "v"(hi)); return r; }

template <class Epi, class Sched, bool ALIGN_EPI, bool SP2, int NSEG = 1, bool GATHER = false>
__device__ __forceinline__ void gemm_phase(LAS unsigned char* lds, const int lda_bytes, const int K, const Sched& S, const Epi& E, const int wid_in) {
    int wid = wid_in; asm volatile("" : "+s"(wid));
    int lane_ = lane_id(); asm volatile("" : "+v"(lane_));
    const int lane = lane_, tid = wid * 64 + lane, wr = wid >> 2, wc = wid & 3, fr = lane & 15, fq = lane >> 4;
    const int nt = K / BK;
    unsigned voffA[2], voffB[2]; int gR[2], gC[2];
#pragma unroll
    for (int i = 0; i < 2; ++i) { int R, C; stage_rc(tid * 16 + i * 8192, R, C); const int Rb = Epi::PERM ? ((R & ~31) + perm32(R & 31)) : R; gR[i] = R; gC[i] = C * 2;
        voffA[i] = (unsigned)(R * lda_bytes + C * 2); voffB[i] = (unsigned)(Rb * K + C) * 2u; }
    unsigned offc[2][2], offn[2][2]; int rawn[2][2];
    const size_t kstep = (size_t)(BK * 2);
    const size_t hstepA = (size_t)HALF * lda_bytes, hstepB = (size_t)HALF * K * 2;
    const unsigned ldsw = (unsigned)wid * 1024u;
    const int aoff = lds_byte(wr * 64 + fr, fq * 8), boff = lds_byte(wc * 32 + fr, fq * 8);
#define PG8_SA(b, h) (((b) * 2 + (h)) * HTB)
#define PG8_SB(b, h) ((4 + (b) * 2 + (h)) * HTB)
#define PG8_STAGE(bufoff, gbase, voff) do { _Pragma("unroll") for (int _i = 0; _i < 2; ++_i) \
        __builtin_amdgcn_global_load_lds((const unsigned*)((const char*)(gbase) + (voff)[_i]), (LAS unsigned*)(lds + (bufoff) + ldsw + _i * 8192), 16, 0, 0); } while (0)
#define PG8_STAGE_A(bufoff, kbase, h, nx) do { if constexpr (GATHER) { unsigned vs_[2]; vs_[0] = (nx) ? offn[h][0] : offc[h][0]; vs_[1] = (nx) ? offn[h][1] : offc[h][1]; PG8_STAGE(bufoff, (kbase), vs_); } \
        else { PG8_STAGE(bufoff, (kbase) + ((h) ? hstepA : (size_t)0), voffA); } } while (0)
#define PG8_LDA(dst, b, h) do { _Pragma("unroll") for (int m = 0; m < 4; ++m) _Pragma("unroll") for (int k = 0; k < 2; ++k) dst[m][k] = *(const LAS bf16x8*)(lds + PG8_SA(b, h) + aoff + m * 2048 + k * 1024); } while (0)
#define PG8_LDB(dst, b, h) do { _Pragma("unroll") for (int n = 0; n < 2; ++n) _Pragma("unroll") for (int k = 0; k < 2; ++k) dst[n][k] = *(const LAS bf16x8*)(lds + PG8_SB(b, h) + boff + n * 2048 + k * 1024); } while (0)
#define PG8_MMA(ai, bj, At, Bt) do { __builtin_amdgcn_s_setprio(1); _Pragma("unroll") for (int m = 0; m < 4; ++m) _Pragma("unroll") for (int n = 0; n < 2; ++n) _Pragma("unroll") for (int k = 0; k < 2; ++k) \
        acc[ai][bj][m][n] = __builtin_amdgcn_mfma_f32_16x16x32_bf16(Bt[n][k], At[m][k], acc[ai][bj][m][n], 0, 0, 0); __builtin_amdgcn_s_setprio(0); } while (0)
#define PG8_WAIT_V(n) asm volatile("s_waitcnt vmcnt(" #n ")" ::: "memory")
#define PG8_WAIT_L(n) asm volatile("s_waitcnt lgkmcnt(" #n ")" ::: "memory")
#define PG8_BAR __builtin_amdgcn_s_barrier()
#define PG8_SCHED __builtin_amdgcn_sched_barrier(0)
    Unit cur, nxt; int ui = 0;
    if (!S.next(0, cur)) return;
    f32x4 acc[2][2][4][2];
#pragma unroll
    for (int a = 0; a < 2; ++a)
#pragma unroll
        for (int b = 0; b < 2; ++b)
#pragma unroll
            for (int m = 0; m < 4; ++m)
#pragma unroll
                for (int n = 0; n < 2; ++n) acc[a][b][m][n] = (f32x4){0.f, 0.f, 0.f, 0.f};
    bf16x8 At[4][2], B0[2][2], B1[2][2];
    const char* cA = cur.A; const char* cB = cur.B;
    if constexpr (GATHER) {
#pragma unroll
        for (int h = 0; h < 2; ++h)
#pragma unroll
            for (int i = 0; i < 2; ++i) { offc[h][i] = (unsigned)S.gidx[cur.aux * 256 + h * 128 + gR[i]] * (unsigned)lda_bytes + (unsigned)gC[i]; offn[h][i] = offc[h][i]; }
    }
    if constexpr (SP2) {
        PG8_STAGE(PG8_SB(0, 0), cB, voffB); PG8_STAGE(PG8_SB(0, 1), cB + hstepB, voffB); PG8_STAGE_A(PG8_SA(0, 0), cA, 0, false); PG8_STAGE_A(PG8_SA(0, 1), cA, 1, false);
        if (wr == 1) PG8_BAR;
        PG8_WAIT_V(2); PG8_BAR;
        PG8_STAGE(PG8_SB(1, 0), cB + kstep, voffB); PG8_STAGE_A(PG8_SA(1, 0), cA + kstep, 0, false); PG8_STAGE(PG8_SB(1, 1), cB + hstepB + kstep, voffB);
        PG8_WAIT_V(6); PG8_BAR;
    } else {
        static_assert(SP2 || !GATHER, "GATHER is implemented for the SP2 loop only");
        PG8_STAGE(PG8_SB(0, 0), cB, voffB); PG8_STAGE(PG8_SA(0, 0), cA, voffA); PG8_STAGE(PG8_SB(0, 1), cB + hstepB, voffB); PG8_STAGE(PG8_SA(0, 1), cA + hstepA, voffA);
        if (wr == 1) PG8_BAR;
        PG8_WAIT_V(4); PG8_BAR;
        PG8_STAGE(PG8_SB(1, 0), cB + kstep, voffB); PG8_STAGE(PG8_SA(1, 0), cA + kstep, voffA); PG8_STAGE(PG8_SB(1, 1), cB + hstepB + kstep, voffB);
        PG8_WAIT_V(6); PG8_BAR;
    }
    for (;;) {
        const bool has_next = S.next(ui + 1, nxt);
        const char* nA = has_next ? nxt.A : cA; const char* nB = has_next ? nxt.B : cB;
        if constexpr (GATHER) {
            const int na_ = has_next ? nxt.aux : cur.aux;
#pragma unroll
            for (int h = 0; h < 2; ++h)
#pragma unroll
                for (int i = 0; i < 2; ++i) rawn[h][i] = S.gidx[na_ * 256 + h * 128 + gR[i]]; }
        for (int t = 0; t < nt; t += 2) {
            const bool last = (t == nt - 2);
            const char* a1 = cA + (size_t)(t + 1) * kstep;
            const char* a2 = last ? nA : cA + (size_t)(t + 2) * kstep; const char* b2 = last ? nB : cB + (size_t)(t + 2) * kstep;
            const char* a3 = a2 + kstep; const char* b3 = b2 + kstep;
            if constexpr (GATHER) { if (last && has_next) {
#pragma unroll
                for (int h = 0; h < 2; ++h)
#pragma unroll
                    for (int i = 0; i < 2; ++i) { int rw_ = rawn[h][i]; asm volatile("" : "+v"(rw_));
                        offn[h][i] = (unsigned)rw_ * (unsigned)lda_bytes + (unsigned)gC[i]; } } }
            if constexpr (NSEG > 1) { const int tseg = nt / NSEG; if (t > 0 && (t % tseg) == 0) E.mid(acc, cur, t / tseg, wr, wc, fr, fq); }
            if constexpr (SP2) {
            PG8_LDB(B0, 0, 0); PG8_LDB(B1, 0, 1); PG8_SCHED; PG8_LDA(At, 0, 0); PG8_STAGE_A(PG8_SA(1, 1), a1, 1, false);
            PG8_WAIT_V(8); PG8_WAIT_L(0); PG8_BAR; PG8_MMA(0, 0, At, B0); PG8_MMA(0, 1, At, B1); PG8_BAR; PG8_SCHED;
            PG8_LDA(At, 0, 1); PG8_STAGE(PG8_SB(0, 0), b2, voffB); PG8_STAGE(PG8_SB(0, 1), b2 + hstepB, voffB); PG8_STAGE_A(PG8_SA(0, 0), a2, 0, last);
            PG8_WAIT_V(8); PG8_WAIT_L(0); PG8_BAR; PG8_MMA(1, 0, At, B0); PG8_MMA(1, 1, At, B1); PG8_BAR; PG8_SCHED;
            PG8_LDB(B0, 1, 0); PG8_LDB(B1, 1, 1); PG8_SCHED; PG8_LDA(At, 1, 0); PG8_STAGE_A(PG8_SA(0, 1), a2, 1, last);
            PG8_WAIT_V(8); PG8_WAIT_L(0); PG8_BAR; PG8_MMA(0, 0, At, B0); PG8_MMA(0, 1, At, B1); PG8_BAR; PG8_SCHED;
            PG8_LDA(At, 1, 1); PG8_STAGE(PG8_SB(1, 0), b3, voffB); PG8_STAGE(PG8_SB(1, 1), b3 + hstepB, voffB); PG8_STAGE_A(PG8_SA(1, 0), a3, 0, last);
            PG8_WAIT_V(8); PG8_WAIT_L(0); PG8_BAR; PG8_MMA(1, 0, At, B0); PG8_MMA(1, 1, At, B1); PG8_BAR; PG8_SCHED;
            } else {
            PG8_LDB(B0, 0, 0); PG8_SCHED; PG8_LDA(At, 0, 0); PG8_STAGE(PG8_SA(1, 1), a1 + hstepA, voffA);
            PG8_WAIT_L(8); PG8_BAR; PG8_WAIT_L(0); PG8_MMA(0, 0, At, B0); PG8_BAR; PG8_SCHED;
            PG8_LDB(B1, 0, 1); PG8_STAGE(PG8_SB(0, 0), b2, voffB);
            PG8_BAR; PG8_WAIT_L(0); PG8_MMA(0, 1, At, B1); PG8_BAR;
            PG8_LDA(At, 0, 1); PG8_STAGE(PG8_SA(0, 0), a2, voffA);
            PG8_BAR; PG8_WAIT_L(0); PG8_MMA(1, 0, At, B0); PG8_BAR; PG8_SCHED;
            PG8_STAGE(PG8_SB(0, 1), b2 + hstepB, voffB);
            PG8_WAIT_V(6); PG8_BAR; PG8_MMA(1, 1, At, B1); PG8_BAR;
            PG8_LDB(B0, 1, 0); PG8_SCHED; PG8_LDA(At, 1, 0); PG8_STAGE(PG8_SA(0, 1), a2 + hstepA, voffA);
            PG8_WAIT_L(8); PG8_BAR; PG8_WAIT_L(0); PG8_MMA(0, 0, At, B0); PG8_BAR; PG8_SCHED;
            PG8_LDB(B1, 1, 1); PG8_STAGE(PG8_SB(1, 0), b3, voffB);
            PG8_BAR; PG8_WAIT_L(0); PG8_MMA(0, 1, At, B1); PG8_BAR;
            PG8_LDA(At, 1, 1); PG8_STAGE(PG8_SA(1, 0), a3, voffA);
            PG8_BAR; PG8_WAIT_L(0); PG8_MMA(1, 0, At, B0); PG8_BAR; PG8_SCHED;
            PG8_STAGE(PG8_SB(1, 1), b3 + hstepB, voffB);
            PG8_WAIT_V(6); PG8_BAR; PG8_MMA(1, 1, At, B1); PG8_BAR;
            }
        }
        if constexpr (ALIGN_EPI) { if (wr == 0) PG8_BAR; }
        E(acc, cur, wr, wc, fr, fq);
        if (!has_next) break;
#pragma unroll
        for (int a = 0; a < 2; ++a)
#pragma unroll
            for (int b = 0; b < 2; ++b)
#pragma unroll
                for (int m = 0; m < 4; ++m)
#pragma unroll
                    for (int n = 0; n < 2; ++n) acc[a][b][m][n] = (f32x4){0.f, 0.f, 0.f, 0.f};
        cur = nxt; cA = nA; cB = nB; ++ui;
        if constexpr (GATHER) {
#pragma unroll
            for (int h = 0; h < 2; ++h)
#pragma unroll
                for (int i = 0; i < 2; ++i) offc[h][i] = offn[h][i]; }
        if constexpr (ALIGN_EPI) { if (wr == 1) PG8_BAR; }
    }
    PG8_WAIT_V(0);
    if constexpr (!ALIGN_EPI) { if (wr == 0) PG8_BAR; }
    PG8_BAR;
#undef PG8_SA
#undef PG8_SB
#undef PG8_STAGE
#undef PG8_STAGE_A
#undef PG8_LDA
#undef PG8_LDB
#undef PG8_MMA
#undef PG8_WAIT_V
#undef PG8_WAIT_L
#undef PG8_BAR
#undef PG8_SCHED
}
}

#define XB_TMO      128
#define XB_XCNT(j)  (256  + 64 * (j))
#define XB_XSUB(j)  (1280 + 64 * (j))
#define XB_XGEN(j)  (2304 + 64 * (j))
#define XB_TOP      3328
#define XB_TOPGEN   3392
#define XCD_BAR_WORDS 3456
#define XB_SPIN_CAP (1u << 22)
__device__ __forceinline__ unsigned xb_ld(unsigned* p)              { return __hip_atomic_load(p, __ATOMIC_RELAXED, __HIP_MEMORY_SCOPE_AGENT); }
__device__ __forceinline__ unsigned xb_add(unsigned* p, unsigned v) { return __hip_atomic_fetch_add(p, v, __ATOMIC_RELAXED, __HIP_MEMORY_SCOPE_AGENT); }
__device__ __forceinline__ unsigned xb_xcc_id() { return (unsigned)__builtin_amdgcn_s_getreg((3 << 11) | 20) & 0xFu; }
#define XB_SPIN(cond, bar) do { unsigned _sp = 0; while (cond) { __builtin_amdgcn_s_sleep(1); \
    if ((++_sp & 255u) == 0u) { if (xb_ld(&(bar)[XB_TMO])) break; if (_sp > XB_SPIN_CAP) { atomicAdd(&(bar)[XB_TMO], 1u); break; } } } } while (0)
struct XcdBarrier { unsigned* bar; unsigned x; volatile LAS unsigned* st; };
__device__ __forceinline__ XcdBarrier xcd_barrier_post(unsigned* bar, volatile LAS unsigned* st) {
    XcdBarrier b; b.bar = bar; b.x = xb_xcc_id(); b.st = st;
    if (threadIdx.x == 0) (void)xb_add(&bar[XB_XCNT(b.x)], 1u);
    return b;
}
__device__ __forceinline__ void xcd_barrier_complete(unsigned* bar, unsigned x, unsigned& nloc, unsigned& nx) {
    const unsigned G = gridDim.x * gridDim.y * gridDim.z;
    unsigned sum, cnt, mine, sp = 0u;
    for (;;) {
        sum = 0u; cnt = 0u; mine = 0u;
#pragma unroll
        for (unsigned j = 0; j < 16; ++j) { const unsigned c = xb_ld(&bar[XB_XCNT(j)]); sum += c; cnt += (c > 0u) ? 1u : 0u; mine = (j == x) ? c : mine; }
        if (sum == G) break;
        __builtin_amdgcn_s_sleep(1);
        if ((++sp & 255u) == 0u) { if (xb_ld(&bar[XB_TMO])) break; if (sp > XB_SPIN_CAP) { atomicAdd(&bar[XB_TMO], 1u); break; } }
    }
    nloc = mine > 0u ? mine : 1u; nx = cnt > 0u ? cnt : 1u;
}
__device__ __forceinline__ void xcd_barrier(const XcdBarrier& b, const int wave) {
    asm volatile("s_waitcnt vmcnt(0)" ::: "memory");
    __syncthreads();
    if (wave == 0 && lane_id() == 0) {
        unsigned* bar = b.bar; asm volatile("" : "+s"(bar)); unsigned bx = b.x; asm volatile("" : "+s"(bx));
        __builtin_amdgcn_s_waitcnt(0);
        unsigned nloc = b.st[0], nx = b.st[1];
        if (nloc == 0u) { xcd_barrier_complete(bar, bx, nloc, nx); b.st[0] = nloc; b.st[1] = nx; }
        const unsigned old = xb_add(&bar[XB_XSUB(bx)], 1u);
        const unsigned gen = old / nloc;
        if (old + 1u == (gen + 1u) * nloc) {
            __builtin_amdgcn_fence(__ATOMIC_RELEASE, "agent");
            asm volatile("s_waitcnt vmcnt(0)" ::: "memory");
            const unsigned og = xb_add(&bar[XB_TOP], 1u);
            const unsigned tg = og / nx;
            if (og + 1u == (tg + 1u) * nx) xb_add(&bar[XB_TOPGEN], 1u);
            else XB_SPIN(xb_ld(&bar[XB_TOPGEN]) == tg, bar);
            __builtin_amdgcn_fence(__ATOMIC_ACQUIRE, "agent");
            xb_add(&bar[XB_XGEN(bx)], 1u);
            asm volatile("s_waitcnt vmcnt(0)" ::: "memory");
        } else {
            XB_SPIN(xb_ld(&bar[XB_XGEN(bx)]) == gen, bar);
            __builtin_amdgcn_fence(__ATOMIC_ACQUIRE, "agent");
            asm volatile("s_waitcnt vmcnt(0)" ::: "memory");
        }
    }
    __syncthreads();
}

struct Args {
    const float* in[19];
    float* out; unsigned char* ws;
    int ph_lo, ph_hi;
};
enum { I_X = 0, I_C, I_CTX, I_CCTX, I_WADA, I_BADA, I_GMIX, I_WIN, I_CONVW, I_RPB, I_SINK, I_WBR, I_WOUT, I_GFFN, I_WROUTER, I_WG, I_WU, I_WD, I_GFINAL };

struct Frame {
    unsigned char* lds;
    LAS unsigned char* ldsl;
    unsigned char* ws;
    int wave, vcu, G;
    float* out;
};

constexpr int PTR_OFF = MISC_OFF + 128;
__device__ __forceinline__ const float* inp(const Frame& F, int i) {
    const u32x2 v = *(const LAS u32x2*)(F.ldsl + PTR_OFF + 8 * i);
    const unsigned lo = __builtin_amdgcn_readfirstlane(v.x), hi = __builtin_amdgcn_readfirstlane(v.y);
    return (const float*)(((unsigned long long)hi << 32) | lo);
}
__device__ __forceinline__ bf16* xbrow(const Frame& F, int ch, int cr) {
    return cr < LROWS ? (bf16*)(F.out + ((size_t)ch * LROWS + cr) * D) : (bf16*)(F.ws + WS_XC) + (size_t)(cr - LROWS) * D;
}
__device__ __forceinline__ const float* xin_row(const Frame& F, int ch, int cr) {
    return cr < LROWS ? inp(F, I_X) + ((size_t)ch * LROWS + cr) * D : inp(F, I_CTX) + (size_t)(cr - LROWS) * D;
}
__device__ __forceinline__ int mv_of(int ch, int cr) { return cr < LROWS ? ch * BC + cr / SEQ : NB; }
__device__ __forceinline__ const float* mod_ptr(const Frame& F, int l, int mv, int which) { return (const float*)(F.ws + WS_MODS) + ((size_t)(l * 33 + mv) * 6 + which) * D; }

__device__ __forceinline__ bf16* hbuf_of(const Frame& F, int ch) { return (bf16*)(F.ws + (ch == 0 ? WS_HBUF : WS_HBUF1)); }
__device__ __forceinline__ bf16* dx_of(const Frame& F, int ch) { return (bf16*)(F.ws + (ch == 0 ? WS_DX0 : WS_DX1)); }
__device__ __forceinline__ float* affl_of(const Frame& F, int ch) { return (float*)(F.ws + WS_AFFL) + (size_t)ch * BC * NE * SEQ; }
__device__ __forceinline__ int* tokslot_of(const Frame& F, int ch) { return (int*)(F.ws + WS_TOKSLOT) + (size_t)ch * RCMAX * NE; }
__device__ __forceinline__ void mods_phase(Frame& F) {
    const int lane = launder(lane_id()), tid = F.wave * 64 + lane; (void)tid; (void)lane;
    float* sl = (float*)F.lds;
    const float* c = inp(F, I_C); const float* cc = inp(F, I_CCTX);
    for (int item = F.vcu; item < DEPTH * 96; item += F.G) {
        const int l = item / 96, jb = item % 96, j = jb * 64 + lane;
        const float* W = inp(F, I_WADA) + (size_t)l * D * 6144;
        float acc[33];
#pragma unroll
        for (int m = 0; m < 33; ++m) acc[m] = 0.f;
        for (int kh = 0; kh < 2; ++kh) {
            __syncthreads();
            for (int i = tid; i < 512 * 33; i += NTHR) { const int k = i % 512, m = i / 512; const float v = (m < 32) ? c[(size_t)m * D + kh * 512 + k] : cc[kh * 512 + k]; sl[k * 36 + m] = v * sigmoidf_(v); }
            __syncthreads();
            for (int kk0 = 0; kk0 < 64; kk0 += 8) {
                float w8[8];
#pragma unroll
                for (int u8 = 0; u8 < 8; ++u8) w8[u8] = W[(size_t)(kh * 512 + F.wave * 64 + kk0 + u8) * 6144 + j];
#pragma unroll
                for (int u8 = 0; u8 < 8; ++u8) { const int k = F.wave * 64 + kk0 + u8; const float w = w8[u8];
                    const f32x4* s4 = (const f32x4*)(sl + k * 36);
#pragma unroll
                    for (int q = 0; q < 8; ++q) { const f32x4 s = s4[q]; acc[4 * q] += s.x * w; acc[4 * q + 1] += s.y * w; acc[4 * q + 2] += s.z * w; acc[4 * q + 3] += s.w * w; }
                    acc[32] += sl[k * 36 + 32] * w; }
            }
        }
        __syncthreads();
        float* rd = (float*)F.lds;
#pragma unroll
        for (int m = 0; m < 33; ++m) rd[(F.wave * 33 + m) * 64 + lane] = acc[m];
        __syncthreads();
        for (int i = tid; i < 33 * 64; i += NTHR) { const int m = i / 64, jj = i % 64; float s = 0.f;
#pragma unroll
            for (int w = 0; w < 8; ++w) s += rd[(w * 33 + m) * 64 + jj];
            const int col = jb * 64 + jj;
            ((float*)(F.ws + WS_MODS))[(size_t)(l * 33 + m) * 6144 + col] = s + inp(F, I_BADA)[(size_t)l * 6144 + col]; }
    }
    __syncthreads();
    f32x2* tab = (f32x2*)(F.ws + WS_ROPE);
    for (int i = F.vcu * NTHR + tid; i < SEQ * 32; i += F.G * NTHR) {
        const int pos = i >> 5, fi = i & 31; const float inv = powf(10000.0f, -(float)(fi & 15) / 16.0f);
        const float ang = (fi < 16 ? (float)(pos / 64) : (float)(pos % 64)) * inv;
        tab[i] = (f32x2){cosf(ang), sinf(ang)};
    }
}

__device__ __forceinline__ void transpose_item(const float* W, int K, int N, bf16* WT, int k0, int n0, int orow0, float* scr, int lane, int ldo = 0, int kofs = 0) {
    if (ldo == 0) ldo = K;
    f32x4 v[8];
#pragma unroll
    for (int i = 0; i < 8; ++i) v[i] = *(const f32x4*)(W + (size_t)(k0 + 8 * i + (lane >> 3)) * N + n0 + 4 * (lane & 7));
#pragma unroll
    for (int i = 0; i < 8; ++i) *(f32x4*)(scr + (8 * i + (lane >> 3)) * 36 + 4 * (lane & 7)) = v[i];
    LDS_WAIT(); asm volatile("" ::: "memory");
    const int c = lane & 7;
#pragma unroll
    for (int j = 0; j < 4; ++j) { const int n = (lane >> 3) + 8 * j; const float* s = scr + (8 * c) * 36 + n;
        u32x4 o; o.x = pk2(s[0 * 36], s[1 * 36]); o.y = pk2(s[2 * 36], s[3 * 36]); o.z = pk2(s[4 * 36], s[5 * 36]); o.w = pk2(s[6 * 36], s[7 * 36]);
        *(u32x4*)(WT + (size_t)(orow0 + n) * ldo + kofs + k0 + 8 * c) = o; }
    LDS_WAIT(); asm volatile("" ::: "memory");
}
__device__ __forceinline__ void wconv_phase(Frame& F, int l) {
    const int lane = launder(lane_id()), tid = F.wave * 64 + lane; (void)tid; (void)lane;
    float* scr = (float*)(F.lds + F.wave * 16384);
    const int gw = F.vcu * NWAVES + F.wave, NGW = F.G * NWAVES;
    constexpr int I_IN = 16 * 216, I_BR = 3 * 8 * 32, I_OUT = 16 * 32, I_EX = 16 * 16 * 32;
    constexpr int NITEMS = I_IN + I_BR + I_OUT + 3 * I_EX;
    for (int it = gw; it < NITEMS; it += NGW) {
        int r = it;
        if (r < I_IN) { const int kb = r / 216, nb = r % 216; transpose_item(inp(F, I_WIN) + (size_t)l * D * INW, D, INW, (bf16*)(F.ws + WS_WIN), kb * 64, nb * 32, nb * 32, scr, lane); continue; } r -= I_IN;
        if (r < I_BR) { const int br = r / 256, q = r % 256, kb = q / 32, nb = q % 32;
            transpose_item(inp(F, I_WBR) + ((size_t)l * 3 + br) * 512 * D, 512, D, (bf16*)(F.ws + WS_WBR), kb * 64, nb * 32, nb * 32, scr, lane, 1536, br * 512); continue; } r -= I_BR;
        if (r < I_OUT) { const int kb = r / 32, nb = r % 32; transpose_item(inp(F, I_WOUT) + (size_t)l * D * D, D, D, (bf16*)(F.ws + WS_WOUT), kb * 64, nb * 32, nb * 32, scr, lane); continue; } r -= I_OUT;
        if (r < 2 * I_EX) { const int s = r / I_EX, q = r % I_EX, e = q / 512, q2 = q % 512, kb = q2 / 32, nb = q2 % 32, n0 = nb * 32;
            const float* W = inp(F, s ? I_WU : I_WG) + ((size_t)l * NE + e) * D * FF;
            transpose_item(W, D, FF, (bf16*)(F.ws + WS_WUP) + (size_t)e * 2048 * D, kb * 64, n0, 256 * (n0 / 128) + 128 * s + (n0 % 128), scr, lane); continue; } r -= 2 * I_EX;
        { const int e = r / 512, q2 = r % 512, kb = q2 / 32, nb = q2 % 32;
            transpose_item(inp(F, I_WD) + ((size_t)l * NE + e) * FF * D, FF, D, (bf16*)(F.ws + WS_WDN) + (size_t)e * D * FF, kb * 64, nb * 32, nb * 32, scr, lane); }
    }
}

__device__ __forceinline__ float xsel(bool c, float a, float b) { return c ? a : b; }
template <bool ROUTER>
__device__ __forceinline__ void norm_phase(Frame& F, int l, int ch, int nrows, bool dry = false) {
    const int lane = launder(lane_id()), tid = F.wave * 64 + lane; (void)tid; (void)lane;
    const int gw = F.vcu * NWAVES + F.wave, NGW = F.G * NWAVES;
    float* wr_l = (float*)F.lds;
    if (ROUTER) {
        const float* wr = inp(F, I_WROUTER) + (size_t)l * D * NE;
        for (int i = tid; i < D * NE; i += NTHR) { const int d = i >> 4, e = i & 15; wr_l[e * D + d] = wr[i]; }
        __syncthreads();
    }
    const float* gv = inp(F, ROUTER ? I_GFFN : I_GMIX) + (size_t)l * D;
    bf16* hb = dry ? (bf16*)(F.ws + WS_OBUF + 160 * MiB) : (bf16*)(F.ws + (ch == 0 ? WS_HBUF : WS_HBUF1));
    const bf16* dxb = dx_of(F, ch);
    f32x4 nx[2][4]; u32x2 nd[2][4];
#define NP_LOAD(c0) do { _Pragma("unroll") for (int rr_ = 0; rr_ < 2; ++rr_) { \
        if (l > 0) { const bf16* xb_ = xbrow(F, ch, (c0) + rr_);     \
            _Pragma("unroll") for (int j_ = 0; j_ < 4; ++j_) { const u32x2 t_ = *(const u32x2*)(xb_ + lane * 4 + 256 * j_); const unsigned tx_ = t_.x, ty_ = t_.y; nx[rr_][j_].x = __builtin_bit_cast(float, tx_); nx[rr_][j_].y = __builtin_bit_cast(float, ty_); } } \
        else { const float* xr_ = xin_row(F, ch, (c0) + rr_); \
            _Pragma("unroll") for (int j_ = 0; j_ < 4; ++j_) nx[rr_][j_] = *(const f32x4*)(xr_ + lane * 4 + 256 * j_); } \
        if (ROUTER) { _Pragma("unroll") for (int j_ = 0; j_ < 4; ++j_) nd[rr_][j_] = *(const u32x2*)(dxb + (size_t)((c0) + rr_) * D + lane * 4 + 256 * j_); } } } while (0)
    const int rpw = (((nrows + NGW - 1) / NGW) + 1) & ~1, rbeg = gw * rpw, rend = (rbeg + rpw < nrows) ? rbeg + rpw : nrows;
    f32x4 gq[4], shq[4], scq[4]; int cmv = -1;
#pragma unroll
    for (int j = 0; j < 4; ++j) gq[j] = *(const f32x4*)(gv + lane * 4 + 256 * j);
    if (rbeg < rend) NP_LOAD(rbeg);
    for (int cr0 = rbeg; cr0 < rend; cr0 += 2) {
        f32x4 v[2][4]; u32x2 dv[2][4];
#pragma unroll
        for (int rr = 0; rr < 2; ++rr)
#pragma unroll
            for (int j = 0; j < 4; ++j) { v[rr][j] = nx[rr][j]; if (ROUTER) dv[rr][j] = nd[rr][j];
                if (l > 0) { const float fx_ = nx[rr][j].x, fy_ = nx[rr][j].y; const unsigned a_ = __builtin_bit_cast(unsigned, fx_), b_ = __builtin_bit_cast(unsigned, fy_); v[rr][j].x = bflo(a_); v[rr][j].y = bfhi(a_); v[rr][j].z = bflo(b_); v[rr][j].w = bfhi(b_); } }
        if (cr0 + 2 < rend) NP_LOAD(cr0 + 2);
#pragma unroll
        for (int rr = 0; rr < 2; ++rr) {
            const int cr = cr0 + rr;
            const int mv = mv_of(ch, cr);
            if (mv != cmv) { cmv = mv; const float* sh = mod_ptr(F, l, mv, ROUTER ? 3 : 0); const float* sc = mod_ptr(F, l, mv, ROUTER ? 4 : 1);
#pragma unroll
                for (int j = 0; j < 4; ++j) { shq[j] = *(const f32x4*)(sh + lane * 4 + 256 * j); scq[j] = *(const f32x4*)(sc + lane * 4 + 256 * j); } }
            float ss = 0.f;
#pragma unroll
            for (int j = 0; j < 4; ++j) {
                if (ROUTER) {
                    const u32x2 dd = dv[rr][j];
                    v[rr][j].x += bflo(dd.x); v[rr][j].y += bfhi(dd.x); v[rr][j].z += bflo(dd.y); v[rr][j].w += bfhi(dd.y); }
                ss += (v[rr][j].x * v[rr][j].x + v[rr][j].y * v[rr][j].y) + (v[rr][j].z * v[rr][j].z + v[rr][j].w * v[rr][j].w); }
            const float rstd = 1.0f / sqrtf(wave_sum(ss) * (1.0f / D) + RMS_EPS);
#pragma unroll
            for (int j = 0; j < 4; ++j) {
                v[rr][j] = (v[rr][j] * rstd * gq[j]) * (scq[j] + 1.0f) + shq[j];
                u32x2 o; o.x = pk2(v[rr][j].x, v[rr][j].y); o.y = pk2(v[rr][j].z, v[rr][j].w);
                *(u32x2*)(hb + (size_t)cr * D + lane * 4 + 256 * j) = o;
            }
        }
#undef NP_LOAD
        if (ROUTER) {
            const bool b5 = lane & 32, b4 = lane & 16, b3 = lane & 8;
            float lg[2][2];
#pragma unroll
            for (int hf = 0; hf < 2; ++hf) {
                float a[2][8];
#pragma unroll
                for (int e = 0; e < 8; ++e) {
                    f32x4 w[4];
#pragma unroll
                    for (int j = 0; j < 4; ++j) w[j] = *(const f32x4*)(wr_l + (hf * 8 + e) * D + lane * 4 + 256 * j);
#pragma unroll
                    for (int rr = 0; rr < 2; ++rr) { float t = 0.f;
#pragma unroll
                        for (int j = 0; j < 4; ++j) t += (v[rr][j].x * w[j].x + v[rr][j].y * w[j].y) + (v[rr][j].z * w[j].z + v[rr][j].w * w[j].w);
                        a[rr][e] = t; }
                    if (e & 1) __builtin_amdgcn_sched_barrier(0);
                }
#pragma unroll
                for (int rr = 0; rr < 2; ++rr) {
                    float c[4], d2[2];
#pragma unroll
                    for (int i = 0; i < 4; ++i) { const float recv = __shfl_xor(xsel(b5, a[rr][i], a[rr][i + 4]), 32); c[i] = xsel(b5, a[rr][i + 4], a[rr][i]) + recv; }
#pragma unroll
                    for (int i = 0; i < 2; ++i) { const float recv = __shfl_xor(xsel(b4, c[i], c[i + 2]), 16); d2[i] = xsel(b4, c[i + 2], c[i]) + recv; }
                    float t = xsel(b3, d2[1], d2[0]) + __shfl_xor(xsel(b3, d2[0], d2[1]), 8);
                    t += __shfl_xor(t, 4); t += __shfl_xor(t, 2); t += __shfl_xor(t, 1);
                    lg[hf][rr] = t;
                }
                __builtin_amdgcn_sched_barrier(0);
            }
#pragma unroll
            for (int rr = 0; rr < 2; ++rr) {
                float m = fmaxf(lg[0][rr], lg[1][rr]);
#pragma unroll
                for (int o = 8; o < 64; o <<= 1) m = fmaxf(m, __shfl_xor(m, o));
                const float p0 = expf(lg[0][rr] - m), p1 = expf(lg[1][rr] - m); float s = p0 + p1;
#pragma unroll
                for (int o = 8; o < 64; o <<= 1) s += __shfl_xor(s, o);
                const float inv = 1.0f / s;
                const int cr = cr0 + rr, e = lane >> 3;
                if ((lane & 7) < 2 && !dry) {
                    const int ee = (lane & 1) ? e + 8 : e; const float mine = ((lane & 1) ? p1 : p0) * inv;
                    if (cr < LROWS) { const int bl = cr / SEQ, t = cr % SEQ; affl_of(F, ch)[(size_t)(bl * NE + ee) * SEQ + t] = mine; }
                    else { const int j = cr - LROWS, bl = j / CTX, t = j % CTX; ((float*)(F.ws + WS_AFFC))[(size_t)(bl * NE + ee) * CTX + t] = mine; }
                }
            }
        }
    }
}

__device__ __forceinline__ const bf16* zrow(const Frame& F, int cr) { return (const bf16*)(F.ws + WS_Z) + (size_t)cr * ZW; }

__device__ __forceinline__ void conv_phase(Frame& F, int l, int nrows) {
    const int lane = launder(lane_id()), tid = F.wave * 64 + lane; (void)tid; (void)lane;
    const int gw = F.vcu * NWAVES + F.wave, NGW = F.G * NWAVES;
    const float* cw = inp(F, I_CONVW) + (size_t)l * 3 * 512;
    float w[3][8];
#pragma unroll
    for (int k = 0; k < 3; ++k)
#pragma unroll
        for (int j = 0; j < 8; ++j) w[k][j] = cw[k * 512 + lane * 8 + j];
    bf16* ob = (bf16*)(F.ws + WS_OBUF);
    const int rpw = (nrows + NGW - 1) / NGW, rbeg = gw * rpw, rend = (rbeg + rpw < nrows) ? rbeg + rpw : nrows;
    if (rbeg >= rend) return;
#define CV_SEQ(cr_) ((cr_) < LROWS ? (cr_) / SEQ : 1024 + ((cr_) - LROWS) / CTX)
#define CV_LOADP(cr_, P) do { const bf16* zr_ = zrow(F, (cr_)); float c8_[8], x8_[8]; unpack8(*(const u32x4*)(zr_ + Z_AC + lane * 8), c8_); unpack8(*(const u32x4*)(zr_ + Z_AX + lane * 8), x8_); \
        _Pragma("unroll") for (int j_ = 0; j_ < 8; ++j_) (P)[j_] = c8_[j_] * x8_[j_]; } while (0)
    float pp[8], pc[8], pn[8];
#pragma unroll
    for (int j = 0; j < 8; ++j) pp[j] = 0.f;
    if (rbeg > 0 && CV_SEQ(rbeg - 1) == CV_SEQ(rbeg)) CV_LOADP(rbeg - 1, pp);
    CV_LOADP(rbeg, pc);
    for (int cr = rbeg; cr < rend; ++cr) {
        const bool hasn = cr + 1 < nrows, same = hasn && CV_SEQ(cr + 1) == CV_SEQ(cr);
#pragma unroll
        for (int j = 0; j < 8; ++j) pn[j] = 0.f;
        if (hasn) CV_LOADP(cr + 1, pn);
        float b8[8]; unpack8(*(const u32x4*)(zrow(F, cr) + Z_AB + lane * 8), b8);
        float acc[8];
#pragma unroll
        for (int j = 0; j < 8; ++j) acc[j] = w[0][j] * pp[j] + w[1][j] * pc[j] + (same ? w[2][j] * pn[j] : 0.f);
        u32x4 o; o.x = pk2(b8[0] * acc[0], b8[1] * acc[1]); o.y = pk2(b8[2] * acc[2], b8[3] * acc[3]); o.z = pk2(b8[4] * acc[4], b8[5] * acc[5]); o.w = pk2(b8[6] * acc[6], b8[7] * acc[7]);
        *(u32x4*)(ob + (size_t)cr * OW + lane * 8) = o;
#pragma unroll
        for (int j = 0; j < 8; ++j) { pp[j] = same ? pc[j] : 0.f; pc[j] = pn[j]; }
    }
#undef CV_SEQ
#undef CV_LOADP
}

struct NaiveState { unsigned q[32]; float o[64], m, l; };
__device__ __forceinline__ void load64(const bf16* p, float* f) {
#pragma unroll
    for (int i = 0; i < 8; ++i) unpack8(*(const u32x4*)(p + 8 * i), f + 8 * i);
}
__device__ __forceinline__ void rope64(float* x, const f32x2* tabrow) {
#pragma unroll
    for (int i = 0; i < 32; ++i) { const f32x2 cs = tabrow[i]; const float a = x[i], b = x[i + 32]; x[i] = a * cs.x - b * cs.y; x[i + 32] = a * cs.y + b * cs.x; }
}
__device__ __forceinline__ void naive_visit(NaiveState& st, const bf16* kp, const bf16* vp, float bias, bool valid, const f32x2* ropetab) {
    float s = 0.f;
#pragma unroll
    for (int c = 0; c < 4; ++c) {
        float a[8], b[8]; unpack8(*(const u32x4*)(kp + 8 * c), a); unpack8(*(const u32x4*)(kp + 32 + 8 * c), b);
        if (ropetab) {
#pragma unroll
            for (int i = 0; i < 8; ++i) { const f32x2 cs = ropetab[8 * c + i]; const float x1 = a[i], x2 = b[i]; a[i] = x1 * cs.x - x2 * cs.y; b[i] = x1 * cs.y + x2 * cs.x; }
        }
#pragma unroll
        for (int i = 0; i < 8; ++i) s += bflo(st.q[8 * c + i]) * a[i] + bfhi(st.q[8 * c + i]) * b[i];
    }
    s = valid ? s + bias : -1e30f;
    const float mn = fmaxf(st.m, s), alpha = __expf(st.m - mn), p = __expf(s - mn);
    st.m = mn; st.l = st.l * alpha + p;
#pragma unroll
    for (int c = 0; c < 8; ++c) { float v[8]; unpack8(*(const u32x4*)(vp + 8 * c), v);
#pragma unroll
        for (int i = 0; i < 8; ++i) st.o[8 * c + i] = st.o[8 * c + i] * alpha + p * v[i]; }
}
__device__ __forceinline__ void naive_attn_phase(Frame& F, int l, int ch, bool last, bf16* ob) {
    const int lane = launder(lane_id()), tid = F.wave * 64 + lane; (void)tid; (void)lane;
    const int n_lat = LROWS / 64, n_ctx = (last || ch != 0) ? 0 : CTXALL / 64;
    const int nunits = 2 * n_lat + 2 * n_ctx;
    const f32x2* tab = (const f32x2*)(F.ws + WS_ROPE);
    for (int u = F.vcu; u < nunits; u += F.G) {
        int type, blk;
        if (u < n_lat) { type = 0; blk = u; } else if (u < 2 * n_lat) { type = 1; blk = u - n_lat; } else if (u < 2 * n_lat + n_ctx) { type = 2; blk = u - 2 * n_lat; } else { type = 3; blk = u - 2 * n_lat - n_ctx; }
        const int h = F.wave;
        const int cr0 = (type < 2) ? blk * 64 : LROWS + blk * 64, cr = cr0 + lane;
        const int bl = (type < 2) ? ch * BC + cr0 / SEQ : (cr0 - LROWS) / CTX;
        const int t0 = (type < 2) ? cr0 % SEQ : (cr0 - LROWS) % CTX, t = t0 + lane;
        const int ctx0 = LROWS + bl * CTX;
        const bool sw = (type == 0 || type == 3);
        const int hk = sw ? h / 4 : h;
        const int qcol = (sw ? Z_SQ : Z_NQ) + 64 * h, kcol = (sw ? Z_SK : Z_NK) + 64 * hk, vcol = (sw ? Z_SV : Z_NV) + 64 * hk;
        NaiveState st;
        { float qf[64]; load64(zrow(F, cr) + qcol, qf);
          if (type == 0) rope64(qf, tab + (size_t)t * 32);
#pragma unroll
          for (int i = 0; i < 32; ++i) st.q[i] = pk2(qf[i] * 0.125f, qf[i + 32] * 0.125f);
#pragma unroll
          for (int i = 0; i < 64; ++i) st.o[i] = 0.f; }
        if (sw) { st.m = inp(F, I_SINK)[l * 8 + h]; st.l = 1.f; } else { st.m = -1e30f; st.l = 0.f; }
        const int lo = t0 - 128 < 0 ? 0 : t0 - 128, hi = t0 + 63 + 128 > SEQ - 1 ? SEQ - 1 : t0 + 63 + 128;
        const int r = t0 / 64, c = lane; int rs = r - 4; rs = rs < 0 ? 0 : (rs > 24 ? 24 : rs); int cs = c - 8; cs = cs < 0 ? 0 : (cs > 48 ? 48 : cs);
        const float* rpb = inp(F, I_RPB) + ((size_t)l * 8 + h) * 15 * 31;
        const int nloc = type == 0 ? hi - lo + 1 : (type == 1 ? 512 : 0);
#pragma unroll 1
        for (int idx = 0; idx < CTX + nloc; ++idx) {
            const bf16* zr; float bias = 0.f; bool valid = true; const f32x2* rt = nullptr;
            if (idx < CTX) zr = zrow(F, ctx0 + idx);
            else if (type == 0) { const int j = lo + idx - CTX, dlt = t - j; zr = zrow(F, cr0 - t0 + j); valid = dlt <= 128 && dlt >= -128; rt = tab + (size_t)j * 32; }
            else { const int q = idx - CTX, kr = rs + (q >> 6), kc = q & 63; zr = zrow(F, cr0 - t0 + kr * 64 + kc); valid = kc >= cs && kc < cs + 16;
                int dc = kc - c + 15; dc = dc < 0 ? 0 : (dc > 30 ? 30 : dc); bias = rpb[(kr - r + 7) * 31 + dc]; }
            naive_visit(st, zr + kcol, zr + vcol, bias, valid, rt);
        }
        const float inv = 1.0f / st.l;
        bf16* op = ob + (size_t)cr * OW + (sw ? 1024 : 512) + 64 * h;
#pragma unroll
        for (int i = 0; i < 8; ++i) { u32x4 o; o.x = pk2(st.o[8 * i] * inv, st.o[8 * i + 1] * inv); o.y = pk2(st.o[8 * i + 2] * inv, st.o[8 * i + 3] * inv); o.z = pk2(st.o[8 * i + 4] * inv, st.o[8 * i + 5] * inv); o.w = pk2(st.o[8 * i + 6] * inv, st.o[8 * i + 7] * inv);
            *(u32x4*)(op + 8 * i) = o; }
    }
}

typedef short s16x4 __attribute__((ext_vector_type(4)));
typedef float f32x16 __attribute__((ext_vector_type(16)));
typedef __bf16 bf16x2_t __attribute__((ext_vector_type(2)));
__device__ __forceinline__ unsigned cvtpk(float lo, float hi) { const f32x2 v = {lo, hi}; return __builtin_bit_cast(unsigned, __builtin_convertvector(v, bf16x2_t)); }
typedef short v4i16_t __attribute__((ext_vector_type(4)));
__device__ __forceinline__ s16x4 vtr(const LAS unsigned char* p) { return __builtin_bit_cast(s16x4, __builtin_amdgcn_ds_read_tr16_b64_v4i16((LAS v4i16_t*)p)); }
constexpr int AK_RS = 144, AV_RS = 192, AK_BYTES = 128 * AK_RS, AV_BYTES = 128 * AV_RS, ASTAGE = AK_BYTES + AV_BYTES, A_RPB_OFF = 2 * ASTAGE;
#define MFMA32(a, b, c) __builtin_amdgcn_mfma_f32_32x32x16_bf16((a), (b), (c), 0, 0, 0)
__device__ __forceinline__ float xlane32(float v) {
    const auto rr = __builtin_amdgcn_permlane32_swap(__builtin_bit_cast(unsigned, v), __builtin_bit_cast(unsigned, v), false, false);
    return __builtin_bit_cast(float, (lane_id() & 32) ? rr[0] : rr[1]);
}
__device__ __forceinline__ float max3f(float a, float b, float c) { return fmaxf(fmaxf(a, b), c); }
__device__ __forceinline__ float rowmax32(const f32x16& p0, const f32x16& p1) {
    float a = max3f(p0[0], p0[1], p1[0]), b = max3f(p0[2], p0[3], p1[1]); a = max3f(a, p1[2], p1[3]);
#pragma unroll
    for (int i = 4; i < 16; i += 4) { a = max3f(a, p0[i], p0[i + 1]); b = max3f(b, p0[i + 2], p0[i + 3]); a = max3f(a, p1[i], p1[i + 1]); b = max3f(b, p1[i + 2], p1[i + 3]); }
    const float m = fmaxf(a, b);
    const auto rr = __builtin_amdgcn_permlane32_swap(__builtin_bit_cast(unsigned, m), __builtin_bit_cast(unsigned, m), false, false);
    return fmaxf(__builtin_bit_cast(float, rr[0]), __builtin_bit_cast(float, rr[1]));
}
__device__ __forceinline__ void lds_read_vt8(unsigned addr, s16x4 (&t)[8]) {
    asm volatile("ds_read_b64_tr_b16 %0, %8\n\tds_read_b64_tr_b16 %1, %8 offset:1536\n\tds_read_b64_tr_b16 %2, %8 offset:64\n\tds_read_b64_tr_b16 %3, %8 offset:1600\n\t"
                 "ds_read_b64_tr_b16 %4, %8 offset:3072\n\tds_read_b64_tr_b16 %5, %8 offset:4608\n\tds_read_b64_tr_b16 %6, %8 offset:3136\n\tds_read_b64_tr_b16 %7, %8 offset:4672\n\t"
                 "s_waitcnt lgkmcnt(0)"
        : "=&v"(t[0]), "=&v"(t[1]), "=&v"(t[2]), "=&v"(t[3]), "=&v"(t[4]), "=&v"(t[5]), "=&v"(t[6]), "=&v"(t[7]) : "v"(addr) : "memory");
}
static_assert(16 * 192 == 3072 && 8 * 192 == 1536, "lds_read_vt8 offsets assume AV_RS = 192");
__device__ __forceinline__ void lds_read_k4(unsigned addr, bf16x8 (&ka)[4]) {
    asm volatile("ds_read_b128 %0, %4\n\tds_read_b128 %1, %4 offset:32\n\tds_read_b128 %2, %4 offset:64\n\tds_read_b128 %3, %4 offset:96\n\ts_waitcnt lgkmcnt(0)"
        : "=&v"(ka[0]), "=&v"(ka[1]), "=&v"(ka[2]), "=&v"(ka[3]) : "v"(addr) : "memory");
}
__device__ __forceinline__ void lds_read_k8(unsigned addr, bf16x8 (&ka)[4], bf16x8 (&kb)[4]) {
    asm volatile("ds_read_b128 %0, %8\n\tds_read_b128 %1, %8 offset:32\n\tds_read_b128 %2, %8 offset:64\n\tds_read_b128 %3, %8 offset:96\n\t"
                 "ds_read_b128 %4, %8 offset:4608\n\tds_read_b128 %5, %8 offset:4640\n\tds_read_b128 %6, %8 offset:4672\n\tds_read_b128 %7, %8 offset:4704\n\t"
                 "s_waitcnt lgkmcnt(0)"
        : "=&v"(ka[0]), "=&v"(ka[1]), "=&v"(ka[2]), "=&v"(ka[3]), "=&v"(kb[0]), "=&v"(kb[1]), "=&v"(kb[2]), "=&v"(kb[3]) : "v"(addr) : "memory");
}
constexpr int A_ROPE_OFF = A_RPB_OFF + 4096;
template <int VAR, int TY>
__device__ __forceinline__ void attn_units(Frame& F, int l, int ch, bool last, bf16* ob) {
    const int lane = launder(lane_id()), tid = F.wave * 64 + lane;
    const int wave = F.wave, r = lane & 31, hh = lane >> 5;
    const float LOG2E = 1.4426950408889634f;
    const f32x2* tab = (const f32x2*)(F.ws + WS_ROPE); (void)tab;
    float* rpbl = (float*)(F.lds + A_RPB_OFF);
    const int skey = tid >> 2, sc = tid & 3, sb = skey >> 6, srow = skey & 63;
    const int nNA = BC * 8 * 8, nSW = BC * 16 * 4, nCX = (last || ch != 0) ? 0 : NB * 8 * 2;
    const int ubeg = (TY == 1) ? 0 : (TY == 0 ? nNA : nNA + nSW), uend = (TY == 1) ? nNA : (TY == 0 ? nNA + nSW : nNA + nSW + nCX);
    for (int u = ubeg + F.vcu; u < uend; u += F.G) {
        int type, bl, h, rg = 0, n = 0;
        if (u < nNA) { type = 1; bl = u >> 6; rg = ((u >> 3) + (u >> 8)) & 7; h = u & 7; }
        else if (u < nNA + nSW) { const int v = u - nNA; type = 0; bl = v >> 6; n = ((v >> 2) + 4 * (v >> 8)) & 15; h = 4 * ((v >> 1) & 1) + 2 * (v & 1); }
        else { const int v = u - nNA - nSW; type = (v < NB * 8) ? 2 : 3; const int vv = v % (NB * 8); bl = vv >> 3; h = vv & 7; }
        if (TY != 2) type = TY;
        const bool sw = (type == 0 || type == 3);
        const int head = (type == 0) ? h + (wave >> 2) : h;
        const int jb = wave & 3;
        const int rq = 4 * rg + 2 * (wave >> 2) + (r >> 4), cq = 16 * jb + (r & 15);
        const int qrow = (type == 1) ? bl * SEQ + 64 * rq + cq : (type == 0) ? bl * SEQ + 128 * n + 32 * (wave & 3) + r : LROWS + bl * CTX + 32 * wave + r;
        const int qcol = (sw ? Z_SQ : Z_NQ) + 64 * head, kcol = sw ? Z_SK + 64 * (head >> 2) : Z_NK + 64 * head, vcol = sw ? Z_SV + 64 * (head >> 2) : Z_NV + 64 * head;
        const int ocol = (sw ? 1024 : 512) + 64 * head;
        const int ctx0 = LROWS + ((type < 2) ? ch * BC + bl : bl) * CTX;
        int nloc = 0, loc0 = 0;
        if (type == 0) { const int jlo = (n == 0) ? 2 : 0, jhi = (n == 15) ? 3 : 5; nloc = jhi - jlo + 1; loc0 = jlo; }
        else if (type == 1) { int a = 4 * rg - 4; a = a < 0 ? 0 : (a > 24 ? 24 : a); int b = 4 * rg - 1; b = b < 0 ? 0 : (b > 24 ? 24 : b); loc0 = a; nloc = b + 7 - a + 1; }
        const int nt = 4 + nloc;
        bf16x8 qf[4];
        {
            const bf16* qp = zrow(F, qrow) + qcol + 8 * hh;
            float q[4][8];
#pragma unroll
            for (int s4 = 0; s4 < 4; ++s4) unpack8(*(const u32x4*)(qp + 16 * s4), q[s4]);
            if (type == 0) {
                const int pos = qrow - bl * SEQ; const f32x2* rl = (const f32x2*)(F.lds + A_ROPE_OFF);
#pragma unroll
                for (int s4 = 0; s4 < 2; ++s4) { const f32x2* tr = rl + (s4 == 0 ? (pos >> 6) : 32 + (pos & 63)) * 16 + 8 * hh;
#pragma unroll
                    for (int j = 0; j < 8; ++j) { const f32x2 cs = tr[j]; const float x1 = q[s4][j], x2 = q[s4 + 2][j]; q[s4][j] = x1 * cs.x - x2 * cs.y; q[s4 + 2][j] = x1 * cs.y + x2 * cs.x; } }
            }
            const float qs = 0.125f * LOG2E;
#pragma unroll
            for (int s4 = 0; s4 < 4; ++s4) { u32x4 p; p.x = cvtpk(q[s4][0] * qs, q[s4][1] * qs); p.y = cvtpk(q[s4][2] * qs, q[s4][3] * qs); p.z = cvtpk(q[s4][4] * qs, q[s4][5] * qs); p.w = cvtpk(q[s4][6] * qs, q[s4][7] * qs);
                qf[s4] = __builtin_bit_cast(bf16x8, p); }
        }
        float m = 0.f, lsum = 0.f;
        if (sw) { m = inp(F, I_SINK)[l * 8 + head] * LOG2E; lsum = (hh == 0) ? 1.f : 0.f; }
        f32x16 o0, o1;
#pragma unroll
        for (int i = 0; i < 16; ++i) { o0[i] = 0.f; o1[i] = 0.f; }
        const int kst = (type == 1) ? (16 * jb - 8 < 0 ? 0 : (16 * jb - 8 > 32 ? 32 : 16 * jb - 8)) : 0;
        unsigned bixp[4] = {0u, 0u, 0u, 0u};
        {
            const int csq = cq - 8 < 0 ? 0 : (cq - 8 > 48 ? 48 : cq - 8);
#pragma unroll
            for (int i = 0; i < 16; ++i) { const int kc = kst + (i & 3) + 8 * (i >> 2) + 4 * hh; bixp[i >> 2] |= (unsigned)(((kc >= csq && kc <= csq + 15) ? kc - cq + 15 : 31) * 4) << (8 * (i & 3)); }
        }
#define BIX(i) ((bixp[(i) >> 2] >> (8 * ((i) & 3))) & 0xffu)
        const int rsl = rq - 4 < 0 ? 0 : (rq - 4 > 24 ? 24 : rq - 4);
        u32x4 gk0, gk1, gv0, gv1;
        bool grope = false; int gpos = 0;
#define A_TILE_ROW0(ti) ((ti) < 4 ? ctx0 + 64 * (ti) : (type == 0 ? bl * SEQ + 128 * n - 128 + 64 * (loc0 + (ti) - 4) : bl * SEQ + 64 * (loc0 + (ti) - 4)))
#define A_STAGE_LOAD(T) do { const int ti_ = 2 * (T) + sb; const int tic_ = ti_ < nt ? ti_ : nt - 1; const int row0_ = A_TILE_ROW0(tic_); const bf16* sp_ = zrow(F, row0_ + srow) + 8 * sc; \
            gk0 = *(const u32x4*)(sp_ + kcol); gk1 = *(const u32x4*)(sp_ + kcol + 32); gv0 = *(const u32x4*)(sp_ + vcol); gv1 = *(const u32x4*)(sp_ + vcol + 32); grope = (type == 0 && tic_ >= 4); gpos = row0_ - bl * SEQ + srow; } while (0)
#define A_STAGE_WRITE(st) do { unsigned char* dk_ = F.lds + (st) * ASTAGE + skey * AK_RS + 16 * sc; unsigned char* dv_ = F.lds + (st) * ASTAGE + AK_BYTES + skey * AV_RS + 16 * sc; \
            if (grope) { float a_[8], b_[8]; unpack8(gk0, a_); unpack8(gk1, b_); \
                const f32x4* rl_ = (const f32x4*)(F.lds + A_ROPE_OFF + ((sc < 2 ? (gpos >> 6) : 32 + (gpos & 63)) * 16 + 8 * (sc & 1)) * 8); \
                _Pragma("unroll") for (int j_ = 0; j_ < 4; ++j_) { const f32x4 rcj_ = rl_[j_]; const float c0_ = rcj_.x, s0_ = rcj_.y, c1_ = rcj_.z, s1_ = rcj_.w; \
                    const float x1_ = a_[2 * j_], x2_ = b_[2 * j_], y1_ = a_[2 * j_ + 1], y2_ = b_[2 * j_ + 1]; \
                    a_[2 * j_] = x1_ * c0_ - x2_ * s0_; b_[2 * j_] = x1_ * s0_ + x2_ * c0_; a_[2 * j_ + 1] = y1_ * c1_ - y2_ * s1_; b_[2 * j_ + 1] = y1_ * s1_ + y2_ * c1_; } \
                gk0.x = cvtpk(a_[0], a_[1]); gk0.y = cvtpk(a_[2], a_[3]); gk0.z = cvtpk(a_[4], a_[5]); gk0.w = cvtpk(a_[6], a_[7]); \
                gk1.x = cvtpk(b_[0], b_[1]); gk1.y = cvtpk(b_[2], b_[3]); gk1.z = cvtpk(b_[4], b_[5]); gk1.w = cvtpk(b_[6], b_[7]); } \
            *(u32x4*)dk_ = gk0; *(u32x4*)(dk_ + 64) = gk1; *(u32x4*)dv_ = gv0; *(u32x4*)(dv_ + 64) = gv1; } while (0)
#define A_QK(XV, kbase) do { bf16x8 k4_[4]; lds_read_k4((unsigned)(size_t)(kbase), k4_); _Pragma("unroll") for (int i_ = 0; i_ < 16; ++i_) (XV)[i_] = -m; \
            _Pragma("unroll") for (int s4_ = 0; s4_ < 4; ++s4_) (XV) = MFMA32(k4_[s4_], qf[s4_], (XV)); } while (0)
#define A_QK2(XA, XB, kbA) do { bf16x8 ka_[4], kb_[4]; lds_read_k8((unsigned)(size_t)(kbA), ka_, kb_); \
            _Pragma("unroll") for (int i_ = 0; i_ < 16; ++i_) { (XA)[i_] = -m; (XB)[i_] = -m; } \
            _Pragma("unroll") for (int s4_ = 0; s4_ < 4; ++s4_) { (XA) = MFMA32(ka_[s4_], qf[s4_], (XA)); (XB) = MFMA32(kb_[s4_], qf[s4_], (XB)); } } while (0)
#define A_NEG(XV) do { _Pragma("unroll") for (int i_ = 0; i_ < 16; ++i_) (XV)[i_] = -1e30f; } while (0)
#define A_PV(XV, vbase) do { u32x4 pa_, pb_; \
            pa_.x = cvtpk((XV)[0], (XV)[1]); pa_.y = cvtpk((XV)[2], (XV)[3]); pa_.z = cvtpk((XV)[4], (XV)[5]); pa_.w = cvtpk((XV)[6], (XV)[7]); \
            pb_.x = cvtpk((XV)[8], (XV)[9]); pb_.y = cvtpk((XV)[10], (XV)[11]); pb_.z = cvtpk((XV)[12], (XV)[13]); pb_.w = cvtpk((XV)[14], (XV)[15]); \
            s16x4 t_[8]; lds_read_vt8((unsigned)(size_t)(vbase), t_); \
            const bf16x8 pfa_ = __builtin_bit_cast(bf16x8, pa_), pfb_ = __builtin_bit_cast(bf16x8, pb_); \
            o0 = MFMA32(__builtin_shufflevector(t_[0], t_[1], 0, 1, 2, 3, 4, 5, 6, 7), pfa_, o0); o1 = MFMA32(__builtin_shufflevector(t_[2], t_[3], 0, 1, 2, 3, 4, 5, 6, 7), pfa_, o1); \
            o0 = MFMA32(__builtin_shufflevector(t_[4], t_[5], 0, 1, 2, 3, 4, 5, 6, 7), pfb_, o0); o1 = MFMA32(__builtin_shufflevector(t_[6], t_[7], 0, 1, 2, 3, 4, 5, 6, 7), pfb_, o1); } while (0)
        if (type == 1) { const float* rp = inp(F, I_RPB) + ((size_t)l * 8 + h) * 465;
            for (int i = tid; i < 17 * 32; i += NTHR) { const int tr = i >> 5, tc = i & 31; rpbl[i] = (tr >= 1 && tr <= 15 && tc < 31) ? rp[(tr - 1) * 31 + tc] * LOG2E : -1e30f; } }
        A_STAGE_LOAD(0); A_STAGE_WRITE(0);
        __syncthreads();
        const int qi = 32 * (wave & 3) + r;
        const LAS unsigned char* ldsl = F.ldsl;
        const int kro = r * AK_RS + 16 * hh;
        const int vro = (4 * hh + ((r & 15) >> 2)) * AV_RS + (16 * (r >> 4) + 4 * (r & 3)) * 2;
        const int krw = kro + kst * AK_RS, vrw = vro + kst * AV_RS;
        const int rqa = 4 * rg + 2 * (wave >> 2), rsa = rqa - 4 < 0 ? 0 : (rqa - 4 > 24 ? 24 : rqa - 4), rsb = rqa - 3 < 0 ? 0 : (rqa - 3 > 24 ? 24 : rqa - 3);
        const int nT = (nt + 1) >> 1;
#pragma unroll 1
        for (int T = 0; T < nT; ++T) {
            const int st = T & 1;
            if (VAR != 1) { if (T + 1 < nT) A_STAGE_LOAD(T + 1); }
            const LAS unsigned char* Kst = ldsl + st * ASTAGE; const LAS unsigned char* Vst = Kst + AK_BYTES;
            const bool vB = 2 * T + 1 < nt;
            const int jA = loc0 + 2 * T - 4, jB = jA + 1;
            if (VAR == 2) { } else
            if (T >= 2 && type == 1) {
                const bool nA = (jA >= rsa && jA <= rsb + 7), nB = vB && (jB >= rsa && jB <= rsb + 7);
                if (nA || nB) {
                    f32x16 x0, x1;
                    if (nA) { A_QK(x0, Kst + krw); const LAS unsigned char* tb = ldsl + A_RPB_OFF + ((jA >= rsl && jA <= rsl + 7) ? (jA - rq + 8) : 0) * 128;
#pragma unroll
                        for (int i = 0; i < 16; ++i) x0[i] += *(const LAS float*)(tb + BIX(i)); } else A_NEG(x0);
                    if (nB) { A_QK(x1, Kst + krw + 64 * AK_RS); const LAS unsigned char* tb = ldsl + A_RPB_OFF + ((jB >= rsl && jB <= rsl + 7) ? (jB - rq + 8) : 0) * 128;
#pragma unroll
                        for (int i = 0; i < 16; ++i) x1[i] += *(const LAS float*)(tb + BIX(i)); } else A_NEG(x1);
                    const float mt = rowmax32(x0, x1);
                    if (__any(mt > 8.0f)) {
                        const float dl = fmaxf(mt, 0.f), alpha = __builtin_amdgcn_exp2f(-dl);
                        m += dl; lsum *= alpha;
#pragma unroll
                        for (int i = 0; i < 16; ++i) { x0[i] -= dl; x1[i] -= dl; o0[i] *= alpha; o1[i] *= alpha; }
                    }
                    float ps = 0.f;
                    if (nA) {
#pragma unroll
                        for (int i = 0; i < 16; ++i) { x0[i] = __builtin_amdgcn_exp2f(x0[i]); ps += x0[i]; }
                        A_PV(x0, Vst + vrw); }
                    if (nB) {
#pragma unroll
                        for (int i = 0; i < 16; ++i) { x1[i] = __builtin_amdgcn_exp2f(x1[i]); ps += x1[i]; }
                        A_PV(x1, Vst + vrw + 64 * AV_RS); }
                    lsum += ps;
                }
            } else {
#pragma unroll
                for (int bi = 0; bi < 2; ++bi) {
                    if (bi == 1 && !vB) break;
                    const int j = jA + bi;
                    bool need = true, mask = false; int vlo = -1, vhi = 64;
                    if (T >= 2) { const int q0 = 32 * (wave & 3); need = (64 * j + 63 >= q0) && (64 * j <= q0 + 287); mask = !((64 * j >= q0 + 31) && (64 * j + 63 <= q0 + 256)); vlo = qi - 64 * j; vhi = qi + 256 - 64 * j; }
                    if (need) {
                        f32x16 x0, x1;
                        A_QK2(x0, x1, Kst + kro + bi * 64 * AK_RS);
                        if (mask) {
#pragma unroll
                            for (int i = 0; i < 16; ++i) { const int k0 = (i & 3) + 8 * (i >> 2) + 4 * hh, k1 = k0 + 32; x0[i] = (k0 >= vlo && k0 <= vhi) ? x0[i] : -1e30f; x1[i] = (k1 >= vlo && k1 <= vhi) ? x1[i] : -1e30f; }
                        }
                        const float mt = rowmax32(x0, x1);
                        const bool fst = !sw && T == 0 && bi == 0;
                        if (fst || __any(mt > 8.0f)) {
                            const float dl = fst ? mt : fmaxf(mt, 0.f), alpha = fst ? 1.f : __builtin_amdgcn_exp2f(-dl);
                            m += dl; lsum *= alpha;
#pragma unroll
                            for (int i = 0; i < 16; ++i) { x0[i] -= dl; x1[i] -= dl; o0[i] *= alpha; o1[i] *= alpha; }
                        }
                        float ps = 0.f;
#pragma unroll
                        for (int i = 0; i < 16; ++i) { x0[i] = __builtin_amdgcn_exp2f(x0[i]); ps += x0[i]; }
                        A_PV(x0, Vst + vro + bi * 64 * AV_RS);
#pragma unroll
                        for (int i = 0; i < 16; ++i) { x1[i] = __builtin_amdgcn_exp2f(x1[i]); ps += x1[i]; }
                        lsum += ps;
                        A_PV(x1, Vst + vro + (bi * 64 + 32) * AV_RS);
                    }
                }
            }
            if (VAR != 1) { if (T + 1 < nT) A_STAGE_WRITE(st ^ 1); }
            __syncthreads();
        }
#undef A_QK
#undef A_QK2
#undef A_NEG
#undef A_PV
#undef BIX
        const float inv = 1.0f / (lsum + __shfl_xor(lsum, 32));
        const int l2 = lane_id(), r2 = l2 & 31, h2 = l2 >> 5;
        const int rq2 = 4 * rg + 2 * (wave >> 2) + (r2 >> 4), cq2 = 16 * (wave & 3) + (r2 & 15);
        const int qrow2 = (type == 1) ? bl * SEQ + 64 * rq2 + cq2 : (type == 0) ? bl * SEQ + 128 * n + 32 * (wave & 3) + r2 : LROWS + bl * CTX + 32 * wave + r2;
        bf16* op = ob + (size_t)qrow2 * OW + ocol + 4 * h2;
#pragma unroll
        for (int g = 0; g < 4; ++g) {
            u32x2 w0, w1; w0.x = cvtpk(o0[4 * g] * inv, o0[4 * g + 1] * inv); w0.y = cvtpk(o0[4 * g + 2] * inv, o0[4 * g + 3] * inv);
            w1.x = cvtpk(o1[4 * g] * inv, o1[4 * g + 1] * inv); w1.y = cvtpk(o1[4 * g + 2] * inv, o1[4 * g + 3] * inv);
            *(u32x2*)(op + 8 * g) = w0; *(u32x2*)(op + 32 + 8 * g) = w1;
        }
    }
#undef A_TILE_ROW0
#undef A_STAGE_LOAD
#undef A_STAGE_WRITE
}
template <int VAR>
__device__ __forceinline__ void attn_phase(Frame& F, int l, int ch, bool last, bf16* ob) {
    { const int tid = F.wave * 64 + launder(lane_id()); const f32x2* tab = (const f32x2*)(F.ws + WS_ROPE);
      f32x2* rl = (f32x2*)(F.lds + A_ROPE_OFF); for (int i = tid; i < 96 * 16; i += NTHR) { const int a = i >> 4, f = i & 15; rl[i] = (a < 32) ? tab[(size_t)(a * 64) * 32 + f] : tab[(size_t)(a - 32) * 32 + 16 + f]; } }
    __syncthreads();
    attn_units<VAR, 1>(F, l, ch, last, ob);
    attn_units<VAR, 0>(F, l, ch, last, ob);
    attn_units<VAR, 2>(F, l, ch, last, ob);
}


template <int NPL>
__device__ __forceinline__ void topk_select_wave(const float* aff, int cap, int crbase, int ubase, int slot0, int e, int* tokslot, float* gatev, int* seltok, int lane) {
    unsigned v[NPL];
#pragma unroll
    for (int i = 0; i < NPL; i += 4) { const u32x4 t = *(const u32x4*)(aff + lane * NPL + i); v[i] = t.x; v[i + 1] = t.y; v[i + 2] = t.z; v[i + 3] = t.w; }
    unsigned T = 0u;
#pragma unroll 1
    for (int bit = 30; bit >= 0; --bit) {
        const unsigned cand = T | (1u << bit); int c = 0;
#pragma unroll
        for (int i = 0; i < NPL; ++i) c += (v[i] >= cand) ? 1 : 0;
#pragma unroll
        for (int o = 1; o < 64; o <<= 1) c += __shfl_xor(c, o);
        if (c >= cap) T = cand;
    }
    int ngt = 0, nti = 0;
#pragma unroll
    for (int i = 0; i < NPL; ++i) { ngt += (v[i] > T) ? 1 : 0; nti += (v[i] == T) ? 1 : 0; }
    int tot_gt = ngt;
#pragma unroll
    for (int o = 1; o < 64; o <<= 1) tot_gt += __shfl_xor(tot_gt, o);
    const int need = cap - tot_gt;
    int tinc = nti;
#pragma unroll
    for (int o = 1; o < 64; o <<= 1) { const int t = __shfl_up(tinc, o); if (lane >= o) tinc += t; }
    int tie_before = tinc - nti;
    unsigned selmask = 0u; int nsel = 0;
#pragma unroll
    for (int i = 0; i < NPL; ++i) { const bool tie = (v[i] == T); const bool sel = (v[i] > T) || (tie && tie_before < need); tie_before += tie ? 1 : 0; selmask |= sel ? (1u << i) : 0u; nsel += sel ? 1 : 0; }
    int sinc = nsel;
#pragma unroll
    for (int o = 1; o < 64; o <<= 1) { const int t = __shfl_up(sinc, o); if (lane >= o) sinc += t; }
    int pos = sinc - nsel;
#pragma unroll
    for (int i = 0; i < NPL; ++i) {
        const bool sel = (selmask >> i) & 1u; const int t = lane * NPL + i;
        tokslot[(size_t)(crbase + t) * NE + e] = sel ? pos : -1;
        if (sel) { seltok[slot0 + pos] = ubase + crbase + t; gatev[slot0 + pos] = __builtin_bit_cast(float, v[i]); ++pos; }
    }
}
__device__ __forceinline__ void topk_phase(Frame& F, bool last) {
    const int lane = launder(lane_id());
    int* gsel = (int*)(F.ws + WS_SELTOK);
    float* gatev = (float*)(F.ws + WS_GATEV);
    const bool cx = !last;
    for (int p = F.vcu; p < BC * NE; p += F.G) {
        const int bl = p / NE, e = p % NE;
        const int slotL = p * CAP_L, slotC0 = SLOT_CT0 + e * (NB * CAP_C) + bl * CAP_C, slotC1 = slotC0 + BC * CAP_C;
        if (F.wave == 0) topk_select_wave<32>(affl_of(F, 0) + (size_t)p * SEQ, CAP_L, bl * SEQ, 0, slotL, e, tokslot_of(F, 0), gatev, gsel, lane);
        else if (F.wave == 3) topk_select_wave<32>(affl_of(F, 1) + (size_t)p * SEQ, CAP_L, bl * SEQ, RCMAX, NSLOTMAX + slotL, e, tokslot_of(F, 1), gatev, gsel, lane);
        else if (F.wave == 1 && cx) topk_select_wave<4>((const float*)(F.ws + WS_AFFC) + (size_t)p * CTX, CAP_C, LROWS + bl * CTX, 0, slotC0, e, tokslot_of(F, 0), gatev, gsel, lane);
        else if (F.wave == 2 && cx) topk_select_wave<4>((const float*)(F.ws + WS_AFFC) + (size_t)(p + BC * NE) * CTX, CAP_C, LROWS + (bl + BC) * CTX, 0, slotC1, e, tokslot_of(F, 0), gatev, gsel, lane);
    }
}

__device__ __forceinline__ void combine_phase(Frame& F, int l, int ch, bool last, bool dry = false) {
    const int lane = launder(lane_id()), tid = F.wave * 64 + lane; (void)tid; (void)lane;
    const int gw = F.vcu * NWAVES + F.wave, NGW = F.G * NWAVES;
    const int nrows = last ? LROWS : nrows_of(ch);
    const bf16* yb = (const bf16*)(F.ws + WS_YBUF) + (size_t)ch * NSLOTMAX * D; const int* tokslot = tokslot_of(F, ch); const float* gatev = (const float*)(F.ws + WS_GATEV) + (size_t)ch * NSLOTMAX;
    int nslot = -1; f32x4 nxv[4]; u32x2 ndx[4]; const bf16* dxb = dx_of(F, ch);
#define CB_LOAD(c) do { nslot = (lane < 16) ? tokslot[(size_t)(c) * NE + lane] : -1; \
        if (l > 0) { const bf16* xb_ = xbrow(F, ch, (c)); \
            _Pragma("unroll") for (int j_ = 0; j_ < 4; ++j_) { const u32x2 t_ = *(const u32x2*)(xb_ + lane * 4 + 256 * j_); const unsigned tx_ = t_.x, ty_ = t_.y; nxv[j_].x = __builtin_bit_cast(float, tx_); nxv[j_].y = __builtin_bit_cast(float, ty_); } } \
        else { const float* xr_ = xin_row(F, ch, (c)); \
            _Pragma("unroll") for (int j_ = 0; j_ < 4; ++j_) nxv[j_] = *(const f32x4*)(xr_ + lane * 4 + 256 * j_); } \
        _Pragma("unroll") for (int j_ = 0; j_ < 4; ++j_) ndx[j_] = *(const u32x2*)(dxb + (size_t)(c) * D + lane * 4 + 256 * j_); } while (0)
    const int rpw = (nrows + NGW - 1) / NGW, rbeg = gw * rpw, rend = (rbeg + rpw < nrows) ? rbeg + rpw : nrows;
    f32x4 gtq[4], shq[4], scq[4], gmq[4]; int cmv = -1;
#pragma unroll
    for (int j = 0; j < 4; ++j) gmq[j] = *(const f32x4*)((last ? inp(F, I_GFINAL) : inp(F, I_GMIX) + (size_t)(l + 1) * D) + lane * 4 + 256 * j);
    if (rbeg < rend) CB_LOAD(rbeg);
    for (int cr = rbeg; cr < rend; ++cr) {
        const bool lat = cr < LROWS; const int bl = lat ? cr / SEQ : (cr - LROWS) / CTX;
        { const int mv = mv_of(ch, cr); if (mv != cmv) { cmv = mv; const float* gt = mod_ptr(F, l, mv, 5); const float* sh = mod_ptr(F, last ? l : l + 1, mv, 0); const float* sc = mod_ptr(F, last ? l : l + 1, mv, 1);
#pragma unroll
            for (int j = 0; j < 4; ++j) { gtq[j] = *(const f32x4*)(gt + lane * 4 + 256 * j); shq[j] = *(const f32x4*)(sh + lane * 4 + 256 * j); scq[j] = *(const f32x4*)(sc + lane * 4 + 256 * j); } } }
        const int myslot = nslot; f32x4 v[4];
#pragma unroll
        for (int j = 0; j < 4; ++j) { v[j] = nxv[j];
            if (l > 0) { const float fx_ = nxv[j].x, fy_ = nxv[j].y; const unsigned a_ = __builtin_bit_cast(unsigned, fx_), b_ = __builtin_bit_cast(unsigned, fy_); v[j].x = bflo(a_); v[j].y = bfhi(a_); v[j].z = bflo(b_); v[j].w = bfhi(b_); }
            v[j].x += bflo(ndx[j].x); v[j].y += bfhi(ndx[j].x); v[j].z += bflo(ndx[j].y); v[j].w += bfhi(ndx[j].y); }
        if (cr + 1 < rend) CB_LOAD(cr + 1);
        float acc[16];
#pragma unroll
        for (int i = 0; i < 16; ++i) acc[i] = 0.f;
        unsigned mask = (unsigned)__ballot(myslot >= 0) & 0xFFFFu;
        while (mask) {
            const int e0 = __builtin_ctz(mask); mask &= mask - 1;
            const bool two = mask != 0u; const int e1 = two ? __builtin_ctz(mask) : e0; if (two) mask &= mask - 1;
            const int p0 = __shfl(myslot, e0), p1 = __shfl(myslot, e1);
            const int s0 = lat ? (bl * NE + e0) * CAP_L + p0 : SLOT_CT0 + e0 * (NB * CAP_C) + bl * CAP_C + p0;
            const int s1 = lat ? (bl * NE + e1) * CAP_L + p1 : SLOT_CT0 + e1 * (NB * CAP_C) + bl * CAP_C + p1;
            u32x2 ua[4], ub[4]; const float ga = gatev[s0], gb = gatev[s1];
#pragma unroll
            for (int j = 0; j < 4; ++j) { ua[j] = *(const u32x2*)(yb + (size_t)s0 * D + lane * 4 + 256 * j); ub[j] = *(const u32x2*)(yb + (size_t)s1 * D + lane * 4 + 256 * j); }
#pragma unroll
            for (int j = 0; j < 4; ++j) { acc[4 * j] += ga * bflo(ua[j].x); acc[4 * j + 1] += ga * bfhi(ua[j].x); acc[4 * j + 2] += ga * bflo(ua[j].y); acc[4 * j + 3] += ga * bfhi(ua[j].y); }
            if (two) {
#pragma unroll
                for (int j = 0; j < 4; ++j) { acc[4 * j] += gb * bflo(ub[j].x); acc[4 * j + 1] += gb * bfhi(ub[j].x); acc[4 * j + 2] += gb * bflo(ub[j].y); acc[4 * j + 3] += gb * bfhi(ub[j].y); }
            }
        }
        float* xr = dry ? (float*)(F.ws + WS_OBUF) + (size_t)cr * D : F.out + ((size_t)ch * LROWS + cr) * D;
        float ss = 0.f;
#pragma unroll
        for (int j = 0; j < 4; ++j) { const f32x4 g4 = gtq[j];
            v[j].x += g4.x * acc[4 * j]; v[j].y += g4.y * acc[4 * j + 1]; v[j].z += g4.z * acc[4 * j + 2]; v[j].w += g4.w * acc[4 * j + 3];
            ss += (v[j].x * v[j].x + v[j].y * v[j].y) + (v[j].z * v[j].z + v[j].w * v[j].w); }
        const float rstd = 1.0f / sqrtf(wave_sum(ss) * (1.0f / D) + RMS_EPS);
        if (!last) {
            { bf16* xb = dry ? (bf16*)(F.ws + WS_OBUF) + (size_t)cr * D : xbrow(F, ch, cr);
#pragma unroll
              for (int j = 0; j < 4; ++j) { u32x2 o; o.x = pk2(v[j].x, v[j].y); o.y = pk2(v[j].z, v[j].w); *(u32x2*)(xb + lane * 4 + 256 * j) = o; } }
            bf16* hb = dry ? (bf16*)(F.ws + WS_OBUF + 160 * MiB) : hbuf_of(F, ch);
#pragma unroll
            for (int j = 0; j < 4; ++j) {
                const f32x4 hv = (v[j] * rstd * gmq[j]) * (scq[j] + 1.0f) + shq[j];
                u32x2 o; o.x = pk2(hv.x, hv.y); o.y = pk2(hv.z, hv.w);
                *(u32x2*)(hb + (size_t)cr * D + lane * 4 + 256 * j) = o;
            }
            continue;
        }
        {
#pragma unroll
            for (int j = 0; j < 4; ++j) v[j] = v[j] * rstd * gmq[j];
#if defined(PROBE_ATTN)
            { const unsigned cn = __hip_atomic_load((unsigned*)(F.ws + WS_CTL) + CW_DIAG, __ATOMIC_RELAXED, __HIP_MEMORY_SCOPE_AGENT); const float sc = 1.0f + 0.02f * log2f(1.0f + (float)cn);
#pragma unroll
              for (int j = 0; j < 4; ++j) v[j] = v[j] * sc; }
#endif
        }
#pragma unroll
        for (int j = 0; j < 4; ++j) *(f32x4*)(xr + lane * 4 + 256 * j) = v[j];
    }
#undef CB_LOAD
}

using pg8::Unit; using pg8::cvt_pk_bf16;
struct SchedBase { int nM, nN, G, c, rep;
    __device__ __forceinline__ bool tile(int i, int& pm, int& pn, int& sub) const { sub = i % rep; return pg8::tile_of((long)(i / rep) * G + c, nM, nN, pm, pn); } };

struct SchedIn : SchedBase { const char* A; const char* B; int nMfull = 0, kvM = 0;
    __device__ __forceinline__ bool next(int i, Unit& u) const { int sub; u.aux = 0; u.pad = 0;
        if (!tile(i, u.pm, u.pn, sub)) {
            const long L = (long)(i / rep) * G + c - (long)nM * nN; if (kvM == 0 || L < 0 || L >= (long)kvM * 5) return false;
            const int q = (int)L % 5; u.pm = nM + (int)L / 5; u.pn = q < 4 ? 8 + q : 14; }
        u.A = A + (size_t)u.pm * 256 * D * 2; u.B = B + (size_t)u.pn * 256 * D * 2; return true; } };
__device__ __forceinline__ size_t gb_off(int pm, int g, int wr, int wc, int fr, int fq) { return ((size_t)(pm * 12 + g) * 131072) + (size_t)(((wr * 4 + wc) * 64 + fq * 16 + fr) * 16); }
struct EpiStoreBf16 { static constexpr bool PERM = true; bf16* O; int ldc; unsigned char* GB;
    __device__ __forceinline__ void operator()(const f32x4 (&acc)[2][2][4][2], const Unit& u, int wr, int wc, int fr, int fq) const {
        if (u.pn >= Z_G / 256) {
            unsigned char* gp = GB + gb_off(u.pm, u.pn - Z_G / 256, wr, wc, fr, fq);
#pragma unroll
            for (int ai = 0; ai < 2; ++ai)
#pragma unroll
                for (int m = 0; m < 4; ++m)
#pragma unroll
                    for (int bj = 0; bj < 2; ++bj) { f32x4 v0 = acc[ai][bj][m][0], v1 = acc[ai][bj][m][1];
#pragma unroll
                        for (int j = 0; j < 4; ++j) { v0[j] = fmaxf(sigmoidf_(v0[j]), 1e-30f); v1[j] = fmaxf(sigmoidf_(v1[j]), 1e-30f); }
                        u32x4 w; w.x = cvt_pk_bf16(v0[0], v0[1]); w.y = cvt_pk_bf16(v0[2], v0[3]); w.z = cvt_pk_bf16(v1[0], v1[1]); w.w = cvt_pk_bf16(v1[2], v1[3]);
                        __builtin_nontemporal_store(w, (u32x4*)(gp + ((ai * 4 + m) * 2 + bj) * 8192)); }
        } else {
            const int row0 = u.pm * 256 + wr * 64 + fr, col0 = u.pn * 256 + wc * 32 + 8 * fq;
#pragma unroll
            for (int ai = 0; ai < 2; ++ai)
#pragma unroll
                for (int m = 0; m < 4; ++m) { bf16* rowp = O + (size_t)(row0 + ai * 128 + m * 16) * ldc + col0;
#pragma unroll
                    for (int bj = 0; bj < 2; ++bj) { const f32x4 v0 = acc[ai][bj][m][0], v1 = acc[ai][bj][m][1];
                        u32x4 w; w.x = cvt_pk_bf16(v0[0], v0[1]); w.y = cvt_pk_bf16(v0[2], v0[3]); w.z = cvt_pk_bf16(v1[0], v1[1]); w.w = cvt_pk_bf16(v1[2], v1[3]);
                        __builtin_nontemporal_store(w, (u32x4*)(rowp + bj * 128)); } }
        }
    } };

struct SchedMerge : SchedBase { const char* A; const char* B;
    __device__ __forceinline__ bool next(int i, Unit& u) const { int sub; if (!tile(i, u.pm, u.pn, sub)) return false; u.aux = 0; u.pad = 0;
        u.A = A + (size_t)u.pm * 256 * OW * 2; u.B = B + (size_t)u.pn * 256 * 1536 * 2; return true; } };
__device__ __forceinline__ void gate_load8x2(const unsigned char* sbase, unsigned vo, u32x4 (&a)[8], u32x4 (&b)[8]) {
    unsigned t0, t1, t2, t3;
    asm volatile("v_add_u32 %[t0], 0, %[vo]\n\tglobal_load_dwordx4 %[a0], %[t0], %[sb]\n\t"
        "v_add_u32 %[t2], 524288, %[vo]\n\tglobal_load_dwordx4 %[b0], %[t2], %[sb]\n\t"
        "v_add_u32 %[t1], 8192, %[vo]\n\tglobal_load_dwordx4 %[a1], %[t1], %[sb]\n\t"
        "v_add_u32 %[t3], 532480, %[vo]\n\tglobal_load_dwordx4 %[b1], %[t3], %[sb]\n\t"
        "v_add_u32 %[t0], 16384, %[vo]\n\tglobal_load_dwordx4 %[a2], %[t0], %[sb]\n\t"
        "v_add_u32 %[t2], 540672, %[vo]\n\tglobal_load_dwordx4 %[b2], %[t2], %[sb]\n\t"
        "v_add_u32 %[t1], 24576, %[vo]\n\tglobal_load_dwordx4 %[a3], %[t1], %[sb]\n\t"
        "v_add_u32 %[t3], 548864, %[vo]\n\tglobal_load_dwordx4 %[b3], %[t3], %[sb]\n\t"
        "v_add_u32 %[t0], 32768, %[vo]\n\tglobal_load_dwordx4 %[a4], %[t0], %[sb]\n\t"
        "v_add_u32 %[t2], 557056, %[vo]\n\tglobal_load_dwordx4 %[b4], %[t2], %[sb]\n\t"
        "v_add_u32 %[t1], 40960, %[vo]\n\tglobal_load_dwordx4 %[a5], %[t1], %[sb]\n\t"
        "v_add_u32 %[t3], 565248, %[vo]\n\tglobal_load_dwordx4 %[b5], %[t3], %[sb]\n\t"
        "v_add_u32 %[t0], 49152, %[vo]\n\tglobal_load_dwordx4 %[a6], %[t0], %[sb]\n\t"
        "v_add_u32 %[t2], 573440, %[vo]\n\tglobal_load_dwordx4 %[b6], %[t2], %[sb]\n\t"
        "v_add_u32 %[t1], 57344, %[vo]\n\tglobal_load_dwordx4 %[a7], %[t1], %[sb]\n\t"
        "v_add_u32 %[t3], 581632, %[vo]\n\tglobal_load_dwordx4 %[b7], %[t3], %[sb]\n\t"
        "s_waitcnt vmcnt(0)"
        : [a0]"=&v"(a[0]), [a1]"=&v"(a[1]), [a2]"=&v"(a[2]), [a3]"=&v"(a[3]), [a4]"=&v"(a[4]), [a5]"=&v"(a[5]), [a6]"=&v"(a[6]), [a7]"=&v"(a[7]), [b0]"=&v"(b[0]), [b1]"=&v"(b[1]), [b2]"=&v"(b[2]), [b3]"=&v"(b[3]), [b4]"=&v"(b[4]), [b5]"=&v"(b[5]), [b6]"=&v"(b[6]), [b7]"=&v"(b[7]), [t0]"=&v"(t0), [t1]"=&v"(t1), [t2]"=&v"(t2), [t3]"=&v"(t3)
        : [vo]"v"(vo), [sb]"s"(sbase) : "memory");
}
__device__ __forceinline__ void gate_load16(const unsigned char* sbase, unsigned vo, u32x4 (&a)[16]) {
    unsigned t0, t1;
    asm volatile("v_add_u32 %[t0], 0, %[vo]\n\tglobal_load_dwordx4 %[a0], %[t0], %[sb]\n\t"
        "v_add_u32 %[t1], 8192, %[vo]\n\tglobal_load_dwordx4 %[a1], %[t1], %[sb]\n\t"
        "v_add_u32 %[t0], 16384, %[vo]\n\tglobal_load_dwordx4 %[a2], %[t0], %[sb]\n\t"
        "v_add_u32 %[t1], 24576, %[vo]\n\tglobal_load_dwordx4 %[a3], %[t1], %[sb]\n\t"
        "v_add_u32 %[t0], 32768, %[vo]\n\tglobal_load_dwordx4 %[a4], %[t0], %[sb]\n\t"
        "v_add_u32 %[t1], 40960, %[vo]\n\tglobal_load_dwordx4 %[a5], %[t1], %[sb]\n\t"
        "v_add_u32 %[t0], 49152, %[vo]\n\tglobal_load_dwordx4 %[a6], %[t0], %[sb]\n\t"
        "v_add_u32 %[t1], 57344, %[vo]\n\tglobal_load_dwordx4 %[a7], %[t1], %[sb]\n\t"
        "v_add_u32 %[t0], 65536, %[vo]\n\tglobal_load_dwordx4 %[a8], %[t0], %[sb]\n\t"
        "v_add_u32 %[t1], 73728, %[vo]\n\tglobal_load_dwordx4 %[a9], %[t1], %[sb]\n\t"
        "v_add_u32 %[t0], 81920, %[vo]\n\tglobal_load_dwordx4 %[a10], %[t0], %[sb]\n\t"
        "v_add_u32 %[t1], 90112, %[vo]\n\tglobal_load_dwordx4 %[a11], %[t1], %[sb]\n\t"
        "v_add_u32 %[t0], 98304, %[vo]\n\tglobal_load_dwordx4 %[a12], %[t0], %[sb]\n\t"
        "v_add_u32 %[t1], 106496, %[vo]\n\tglobal_load_dwordx4 %[a13], %[t1], %[sb]\n\t"
        "v_add_u32 %[t0], 114688, %[vo]\n\tglobal_load_dwordx4 %[a14], %[t0], %[sb]\n\t"
        "v_add_u32 %[t1], 122880, %[vo]\n\tglobal_load_dwordx4 %[a15], %[t1], %[sb]\n\t"
        "s_waitcnt vmcnt(0)"
        : [a0]"=&v"(a[0]), [a1]"=&v"(a[1]), [a2]"=&v"(a[2]), [a3]"=&v"(a[3]), [a4]"=&v"(a[4]), [a5]"=&v"(a[5]), [a6]"=&v"(a[6]), [a7]"=&v"(a[7]), [a8]"=&v"(a[8]), [a9]"=&v"(a[9]), [a10]"=&v"(a[10]), [a11]"=&v"(a[11]), [a12]"=&v"(a[12]), [a13]"=&v"(a[13]), [a14]"=&v"(a[14]), [a15]"=&v"(a[15]), [t0]"=&v"(t0), [t1]"=&v"(t1)
        : [vo]"v"(vo), [sb]"s"(sbase) : "memory");
}
struct EpiMerge { static constexpr bool PERM = true; const unsigned char* GB; bf16* O;
    __device__ __forceinline__ void mid(f32x4 (&acc)[2][2][4][2], const Unit& u, int seg, int wr, int wc, int fr, int fq) const {
        const unsigned char* tb = GB + (size_t)(u.pm * 12 + (seg - 1) * 4 + u.pn) * 131072;
        const unsigned vo = (unsigned)(((wr * 4 + wc) * 64 + fq * 16 + fr) * 16);
#pragma unroll
        for (int ai = 0; ai < 2; ++ai) {
            u32x4 a[8], b[8]; gate_load8x2(tb + ai * 65536, vo, a, b);
#pragma unroll
            for (int m = 0; m < 4; ++m)
#pragma unroll
                for (int bj = 0; bj < 2; ++bj) { float gpv[8], gnv[8]; unpack8(a[m * 2 + bj], gpv); unpack8(b[m * 2 + bj], gnv);
#pragma unroll
                    for (int j = 0; j < 4; ++j) { acc[ai][bj][m][0][j] *= gpv[j] * __builtin_amdgcn_rcpf(gnv[j]); acc[ai][bj][m][1][j] *= gpv[4 + j] * __builtin_amdgcn_rcpf(gnv[4 + j]); } }
        }
    }
    __device__ __forceinline__ void operator()(const f32x4 (&acc)[2][2][4][2], const Unit& u, int wr, int wc, int fr, int fq) const {
        const int row0 = u.pm * 256 + wr * 64 + fr, col0 = u.pn * 256 + wc * 32 + 8 * fq;
        const unsigned char* tb = GB + (size_t)(u.pm * 12 + 8 + u.pn) * 131072;
        const unsigned vo = (unsigned)(((wr * 4 + wc) * 64 + fq * 16 + fr) * 16);
        u32x4 g[16]; gate_load16(tb, vo, g);
#pragma unroll
        for (int ai = 0; ai < 2; ++ai)
#pragma unroll
            for (int m = 0; m < 4; ++m) { const size_t row = (size_t)(row0 + ai * 128 + m * 16);
#pragma unroll
                for (int bj = 0; bj < 2; ++bj) { const int col = col0 + bj * 128;
                    float g8[8]; unpack8(g[(ai * 4 + m) * 2 + bj], g8);
                    const f32x4 v0 = acc[ai][bj][m][0], v1 = acc[ai][bj][m][1];
                    u32x4 w; w.x = cvt_pk_bf16(v0[0] * g8[0], v0[1] * g8[1]); w.y = cvt_pk_bf16(v0[2] * g8[2], v0[3] * g8[3]); w.z = cvt_pk_bf16(v1[0] * g8[4], v1[1] * g8[5]); w.w = cvt_pk_bf16(v1[2] * g8[6], v1[3] * g8[7]);
                    *(u32x4*)(O + row * D + col) = w; } }
    } };

struct EpiOut { static constexpr bool PERM = true; const Frame* F; int l, ch; bf16* O;
    __device__ __forceinline__ void operator()(const f32x4 (&acc)[2][2][4][2], const Unit& u, int wr, int wc, int fr, int fq) const {
        const int cr0 = u.pm * 256; const float* gt = mod_ptr(*F, l, mv_of(ch, cr0), 2);
        const int row0 = cr0 + wr * 64 + fr, col0 = u.pn * 256 + wc * 32 + 8 * fq;
#pragma unroll
        for (int bj = 0; bj < 2; ++bj) { const f32x4 g0 = *(const f32x4*)(gt + col0 + bj * 128), g1 = *(const f32x4*)(gt + col0 + bj * 128 + 4);
#pragma unroll
            for (int ai = 0; ai < 2; ++ai)
#pragma unroll
                for (int m = 0; m < 4; ++m) { const f32x4 v0 = acc[ai][bj][m][0] * g0, v1 = acc[ai][bj][m][1] * g1;
                    u32x4 w; w.x = cvt_pk_bf16(v0[0], v0[1]); w.y = cvt_pk_bf16(v0[2], v0[3]); w.z = cvt_pk_bf16(v1[0], v1[1]); w.w = cvt_pk_bf16(v1[2], v1[3]);
                    *(u32x4*)(O + (size_t)(row0 + ai * 128 + m * 16) * D + col0 + bj * 128) = w; } }
    } };

__device__ __forceinline__ int expert_of_tile(int pm) { return pm < SLT ? pm % NE : (pm - SLT) / (NB * CAP_C / 256); }
__device__ __forceinline__ void ffn_tile(int t, bool last, int& c1, int& pml) {
    const int per = last ? 2 * BC : 2 * BC + NB * CAP_C / 256;
    const int e = t / per, k = t % per;
    if (k < BC) { c1 = 0; pml = k * NE + e; }
    else if (!last && k < BC + NB * CAP_C / 256) { c1 = 0; pml = SLT + e * (NB * CAP_C / 256) + (k - BC); }
    else { c1 = 1; pml = (k - (per - BC)) * NE + e; }
}
struct SchedUp : SchedBase { const char* A; const char* B; const int* gidx; int nM0;
    __device__ __forceinline__ bool next(int i, Unit& u) const { int sub; if (!tile(i, u.pm, u.pn, sub)) return false; u.pad = 0;
        int c1, pml; ffn_tile(u.pm, nM0 == SLT, c1, pml); u.aux = c1 * PBT + pml;
        u.A = A; u.B = B + ((size_t)expert_of_tile(pml) * 2048 + (size_t)u.pn * 256) * D * 2; return true; } };
struct EpiUp { static constexpr bool PERM = true; bf16* O;
    __device__ __forceinline__ void operator()(const f32x4 (&acc)[2][2][4][2], const Unit& u, int wr, int wc, int fr, int fq) const {
        const int row0 = u.aux * 256 + wr * 64 + fr, col0 = u.pn * 128 + wc * 32 + 8 * fq;
#pragma unroll
        for (int ai = 0; ai < 2; ++ai)
#pragma unroll
            for (int m = 0; m < 4; ++m) { float h[8];
#pragma unroll
                for (int n = 0; n < 2; ++n)
#pragma unroll
                    for (int j = 0; j < 4; ++j) { const float g = acc[ai][0][m][n][j], uu = acc[ai][1][m][n][j]; h[4 * n + j] = g * sigmoidf_(g) * uu; }
                u32x4 w; w.x = cvt_pk_bf16(h[0], h[1]); w.y = cvt_pk_bf16(h[2], h[3]); w.z = cvt_pk_bf16(h[4], h[5]); w.w = cvt_pk_bf16(h[6], h[7]);
                *(u32x4*)(O + (size_t)(row0 + ai * 128 + m * 16) * FF + col0) = w; }
    } };

struct SchedDown : SchedBase { const char* A; const char* B; int nM0;
    __device__ __forceinline__ bool next(int i, Unit& u) const { int sub; if (!tile(i, u.pm, u.pn, sub)) return false; u.pad = 0;
        int c1, pml; ffn_tile(nM - 1 - u.pm, nM0 == SLT, c1, pml); u.aux = c1 * PBT + pml;
        u.A = A + (size_t)u.aux * 256 * FF * 2; u.B = B + ((size_t)expert_of_tile(pml) * D + (size_t)u.pn * 256) * FF * 2; return true; } };
__device__ __forceinline__ void load8_rows_f32(const float* sbase, unsigned vo, float (&g)[8]) {
    asm volatile("global_load_dword %[g0], %[vo], %[sb]\n\tglobal_load_dword %[g1], %[vo], %[sb] offset:64\n\tglobal_load_dword %[g2], %[vo], %[sb] offset:128\n\tglobal_load_dword %[g3], %[vo], %[sb] offset:192\n\t"
                 "global_load_dword %[g4], %[vo], %[sb] offset:512\n\tglobal_load_dword %[g5], %[vo], %[sb] offset:576\n\tglobal_load_dword %[g6], %[vo], %[sb] offset:640\n\tglobal_load_dword %[g7], %[vo], %[sb] offset:704\n\t"
                 "s_waitcnt vmcnt(0)"
        : [g0]"=&v"(g[0]), [g1]"=&v"(g[1]), [g2]"=&v"(g[2]), [g3]"=&v"(g[3]), [g4]"=&v"(g[4]), [g5]"=&v"(g[5]), [g6]"=&v"(g[6]), [g7]"=&v"(g[7])
        : [vo]"v"(vo), [sb]"s"(sbase) : "memory");
}
struct EpiDown { static constexpr bool PERM = true; bf16* O; const float* gv;
    __device__ __forceinline__ void operator()(const f32x4 (&acc)[2][2][4][2], const Unit& u, int wr, int wc, int fr, int fq) const {
        const int row0 = u.aux * 256 + wr * 64 + fr, col0 = u.pn * 256 + wc * 32 + 8 * fq;
#pragma unroll
        for (int ai = 0; ai < 2; ++ai)
#pragma unroll
            for (int m = 0; m < 4; ++m) { const int row = row0 + ai * 128 + m * 16; const float g = 1.0f; bf16* rowp = O + (size_t)row * D + col0;
#pragma unroll
                for (int bj = 0; bj < 2; ++bj) { const f32x4 v0 = acc[ai][bj][m][0] * g, v1 = acc[ai][bj][m][1] * g;
                    u32x4 w; w.x = cvt_pk_bf16(v0[0], v0[1]); w.y = cvt_pk_bf16(v0[2], v0[3]); w.z = cvt_pk_bf16(v1[0], v1[1]); w.w = cvt_pk_bf16(v1[2], v1[3]);
                    *(u32x4*)(rowp + bj * 128) = w; } }
    } };

#if defined(PROBE_ATTN)
__device__ __forceinline__ void probe_compare(Frame& F, int nrows, const bf16* a, const bf16* b) {
    const int lane = launder(lane_id());
    const int gw = F.vcu * NWAVES + F.wave, NGW = F.G * NWAVES;
    unsigned cnt = 0;
    for (int cr = gw; cr < nrows; cr += NGW) {
#pragma unroll
        for (int j = 0; j < 2; ++j) { float x[8], y[8]; unpack8(*(const u32x4*)(a + (size_t)cr * OW + 512 + lane * 8 + 512 * j), x); unpack8(*(const u32x4*)(b + (size_t)cr * OW + 512 + lane * 8 + 512 * j), y);
#pragma unroll
            for (int i = 0; i < 8; ++i) { const float d = fabsf(x[i] - y[i]); cnt += (!(d <= 0.01f + 0.05f * fabsf(y[i]))) ? 1u : 0u; } }
    }
#pragma unroll
    for (int o = 1; o < 64; o <<= 1) cnt += __shfl_xor(cnt, o);
    if (lane == 0 && cnt) atomicAdd((unsigned*)(F.ws + WS_CTL) + CW_DIAG, cnt);
}
#endif

constexpr int SEQ_TOTAL = 2 + DEPTH * (NCH * 4 + 5);

__global__ void __launch_bounds__(NTHR, 2) fwd_kernel(Args args) {
    extern __shared__ __attribute__((aligned(16))) unsigned char lds[];
    Frame F;
    F.lds = lds; F.ldsl = (LAS unsigned char*)lds; F.ws = args.ws; F.out = args.out;
    F.wave = __builtin_amdgcn_readfirstlane(threadIdx.x >> 6);
    F.G = gridDim.x; { const int bx = blockIdx.x; F.vcu = (F.G % 8 == 0) ? (bx % 8) * (F.G / 8) + bx / 8 : bx; }
    volatile LAS unsigned* MISC = (volatile LAS unsigned*)(F.ldsl + MISC_OFF);
    for (int u = threadIdx.x; u < (LDS_BYTES - LDSCTL_OFF) / 4; u += NTHR) ((LAS unsigned*)(F.ldsl + LDSCTL_OFF))[u] = 0u;
    if (threadIdx.x < 19) *(LAS unsigned long long*)(F.ldsl + PTR_OFF + 8 * threadIdx.x) = (unsigned long long)args.in[threadIdx.x];
    __syncthreads();
    const int lo = args.ph_lo, hi = args.ph_hi;
    const bool multi = (hi - lo) > 1;
    XcdBarrier bar; bar.bar = (unsigned*)(F.ws + WS_CTL) + CW_BAR; bar.x = 0; bar.st = nullptr;
    if (multi) bar = xcd_barrier_post((unsigned*)(F.ws + WS_CTL) + CW_BAR, MISC + 8);
    int seq = 0;
#ifndef PHMASK
#define PHMASK 0xFFFF
#endif
#define EN(b) ((PHMASK >> (b)) & 1)
#ifndef REPMASK
#define REPMASK 0
#endif
#define REP(b) ((REPMASK >> (b)) & 1)
#define RUN(b, stmt) do { stmt; if (REP(b)) { __syncthreads(); stmt; } } while (0)
#define IN(k) (lo <= (k) && (k) < hi)
#define SEAM(k) do { if (IN(k) && IN((k) + 1)) xcd_barrier(bar, F.wave); } while (0)

    if (IN(seq)) { if (EN(0)) RUN(0, mods_phase(F)); if (EN(1)) RUN(1, wconv_phase(F, 0)); } SEAM(seq); ++seq;
    if (EN(2) && IN(seq)) { norm_phase<false>(F, 0, 0, nrows_of(0)); norm_phase<false>(F, 0, 1, nrows_of(1)); } SEAM(seq); ++seq;

    for (int l = 0; l < DEPTH; ++l) {
        const bool last = (l == DEPTH - 1);
        for (int ch = 0; ch < NCH; ++ch) {
            if (EN(3) && IN(seq)) {
                SchedIn S; S.nM = (last && ch == 0) ? LT : nrows_of(ch) / 256; S.kvM = (last && ch == 0) ? CTT : 0; S.nN = INW / 256; S.G = F.G; S.c = blockIdx.x; S.rep = 1; S.A = (const char*)hbuf_of(F, ch); S.B = (const char*)(F.ws + WS_WIN);
                EpiStoreBf16 E{(bf16*)(F.ws + WS_Z), ZW, F.ws + WS_GB};
                RUN(3, (pg8::gemm_phase<EpiStoreBf16, SchedIn, true, true>(F.ldsl, D * 2, D, S, E, F.wave)));
            } SEAM(seq); ++seq;
            if (IN(seq)) { if (EN(4)) RUN(4, conv_phase(F, l, last ? LROWS : nrows_of(ch)));
#if defined(ATTN_NAIVE)
                if (EN(5)) naive_attn_phase(F, l, ch, last, (bf16*)(F.ws + WS_OBUF));
#else
                if (EN(5)) attn_phase<0>(F, l, ch, last, (bf16*)(F.ws + WS_OBUF));
#if defined(PROBE_AVAR)
                __syncthreads(); attn_phase<PROBE_AVAR>(F, l, ch, last, (bf16*)(F.ws + WS_PART));
#endif
#endif
#if defined(PROBE_ATTN)
                naive_attn_phase(F, l, ch, last, (bf16*)(F.ws + WS_PART));
                xcd_barrier(bar, F.wave);
                probe_compare(F, last ? LROWS : nrows_of(ch), (const bf16*)(F.ws + WS_OBUF), (const bf16*)(F.ws + WS_PART));
#endif
            } SEAM(seq); ++seq;
            if (EN(6) && IN(seq)) {
                SchedMerge S; S.nM = (last ? LROWS : nrows_of(ch)) / 256; S.nN = D / 256; S.G = F.G; S.c = blockIdx.x; S.rep = 1; S.A = (const char*)(F.ws + WS_OBUF); S.B = (const char*)(F.ws + WS_WBR);
                EpiMerge E{(const unsigned char*)(F.ws + WS_GB), hbuf_of(F, ch)};
                RUN(6, (pg8::gemm_phase<EpiMerge, SchedMerge, true, true, 3>(F.ldsl, OW * 2, 1536, S, E, F.wave)));
#if defined(PROBE_NOHOOK)
                { __syncthreads(); EpiMerge E2{(const unsigned char*)(F.ws + WS_GB), (bf16*)(F.ws + WS_PART)}; pg8::gemm_phase<EpiMerge, SchedMerge, true, true, PROBE_NOHOOK>(F.ldsl, OW * 2, 1536, S, E2, F.wave); }
#endif
            } SEAM(seq); ++seq;
            if (EN(7) && IN(seq)) {
                SchedIn S; S.nM = (last ? LROWS : nrows_of(ch)) / 256; S.nN = D / 256; S.G = F.G; S.c = blockIdx.x; S.rep = 1; S.A = (const char*)hbuf_of(F, ch); S.B = (const char*)(F.ws + WS_WOUT);
                EpiOut E{&F, l, ch, dx_of(F, ch)};
                RUN(7, (pg8::gemm_phase<EpiOut, SchedIn, true, true>(F.ldsl, D * 2, D, S, E, F.wave)));
#if defined(PROBE_OUTK)
                { __syncthreads(); EpiOut E2{&F, l, ch, (bf16*)(F.ws + WS_PART)}; pg8::gemm_phase<EpiOut, SchedIn, true, true>(F.ldsl, D * 2, PROBE_OUTK, S, E2, F.wave); }
#endif
            } SEAM(seq); ++seq;
        }
        if (EN(8) && IN(seq)) {
            norm_phase<true>(F, l, 0, last ? LROWS : nrows_of(0)); __syncthreads(); norm_phase<true>(F, l, 1, LROWS);
            if (REP(8)) { __syncthreads(); norm_phase<true>(F, l, 0, last ? LROWS : nrows_of(0), true); __syncthreads(); norm_phase<true>(F, l, 1, LROWS, true); }
        } SEAM(seq); ++seq;
        if (EN(9) && IN(seq)) { topk_phase(F, last); } SEAM(seq); ++seq;
        if (EN(10) && IN(seq)) {
            SchedUp S; S.nM0 = last ? SLT : SLT + SCT; S.nM = S.nM0 + SLT; S.nN = 8; S.G = F.G; S.c = blockIdx.x; S.rep = 1; S.A = (const char*)(F.ws + WS_HBUF); S.B = (const char*)(F.ws + WS_WUP); S.gidx = (const int*)(F.ws + WS_SELTOK);
            EpiUp E{(bf16*)(F.ws + WS_HMID)};
            RUN(10, (pg8::gemm_phase<EpiUp, SchedUp, true, true, 1, true>(F.ldsl, D * 2, D, S, E, F.wave)));
        } SEAM(seq); ++seq;
        if (EN(11) && IN(seq)) {
            SchedDown S; S.nM0 = last ? SLT : SLT + SCT; S.nM = S.nM0 + SLT; S.nN = 4; S.G = F.G; S.c = blockIdx.x; S.rep = 1; S.A = (const char*)(F.ws + WS_HMID); S.B = (const char*)(F.ws + WS_WDN);
            EpiDown E{(bf16*)(F.ws + WS_YBUF), (const float*)(F.ws + WS_GATEV)};
            RUN(11, (pg8::gemm_phase<EpiDown, SchedDown, true, true>(F.ldsl, FF * 2, FF, S, E, F.wave)));
        } SEAM(seq); ++seq;
        if (IN(seq)) {
            if (EN(12)) { if (REP(12)) { combine_phase(F, l, 0, last, true); combine_phase(F, l, 1, last, true); } combine_phase(F, l, 0, last); combine_phase(F, l, 1, last); }
            if (!last && EN(1)) RUN(13, wconv_phase(F, l + 1));
        } SEAM(seq); ++seq;
    }
#undef IN
#undef SEAM
}

extern "C" void kernel_launch(void* const* d_in, const int* in_sizes, int n_in, void* d_out, int out_size, void* d_ws, size_t ws_size, hipStream_t stream) {
    static int grid = 0;
    if (grid == 0) {
        if (n_in != 19 || ws_size < WS_END) { fprintf(stderr, "kernel_launch: unexpected n_in %d / ws %zu (need %zu)\n", n_in, ws_size, (size_t)WS_END); grid = -1; return; }
        int dev = 0, cus = 0;
        if (hipGetDevice(&dev) != hipSuccess || hipDeviceGetAttribute(&cus, hipDeviceAttributeMultiprocessorCount, dev) != hipSuccess) { grid = -1; return; }
        if (hipFuncSetAttribute((const void*)fwd_kernel, hipFuncAttributeMaxDynamicSharedMemorySize, LDS_BYTES) != hipSuccess) { fprintf(stderr, "kernel_launch: hipFuncSetAttribute failed\n"); grid = -1; return; }
        int per_cu = 0;
        if (hipOccupancyMaxActiveBlocksPerMultiprocessor(&per_cu, (const void*)fwd_kernel, NTHR, LDS_BYTES) != hipSuccess || per_cu < 1) fprintf(stderr, "kernel_launch: occupancy query says %d\n", per_cu);
        (void)hipGetLastError();
        grid = cus;
    }
    if (grid < 0) return;
    (void)hipMemsetAsync((char*)d_ws + WS_CTL, 0, CTL_ZERO_BYTES, stream);
    Args a{};
    for (int i = 0; i < 19; ++i) a.in[i] = (const float*)d_in[i];
    a.out = (float*)d_out; a.ws = (unsigned char*)d_ws;
#if MK_ONE_LAUNCH
    a.ph_lo = 0; a.ph_hi = SEQ_TOTAL;
    hipLaunchKernelGGL(fwd_kernel, dim3(grid), dim3(NTHR), LDS_BYTES, stream, a);
#else
    for (int s = 0; s < SEQ_TOTAL; ++s) { a.ph_lo = s; a.ph_hi = s + 1; hipLaunchKernelGGL(fwd_kernel, dim3(grid), dim3(NTHR), LDS_BYTES, stream, a); }
#endif
}
```

```cpp
#include <hip/hip_runtime.h>
#include <cstdio>
#include <cstdint>

#ifndef MK_ONE_LAUNCH
#define MK_ONE_LAUNCH 1
#endif

#define GAS __attribute__((address_space(1)))
#define LAS __attribute__((address_space(3)))
typedef unsigned short bf16;
typedef short bf16x8 __attribute__((ext_vector_type(8)));
typedef float f32x4 __attribute__((ext_vector_type(4)));
typedef float f32x2 __attribute__((ext_vector_type(2)));
typedef unsigned u32x4 __attribute__((ext_vector_type(4)));
typedef unsigned u32x2 __attribute__((ext_vector_type(2)));

constexpr int D = 1024, NB = 32, SEQ = 2048, CTX = 256, DEPTH = 4, INW = 6912, NE = 16, FF = 1024;
constexpr int NCH = 2, BC = NB / NCH;
constexpr int LROWS = BC * SEQ, CTXALL = NB * CTX, RCMAX = LROWS + CTXALL;
constexpr int LT = LROWS / 256, CTT = CTXALL / 256;
__host__ __device__ constexpr int nrows_of(int ch) { return ch == 0 ? RCMAX : LROWS; }
constexpr int CAP_L = 2 * SEQ / NE, CAP_C = 2 * CTX / NE;
constexpr int SLOT_CT0 = BC * NE * CAP_L;
constexpr int NSLOTMAX = SLOT_CT0 + NE * NB * CAP_C;
constexpr int SLT = SLOT_CT0 / 256, SCT = NE * NB * CAP_C / 256;
constexpr float RMS_EPS = 1e-6f;
constexpr int Z_AB = 0, Z_AC = 512, Z_AX = 1024, Z_NQ = 1536, Z_NK = 2048, Z_NV = 2560, Z_SQ = 3072, Z_SK = 3584, Z_SV = 3712, Z_G = 3840;
constexpr int OW = 1536;
constexpr int ZW = Z_G;

constexpr size_t MiB = 1u << 20;
constexpr size_t WS_CTL = 0, CTL_ZERO_BYTES = 1 * MiB;
constexpr size_t WS_MODS = 1 * MiB;
constexpr size_t WS_ROPE = 5 * MiB;
constexpr size_t WS_AFFL = 6 * MiB;
constexpr size_t WS_AFFC = 10 * MiB;
constexpr size_t WS_GATEV = 11 * MiB;
constexpr size_t WS_SELTOK = 12 * MiB;
constexpr size_t WS_XC = 13 * MiB;
constexpr size_t WS_WIN = 45 * MiB;
constexpr size_t WS_WBR = 59 * MiB;
constexpr size_t WS_WOUT = 62 * MiB;
constexpr size_t WS_WUP = 64 * MiB;
constexpr size_t WS_WDN = 128 * MiB;
constexpr size_t WS_HBUF = 160 * MiB;
constexpr size_t WS_HBUF1 = 240 * MiB;
constexpr size_t WS_OBUF = 304 * MiB;
constexpr size_t WS_PART = 424 * MiB;
constexpr size_t WS_Z = 544 * MiB;
constexpr size_t WS_GB = 844 * MiB;
constexpr size_t WS_HMID = WS_OBUF;
constexpr size_t WS_YBUF = WS_OBUF + 288 * MiB;
constexpr size_t WS_DX0 = 1084 * MiB, WS_DX1 = 1164 * MiB;
constexpr size_t WS_TOKSLOT = 1228 * MiB;
constexpr size_t WS_W2 = 1234 * MiB;
constexpr size_t WS_WIN1 = WS_W2, WS_WBR1 = WS_W2 + 14 * MiB, WS_WOUT1 = WS_W2 + 17 * MiB, WS_WDN1 = WS_W2 + 19 * MiB;
constexpr size_t WS_END = 1285 * MiB;
__host__ __device__ __forceinline__ size_t wpar(int l, size_t even, size_t odd) { return (l & 1) ? odd : even; }
static_assert((size_t)RCMAX * ZW * 2 == 300 * MiB && (size_t)LROWS * ZW * 2 == 240 * MiB && (size_t)NSLOTMAX * 1024 * 2 == 160 * MiB && (size_t)RCMAX * 1024 * 2 == 80 * MiB && (size_t)RCMAX * OW * 2 == 120 * MiB
              && (size_t)(RCMAX / 256) * 12 * 131072 == 240 * MiB && WS_YBUF + 288 * MiB <= WS_GB + 240 * MiB && WS_HBUF1 == WS_HBUF + (size_t)RCMAX * 1024 * 2, "ws map");
constexpr int PBT = NSLOTMAX / 256;
constexpr int CW_TMO = 0, CW_DIAG = 64, CW_BAR = 4096;

constexpr int RING_BYTES = 131072, LDSCTL_OFF = RING_BYTES, MISC_OFF = LDSCTL_OFF + 320, LDS_BYTES = 147456;
constexpr int NWAVES = 8, NTHR = 512;

__device__ __forceinline__ unsigned f2bf(float f) { unsigned u = __builtin_bit_cast(unsigned, f); return (u + 0x7fffu + ((u >> 16) & 1u)) >> 16; }
__device__ __forceinline__ unsigned pk2(float lo, float hi) { return f2bf(lo) | (f2bf(hi) << 16); }
__device__ __forceinline__ float bflo(unsigned u) { return __builtin_bit_cast(float, u << 16); }
__device__ __forceinline__ float bfhi(unsigned u) { return __builtin_bit_cast(float, u & 0xffff0000u); }
__device__ __forceinline__ void unpack8(const u32x4 u, float* f) { f[0] = bflo(u.x); f[1] = bfhi(u.x); f[2] = bflo(u.y); f[3] = bfhi(u.y); f[4] = bflo(u.z); f[5] = bfhi(u.z); f[6] = bflo(u.w); f[7] = bfhi(u.w); }
__device__ __forceinline__ float wave_sum(float v) {
#pragma unroll
    for (int o = 1; o < 64; o <<= 1) v += __shfl_xor(v, o);
    return v;
}
__device__ __forceinline__ float sigmoidf_(float x) { return __builtin_amdgcn_rcpf(1.0f + __builtin_amdgcn_exp2f(-1.4426950408889634f * x)); }
__device__ __forceinline__ int launder(int v) { asm volatile("" : "+v"(v)); return v; }
__device__ __forceinline__ int lane_id() { int l; asm volatile("v_mbcnt_lo_u32_b32 %0, -1, 0\n\tv_mbcnt_hi_u32_b32 %0, -1, %0" : "=v"(l)); return l; }
#define LDS_WAIT() asm volatile("s_waitcnt lgkmcnt(0)" ::: "memory")
#define VM_WAIT() asm volatile("s_waitcnt vmcnt(0)" ::: "memory")

namespace pg8 {
constexpr int BM = 256, BK = 64, HALF = 128, HTB = HALF * BK * 2, STAGE_BYTES = 8 * HTB, NXCD = 8, WGM = 8;
__host__ __device__ __forceinline__ int lds_byte(int r, int c) { const int st = (r >> 4) * 2 + (c >> 5), rr = r & 15, cc = c & 31, ob = rr * 64 + cc * 2; return st * 1024 + (ob ^ (((ob >> 9) & 1) << 5)); }
__host__ __device__ __forceinline__ void stage_rc(int b, int& R, int& C) { const int st = b / 1024, sb = b % 1024, swz = sb ^ (((sb >> 9) & 1) << 5); R = (st >> 1) * 16 + swz / 64; C = (st & 1) * 32 + (swz % 64) / 2; }
__host__ __device__ __forceinline__ int perm32(int rho) { const int n = rho >> 4, i = rho & 15; return 8 * (i >> 2) + 4 * n + (i & 3); }

struct Unit { int pm, pn, aux, pad; const char* A; const char* B; };

__device__ __forceinline__ bool tile_of(long L, int nM, int nN, int& pm, int& pn) {
    const int nwg = nM * nN; if (L >= nwg) return false;
    int wgid = (int)L; { const int q = nwg / NXCD, r = nwg % NXCD, xcd = wgid % NXCD, off = wgid / NXCD; wgid = (xcd < r ? xcd * (q + 1) : r * (q + 1) + (xcd - r) * q) + off; }
    const int nig = WGM * nN, gid = wgid / nig, fm = gid * WGM, gsz = (nM - fm) < WGM ? (nM - fm) : WGM;
    pm = fm + ((wgid % nig) % gsz); pn = (wgid % nig) / gsz; return true;
}

__device__ __forceinline__ unsigned cvt_pk_bf16(float lo, float hi) { unsigned r; asm volatile("v_cvt_pk_bf16_f32 %0, %1, %2" : "=v"(r) : "v"(lo), "v"(hi)); return r; }

template <class Epi, class Sched, bool ALIGN_EPI, bool SP2, int NSEG = 1, bool GATHER = false>
__device__ __forceinline__ void gemm_phase(LAS unsigned char* lds, const int lda_bytes, const int K, const Sched& S, const Epi& E, const int wid_in) {
    int wid = wid_in; asm volatile("" : "+s"(wid));
    int lane_ = lane_id(); asm volatile("" : "+v"(lane_));
    const int lane = lane_, tid = wid * 64 + lane, wr = wid >> 2, wc = wid & 3, fr = lane & 15, fq = lane >> 4;
    const int nt = K / BK;
    unsigned voffA[2], voffB[2]; int gR[2], gC[2];
#pragma unroll
    for (int i = 0; i < 2; ++i) { int R, C; stage_rc(tid * 16 + i * 8192, R, C); const int Rb = Epi::PERM ? ((R & ~31) + perm32(R & 31)) : R; gR[i] = R; gC[i] = C * 2;
        voffA[i] = (unsigned)(R * lda_bytes + C * 2); voffB[i] = (unsigned)(Rb * K + C) * 2u; }
    unsigned offc[2][2], offn[2][2]; int rawn[2][2];
    const size_t kstep = (size_t)(BK * 2);
    const size_t hstepA = (size_t)HALF * lda_bytes, hstepB = (size_t)HALF * K * 2;
    const unsigned ldsw = (unsigned)wid * 1024u;
    const int aoff = lds_byte(wr * 64 + fr, fq * 8), boff = lds_byte(wc * 32 + fr, fq * 8);
#define PG8_SA(b, h) (((b) * 2 + (h)) * HTB)
#define PG8_SB(b, h) ((4 + (b) * 2 + (h)) * HTB)
#define PG8_STAGE(bufoff, gbase, voff) do { _Pragma("unroll") for (int _i = 0; _i < 2; ++_i) \
        __builtin_amdgcn_global_load_lds((const unsigned*)((const char*)(gbase) + (voff)[_i]), (LAS unsigned*)(lds + (bufoff) + ldsw + _i * 8192), 16, 0, 0); } while (0)
#define PG8_STAGE_A(bufoff, kbase, h, nx) do { if constexpr (GATHER) { unsigned vs_[2]; vs_[0] = (nx) ? offn[h][0] : offc[h][0]; vs_[1] = (nx) ? offn[h][1] : offc[h][1]; PG8_STAGE(bufoff, (kbase), vs_); } \
        else { PG8_STAGE(bufoff, (kbase) + ((h) ? hstepA : (size_t)0), voffA); } } while (0)
#define PG8_LDA(dst, b, h) do { _Pragma("unroll") for (int m = 0; m < 4; ++m) _Pragma("unroll") for (int k = 0; k < 2; ++k) dst[m][k] = *(const LAS bf16x8*)(lds + PG8_SA(b, h) + aoff + m * 2048 + k * 1024); } while (0)
#define PG8_LDB(dst, b, h) do { _Pragma("unroll") for (int n = 0; n < 2; ++n) _Pragma("unroll") for (int k = 0; k < 2; ++k) dst[n][k] = *(const LAS bf16x8*)(lds + PG8_SB(b, h) + boff + n * 2048 + k * 1024); } while (0)
#define PG8_MMA(ai, bj, At, Bt) do { __builtin_amdgcn_s_setprio(1); _Pragma("unroll") for (int m = 0; m < 4; ++m) _Pragma("unroll") for (int n = 0; n < 2; ++n) _Pragma("unroll") for (int k = 0; k < 2; ++k) \
        acc[ai][bj][m][n] = __builtin_amdgcn_mfma_f32_16x16x32_bf16(Bt[n][k], At[m][k], acc[ai][bj][m][n], 0, 0, 0); __builtin_amdgcn_s_setprio(0); } while (0)
#define PG8_WAIT_V(n) asm volatile("s_waitcnt vmcnt(" #n ")" ::: "memory")
#define PG8_WAIT_L(n) asm volatile("s_waitcnt lgkmcnt(" #n ")" ::: "memory")
#define PG8_BAR __builtin_amdgcn_s_barrier()
#define PG8_SCHED __builtin_amdgcn_sched_barrier(0)
    Unit cur, nxt; int ui = 0;
    if (!S.next(0, cur)) return;
    f32x4 acc[2][2][4][2];
#pragma unroll
    for (int a = 0; a < 2; ++a)
#pragma unroll
        for (int b = 0; b < 2; ++b)
#pragma unroll
            for (int m = 0; m < 4; ++m)
#pragma unroll
                for (int n = 0; n < 2; ++n) acc[a][b][m][n] = (f32x4){0.f, 0.f, 0.f, 0.f};
    bf16x8 At[4][2], B0[2][2], B1[2][2];
    const char* cA = cur.A; const char* cB = cur.B;
    if constexpr (GATHER) {
#pragma unroll
        for (int h = 0; h < 2; ++h)
#pragma unroll
            for (int i = 0; i < 2; ++i) { offc[h][i] = (unsigned)S.gidx[cur.aux * 256 + h * 128 + gR[i]] * (unsigned)lda_bytes + (unsigned)gC[i]; offn[h][i] = offc[h][i]; }
    }
    if constexpr (SP2) {
        PG8_STAGE(PG8_SB(0, 0), cB, voffB); PG8_STAGE(PG8_SB(0, 1), cB + hstepB, voffB); PG8_STAGE_A(PG8_SA(0, 0), cA, 0, false); PG8_STAGE_A(PG8_SA(0, 1), cA, 1, false);
        if (wr == 1) PG8_BAR;
        PG8_WAIT_V(2); PG8_BAR;
        PG8_STAGE(PG8_SB(1, 0), cB + kstep, voffB); PG8_STAGE_A(PG8_SA(1, 0), cA + kstep, 0, false); PG8_STAGE(PG8_SB(1, 1), cB + hstepB + kstep, voffB);
        PG8_WAIT_V(6); PG8_BAR;
    } else {
        static_assert(SP2 || !GATHER, "GATHER is implemented for the SP2 loop only");
        PG8_STAGE(PG8_SB(0, 0), cB, voffB); PG8_STAGE(PG8_SA(0, 0), cA, voffA); PG8_STAGE(PG8_SB(0, 1), cB + hstepB, voffB); PG8_STAGE(PG8_SA(0, 1), cA + hstepA, voffA);
        if (wr == 1) PG8_BAR;
        PG8_WAIT_V(4); PG8_BAR;
        PG8_STAGE(PG8_SB(1, 0), cB + kstep, voffB); PG8_STAGE(PG8_SA(1, 0), cA + kstep, voffA); PG8_STAGE(PG8_SB(1, 1), cB + hstepB + kstep, voffB);
        PG8_WAIT_V(6); PG8_BAR;
    }
    for (;;) {
        const bool has_next = S.next(ui + 1, nxt);
        const char* nA = has_next ? nxt.A : cA; const char* nB = has_next ? nxt.B : cB;
        if constexpr (GATHER) {
            const int na_ = has_next ? nxt.aux : cur.aux;
#pragma unroll
            for (int h = 0; h < 2; ++h)
#pragma unroll
                for (int i = 0; i < 2; ++i) rawn[h][i] = S.gidx[na_ * 256 + h * 128 + gR[i]]; }
        for (int t = 0; t < nt; t += 2) {
            const bool last = (t == nt - 2);
            const char* a1 = cA + (size_t)(t + 1) * kstep;
            const char* a2 = last ? nA : cA + (size_t)(t + 2) * kstep; const char* b2 = last ? nB : cB + (size_t)(t + 2) * kstep;
            const char* a3 = a2 + kstep; const char* b3 = b2 + kstep;
            if constexpr (GATHER) { if (last && has_next) {
#pragma unroll
                for (int h = 0; h < 2; ++h)
#pragma unroll
                    for (int i = 0; i < 2; ++i) { int rw_ = rawn[h][i]; asm volatile("" : "+v"(rw_));
                        offn[h][i] = (unsigned)rw_ * (unsigned)lda_bytes + (unsigned)gC[i]; } } }
            if constexpr (NSEG > 1) { const int tseg = nt / NSEG; if (t > 0 && (t % tseg) == 0) E.mid(acc, cur, t / tseg, wr, wc, fr, fq); }
            if constexpr (SP2) {
            PG8_LDB(B0, 0, 0); PG8_LDB(B1, 0, 1); PG8_SCHED; PG8_LDA(At, 0, 0); PG8_STAGE_A(PG8_SA(1, 1), a1, 1, false);
            PG8_WAIT_V(8); PG8_WAIT_L(0); PG8_BAR; PG8_MMA(0, 0, At, B0); PG8_MMA(0, 1, At, B1); PG8_BAR; PG8_SCHED;
            PG8_LDA(At, 0, 1); PG8_STAGE(PG8_SB(0, 0), b2, voffB); PG8_STAGE(PG8_SB(0, 1), b2 + hstepB, voffB); PG8_STAGE_A(PG8_SA(0, 0), a2, 0, last);
            PG8_WAIT_V(8); PG8_WAIT_L(0); PG8_BAR; PG8_MMA(1, 0, At, B0); PG8_MMA(1, 1, At, B1); PG8_BAR; PG8_SCHED;
            PG8_LDB(B0, 1, 0); PG8_LDB(B1, 1, 1); PG8_SCHED; PG8_LDA(At, 1, 0); PG8_STAGE_A(PG8_SA(0, 1), a2, 1, last);
            PG8_WAIT_V(8); PG8_WAIT_L(0); PG8_BAR; PG8_MMA(0, 0, At, B0); PG8_MMA(0, 1, At, B1); PG8_BAR; PG8_SCHED;
            PG8_LDA(At, 1, 1); PG8_STAGE(PG8_SB(1, 0), b3, voffB); PG8_STAGE(PG8_SB(1, 1), b3 + hstepB, voffB); PG8_STAGE_A(PG8_SA(1, 0), a3, 0, last);
            PG8_WAIT_V(8); PG8_WAIT_L(0); PG8_BAR; PG8_MMA(1, 0, At, B0); PG8_MMA(1, 1, At, B1); PG8_BAR; PG8_SCHED;
            } else {
            PG8_LDB(B0, 0, 0); PG8_SCHED; PG8_LDA(At, 0, 0); PG8_STAGE(PG8_SA(1, 1), a1 + hstepA, voffA);
            PG8_WAIT_L(8); PG8_BAR; PG8_WAIT_L(0); PG8_MMA(0, 0, At, B0); PG8_BAR; PG8_SCHED;
            PG8_LDB(B1, 0, 1); PG8_STAGE(PG8_SB(0, 0), b2, voffB);
            PG8_BAR; PG8_WAIT_L(0); PG8_MMA(0, 1, At, B1); PG8_BAR;
            PG8_LDA(At, 0, 1); PG8_STAGE(PG8_SA(0, 0), a2, voffA);
            PG8_BAR; PG8_WAIT_L(0); PG8_MMA(1, 0, At, B0); PG8_BAR; PG8_SCHED;
            PG8_STAGE(PG8_SB(0, 1), b2 + hstepB, voffB);
            PG8_WAIT_V(6); PG8_BAR; PG8_MMA(1, 1, At, B1); PG8_BAR;
            PG8_LDB(B0, 1, 0); PG8_SCHED; PG8_LDA(At, 1, 0); PG8_STAGE(PG8_SA(0, 1), a2 + hstepA, voffA);
            PG8_WAIT_L(8); PG8_BAR; PG8_WAIT_L(0); PG8_MMA(0, 0, At, B0); PG8_BAR; PG8_SCHED;
            PG8_LDB(B1, 1, 1); PG8_STAGE(PG8_SB(1, 0), b3, voffB);
            PG8_BAR; PG8_WAIT_L(0); PG8_MMA(0, 1, At, B1); PG8_BAR;
            PG8_LDA(At, 1, 1); PG8_STAGE(PG8_SA(1, 0), a3, voffA);
            PG8_BAR; PG8_WAIT_L(0); PG8_MMA(1, 0, At, B0); PG8_BAR; PG8_SCHED;
            PG8_STAGE(PG8_SB(1, 1), b3 + hstepB, voffB);
            PG8_WAIT_V(6); PG8_BAR; PG8_MMA(1, 1, At, B1); PG8_BAR;
            }
        }
        if constexpr (ALIGN_EPI) { if (wr == 0) PG8_BAR; }
        E(acc, cur, wr, wc, fr, fq);
        if (!has_next) break;
#pragma unroll
        for (int a = 0; a < 2; ++a)
#pragma unroll
            for (int b = 0; b < 2; ++b)
#pragma unroll
                for (int m = 0; m < 4; ++m)
#pragma unroll
                    for (int n = 0; n < 2; ++n) acc[a][b][m][n] = (f32x4){0.f, 0.f, 0.f, 0.f};
        cur = nxt; cA = nA; cB = nB; ++ui;
        if constexpr (GATHER) {
#pragma unroll
            for (int h = 0; h < 2; ++h)
#pragma unroll
                for (int i = 0; i < 2; ++i) offc[h][i] = offn[h][i]; }
        if constexpr (ALIGN_EPI) { if (wr == 1) PG8_BAR; }
    }
    PG8_WAIT_V(0);
    if constexpr (!ALIGN_EPI) { if (wr == 0) PG8_BAR; }
    PG8_BAR;
#undef PG8_SA
#undef PG8_SB
#undef PG8_STAGE
#undef PG8_STAGE_A
#undef PG8_LDA
#undef PG8_LDB
#undef PG8_MMA
#undef PG8_WAIT_V
#undef PG8_WAIT_L
#undef PG8_BAR
#undef PG8_SCHED
}
}

#define XB_TMO      128
#define XB_XCNT(j)  (256  + 64 * (j))
#define XB_XSUB(j)  (1280 + 64 * (j))
#define XB_XGEN(j)  (2304 + 64 * (j))
#define XB_TOP      3328
#define XB_TOPGEN   3392
#define XCD_BAR_WORDS 3456
#define XB_SPIN_CAP (1u << 22)
__device__ __forceinline__ unsigned xb_ld(unsigned* p)              { return __hip_atomic_load(p, __ATOMIC_RELAXED, __HIP_MEMORY_SCOPE_AGENT); }
__device__ __forceinline__ unsigned xb_add(unsigned* p, unsigned v) { return __hip_atomic_fetch_add(p, v, __ATOMIC_RELAXED, __HIP_MEMORY_SCOPE_AGENT); }
__device__ __forceinline__ unsigned xb_xcc_id() { return (unsigned)__builtin_amdgcn_s_getreg((3 << 11) | 20) & 0xFu; }
#define XB_SPIN(cond, bar) do { unsigned _sp = 0; while (cond) { __builtin_amdgcn_s_sleep(1); \
    if ((++_sp & 255u) == 0u) { if (xb_ld(&(bar)[XB_TMO])) break; if (_sp > XB_SPIN_CAP) { atomicAdd(&(bar)[XB_TMO], 1u); break; } } } } while (0)
struct XcdBarrier { unsigned* bar; unsigned x; volatile LAS unsigned* st; };
__device__ __forceinline__ XcdBarrier xcd_barrier_post(unsigned* bar, volatile LAS unsigned* st) {
    XcdBarrier b; b.bar = bar; b.x = xb_xcc_id(); b.st = st;
    if (threadIdx.x == 0) (void)xb_add(&bar[XB_XCNT(b.x)], 1u);
    return b;
}
__device__ __forceinline__ void xcd_barrier_complete(unsigned* bar, unsigned x, unsigned& nloc, unsigned& nx) {
    const unsigned G = gridDim.x * gridDim.y * gridDim.z;
    unsigned sum, cnt, mine, sp = 0u;
    for (;;) {
        sum = 0u; cnt = 0u; mine = 0u;
#pragma unroll
        for (unsigned j = 0; j < 16; ++j) { const unsigned c = xb_ld(&bar[XB_XCNT(j)]); sum += c; cnt += (c > 0u) ? 1u : 0u; mine = (j == x) ? c : mine; }
        if (sum == G) break;
        __builtin_amdgcn_s_sleep(1);
        if ((++sp & 255u) == 0u) { if (xb_ld(&bar[XB_TMO])) break; if (sp > XB_SPIN_CAP) { atomicAdd(&bar[XB_TMO], 1u); break; } }
    }
    nloc = mine > 0u ? mine : 1u; nx = cnt > 0u ? cnt : 1u;
}
__device__ __forceinline__ void xcd_barrier(const XcdBarrier& b, const int wave, const bool cnt_wait = false) {
    asm volatile("s_waitcnt vmcnt(0)" ::: "memory");
    __syncthreads();
    if (wave == 0 && lane_id() == 0) {
#if defined(PROBE_BW)
        const unsigned long long bw_t0 = __builtin_amdgcn_s_memrealtime();
#endif
        unsigned* bar = b.bar; asm volatile("" : "+s"(bar)); unsigned bx = b.x; asm volatile("" : "+s"(bx));
        __builtin_amdgcn_s_waitcnt(0);
        unsigned nloc = b.st[0], nx = b.st[1];
        if (nloc == 0u) { xcd_barrier_complete(bar, bx, nloc, nx); b.st[0] = nloc; b.st[1] = nx; }
        const unsigned old = xb_add(&bar[XB_XSUB(bx)], 1u);
        const unsigned gen = old / nloc;
        if (old + 1u == (gen + 1u) * nloc) {
            __builtin_amdgcn_fence(__ATOMIC_RELEASE, "agent");
            asm volatile("s_waitcnt vmcnt(0)" ::: "memory");
            const unsigned og = xb_add(&bar[XB_TOP], 1u);
            const unsigned tg = og / nx;
            if (og + 1u == (tg + 1u) * nx) xb_add(&bar[XB_TOPGEN], 1u);
            else XB_SPIN(xb_ld(&bar[XB_TOPGEN]) == tg, bar);
            __builtin_amdgcn_fence(__ATOMIC_ACQUIRE, "agent");
            xb_add(&bar[XB_XGEN(bx)], 1u);
            asm volatile("s_waitcnt vmcnt(0)" ::: "memory");
        } else {
            XB_SPIN(xb_ld(&bar[XB_XGEN(bx)]) == gen, bar);
            __builtin_amdgcn_fence(__ATOMIC_ACQUIRE, "agent");
            asm volatile("s_waitcnt vmcnt(0)" ::: "memory");
        }
#if defined(PROBE_BW)
        if (cnt_wait) b.st[2] += (unsigned)(__builtin_amdgcn_s_memrealtime() - bw_t0);
#endif
    }
    __syncthreads();
}

struct Args {
    const float* in[19];
    float* out; unsigned char* ws;
    int ph_lo, ph_hi;
};
enum { I_X = 0, I_C, I_CTX, I_CCTX, I_WADA, I_BADA, I_GMIX, I_WIN, I_CONVW, I_RPB, I_SINK, I_WBR, I_WOUT, I_GFFN, I_WROUTER, I_WG, I_WU, I_WD, I_GFINAL };

struct Frame {
    unsigned char* lds;
    LAS unsigned char* ldsl;
    unsigned char* ws;
    int wave, vcu, G;
    float* out;
};

constexpr int PTR_OFF = MISC_OFF + 128;
__device__ __forceinline__ const float* inp(const Frame& F, int i) {
    const u32x2 v = *(const LAS u32x2*)(F.ldsl + PTR_OFF + 8 * i);
    const unsigned lo = __builtin_amdgcn_readfirstlane(v.x), hi = __builtin_amdgcn_readfirstlane(v.y);
    typedef const float __attribute__((address_space(1)))* gptr_t;
    return (const float*)(gptr_t)(((unsigned long long)hi << 32) | lo);
}
__device__ __forceinline__ bf16* xbrow(const Frame& F, int ch, int cr) {
    return cr < LROWS ? (bf16*)(F.out + ((size_t)ch * LROWS + cr) * D) : (bf16*)(F.ws + WS_XC) + (size_t)(cr - LROWS) * D;
}
__device__ __forceinline__ const float* xin_row(const Frame& F, int ch, int cr) {
    return cr < LROWS ? inp(F, I_X) + ((size_t)ch * LROWS + cr) * D : inp(F, I_CTX) + (size_t)(cr - LROWS) * D;
}
__device__ __forceinline__ int mv_of(int ch, int cr) { return cr < LROWS ? ch * BC + cr / SEQ : NB; }
__device__ __forceinline__ const float* mod_ptr(const Frame& F, int l, int mv, int which) { return (const float*)(F.ws + WS_MODS) + ((size_t)(l * 33 + mv) * 6 + which) * D; }

__device__ __forceinline__ bf16* hbuf_of(const Frame& F, int ch) { return (bf16*)(F.ws + (ch == 0 ? WS_HBUF : WS_HBUF1)); }
__device__ __forceinline__ float* affl_of(const Frame& F, int ch) { return (float*)(F.ws + WS_AFFL) + (size_t)ch * BC * NE * SEQ; }
__device__ __forceinline__ int* tokslot_of(const Frame& F, int ch) { return (int*)(F.ws + WS_TOKSLOT) + (size_t)ch * RCMAX * NE; }
__device__ __forceinline__ void mods_phase(Frame& F) {
    const int lane = launder(lane_id()), tid = F.wave * 64 + lane; (void)tid; (void)lane;
    float* sl = (float*)F.lds;
    const float* c = inp(F, I_C); const float* cc = inp(F, I_CCTX);
    for (int item = F.vcu; item < DEPTH * 96; item += F.G) {
        const int l = item / 96, jb = item % 96, j = jb * 64 + lane;
        const float* W = inp(F, I_WADA) + (size_t)l * D * 6144;
        float acc[33];
#pragma unroll
        for (int m = 0; m < 33; ++m) acc[m] = 0.f;
        for (int kh = 0; kh < 2; ++kh) {
            __syncthreads();
            for (int i = tid; i < 512 * 33; i += NTHR) { const int k = i % 512, m = i / 512; const float v = (m < 32) ? c[(size_t)m * D + kh * 512 + k] : cc[kh * 512 + k]; sl[k * 36 + m] = v * sigmoidf_(v); }
            __syncthreads();
            for (int kk0 = 0; kk0 < 64; kk0 += 8) {
                float w8[8];
#pragma unroll
                for (int u8 = 0; u8 < 8; ++u8) w8[u8] = W[(size_t)(kh * 512 + F.wave * 64 + kk0 + u8) * 6144 + j];
#pragma unroll
                for (int u8 = 0; u8 < 8; ++u8) { const int k = F.wave * 64 + kk0 + u8; const float w = w8[u8];
                    const f32x4* s4 = (const f32x4*)(sl + k * 36);
#pragma unroll
                    for (int q = 0; q < 8; ++q) { const f32x4 s = s4[q]; acc[4 * q] += s.x * w; acc[4 * q + 1] += s.y * w; acc[4 * q + 2] += s.z * w; acc[4 * q + 3] += s.w * w; }
                    acc[32] += sl[k * 36 + 32] * w; }
            }
        }
        __syncthreads();
        float* rd = (float*)F.lds;
#pragma unroll
        for (int m = 0; m < 33; ++m) rd[(F.wave * 33 + m) * 64 + lane] = acc[m];
        __syncthreads();
        for (int i = tid; i < 33 * 64; i += NTHR) { const int m = i / 64, jj = i % 64; float s = 0.f;
#pragma unroll
            for (int w = 0; w < 8; ++w) s += rd[(w * 33 + m) * 64 + jj];
            const int col = jb * 64 + jj;
            ((float*)(F.ws + WS_MODS))[(size_t)(l * 33 + m) * 6144 + col] = s + inp(F, I_BADA)[(size_t)l * 6144 + col]; }
    }
    __syncthreads();
    f32x2* tab = (f32x2*)(F.ws + WS_ROPE);
    for (int i = F.vcu * NTHR + tid; i < SEQ * 32; i += F.G * NTHR) {
        const int pos = i >> 5, fi = i & 31; const float inv = powf(10000.0f, -(float)(fi & 15) / 16.0f);
        const float ang = (fi < 16 ? (float)(pos / 64) : (float)(pos % 64)) * inv;
        tab[i] = (f32x2){cosf(ang), sinf(ang)};
    }
}

__device__ __forceinline__ void transpose_item(const float* W, int K, int N, bf16* WT, int k0, int n0, int orow0, float* scr, int lane, int ldo = 0, int kofs = 0) {
    if (ldo == 0) ldo = K;
    f32x4 v[8];
#pragma unroll
    for (int i = 0; i < 8; ++i) v[i] = *(const f32x4*)(W + (size_t)(k0 + 8 * i + (lane >> 3)) * N + n0 + 4 * (lane & 7));
#pragma unroll
    for (int i = 0; i < 8; ++i) *(f32x4*)(scr + (8 * i + (lane >> 3)) * 36 + 4 * (lane & 7)) = v[i];
    LDS_WAIT(); asm volatile("" ::: "memory");
    const int c = lane & 7;
#pragma unroll
    for (int j = 0; j < 4; ++j) { const int n = (lane >> 3) + 8 * j; const float* s = scr + (8 * c) * 36 + n;
        u32x4 o; o.x = pk2(s[0 * 36], s[1 * 36]); o.y = pk2(s[2 * 36], s[3 * 36]); o.z = pk2(s[4 * 36], s[5 * 36]); o.w = pk2(s[6 * 36], s[7 * 36]);
        *(u32x4*)(WT + (size_t)(orow0 + n) * ldo + kofs + k0 + 8 * c) = o; }
    LDS_WAIT(); asm volatile("" ::: "memory");
}
constexpr int I_IN = 16 * 216, I_BR = 3 * 8 * 32, I_OUT = 16 * 32, I_EX = 16 * 16 * 32;
constexpr int NITEMS = I_IN + I_BR + I_OUT + 3 * I_EX;
constexpr int IT_UP0 = I_IN + I_BR + I_OUT, IT_DN0 = IT_UP0 + 2 * I_EX;
__device__ __forceinline__ void wconv_phase(Frame& F, int l, int it_lo, int it_hi, int widx, int nw) {
    const int lane = launder(lane_id()), tid = F.wave * 64 + lane; (void)tid; (void)lane;
    float* scr = (float*)(F.lds + F.wave * 16384);
    const int gw = widx * NWAVES + F.wave, NGW = nw * NWAVES;
    for (int it = it_lo + gw; it < it_hi; it += NGW) {
        int r = it;
        if (r < I_IN) { const int kb = r / 216, nb = r % 216; transpose_item(inp(F, I_WIN) + (size_t)l * D * INW, D, INW, (bf16*)(F.ws + wpar(l, WS_WIN, WS_WIN1)), kb * 64, nb * 32, nb * 32, scr, lane); continue; } r -= I_IN;
        if (r < I_BR) { const int br = r / 256, q = r % 256, kb = q / 32, nb = q % 32;
            transpose_item(inp(F, I_WBR) + ((size_t)l * 3 + br) * 512 * D, 512, D, (bf16*)(F.ws + wpar(l, WS_WBR, WS_WBR1)), kb * 64, nb * 32, nb * 32, scr, lane, 1536, br * 512); continue; } r -= I_BR;
        if (r < I_OUT) { const int kb = r / 32, nb = r % 32; transpose_item(inp(F, I_WOUT) + (size_t)l * D * D, D, D, (bf16*)(F.ws + wpar(l, WS_WOUT, WS_WOUT1)), kb * 64, nb * 32, nb * 32, scr, lane); continue; } r -= I_OUT;
        if (r < 2 * I_EX) { const int s = r / I_EX, q = r % I_EX, e = q / 512, q2 = q % 512, kb = q2 / 32, nb = q2 % 32, n0 = nb * 32;
            const float* W = inp(F, s ? I_WU : I_WG) + ((size_t)l * NE + e) * D * FF;
            transpose_item(W, D, FF, (bf16*)(F.ws + WS_WUP) + (size_t)e * 2048 * D, kb * 64, n0, 256 * (n0 / 128) + 128 * s + (n0 % 128), scr, lane); continue; } r -= 2 * I_EX;
        { const int e = r / 512, q2 = r % 512, kb = q2 / 32, nb = q2 % 32;
            transpose_item(inp(F, I_WD) + ((size_t)l * NE + e) * FF * D, FF, D, (bf16*)(F.ws + wpar(l, WS_WDN, WS_WDN1)) + (size_t)e * D * FF, kb * 64, nb * 32, nb * 32, scr, lane); }
    }
}

__device__ __forceinline__ float xsel(bool c, float a, float b) { return c ? a : b; }
template <bool ROUTER>
__device__ __forceinline__ void norm_phase(Frame& F, int l, int ch, int nrows, bool dry = false) {
    const int lane = launder(lane_id()), tid = F.wave * 64 + lane; (void)tid; (void)lane;
    const int gw = F.vcu * NWAVES + F.wave, NGW = F.G * NWAVES;
    float* wr_l = (float*)F.lds;
    if (ROUTER) {
        const float* wr = inp(F, I_WROUTER) + (size_t)l * D * NE;
        for (int i = tid; i < D * NE; i += NTHR) { const int d = i >> 4, e = i & 15; wr_l[e * D + d] = wr[i]; }
        __syncthreads();
    }
    const float* gv = inp(F, ROUTER ? I_GFFN : I_GMIX) + (size_t)l * D;
    bf16* hb = dry ? (bf16*)(F.ws + WS_OBUF + 160 * MiB) : (bf16*)(F.ws + (ch == 0 ? WS_HBUF : WS_HBUF1));
    f32x4 nx[2][4]; u32x2 nb[2][4];
#define NP_LOAD(c0) do { _Pragma("unroll") for (int rr_ = 0; rr_ < 2; ++rr_) { \
        if (ROUTER) { const bf16* xb_ = xbrow(F, ch, (c0) + rr_); \
            _Pragma("unroll") for (int j_ = 0; j_ < 4; ++j_) nb[rr_][j_] = *(const u32x2*)(xb_ + lane * 4 + 256 * j_); } \
        else { const float* xr_ = xin_row(F, ch, (c0) + rr_); \
            _Pragma("unroll") for (int j_ = 0; j_ < 4; ++j_) nx[rr_][j_] = *(const f32x4*)(xr_ + lane * 4 + 256 * j_); } } } while (0)
    const int rpw = (((nrows + NGW - 1) / NGW) + 1) & ~1, rbeg = gw * rpw, rend = (rbeg + rpw < nrows) ? rbeg + rpw : nrows;
    f32x4 gq[4], shq[4], scq[4]; int cmv = -1;
#pragma unroll
    for (int j = 0; j < 4; ++j) gq[j] = *(const f32x4*)(gv + lane * 4 + 256 * j);
    if (rbeg < rend) NP_LOAD(rbeg);
    for (int cr0 = rbeg; cr0 < rend; cr0 += 2) {
        f32x4 v[2][4];
#pragma unroll
        for (int rr = 0; rr < 2; ++rr)
#pragma unroll
            for (int j = 0; j < 4; ++j) {
                if (ROUTER) { const u32x2 t = nb[rr][j]; v[rr][j].x = bflo(t.x); v[rr][j].y = bfhi(t.x); v[rr][j].z = bflo(t.y); v[rr][j].w = bfhi(t.y); }
                else v[rr][j] = nx[rr][j]; }
        if (cr0 + 2 < rend) NP_LOAD(cr0 + 2);
#pragma unroll
        for (int rr = 0; rr < 2; ++rr) {
            const int cr = cr0 + rr;
            const int mv = mv_of(ch, cr);
            if (mv != cmv) { cmv = mv; const float* sh = mod_ptr(F, l, mv, ROUTER ? 3 : 0); const float* sc = mod_ptr(F, l, mv, ROUTER ? 4 : 1);
#pragma unroll
                for (int j = 0; j < 4; ++j) { shq[j] = *(const f32x4*)(sh + lane * 4 + 256 * j); scq[j] = *(const f32x4*)(sc + lane * 4 + 256 * j); } }
            float ss = 0.f;
#pragma unroll
            for (int j = 0; j < 4; ++j) {
                if (!ROUTER) { u32x2 o; o.x = pk2(v[rr][j].x, v[rr][j].y); o.y = pk2(v[rr][j].z, v[rr][j].w); *(u32x2*)(xbrow(F, ch, cr) + lane * 4 + 256 * j) = o; }
                ss += (v[rr][j].x * v[rr][j].x + v[rr][j].y * v[rr][j].y) + (v[rr][j].z * v[rr][j].z + v[rr][j].w * v[rr][j].w); }
            const float rstd = 1.0f / sqrtf(wave_sum(ss) * (1.0f / D) + RMS_EPS);
#pragma unroll
            for (int j = 0; j < 4; ++j) {
                v[rr][j] = (v[rr][j] * rstd * gq[j]) * (scq[j] + 1.0f) + shq[j];
                u32x2 o; o.x = pk2(v[rr][j].x, v[rr][j].y); o.y = pk2(v[rr][j].z, v[rr][j].w);
                *(u32x2*)(hb + (size_t)cr * D + lane * 4 + 256 * j) = o;
            }
        }
#undef NP_LOAD
        if (ROUTER) {
            const bool b5 = lane & 32, b4 = lane & 16, b3 = lane & 8;
            float lg[2][2];
#pragma unroll
            for (int hf = 0; hf < 2; ++hf) {
                float a[2][8];
#pragma unroll
                for (int e = 0; e < 8; ++e) {
                    f32x4 w[4];
#pragma unroll
                    for (int j = 0; j < 4; ++j) w[j] = *(const f32x4*)(wr_l + (hf * 8 + e) * D + lane * 4 + 256 * j);
#pragma unroll
                    for (int rr = 0; rr < 2; ++rr) { float t = 0.f;
#pragma unroll
                        for (int j = 0; j < 4; ++j) t += (v[rr][j].x * w[j].x + v[rr][j].y * w[j].y) + (v[rr][j].z * w[j].z + v[rr][j].w * w[j].w);
                        a[rr][e] = t; }
                    if (e & 1) __builtin_amdgcn_sched_barrier(0);
                }
#pragma unroll
                for (int rr = 0; rr < 2; ++rr) {
                    float c[4], d2[2];
#pragma unroll
                    for (int i = 0; i < 4; ++i) { const float recv = __shfl_xor(xsel(b5, a[rr][i], a[rr][i + 4]), 32); c[i] = xsel(b5, a[rr][i + 4], a[rr][i]) + recv; }
#pragma unroll
                    for (int i = 0; i < 2; ++i) { const float recv = __shfl_xor(xsel(b4, c[i], c[i + 2]), 16); d2[i] = xsel(b4, c[i + 2], c[i]) + recv; }
                    float t = xsel(b3, d2[1], d2[0]) + __shfl_xor(xsel(b3, d2[0], d2[1]), 8);
                    t += __shfl_xor(t, 4); t += __shfl_xor(t, 2); t += __shfl_xor(t, 1);
                    lg[hf][rr] = t;
                }
                __builtin_amdgcn_sched_barrier(0);
            }
#pragma unroll
            for (int rr = 0; rr < 2; ++rr) {
                float m = fmaxf(lg[0][rr], lg[1][rr]);
#pragma unroll
                for (int o = 8; o < 64; o <<= 1) m = fmaxf(m, __shfl_xor(m, o));
                const float p0 = expf(lg[0][rr] - m), p1 = expf(lg[1][rr] - m); float s = p0 + p1;
#pragma unroll
                for (int o = 8; o < 64; o <<= 1) s += __shfl_xor(s, o);
                const float inv = 1.0f / s;
                const int cr = cr0 + rr, e = lane >> 3;
                if ((lane & 7) < 2 && !dry) {
                    const int ee = (lane & 1) ? e + 8 : e; const float mine = ((lane & 1) ? p1 : p0) * inv;
                    if (cr < LROWS) { const int bl = cr / SEQ, t = cr % SEQ; affl_of(F, ch)[(size_t)(bl * NE + ee) * SEQ + t] = mine; }
                    else { const int j = cr - LROWS, bl = j / CTX, t = j % CTX; ((float*)(F.ws + WS_AFFC))[(size_t)(bl * NE + ee) * CTX + t] = mine; }
                }
            }
        }
    }
}

__device__ __forceinline__ const bf16* zrow(const Frame& F, int cr) { return (const bf16*)(F.ws + WS_Z) + (size_t)cr * ZW; }

__device__ __forceinline__ void conv_phase(Frame& F, int l, int nrows) {
    const int lane = launder(lane_id()), tid = F.wave * 64 + lane; (void)tid; (void)lane;
    const int gw = F.vcu * NWAVES + F.wave, NGW = F.G * NWAVES;
    const float* cw = inp(F, I_CONVW) + (size_t)l * 3 * 512;
    float w[3][8];
#pragma unroll
    for (int k = 0; k < 3; ++k)
#pragma unroll
        for (int j = 0; j < 8; ++j) w[k][j] = cw[k * 512 + lane * 8 + j];
    bf16* ob = (bf16*)(F.ws + WS_OBUF);
    const int rpw = (nrows + NGW - 1) / NGW, rbeg = gw * rpw, rend = (rbeg + rpw < nrows) ? rbeg + rpw : nrows;
    if (rbeg >= rend) return;
#define CV_SEQ(cr_) ((cr_) < LROWS ? (cr_) / SEQ : 1024 + ((cr_) - LROWS) / CTX)
#define CV_LOADP(cr_, P) do { const bf16* zr_ = zrow(F, (cr_)); float c8_[8], x8_[8]; unpack8(*(const u32x4*)(zr_ + Z_AC + lane * 8), c8_); unpack8(*(const u32x4*)(zr_ + Z_AX + lane * 8), x8_); \
        _Pragma("unroll") for (int j_ = 0; j_ < 8; ++j_) (P)[j_] = c8_[j_] * x8_[j_]; } while (0)
    float pp[8], pc[8], pn[8];
#pragma unroll
    for (int j = 0; j < 8; ++j) pp[j] = 0.f;
    if (rbeg > 0 && CV_SEQ(rbeg - 1) == CV_SEQ(rbeg)) CV_LOADP(rbeg - 1, pp);
    CV_LOADP(rbeg, pc);
    for (int cr = rbeg; cr < rend; ++cr) {
        const bool hasn = cr + 1 < nrows, same = hasn && CV_SEQ(cr + 1) == CV_SEQ(cr);
#pragma unroll
        for (int j = 0; j < 8; ++j) pn[j] = 0.f;
        if (hasn) CV_LOADP(cr + 1, pn);
        float b8[8]; unpack8(*(const u32x4*)(zrow(F, cr) + Z_AB + lane * 8), b8);
        float acc[8];
#pragma unroll
        for (int j = 0; j < 8; ++j) acc[j] = w[0][j] * pp[j] + w[1][j] * pc[j] + (same ? w[2][j] * pn[j] : 0.f);
        u32x4 o; o.x = pk2(b8[0] * acc[0], b8[1] * acc[1]); o.y = pk2(b8[2] * acc[2], b8[3] * acc[3]); o.z = pk2(b8[4] * acc[4], b8[5] * acc[5]); o.w = pk2(b8[6] * acc[6], b8[7] * acc[7]);
        *(u32x4*)(ob + (size_t)cr * OW + lane * 8) = o;
#pragma unroll
        for (int j = 0; j < 8; ++j) { pp[j] = same ? pc[j] : 0.f; pc[j] = pn[j]; }
    }
#undef CV_SEQ
#undef CV_LOADP
}

struct NaiveState { unsigned q[32]; float o[64], m, l; };
__device__ __forceinline__ void load64(const bf16* p, float* f) {
#pragma unroll
    for (int i = 0; i < 8; ++i) unpack8(*(const u32x4*)(p + 8 * i), f + 8 * i);
}
__device__ __forceinline__ void rope64(float* x, const f32x2* tabrow) {
#pragma unroll
    for (int i = 0; i < 32; ++i) { const f32x2 cs = tabrow[i]; const float a = x[i], b = x[i + 32]; x[i] = a * cs.x - b * cs.y; x[i + 32] = a * cs.y + b * cs.x; }
}
__device__ __forceinline__ void naive_visit(NaiveState& st, const bf16* kp, const bf16* vp, float bias, bool valid, const f32x2* ropetab) {
    float s = 0.f;
#pragma unroll
    for (int c = 0; c < 4; ++c) {
        float a[8], b[8]; unpack8(*(const u32x4*)(kp + 8 * c), a); unpack8(*(const u32x4*)(kp + 32 + 8 * c), b);
        if (ropetab) {
#pragma unroll
            for (int i = 0; i < 8; ++i) { const f32x2 cs = ropetab[8 * c + i]; const float x1 = a[i], x2 = b[i]; a[i] = x1 * cs.x - x2 * cs.y; b[i] = x1 * cs.y + x2 * cs.x; }
        }
#pragma unroll
        for (int i = 0; i < 8; ++i) s += bflo(st.q[8 * c + i]) * a[i] + bfhi(st.q[8 * c + i]) * b[i];
    }
    s = valid ? s + bias : -1e30f;
    const float mn = fmaxf(st.m, s), alpha = __expf(st.m - mn), p = __expf(s - mn);
    st.m = mn; st.l = st.l * alpha + p;
#pragma unroll
    for (int c = 0; c < 8; ++c) { float v[8]; unpack8(*(const u32x4*)(vp + 8 * c), v);
#pragma unroll
        for (int i = 0; i < 8; ++i) st.o[8 * c + i] = st.o[8 * c + i] * alpha + p * v[i]; }
}
__device__ __forceinline__ void naive_attn_phase(Frame& F, int l, int ch, bool last, bf16* ob) {
    const int lane = launder(lane_id()), tid = F.wave * 64 + lane; (void)tid; (void)lane;
    const int n_lat = LROWS / 64, n_ctx = (last || ch != 0) ? 0 : CTXALL / 64;
    const int nunits = 2 * n_lat + 2 * n_ctx;
    const f32x2* tab = (const f32x2*)(F.ws + WS_ROPE);
    for (int u = F.vcu; u < nunits; u += F.G) {
        int type, blk;
        if (u < n_lat) { type = 0; blk = u; } else if (u < 2 * n_lat) { type = 1; blk = u - n_lat; } else if (u < 2 * n_lat + n_ctx) { type = 2; blk = u - 2 * n_lat; } else { type = 3; blk = u - 2 * n_lat - n_ctx; }
        const int h = F.wave;
        const int cr0 = (type < 2) ? blk * 64 : LROWS + blk * 64, cr = cr0 + lane;
        const int bl = (type < 2) ? ch * BC + cr0 / SEQ : (cr0 - LROWS) / CTX;
        const int t0 = (type < 2) ? cr0 % SEQ : (cr0 - LROWS) % CTX, t = t0 + lane;
        const int ctx0 = LROWS + bl * CTX;
        const bool sw = (type == 0 || type == 3);
        const int hk = sw ? h / 4 : h;
        const int qcol = (sw ? Z_SQ : Z_NQ) + 64 * h, kcol = (sw ? Z_SK : Z_NK) + 64 * hk, vcol = (sw ? Z_SV : Z_NV) + 64 * hk;
        NaiveState st;
        { float qf[64]; load64(zrow(F, cr) + qcol, qf);
          if (type == 0) rope64(qf, tab + (size_t)t * 32);
#pragma unroll
          for (int i = 0; i < 32; ++i) st.q[i] = pk2(qf[i] * 0.125f, qf[i + 32] * 0.125f);
#pragma unroll
          for (int i = 0; i < 64; ++i) st.o[i] = 0.f; }
        if (sw) { st.m = inp(F, I_SINK)[l * 8 + h]; st.l = 1.f; } else { st.m = -1e30f; st.l = 0.f; }
        const int lo = t0 - 128 < 0 ? 0 : t0 - 128, hi = t0 + 63 + 128 > SEQ - 1 ? SEQ - 1 : t0 + 63 + 128;
        const int r = t0 / 64, c = lane; int rs = r - 4; rs = rs < 0 ? 0 : (rs > 24 ? 24 : rs); int cs = c - 8; cs = cs < 0 ? 0 : (cs > 48 ? 48 : cs);
        const float* rpb = inp(F, I_RPB) + ((size_t)l * 8 + h) * 15 * 31;
        const int nloc = type == 0 ? hi - lo + 1 : (type == 1 ? 512 : 0);
#pragma unroll 1
        for (int idx = 0; idx < CTX + nloc; ++idx) {
            const bf16* zr; float bias = 0.f; bool valid = true; const f32x2* rt = nullptr;
            if (idx < CTX) zr = zrow(F, ctx0 + idx);
            else if (type == 0) { const int j = lo + idx - CTX, dlt = t - j; zr = zrow(F, cr0 - t0 + j); valid = dlt <= 128 && dlt >= -128; rt = tab + (size_t)j * 32; }
            else { const int q = idx - CTX, kr = rs + (q >> 6), kc = q & 63; zr = zrow(F, cr0 - t0 + kr * 64 + kc); valid = kc >= cs && kc < cs + 16;
                int dc = kc - c + 15; dc = dc < 0 ? 0 : (dc > 30 ? 30 : dc); bias = rpb[(kr - r + 7) * 31 + dc]; }
            naive_visit(st, zr + kcol, zr + vcol, bias, valid, rt);
        }
        const float inv = 1.0f / st.l;
        bf16* op = ob + (size_t)cr * OW + (sw ? 1024 : 512) + 64 * h;
#pragma unroll
        for (int i = 0; i < 8; ++i) { u32x4 o; o.x = pk2(st.o[8 * i] * inv, st.o[8 * i + 1] * inv); o.y = pk2(st.o[8 * i + 2] * inv, st.o[8 * i + 3] * inv); o.z = pk2(st.o[8 * i + 4] * inv, st.o[8 * i + 5] * inv); o.w = pk2(st.o[8 * i + 6] * inv, st.o[8 * i + 7] * inv);
            *(u32x4*)(op + 8 * i) = o; }
    }
}

typedef short s16x4 __attribute__((ext_vector_type(4)));
typedef float f32x16 __attribute__((ext_vector_type(16)));
typedef __bf16 bf16x2_t __attribute__((ext_vector_type(2)));
__device__ __forceinline__ unsigned cvtpk(float lo, float hi) { const f32x2 v = {lo, hi}; return __builtin_bit_cast(unsigned, __builtin_convertvector(v, bf16x2_t)); }
typedef short v4i16_t __attribute__((ext_vector_type(4)));
__device__ __forceinline__ s16x4 vtr(const LAS unsigned char* p) { return __builtin_bit_cast(s16x4, __builtin_amdgcn_ds_read_tr16_b64_v4i16((LAS v4i16_t*)p)); }
constexpr int AK_RS = 144, AV_RS = 192, AK_BYTES = 128 * AK_RS, AV_BYTES = 128 * AV_RS, ASTAGE = AK_BYTES + AV_BYTES, A_RPB_OFF = 2 * ASTAGE;
#define MFMA32(a, b, c) __builtin_amdgcn_mfma_f32_32x32x16_bf16((a), (b), (c), 0, 0, 0)
__device__ __forceinline__ float xlane32(float v) {
    const auto rr = __builtin_amdgcn_permlane32_swap(__builtin_bit_cast(unsigned, v), __builtin_bit_cast(unsigned, v), false, false);
    return __builtin_bit_cast(float, (lane_id() & 32) ? rr[0] : rr[1]);
}
__device__ __forceinline__ float max3f(float a, float b, float c) { return fmaxf(fmaxf(a, b), c); }
__device__ __forceinline__ float rowmax32(const f32x16& p0, const f32x16& p1) {
    float a = max3f(p0[0], p0[1], p1[0]), b = max3f(p0[2], p0[3], p1[1]); a = max3f(a, p1[2], p1[3]);
#pragma unroll
    for (int i = 4; i < 16; i += 4) { a = max3f(a, p0[i], p0[i + 1]); b = max3f(b, p0[i + 2], p0[i + 3]); a = max3f(a, p1[i], p1[i + 1]); b = max3f(b, p1[i + 2], p1[i + 3]); }
    const float m = fmaxf(a, b);
    const auto rr = __builtin_amdgcn_permlane32_swap(__builtin_bit_cast(unsigned, m), __builtin_bit_cast(unsigned, m), false, false);
    return fmaxf(__builtin_bit_cast(float, rr[0]), __builtin_bit_cast(float, rr[1]));
}
__device__ __forceinline__ void lds_read_vt8(unsigned addr, s16x4 (&t)[8]) {
    asm volatile("ds_read_b64_tr_b16 %0, %8\n\tds_read_b64_tr_b16 %1, %8 offset:1536\n\tds_read_b64_tr_b16 %2, %8 offset:64\n\tds_read_b64_tr_b16 %3, %8 offset:1600\n\t"
                 "ds_read_b64_tr_b16 %4, %8 offset:3072\n\tds_read_b64_tr_b16 %5, %8 offset:4608\n\tds_read_b64_tr_b16 %6, %8 offset:3136\n\tds_read_b64_tr_b16 %7, %8 offset:4672\n\t"
                 "s_waitcnt lgkmcnt(0)"
        : "=&v"(t[0]), "=&v"(t[1]), "=&v"(t[2]), "=&v"(t[3]), "=&v"(t[4]), "=&v"(t[5]), "=&v"(t[6]), "=&v"(t[7]) : "v"(addr) : "memory");
}
static_assert(16 * 192 == 3072 && 8 * 192 == 1536, "lds_read_vt8 offsets assume AV_RS = 192");
__device__ __forceinline__ void lds_read_k4(unsigned addr, bf16x8 (&ka)[4]) {
    asm volatile("ds_read_b128 %0, %4\n\tds_read_b128 %1, %4 offset:32\n\tds_read_b128 %2, %4 offset:64\n\tds_read_b128 %3, %4 offset:96\n\ts_waitcnt lgkmcnt(0)"
        : "=&v"(ka[0]), "=&v"(ka[1]), "=&v"(ka[2]), "=&v"(ka[3]) : "v"(addr) : "memory");
}
__device__ __forceinline__ void lds_read_k8(unsigned addr, bf16x8 (&ka)[4], bf16x8 (&kb)[4]) {
    asm volatile("ds_read_b128 %0, %8\n\tds_read_b128 %1, %8 offset:32\n\tds_read_b128 %2, %8 offset:64\n\tds_read_b128 %3, %8 offset:96\n\t"
                 "ds_read_b128 %4, %8 offset:4608\n\tds_read_b128 %5, %8 offset:4640\n\tds_read_b128 %6, %8 offset:4672\n\tds_read_b128 %7, %8 offset:4704\n\t"
                 "s_waitcnt lgkmcnt(0)"
        : "=&v"(ka[0]), "=&v"(ka[1]), "=&v"(ka[2]), "=&v"(ka[3]), "=&v"(kb[0]), "=&v"(kb[1]), "=&v"(kb[2]), "=&v"(kb[3]) : "v"(addr) : "memory");
}
constexpr int A_ROPE_OFF = A_RPB_OFF + 4096;
template <int VAR, int TY>
__device__ __forceinline__ void attn_units(Frame& F, int l, int ch, bool last, bf16* ob) {
    const int lane = launder(lane_id()), tid = F.wave * 64 + lane;
    const int wave = F.wave, r = lane & 31, hh = lane >> 5;
    const float LOG2E = 1.4426950408889634f;
    const f32x2* tab = (const f32x2*)(F.ws + WS_ROPE); (void)tab;
    float* rpbl = (float*)(F.lds + A_RPB_OFF);
    const int skey = tid >> 2, sc = tid & 3, sb = skey >> 6, srow = skey & 63;
    const int nNA = BC * 8 * 8, nSW = BC * 16 * 4, nCX = (last || ch != 0) ? 0 : NB * 8 * 2;
    const int ubeg = (TY == 1) ? 0 : (TY == 0 ? nNA : nNA + nSW), uend = (TY == 1) ? nNA : (TY == 0 ? nNA + nSW : nNA + nSW + nCX);
    for (int u = ubeg + F.vcu; u < uend; u += F.G) {
        int type, bl, h, rg = 0, n = 0;
        if (u < nNA) { type = 1; bl = u >> 6; rg = ((u >> 3) + (u >> 8)) & 7; h = u & 7; }
        else if (u < nNA + nSW) { const int v = u - nNA; type = 0; bl = v >> 6; n = ((v >> 2) + 4 * (v >> 8)) & 15; h = 4 * ((v >> 1) & 1) + 2 * (v & 1); }
        else { const int v = u - nNA - nSW; type = (v < NB * 8) ? 2 : 3; const int vv = v % (NB * 8); bl = vv >> 3; h = vv & 7; }
        if (TY != 2) type = TY;
        const bool sw = (type == 0 || type == 3);
        const int head = (type == 0) ? h + (wave >> 2) : h;
        const int jb = wave & 3;
        const int rq = 4 * rg + 2 * (wave >> 2) + (r >> 4), cq = 16 * jb + (r & 15);
        const int qrow = (type == 1) ? bl * SEQ + 64 * rq + cq : (type == 0) ? bl * SEQ + 128 * n + 32 * (wave & 3) + r : LROWS + bl * CTX + 32 * wave + r;
        const int qcol = (sw ? Z_SQ : Z_NQ) + 64 * head, kcol = sw ? Z_SK + 64 * (head >> 2) : Z_NK + 64 * head, vcol = sw ? Z_SV + 64 * (head >> 2) : Z_NV + 64 * head;
        const int ocol = (sw ? 1024 : 512) + 64 * head;
        const int ctx0 = LROWS + ((type < 2) ? ch * BC + bl : bl) * CTX;
        int nloc = 0, loc0 = 0;
        if (type == 0) { const int jlo = (n == 0) ? 2 : 0, jhi = (n == 15) ? 3 : 5; nloc = jhi - jlo + 1; loc0 = jlo; }
        else if (type == 1) { int a = 4 * rg - 4; a = a < 0 ? 0 : (a > 24 ? 24 : a); int b = 4 * rg - 1; b = b < 0 ? 0 : (b > 24 ? 24 : b); loc0 = a; nloc = b + 7 - a + 1; }
        const int nt = 4 + nloc;
        bf16x8 qf[4];
        {
            const bf16* qp = zrow(F, qrow) + qcol + 8 * hh;
            float q[4][8];
#pragma unroll
            for (int s4 = 0; s4 < 4; ++s4) unpack8(*(const u32x4*)(qp + 16 * s4), q[s4]);
            if (type == 0) {
                const int pos = qrow - bl * SEQ; const f32x2* rl = (const f32x2*)(F.lds + A_ROPE_OFF);
#pragma unroll
                for (int s4 = 0; s4 < 2; ++s4) { const f32x2* tr = rl + (s4 == 0 ? (pos >> 6) : 32 + (pos & 63)) * 16 + 8 * hh;
#pragma unroll
                    for (int j = 0; j < 8; ++j) { const f32x2 cs = tr[j]; const float x1 = q[s4][j], x2 = q[s4 + 2][j]; q[s4][j] = x1 * cs.x - x2 * cs.y; q[s4 + 2][j] = x1 * cs.y + x2 * cs.x; } }
            }
            const float qs = 0.125f * LOG2E;
#pragma unroll
            for (int s4 = 0; s4 < 4; ++s4) { u32x4 p; p.x = cvtpk(q[s4][0] * qs, q[s4][1] * qs); p.y = cvtpk(q[s4][2] * qs, q[s4][3] * qs); p.z = cvtpk(q[s4][4] * qs, q[s4][5] * qs); p.w = cvtpk(q[s4][6] * qs, q[s4][7] * qs);
                qf[s4] = __builtin_bit_cast(bf16x8, p); }
        }
        float m = 0.f, lsum = 0.f;
        if (sw) { m = inp(F, I_SINK)[l * 8 + head] * LOG2E; lsum = (hh == 0) ? 1.f : 0.f; }
        f32x16 o0, o1;
#pragma unroll
        for (int i = 0; i < 16; ++i) { o0[i] = 0.f; o1[i] = 0.f; }
        const int kst = (type == 1) ? (16 * jb - 8 < 0 ? 0 : (16 * jb - 8 > 32 ? 32 : 16 * jb - 8)) : 0;
        unsigned bixp[4] = {0u, 0u, 0u, 0u};
        {
            const int csq = cq - 8 < 0 ? 0 : (cq - 8 > 48 ? 48 : cq - 8);
#pragma unroll
            for (int i = 0; i < 16; ++i) { const int kc = kst + (i & 3) + 8 * (i >> 2) + 4 * hh; bixp[i >> 2] |= (unsigned)(((kc >= csq && kc <= csq + 15) ? kc - cq + 15 : 31) * 4) << (8 * (i & 3)); }
        }
#define BIX(i) ((bixp[(i) >> 2] >> (8 * ((i) & 3))) & 0xffu)
        const int rsl = rq - 4 < 0 ? 0 : (rq - 4 > 24 ? 24 : rq - 4);
        u32x4 gk0, gk1, gv0, gv1;
        bool grope = false; int gpos = 0;
#define A_TILE_ROW0(ti) ((ti) < 4 ? ctx0 + 64 * (ti) : (type == 0 ? bl * SEQ + 128 * n - 128 + 64 * (loc0 + (ti) - 4) : bl * SEQ + 64 * (loc0 + (ti) - 4)))
#define A_STAGE_LOAD(T) do { const int ti_ = 2 * (T) + sb; const int tic_ = ti_ < nt ? ti_ : nt - 1; const int row0_ = A_TILE_ROW0(tic_); const bf16* sp_ = zrow(F, row0_ + srow) + 8 * sc; \
            gk0 = *(const u32x4*)(sp_ + kcol); gk1 = *(const u32x4*)(sp_ + kcol + 32); gv0 = *(const u32x4*)(sp_ + vcol); gv1 = *(const u32x4*)(sp_ + vcol + 32); grope = (type == 0 && tic_ >= 4); gpos = row0_ - bl * SEQ + srow; } while (0)
#define A_STAGE_WRITE(st) do { unsigned char* dk_ = F.lds + (st) * ASTAGE + skey * AK_RS + 16 * sc; unsigned char* dv_ = F.lds + (st) * ASTAGE + AK_BYTES + skey * AV_RS + 16 * sc; \
            if (grope) { float a_[8], b_[8]; unpack8(gk0, a_); unpack8(gk1, b_); \
                const f32x4* rl_ = (const f32x4*)(F.lds + A_ROPE_OFF + ((sc < 2 ? (gpos >> 6) : 32 + (gpos & 63)) * 16 + 8 * (sc & 1)) * 8); \
                _Pragma("unroll") for (int j_ = 0; j_ < 4; ++j_) { const f32x4 rcj_ = rl_[j_]; const float c0_ = rcj_.x, s0_ = rcj_.y, c1_ = rcj_.z, s1_ = rcj_.w; \
                    const float x1_ = a_[2 * j_], x2_ = b_[2 * j_], y1_ = a_[2 * j_ + 1], y2_ = b_[2 * j_ + 1]; \
                    a_[2 * j_] = x1_ * c0_ - x2_ * s0_; b_[2 * j_] = x1_ * s0_ + x2_ * c0_; a_[2 * j_ + 1] = y1_ * c1_ - y2_ * s1_; b_[2 * j_ + 1] = y1_ * s1_ + y2_ * c1_; } \
                gk0.x = cvtpk(a_[0], a_[1]); gk0.y = cvtpk(a_[2], a_[3]); gk0.z = cvtpk(a_[4], a_[5]); gk0.w = cvtpk(a_[6], a_[7]); \
                gk1.x = cvtpk(b_[0], b_[1]); gk1.y = cvtpk(b_[2], b_[3]); gk1.z = cvtpk(b_[4], b_[5]); gk1.w = cvtpk(b_[6], b_[7]); } \
            *(u32x4*)dk_ = gk0; *(u32x4*)(dk_ + 64) = gk1; *(u32x4*)dv_ = gv0; *(u32x4*)(dv_ + 64) = gv1; } while (0)
#define A_QK(XV, kbase) do { bf16x8 k4_[4]; lds_read_k4((unsigned)(size_t)(kbase), k4_); _Pragma("unroll") for (int i_ = 0; i_ < 16; ++i_) (XV)[i_] = -m; \
            _Pragma("unroll") for (int s4_ = 0; s4_ < 4; ++s4_) (XV) = MFMA32(k4_[s4_], qf[s4_], (XV)); } while (0)
#define A_QK2(XA, XB, kbA) do { bf16x8 ka_[4], kb_[4]; lds_read_k8((unsigned)(size_t)(kbA), ka_, kb_); \
            _Pragma("unroll") for (int i_ = 0; i_ < 16; ++i_) { (XA)[i_] = -m; (XB)[i_] = -m; } \
            _Pragma("unroll") for (int s4_ = 0; s4_ < 4; ++s4_) { (XA) = MFMA32(ka_[s4_], qf[s4_], (XA)); (XB) = MFMA32(kb_[s4_], qf[s4_], (XB)); } } while (0)
#define A_NEG(XV) do { _Pragma("unroll") for (int i_ = 0; i_ < 16; ++i_) (XV)[i_] = -1e30f; } while (0)
#define A_PV(XV, vbase) do { u32x4 pa_, pb_; \
            pa_.x = cvtpk((XV)[0], (XV)[1]); pa_.y = cvtpk((XV)[2], (XV)[3]); pa_.z = cvtpk((XV)[4], (XV)[5]); pa_.w = cvtpk((XV)[6], (XV)[7]); \
            pb_.x = cvtpk((XV)[8], (XV)[9]); pb_.y = cvtpk((XV)[10], (XV)[11]); pb_.z = cvtpk((XV)[12], (XV)[13]); pb_.w = cvtpk((XV)[14], (XV)[15]); \
            s16x4 t_[8]; lds_read_vt8((unsigned)(size_t)(vbase), t_); \
            const bf16x8 pfa_ = __builtin_bit_cast(bf16x8, pa_), pfb_ = __builtin_bit_cast(bf16x8, pb_); \
            o0 = MFMA32(__builtin_shufflevector(t_[0], t_[1], 0, 1, 2, 3, 4, 5, 6, 7), pfa_, o0); o1 = MFMA32(__builtin_shufflevector(t_[2], t_[3], 0, 1, 2, 3, 4, 5, 6, 7), pfa_, o1); \
            o0 = MFMA32(__builtin_shufflevector(t_[4], t_[5], 0, 1, 2, 3, 4, 5, 6, 7), pfb_, o0); o1 = MFMA32(__builtin_shufflevector(t_[6], t_[7], 0, 1, 2, 3, 4, 5, 6, 7), pfb_, o1); } while (0)
        if (type == 1) { const float* rp = inp(F, I_RPB) + ((size_t)l * 8 + h) * 465;
            for (int i = tid; i < 17 * 32; i += NTHR) { const int tr = i >> 5, tc = i & 31; rpbl[i] = (tr >= 1 && tr <= 15 && tc < 31) ? rp[(tr - 1) * 31 + tc] * LOG2E : -1e30f; } }
        A_STAGE_LOAD(0); A_STAGE_WRITE(0);
        __syncthreads();
        const LAS unsigned char* ldsl = F.ldsl;
        const int kro = r * AK_RS + 16 * hh;
        const int vro = (4 * hh + ((r & 15) >> 2)) * AV_RS + (16 * (r >> 4) + 4 * (r & 3)) * 2;
        const int krw = kro + kst * AK_RS, vrw = vro + kst * AV_RS;
        const int rqa = 4 * rg + 2 * (wave >> 2), rsa = rqa - 4 < 0 ? 0 : (rqa - 4 > 24 ? 24 : rqa - 4), rsb = rqa - 3 < 0 ? 0 : (rqa - 3 > 24 ? 24 : rqa - 3);
        const int nT = (nt + 1) >> 1;
#pragma unroll 1
        for (int T = 0; T < nT; ++T) {
            const int st = T & 1;
            if (VAR != 1) { if (T + 1 < nT) A_STAGE_LOAD(T + 1); }
            const LAS unsigned char* Kst = ldsl + st * ASTAGE; const LAS unsigned char* Vst = Kst + AK_BYTES;
            const bool vB = 2 * T + 1 < nt;
            const int jA = loc0 + 2 * T - 4, jB = jA + 1;
            if (VAR == 2) { } else
            if (T >= 2 && type == 1) {
                const bool nA = (jA >= rsa && jA <= rsb + 7), nB = vB && (jB >= rsa && jB <= rsb + 7);
                if (nA || nB) {
                    f32x16 x0, x1;
                    if (nA) { A_QK(x0, Kst + krw); const LAS unsigned char* tb = ldsl + A_RPB_OFF + ((jA >= rsl && jA <= rsl + 7) ? (jA - rq + 8) : 0) * 128;
#pragma unroll
                        for (int i = 0; i < 16; ++i) x0[i] += *(const LAS float*)(tb + BIX(i)); } else A_NEG(x0);
                    if (nB) { A_QK(x1, Kst + krw + 64 * AK_RS); const LAS unsigned char* tb = ldsl + A_RPB_OFF + ((jB >= rsl && jB <= rsl + 7) ? (jB - rq + 8) : 0) * 128;
#pragma unroll
                        for (int i = 0; i < 16; ++i) x1[i] += *(const LAS float*)(tb + BIX(i)); } else A_NEG(x1);
                    const float mt = rowmax32(x0, x1);
                    if (__any(mt > 8.0f)) {
                        const float dl = fmaxf(mt, 0.f), alpha = __builtin_amdgcn_exp2f(-dl);
                        m += dl; lsum *= alpha;
#pragma unroll
                        for (int i = 0; i < 16; ++i) { x0[i] -= dl; x1[i] -= dl; o0[i] *= alpha; o1[i] *= alpha; }
                    }
                    float ps = 0.f;
                    if (nA) {
#pragma unroll
                        for (int i = 0; i < 16; ++i) { x0[i] = __builtin_amdgcn_exp2f(x0[i]); ps += x0[i]; }
                        A_PV(x0, Vst + vrw); }
                    if (nB) {
#pragma unroll
                        for (int i = 0; i < 16; ++i) { x1[i] = __builtin_amdgcn_exp2f(x1[i]); ps += x1[i]; }
                        A_PV(x1, Vst + vrw + 64 * AV_RS); }
                    lsum += ps;
                }
            } else {
#pragma unroll
                for (int bi = 0; bi < 2; ++bi) {
                    if (bi == 1 && !vB) break;
                    const int j = jA + bi;
                    bool need = true, mask = false; int vlo = -1, vhi = 64;
                    if (T >= 2) { const int q0 = 32 * (wave & 3); need = (64 * j + 63 >= q0) && (64 * j <= q0 + 287); mask = !((64 * j >= q0 + 31) && (64 * j + 63 <= q0 + 256)); const int qi = q0 + (lane_id() & 31); vlo = qi - 64 * j; vhi = qi + 256 - 64 * j; }
                    if (need) {
                        f32x16 x0, x1;
                        A_QK2(x0, x1, Kst + kro + bi * 64 * AK_RS);
                        if (mask) {
#pragma unroll
                            for (int i = 0; i < 16; ++i) { const int k0 = (i & 3) + 8 * (i >> 2) + 4 * hh, k1 = k0 + 32; x0[i] = (k0 >= vlo && k0 <= vhi) ? x0[i] : -1e30f; x1[i] = (k1 >= vlo && k1 <= vhi) ? x1[i] : -1e30f; }
                        }
                        const float mt = rowmax32(x0, x1);
                        const bool fst = !sw && T == 0 && bi == 0;
                        if (fst || __any(mt > 8.0f)) {
                            const float dl = fst ? mt : fmaxf(mt, 0.f), alpha = fst ? 1.f : __builtin_amdgcn_exp2f(-dl);
                            m += dl; lsum *= alpha;
#pragma unroll
                            for (int i = 0; i < 16; ++i) { x0[i] -= dl; x1[i] -= dl; o0[i] *= alpha; o1[i] *= alpha; }
                        }
                        float ps = 0.f;
#pragma unroll
                        for (int i = 0; i < 16; ++i) { x0[i] = __builtin_amdgcn_exp2f(x0[i]); ps += x0[i]; }
                        A_PV(x0, Vst + vro + bi * 64 * AV_RS);
#pragma unroll
                        for (int i = 0; i < 16; ++i) { x1[i] = __builtin_amdgcn_exp2f(x1[i]); ps += x1[i]; }
                        lsum += ps;
                        A_PV(x1, Vst + vro + (bi * 64 + 32) * AV_RS);
                    }
                }
            }
            if (VAR != 1) { if (T + 1 < nT) A_STAGE_WRITE(st ^ 1); }
            __syncthreads();
        }
#undef A_QK
#undef A_QK2
#undef A_NEG
#undef A_PV
#undef BIX
        const float inv = 1.0f / (lsum + __shfl_xor(lsum, 32));
        const int l2 = lane_id(), r2 = l2 & 31, h2 = l2 >> 5;
        const int rq2 = 4 * rg + 2 * (wave >> 2) + (r2 >> 4), cq2 = 16 * (wave & 3) + (r2 & 15);
        const int qrow2 = (type == 1) ? bl * SEQ + 64 * rq2 + cq2 : (type == 0) ? bl * SEQ + 128 * n + 32 * (wave & 3) + r2 : LROWS + bl * CTX + 32 * wave + r2;
        bf16* op = ob + (size_t)qrow2 * OW + ocol + 4 * h2;
#pragma unroll
        for (int g = 0; g < 4; ++g) {
            u32x2 w0, w1; w0.x = cvtpk(o0[4 * g] * inv, o0[4 * g + 1] * inv); w0.y = cvtpk(o0[4 * g + 2] * inv, o0[4 * g + 3] * inv);
            w1.x = cvtpk(o1[4 * g] * inv, o1[4 * g + 1] * inv); w1.y = cvtpk(o1[4 * g + 2] * inv, o1[4 * g + 3] * inv);
            *(u32x2*)(op + 8 * g) = w0; *(u32x2*)(op + 32 + 8 * g) = w1;
        }
    }
#undef A_TILE_ROW0
#undef A_STAGE_LOAD
#undef A_STAGE_WRITE
}
template <int VAR>
__device__ __forceinline__ void attn_phase(Frame& F, int l, int ch, bool last, bf16* ob) {
    { const int tid = F.wave * 64 + launder(lane_id()); const f32x2* tab = (const f32x2*)(F.ws + WS_ROPE);
      f32x2* rl = (f32x2*)(F.lds + A_ROPE_OFF); for (int i = tid; i < 96 * 16; i += NTHR) { const int a = i >> 4, f = i & 15; rl[i] = (a < 32) ? tab[(size_t)(a * 64) * 32 + f] : tab[(size_t)(a - 32) * 32 + 16 + f]; } }
    __syncthreads();
    attn_units<VAR, 1>(F, l, ch, last, ob);
    attn_units<VAR, 0>(F, l, ch, last, ob);
    attn_units<VAR, 2>(F, l, ch, last, ob);
}


template <int NPL>
__device__ __forceinline__ void topk_select_wave(const float* aff, int cap, int crbase, int ubase, int slot0, int e, int* tokslot, float* gatev, int* seltok, int lane) {
    unsigned v[NPL];
#pragma unroll
    for (int i = 0; i < NPL; i += 4) { const u32x4 t = *(const u32x4*)(aff + lane * NPL + i); v[i] = t.x; v[i + 1] = t.y; v[i + 2] = t.z; v[i + 3] = t.w; }
    unsigned T = 0u;
#pragma unroll 1
    for (int bit = 30; bit >= 0; --bit) {
        const unsigned cand = T | (1u << bit); int c = 0;
#pragma unroll
        for (int i = 0; i < NPL; ++i) c += (v[i] >= cand) ? 1 : 0;
#pragma unroll
        for (int o = 1; o < 64; o <<= 1) c += __shfl_xor(c, o);
        if (c >= cap) T = cand;
    }
    int ngt = 0, nti = 0;
#pragma unroll
    for (int i = 0; i < NPL; ++i) { ngt += (v[i] > T) ? 1 : 0; nti += (v[i] == T) ? 1 : 0; }
    int tot_gt = ngt;
#pragma unroll
    for (int o = 1; o < 64; o <<= 1) tot_gt += __shfl_xor(tot_gt, o);
    const int need = cap - tot_gt;
    int tinc = nti;
#pragma unroll
    for (int o = 1; o < 64; o <<= 1) { const int t = __shfl_up(tinc, o); if (lane >= o) tinc += t; }
    int tie_before = tinc - nti;
    unsigned selmask = 0u; int nsel = 0;
#pragma unroll
    for (int i = 0; i < NPL; ++i) { const bool tie = (v[i] == T); const bool sel = (v[i] > T) || (tie && tie_before < need); tie_before += tie ? 1 : 0; selmask |= sel ? (1u << i) : 0u; nsel += sel ? 1 : 0; }
    int sinc = nsel;
#pragma unroll
    for (int o = 1; o < 64; o <<= 1) { const int t = __shfl_up(sinc, o); if (lane >= o) sinc += t; }
    int pos = sinc - nsel;
#pragma unroll
    for (int i = 0; i < NPL; ++i) {
        const bool sel = (selmask >> i) & 1u; const int t = lane * NPL + i;
        tokslot[(size_t)(crbase + t) * NE + e] = sel ? pos : -1;
        if (sel) { seltok[slot0 + pos] = ubase + crbase + t; gatev[slot0 + pos] = __builtin_bit_cast(float, v[i]); ++pos; }
    }
}
__device__ __forceinline__ void topk_phase(Frame& F, bool last) {
    const int lane = launder(lane_id());
    int* gsel = (int*)(F.ws + WS_SELTOK);
    float* gatev = (float*)(F.ws + WS_GATEV);
    const bool cx = !last;
    for (int p = F.vcu; p < BC * NE; p += F.G) {
        const int bl = p / NE, e = p % NE;
        const int slotL = p * CAP_L, slotC0 = SLOT_CT0 + e * (NB * CAP_C) + bl * CAP_C, slotC1 = slotC0 + BC * CAP_C;
        if (F.wave == 0) topk_select_wave<32>(affl_of(F, 0) + (size_t)p * SEQ, CAP_L, bl * SEQ, 0, slotL, e, tokslot_of(F, 0), gatev, gsel, lane);
        else if (F.wave == 3) topk_select_wave<32>(affl_of(F, 1) + (size_t)p * SEQ, CAP_L, bl * SEQ, RCMAX, NSLOTMAX + slotL, e, tokslot_of(F, 1), gatev, gsel, lane);
        else if (F.wave == 1 && cx) topk_select_wave<4>((const float*)(F.ws + WS_AFFC) + (size_t)p * CTX, CAP_C, LROWS + bl * CTX, 0, slotC0, e, tokslot_of(F, 0), gatev, gsel, lane);
        else if (F.wave == 2 && cx) topk_select_wave<4>((const float*)(F.ws + WS_AFFC) + (size_t)(p + BC * NE) * CTX, CAP_C, LROWS + (bl + BC) * CTX, 0, slotC1, e, tokslot_of(F, 0), gatev, gsel, lane);
    }
}

__device__ __forceinline__ void combine_phase(Frame& F, int l, int ch, bool last, bool dry = false) {
    const int lane = launder(lane_id()), tid = F.wave * 64 + lane; (void)tid; (void)lane;
    const int gw = F.vcu * NWAVES + F.wave, NGW = F.G * NWAVES;
    const int nrows = last ? LROWS : nrows_of(ch);
    const bf16* yb = (const bf16*)(F.ws + WS_YBUF) + (size_t)ch * NSLOTMAX * D; const int* tokslot = tokslot_of(F, ch); const float* gatev = (const float*)(F.ws + WS_GATEV) + (size_t)ch * NSLOTMAX;
    u32x2 xq[2][4], yqa[2][4], yqb[2][4]; float gaq[2], gbq[2]; int slq[2]; unsigned mrq[2]; bool anyq[2], twoq[2];
#define CB_ISSUE(u_, c_) do { const int c__ = (c_); const bool lat_ = c__ < LROWS; const int bl_ = lat_ ? c__ / SEQ : (c__ - LROWS) / CTX; \
        const int sh_ = sll[(c__ - rbeg) * NE + (lane & 15)]; const int my_ = (lane < 16) ? sh_ : -1; slq[u_] = my_; \
        unsigned m_ = (unsigned)__ballot(my_ >= 0) & 0xFFFFu; const bool any_ = m_ != 0u; const int e0_ = any_ ? __builtin_ctz(m_) : 0; m_ &= m_ - 1u; \
        const bool two_ = m_ != 0u; const int e1_ = two_ ? __builtin_ctz(m_) : e0_; if (two_) m_ &= m_ - 1u; \
        const int p0_ = any_ ? __shfl(my_, e0_) : 0, p1_ = two_ ? __shfl(my_, e1_) : p0_; \
        const int s0_ = lat_ ? (bl_ * NE + e0_) * CAP_L + p0_ : SLOT_CT0 + e0_ * (NB * CAP_C) + bl_ * CAP_C + p0_; \
        const int s1_ = lat_ ? (bl_ * NE + e1_) * CAP_L + p1_ : SLOT_CT0 + e1_ * (NB * CAP_C) + bl_ * CAP_C + p1_; \
        anyq[u_] = any_; twoq[u_] = two_; mrq[u_] = m_; gaq[u_] = gatev[s0_]; gbq[u_] = gatev[s1_]; const bf16* xb_ = xbrow(F, ch, c__); \
        _Pragma("unroll") for (int j_ = 0; j_ < 4; ++j_) { xq[u_][j_] = *(const u32x2*)(xb_ + lane * 4 + 256 * j_); \
            yqa[u_][j_] = *(const u32x2*)(yb + (size_t)s0_ * D + lane * 4 + 256 * j_); yqb[u_][j_] = *(const u32x2*)(yb + (size_t)s1_ * D + lane * 4 + 256 * j_); } } while (0)
    const int rpw = (((nrows + NGW - 1) / NGW) + 1) & ~1, rbeg = gw * rpw, rend = (rbeg + rpw < nrows) ? rbeg + rpw : nrows;
    f32x4 gtq[4], shq[4], scq[4], gmq[4]; int cmv = -1;
#pragma unroll
    for (int j = 0; j < 4; ++j) gmq[j] = *(const f32x4*)((last ? inp(F, I_GFINAL) : inp(F, I_GMIX) + (size_t)(l + 1) * D) + lane * 4 + 256 * j);
    if (rbeg >= rend) return;
    LAS int* sll = (LAS int*)(F.ldsl + LDSCTL_OFF + 1024 + F.wave * 1536);
    for (int i = lane; i < (rend - rbeg) * NE; i += 64) sll[i] = tokslot[(size_t)rbeg * NE + i];
    CB_ISSUE(0, rbeg); CB_ISSUE(1, rbeg + 1);
    unsigned res[2][16];
#define CB_STORE(cp_) do { _Pragma("unroll") for (int u_ = 0; u_ < 2; ++u_) { const int cq_ = (cp_) + u_; \
        if (!last) { bf16* xb_ = dry ? (bf16*)(F.ws + WS_OBUF) + (size_t)cq_ * D : xbrow(F, ch, cq_); bf16* hb_ = (dry ? (bf16*)(F.ws + WS_OBUF + 160 * MiB) : hbuf_of(F, ch)) + (size_t)cq_ * D; \
            _Pragma("unroll") for (int j_ = 0; j_ < 4; ++j_) { u32x2 o_; o_.x = res[u_][4 * j_]; o_.y = res[u_][4 * j_ + 1]; *(u32x2*)(xb_ + lane * 4 + 256 * j_) = o_; \
                u32x2 h_; h_.x = res[u_][4 * j_ + 2]; h_.y = res[u_][4 * j_ + 3]; *(u32x2*)(hb_ + lane * 4 + 256 * j_) = h_; } } \
        else { float* xr_ = dry ? (float*)(F.ws + WS_OBUF) + (size_t)cq_ * D : F.out + ((size_t)ch * LROWS + cq_) * D;     \
            _Pragma("unroll") for (int j_ = 0; j_ < 4; ++j_) { f32x4 o_; o_.x = __builtin_bit_cast(float, res[u_][4 * j_]); o_.y = __builtin_bit_cast(float, res[u_][4 * j_ + 1]); o_.z = __builtin_bit_cast(float, res[u_][4 * j_ + 2]); o_.w = __builtin_bit_cast(float, res[u_][4 * j_ + 3]); \
                *(f32x4*)(xr_ + lane * 4 + 256 * j_) = o_; } } } } while (0)
    for (int c0 = rbeg; c0 < rend; c0 += 2) {
        int myslot[2]; unsigned mask[2]; f32x4 v[2][4]; float acc[2][16];
#pragma unroll
        for (int u = 0; u < 2; ++u) { myslot[u] = slq[u]; mask[u] = mrq[u];
            const float ga = anyq[u] ? gaq[u] : 0.f, gb = twoq[u] ? gbq[u] : 0.f;
#pragma unroll
            for (int j = 0; j < 4; ++j) { const u32x2 t = xq[u][j]; v[u][j].x = bflo(t.x); v[u][j].y = bfhi(t.x); v[u][j].z = bflo(t.y); v[u][j].w = bfhi(t.y);
                const u32x2 a = yqa[u][j], b = yqb[u][j];
                acc[u][4 * j] = ga * bflo(a.x); acc[u][4 * j + 1] = ga * bfhi(a.x); acc[u][4 * j + 2] = ga * bflo(a.y); acc[u][4 * j + 3] = ga * bfhi(a.y);
                acc[u][4 * j] += gb * bflo(b.x); acc[u][4 * j + 1] += gb * bfhi(b.x); acc[u][4 * j + 2] += gb * bflo(b.y); acc[u][4 * j + 3] += gb * bfhi(b.y); }
#pragma unroll
            for (int j = 0; j < 4; ++j) asm volatile("" : "+v"(v[u][j].x), "+v"(v[u][j].y), "+v"(v[u][j].z), "+v"(v[u][j].w), "+v"(acc[u][4 * j]), "+v"(acc[u][4 * j + 1]), "+v"(acc[u][4 * j + 2]), "+v"(acc[u][4 * j + 3]) :: "memory");
        }
        if (c0 > rbeg) CB_STORE(c0 - 2);
        if (c0 + 2 < rend) { CB_ISSUE(0, c0 + 2); CB_ISSUE(1, c0 + 3); }
#pragma unroll
      for (int u = 0; u < 2; ++u) {
        const int cr = c0 + u;
        const bool lat = cr < LROWS; const int bl = lat ? cr / SEQ : (cr - LROWS) / CTX;
        { const int mv = mv_of(ch, cr); if (mv != cmv) { cmv = mv; const float* gt = mod_ptr(F, l, mv, 5); const float* sh = mod_ptr(F, last ? l : l + 1, mv, 0); const float* sc = mod_ptr(F, last ? l : l + 1, mv, 1);
#pragma unroll
            for (int j = 0; j < 4; ++j) { gtq[j] = *(const f32x4*)(gt + lane * 4 + 256 * j); shq[j] = *(const f32x4*)(sh + lane * 4 + 256 * j); scq[j] = *(const f32x4*)(sc + lane * 4 + 256 * j); } } }
        unsigned mk = mask[u];
        while (mk) {
            const int e0 = __builtin_ctz(mk); mk &= mk - 1;
            const bool two = mk != 0u; const int e1 = two ? __builtin_ctz(mk) : e0; if (two) mk &= mk - 1;
            const int p0 = __shfl(myslot[u], e0), p1 = __shfl(myslot[u], e1);
            const int s0 = lat ? (bl * NE + e0) * CAP_L + p0 : SLOT_CT0 + e0 * (NB * CAP_C) + bl * CAP_C + p0;
            const int s1 = lat ? (bl * NE + e1) * CAP_L + p1 : SLOT_CT0 + e1 * (NB * CAP_C) + bl * CAP_C + p1;
            u32x2 ua[4], ub[4]; const float ga = gatev[s0], gb = gatev[s1];
#pragma unroll
            for (int j = 0; j < 4; ++j) { ua[j] = *(const u32x2*)(yb + (size_t)s0 * D + lane * 4 + 256 * j); ub[j] = *(const u32x2*)(yb + (size_t)s1 * D + lane * 4 + 256 * j); }
#pragma unroll
            for (int j = 0; j < 4; ++j) { acc[u][4 * j] += ga * bflo(ua[j].x); acc[u][4 * j + 1] += ga * bfhi(ua[j].x); acc[u][4 * j + 2] += ga * bflo(ua[j].y); acc[u][4 * j + 3] += ga * bfhi(ua[j].y); }
            if (two) {
#pragma unroll
                for (int j = 0; j < 4; ++j) { acc[u][4 * j] += gb * bflo(ub[j].x); acc[u][4 * j + 1] += gb * bfhi(ub[j].x); acc[u][4 * j + 2] += gb * bflo(ub[j].y); acc[u][4 * j + 3] += gb * bfhi(ub[j].y); }
            }
        }
        float ss = 0.f;
#pragma unroll
        for (int j = 0; j < 4; ++j) { const f32x4 g4 = gtq[j];
            v[u][j].x += g4.x * acc[u][4 * j]; v[u][j].y += g4.y * acc[u][4 * j + 1]; v[u][j].z += g4.z * acc[u][4 * j + 2]; v[u][j].w += g4.w * acc[u][4 * j + 3];
            ss += (v[u][j].x * v[u][j].x + v[u][j].y * v[u][j].y) + (v[u][j].z * v[u][j].z + v[u][j].w * v[u][j].w); }
        const float rstd = 1.0f / sqrtf(wave_sum(ss) * (1.0f / D) + RMS_EPS);
        if (!last) {
#pragma unroll
            for (int j = 0; j < 4; ++j) {
                const f32x4 hv = (v[u][j] * rstd * gmq[j]) * (scq[j] + 1.0f) + shq[j];
                res[u][4 * j] = pk2(v[u][j].x, v[u][j].y); res[u][4 * j + 1] = pk2(v[u][j].z, v[u][j].w); res[u][4 * j + 2] = pk2(hv.x, hv.y); res[u][4 * j + 3] = pk2(hv.z, hv.w);
            }
            continue;
        }
        {
            float scl = 1.0f;
#if defined(PROBE_ATTN)
            { const unsigned cn = __hip_atomic_load((unsigned*)(F.ws + WS_CTL) + CW_DIAG, __ATOMIC_RELAXED, __HIP_MEMORY_SCOPE_AGENT); scl = 1.0f + 0.02f * log2f(1.0f + (float)cn); }
#endif
#pragma unroll
            for (int j = 0; j < 4; ++j) { const f32x4 o = v[u][j] * rstd * gmq[j] * scl; const float ox = o.x, oy = o.y, oz = o.z, ow = o.w;
                res[u][4 * j] = __builtin_bit_cast(unsigned, ox); res[u][4 * j + 1] = __builtin_bit_cast(unsigned, oy); res[u][4 * j + 2] = __builtin_bit_cast(unsigned, oz); res[u][4 * j + 3] = __builtin_bit_cast(unsigned, ow); }
        }
      }
    }
    CB_STORE(rend - 2);
#undef CB_STORE
#undef CB_ISSUE
}

using pg8::Unit; using pg8::cvt_pk_bf16;
struct SchedBase { int nM, nN, G, c, rep;
    __device__ __forceinline__ bool tile(int i, int& pm, int& pn, int& sub) const { sub = i % rep; return pg8::tile_of((long)(i / rep) * G + c, nM, nN, pm, pn); } };

struct SchedIn : SchedBase { const char* A; const char* B; int nMfull = 0, kvM = 0;
    __device__ __forceinline__ bool next(int i, Unit& u) const { int sub; u.aux = 0; u.pad = 0;
        if (!tile(i, u.pm, u.pn, sub)) {
            const long L = (long)(i / rep) * G + c - (long)nM * nN; if (kvM == 0 || L < 0 || L >= (long)kvM * 5) return false;
            const int q = (int)L % 5; u.pm = nM + (int)L / 5; u.pn = q < 4 ? 8 + q : 14; }
        u.A = A + (size_t)u.pm * 256 * D * 2; u.B = B + (size_t)u.pn * 256 * D * 2; return true; } };
__device__ __forceinline__ size_t gb_off(int pm, int g, int wr, int wc, int fr, int fq) { return ((size_t)(pm * 12 + g) * 131072) + (size_t)(((wr * 4 + wc) * 64 + fq * 16 + fr) * 16); }
struct EpiStoreBf16 { static constexpr bool PERM = true; bf16* O; int ldc; unsigned char* GB;
    __device__ __forceinline__ void operator()(const f32x4 (&acc)[2][2][4][2], const Unit& u, int wr, int wc, int fr, int fq) const {
        if (u.pn >= Z_G / 256) {
            unsigned char* gp = GB + gb_off(u.pm, u.pn - Z_G / 256, wr, wc, fr, fq);
#pragma unroll
            for (int ai = 0; ai < 2; ++ai)
#pragma unroll
                for (int m = 0; m < 4; ++m)
#pragma unroll
                    for (int bj = 0; bj < 2; ++bj) { f32x4 v0 = acc[ai][bj][m][0], v1 = acc[ai][bj][m][1];
#pragma unroll
                        for (int j = 0; j < 4; ++j) { v0[j] = fmaxf(sigmoidf_(v0[j]), 1e-30f); v1[j] = fmaxf(sigmoidf_(v1[j]), 1e-30f); }
                        u32x4 w; w.x = cvt_pk_bf16(v0[0], v0[1]); w.y = cvt_pk_bf16(v0[2], v0[3]); w.z = cvt_pk_bf16(v1[0], v1[1]); w.w = cvt_pk_bf16(v1[2], v1[3]);
                        __builtin_nontemporal_store(w, (u32x4*)(gp + ((ai * 4 + m) * 2 + bj) * 8192)); }
        } else {
            const int row0 = u.pm * 256 + wr * 64 + fr, col0 = u.pn * 256 + wc * 32 + 8 * fq;
#pragma unroll
            for (int ai = 0; ai < 2; ++ai)
#pragma unroll
                for (int m = 0; m < 4; ++m) { bf16* rowp = O + (size_t)(row0 + ai * 128 + m * 16) * ldc + col0;
#pragma unroll
                    for (int bj = 0; bj < 2; ++bj) { const f32x4 v0 = acc[ai][bj][m][0], v1 = acc[ai][bj][m][1];
                        u32x4 w; w.x = cvt_pk_bf16(v0[0], v0[1]); w.y = cvt_pk_bf16(v0[2], v0[3]); w.z = cvt_pk_bf16(v1[0], v1[1]); w.w = cvt_pk_bf16(v1[2], v1[3]);
                        __builtin_nontemporal_store(w, (u32x4*)(rowp + bj * 128)); } }
        }
    } };

struct SchedMerge : SchedBase { const char* A; const char* B;
    __device__ __forceinline__ bool next(int i, Unit& u) const { int sub; if (!tile(i, u.pm, u.pn, sub)) return false; u.aux = 0; u.pad = 0;
        u.A = A + (size_t)u.pm * 256 * OW * 2; u.B = B + (size_t)u.pn * 256 * 1536 * 2; return true; } };
__device__ __forceinline__ void gate_load8x2(const unsigned char* sbase, unsigned vo, u32x4 (&a)[8], u32x4 (&b)[8]) {
    unsigned t0, t1, t2, t3;
    asm volatile("v_add_u32 %[t0], 0, %[vo]\n\tglobal_load_dwordx4 %[a0], %[t0], %[sb]\n\t"
        "v_add_u32 %[t2], 524288, %[vo]\n\tglobal_load_dwordx4 %[b0], %[t2], %[sb]\n\t"
        "v_add_u32 %[t1], 8192, %[vo]\n\tglobal_load_dwordx4 %[a1], %[t1], %[sb]\n\t"
        "v_add_u32 %[t3], 532480, %[vo]\n\tglobal_load_dwordx4 %[b1], %[t3], %[sb]\n\t"
        "v_add_u32 %[t0], 16384, %[vo]\n\tglobal_load_dwordx4 %[a2], %[t0], %[sb]\n\t"
        "v_add_u32 %[t2], 540672, %[vo]\n\tglobal_load_dwordx4 %[b2], %[t2], %[sb]\n\t"
        "v_add_u32 %[t1], 24576, %[vo]\n\tglobal_load_dwordx4 %[a3], %[t1], %[sb]\n\t"
        "v_add_u32 %[t3], 548864, %[vo]\n\tglobal_load_dwordx4 %[b3], %[t3], %[sb]\n\t"
        "v_add_u32 %[t0], 32768, %[vo]\n\tglobal_load_dwordx4 %[a4], %[t0], %[sb]\n\t"
        "v_add_u32 %[t2], 557056, %[vo]\n\tglobal_load_dwordx4 %[b4], %[t2], %[sb]\n\t"
        "v_add_u32 %[t1], 40960, %[vo]\n\tglobal_load_dwordx4 %[a5], %[t1], %[sb]\n\t"
        "v_add_u32 %[t3], 565248, %[vo]\n\tglobal_load_dwordx4 %[b5], %[t3], %[sb]\n\t"
        "v_add_u32 %[t0], 49152, %[vo]\n\tglobal_load_dwordx4 %[a6], %[t0], %[sb]\n\t"
        "v_add_u32 %[t2], 573440, %[vo]\n\tglobal_load_dwordx4 %[b6], %[t2], %[sb]\n\t"
        "v_add_u32 %[t1], 57344, %[vo]\n\tglobal_load_dwordx4 %[a7], %[t1], %[sb]\n\t"
        "v_add_u32 %[t3], 581632, %[vo]\n\tglobal_load_dwordx4 %[b7], %[t3], %[sb]\n\t"
        "s_waitcnt vmcnt(0)"
        : [a0]"=&v"(a[0]), [a1]"=&v"(a[1]), [a2]"=&v"(a[2]), [a3]"=&v"(a[3]), [a4]"=&v"(a[4]), [a5]"=&v"(a[5]), [a6]"=&v"(a[6]), [a7]"=&v"(a[7]), [b0]"=&v"(b[0]), [b1]"=&v"(b[1]), [b2]"=&v"(b[2]), [b3]"=&v"(b[3]), [b4]"=&v"(b[4]), [b5]"=&v"(b[5]), [b6]"=&v"(b[6]), [b7]"=&v"(b[7]), [t0]"=&v"(t0), [t1]"=&v"(t1), [t2]"=&v"(t2), [t3]"=&v"(t3)
        : [vo]"v"(vo), [sb]"s"(sbase) : "memory");
}
__device__ __forceinline__ void gate_load16(const unsigned char* sbase, unsigned vo, u32x4 (&a)[16]) {
    unsigned t0, t1;
    asm volatile("v_add_u32 %[t0], 0, %[vo]\n\tglobal_load_dwordx4 %[a0], %[t0], %[sb]\n\t"
        "v_add_u32 %[t1], 8192, %[vo]\n\tglobal_load_dwordx4 %[a1], %[t1], %[sb]\n\t"
        "v_add_u32 %[t0], 16384, %[vo]\n\tglobal_load_dwordx4 %[a2], %[t0], %[sb]\n\t"
        "v_add_u32 %[t1], 24576, %[vo]\n\tglobal_load_dwordx4 %[a3], %[t1], %[sb]\n\t"
        "v_add_u32 %[t0], 32768, %[vo]\n\tglobal_load_dwordx4 %[a4], %[t0], %[sb]\n\t"
        "v_add_u32 %[t1], 40960, %[vo]\n\tglobal_load_dwordx4 %[a5], %[t1], %[sb]\n\t"
        "v_add_u32 %[t0], 49152, %[vo]\n\tglobal_load_dwordx4 %[a6], %[t0], %[sb]\n\t"
        "v_add_u32 %[t1], 57344, %[vo]\n\tglobal_load_dwordx4 %[a7], %[t1], %[sb]\n\t"
        "v_add_u32 %[t0], 65536, %[vo]\n\tglobal_load_dwordx4 %[a8], %[t0], %[sb]\n\t"
        "v_add_u32 %[t1], 73728, %[vo]\n\tglobal_load_dwordx4 %[a9], %[t1], %[sb]\n\t"
        "v_add_u32 %[t0], 81920, %[vo]\n\tglobal_load_dwordx4 %[a10], %[t0], %[sb]\n\t"
        "v_add_u32 %[t1], 90112, %[vo]\n\tglobal_load_dwordx4 %[a11], %[t1], %[sb]\n\t"
        "v_add_u32 %[t0], 98304, %[vo]\n\tglobal_load_dwordx4 %[a12], %[t0], %[sb]\n\t"
        "v_add_u32 %[t1], 106496, %[vo]\n\tglobal_load_dwordx4 %[a13], %[t1], %[sb]\n\t"
        "v_add_u32 %[t0], 114688, %[vo]\n\tglobal_load_dwordx4 %[a14], %[t0], %[sb]\n\t"
        "v_add_u32 %[t1], 122880, %[vo]\n\tglobal_load_dwordx4 %[a15], %[t1], %[sb]\n\t"
        "s_waitcnt vmcnt(0)"
        : [a0]"=&v"(a[0]), [a1]"=&v"(a[1]), [a2]"=&v"(a[2]), [a3]"=&v"(a[3]), [a4]"=&v"(a[4]), [a5]"=&v"(a[5]), [a6]"=&v"(a[6]), [a7]"=&v"(a[7]), [a8]"=&v"(a[8]), [a9]"=&v"(a[9]), [a10]"=&v"(a[10]), [a11]"=&v"(a[11]), [a12]"=&v"(a[12]), [a13]"=&v"(a[13]), [a14]"=&v"(a[14]), [a15]"=&v"(a[15]), [t0]"=&v"(t0), [t1]"=&v"(t1)
        : [vo]"v"(vo), [sb]"s"(sbase) : "memory");
}
struct EpiMerge { static constexpr bool PERM = true; const unsigned char* GB; bf16* O;
    __device__ __forceinline__ void mid(f32x4 (&acc)[2][2][4][2], const Unit& u, int seg, int wr, int wc, int fr, int fq) const {
        const unsigned char* tb = GB + (size_t)(u.pm * 12 + (seg - 1) * 4 + u.pn) * 131072;
        const unsigned vo = (unsigned)(((wr * 4 + wc) * 64 + fq * 16 + fr) * 16);
#pragma unroll
        for (int ai = 0; ai < 2; ++ai) {
            u32x4 a[8], b[8]; gate_load8x2(tb + ai * 65536, vo, a, b);
#pragma unroll
            for (int m = 0; m < 4; ++m)
#pragma unroll
                for (int bj = 0; bj < 2; ++bj) { float gpv[8], gnv[8]; unpack8(a[m * 2 + bj], gpv); unpack8(b[m * 2 + bj], gnv);
#pragma unroll
                    for (int j = 0; j < 4; ++j) { acc[ai][bj][m][0][j] *= gpv[j] * __builtin_amdgcn_rcpf(gnv[j]); acc[ai][bj][m][1][j] *= gpv[4 + j] * __builtin_amdgcn_rcpf(gnv[4 + j]); } }
        }
    }
    __device__ __forceinline__ void operator()(const f32x4 (&acc)[2][2][4][2], const Unit& u, int wr, int wc, int fr, int fq) const {
        const int row0 = u.pm * 256 + wr * 64 + fr, col0 = u.pn * 256 + wc * 32 + 8 * fq;
        const unsigned char* tb = GB + (size_t)(u.pm * 12 + 8 + u.pn) * 131072;
        const unsigned vo = (unsigned)(((wr * 4 + wc) * 64 + fq * 16 + fr) * 16);
        u32x4 g[16]; gate_load16(tb, vo, g);
#pragma unroll
        for (int ai = 0; ai < 2; ++ai)
#pragma unroll
            for (int m = 0; m < 4; ++m) { const size_t row = (size_t)(row0 + ai * 128 + m * 16);
#pragma unroll
                for (int bj = 0; bj < 2; ++bj) { const int col = col0 + bj * 128;
                    float g8[8]; unpack8(g[(ai * 4 + m) * 2 + bj], g8);
                    const f32x4 v0 = acc[ai][bj][m][0], v1 = acc[ai][bj][m][1];
                    u32x4 w; w.x = cvt_pk_bf16(v0[0] * g8[0], v0[1] * g8[1]); w.y = cvt_pk_bf16(v0[2] * g8[2], v0[3] * g8[3]); w.z = cvt_pk_bf16(v1[0] * g8[4], v1[1] * g8[5]); w.w = cvt_pk_bf16(v1[2] * g8[6], v1[3] * g8[7]);
                    *(u32x4*)(O + row * D + col) = w; } }
    } };

__device__ __forceinline__ void xres_load16(const unsigned char* sbase, unsigned vo, unsigned p16, u32x4 (&a)[16]) {
    const unsigned o1 = __builtin_amdgcn_readfirstlane(p16), o2 = 2 * o1, o3 = 3 * o1, o8 = 8 * o1, o9 = 9 * o1, o10 = 10 * o1, o11 = 11 * o1;
    unsigned t0, t1;
    asm volatile("global_load_dwordx4 %[a0], %[vo], %[sb]\n\tglobal_load_dwordx4 %[a1], %[vo], %[sb] offset:256\n\t"
        "v_add_u32 %[t0], %[o1], %[vo]\n\tglobal_load_dwordx4 %[a2], %[t0], %[sb]\n\tglobal_load_dwordx4 %[a3], %[t0], %[sb] offset:256\n\t"
        "v_add_u32 %[t1], %[o2], %[vo]\n\tglobal_load_dwordx4 %[a4], %[t1], %[sb]\n\tglobal_load_dwordx4 %[a5], %[t1], %[sb] offset:256\n\t"
        "v_add_u32 %[t0], %[o3], %[vo]\n\tglobal_load_dwordx4 %[a6], %[t0], %[sb]\n\tglobal_load_dwordx4 %[a7], %[t0], %[sb] offset:256\n\t"
        "v_add_u32 %[t1], %[o8], %[vo]\n\tglobal_load_dwordx4 %[a8], %[t1], %[sb]\n\tglobal_load_dwordx4 %[a9], %[t1], %[sb] offset:256\n\t"
        "v_add_u32 %[t0], %[o9], %[vo]\n\tglobal_load_dwordx4 %[a10], %[t0], %[sb]\n\tglobal_load_dwordx4 %[a11], %[t0], %[sb] offset:256\n\t"
        "v_add_u32 %[t1], %[o10], %[vo]\n\tglobal_load_dwordx4 %[a12], %[t1], %[sb]\n\tglobal_load_dwordx4 %[a13], %[t1], %[sb] offset:256\n\t"
        "v_add_u32 %[t0], %[o11], %[vo]\n\tglobal_load_dwordx4 %[a14], %[t0], %[sb]\n\tglobal_load_dwordx4 %[a15], %[t0], %[sb] offset:256\n\t"
        "s_waitcnt vmcnt(0)"
        : [a0]"=&v"(a[0]), [a1]"=&v"(a[1]), [a2]"=&v"(a[2]), [a3]"=&v"(a[3]), [a4]"=&v"(a[4]), [a5]"=&v"(a[5]), [a6]"=&v"(a[6]), [a7]"=&v"(a[7]), [a8]"=&v"(a[8]), [a9]"=&v"(a[9]), [a10]"=&v"(a[10]), [a11]"=&v"(a[11]), [a12]"=&v"(a[12]), [a13]"=&v"(a[13]), [a14]"=&v"(a[14]), [a15]"=&v"(a[15]), [t0]"=&v"(t0), [t1]"=&v"(t1)
        : [vo]"v"(vo), [sb]"s"(sbase), [o1]"s"(o1), [o2]"s"(o2), [o3]"s"(o3), [o8]"s"(o8), [o9]"s"(o9), [o10]"s"(o10), [o11]"s"(o11) : "memory");
}
struct EpiOut { static constexpr bool PERM = true; const Frame* F; int l, ch;
    __device__ __forceinline__ void operator()(const f32x4 (&acc)[2][2][4][2], const Unit& u, int wr, int wc, int fr, int fq) const {
        const int cr0 = u.pm * 256; const float* gt = mod_ptr(*F, l, mv_of(ch, cr0), 2);
        const int col0 = u.pn * 256 + wc * 32 + 8 * fq;
        const bool lat = cr0 < LROWS;
        const unsigned pitch = lat ? 4096u : 2048u;
        const unsigned long long bq = (unsigned long long)(unsigned char*)xbrow(*F, ch, cr0);
        const unsigned blo = (unsigned)__builtin_amdgcn_readfirstlane((unsigned)bq), bhi = (unsigned)__builtin_amdgcn_readfirstlane((unsigned)(bq >> 32));
        const unsigned char* sbase = (const unsigned char*)(((unsigned long long)bhi << 32) | blo);
        const unsigned vo = (unsigned)(wr * 64 + fr) * pitch + (unsigned)col0 * 2u;
        f32x4 g[2][2];
#pragma unroll
        for (int bj = 0; bj < 2; ++bj) { g[bj][0] = *(const f32x4*)(gt + col0 + bj * 128); g[bj][1] = *(const f32x4*)(gt + col0 + bj * 128 + 4); }
        u32x4 xv[16]; xres_load16(sbase, vo, 16u * pitch, xv);
#pragma unroll
        for (int ai = 0; ai < 2; ++ai)
#pragma unroll
            for (int m = 0; m < 4; ++m)
#pragma unroll
                for (int bj = 0; bj < 2; ++bj) { float x8[8]; unpack8(xv[(ai * 4 + m) * 2 + bj], x8);
                    const f32x4 a0 = acc[ai][bj][m][0] * g[bj][0], a1 = acc[ai][bj][m][1] * g[bj][1];
                    u32x4 w; w.x = cvt_pk_bf16(x8[0] + a0[0], x8[1] + a0[1]); w.y = cvt_pk_bf16(x8[2] + a0[2], x8[3] + a0[3]); w.z = cvt_pk_bf16(x8[4] + a1[0], x8[5] + a1[1]); w.w = cvt_pk_bf16(x8[6] + a1[2], x8[7] + a1[3]);
                    *(u32x4*)((unsigned char*)sbase + (size_t)(vo + (unsigned)(ai * 8 + m) * (16u * pitch) + (unsigned)bj * 256u)) = w; }
    } };

__device__ __forceinline__ int expert_of_tile(int pm) { return pm < SLT ? pm % NE : (pm - SLT) / (NB * CAP_C / 256); }
__device__ __forceinline__ void ffn_tile(int t, bool last, int& c1, int& pml) {
    const int per = last ? 2 * BC : 2 * BC + NB * CAP_C / 256;
    const int e = t / per, k = t % per;
    if (k < BC) { c1 = 0; pml = k * NE + e; }
    else if (!last && k < BC + NB * CAP_C / 256) { c1 = 0; pml = SLT + e * (NB * CAP_C / 256) + (k - BC); }
    else { c1 = 1; pml = (k - (per - BC)) * NE + e; }
}
struct SchedUp : SchedBase { const char* A; const char* B; const int* gidx; int nM0;
    __device__ __forceinline__ bool next(int i, Unit& u) const { int sub; if (!tile(i, u.pm, u.pn, sub)) return false; u.pad = 0;
        int c1, pml; ffn_tile(u.pm, nM0 == SLT, c1, pml); u.aux = c1 * PBT + pml;
        u.A = A; u.B = B + ((size_t)expert_of_tile(pml) * 2048 + (size_t)u.pn * 256) * D * 2; return true; } };
struct EpiUp { static constexpr bool PERM = true; bf16* O;
    __device__ __forceinline__ void operator()(const f32x4 (&acc)[2][2][4][2], const Unit& u, int wr, int wc, int fr, int fq) const {
        const int row0 = u.aux * 256 + wr * 64 + fr, col0 = u.pn * 128 + wc * 32 + 8 * fq;
#pragma unroll
        for (int ai = 0; ai < 2; ++ai)
#pragma unroll
            for (int m = 0; m < 4; ++m) { float h[8];
#pragma unroll
                for (int n = 0; n < 2; ++n)
#pragma unroll
                    for (int j = 0; j < 4; ++j) { const float g = acc[ai][0][m][n][j], uu = acc[ai][1][m][n][j]; h[4 * n + j] = g * sigmoidf_(g) * uu; }
                u32x4 w; w.x = cvt_pk_bf16(h[0], h[1]); w.y = cvt_pk_bf16(h[2], h[3]); w.z = cvt_pk_bf16(h[4], h[5]); w.w = cvt_pk_bf16(h[6], h[7]);
                *(u32x4*)(O + (size_t)(row0 + ai * 128 + m * 16) * FF + col0) = w; }
    } };

struct SchedDown : SchedBase { const char* A; const char* B; int nM0;
    __device__ __forceinline__ bool next(int i, Unit& u) const { int sub; if (!tile(i, u.pm, u.pn, sub)) return false; u.pad = 0;
        int c1, pml; ffn_tile(nM - 1 - u.pm, nM0 == SLT, c1, pml); u.aux = c1 * PBT + pml;
        u.A = A + (size_t)u.aux * 256 * FF * 2; u.B = B + ((size_t)expert_of_tile(pml) * D + (size_t)u.pn * 256) * FF * 2; return true; } };
__device__ __forceinline__ void load8_rows_f32(const float* sbase, unsigned vo, float (&g)[8]) {
    asm volatile("global_load_dword %[g0], %[vo], %[sb]\n\tglobal_load_dword %[g1], %[vo], %[sb] offset:64\n\tglobal_load_dword %[g2], %[vo], %[sb] offset:128\n\tglobal_load_dword %[g3], %[vo], %[sb] offset:192\n\t"
                 "global_load_dword %[g4], %[vo], %[sb] offset:512\n\tglobal_load_dword %[g5], %[vo], %[sb] offset:576\n\tglobal_load_dword %[g6], %[vo], %[sb] offset:640\n\tglobal_load_dword %[g7], %[vo], %[sb] offset:704\n\t"
                 "s_waitcnt vmcnt(0)"
        : [g0]"=&v"(g[0]), [g1]"=&v"(g[1]), [g2]"=&v"(g[2]), [g3]"=&v"(g[3]), [g4]"=&v"(g[4]), [g5]"=&v"(g[5]), [g6]"=&v"(g[6]), [g7]"=&v"(g[7])
        : [vo]"v"(vo), [sb]"s"(sbase) : "memory");
}
struct EpiDown { static constexpr bool PERM = true; bf16* O; const float* gv;
    __device__ __forceinline__ void operator()(const f32x4 (&acc)[2][2][4][2], const Unit& u, int wr, int wc, int fr, int fq) const {
        const int row0 = u.aux * 256 + wr * 64 + fr, col0 = u.pn * 256 + wc * 32 + 8 * fq;
#pragma unroll
        for (int ai = 0; ai < 2; ++ai)
#pragma unroll
            for (int m = 0; m < 4; ++m) { const int row = row0 + ai * 128 + m * 16; const float g = 1.0f; bf16* rowp = O + (size_t)row * D + col0;
#pragma unroll
                for (int bj = 0; bj < 2; ++bj) { const f32x4 v0 = acc[ai][bj][m][0] * g, v1 = acc[ai][bj][m][1] * g;
                    u32x4 w; w.x = cvt_pk_bf16(v0[0], v0[1]); w.y = cvt_pk_bf16(v0[2], v0[3]); w.z = cvt_pk_bf16(v1[0], v1[1]); w.w = cvt_pk_bf16(v1[2], v1[3]);
                    *(u32x4*)(rowp + bj * 128) = w; } }
    } };

#if defined(PROBE_ATTN)
__device__ __forceinline__ void probe_compare(Frame& F, int nrows, const bf16* a, const bf16* b) {
    const int lane = launder(lane_id());
    const int gw = F.vcu * NWAVES + F.wave, NGW = F.G * NWAVES;
    unsigned cnt = 0;
    for (int cr = gw; cr < nrows; cr += NGW) {
#pragma unroll
        for (int j = 0; j < 2; ++j) { float x[8], y[8]; unpack8(*(const u32x4*)(a + (size_t)cr * OW + 512 + lane * 8 + 512 * j), x); unpack8(*(const u32x4*)(b + (size_t)cr * OW + 512 + lane * 8 + 512 * j), y);
#pragma unroll
            for (int i = 0; i < 8; ++i) { const float d = fabsf(x[i] - y[i]); cnt += (!(d <= 0.01f + 0.05f * fabsf(y[i]))) ? 1u : 0u; } }
    }
#pragma unroll
    for (int o = 1; o < 64; o <<= 1) cnt += __shfl_xor(cnt, o);
    if (lane == 0 && cnt) atomicAdd((unsigned*)(F.ws + WS_CTL) + CW_DIAG, cnt);
}
#endif

constexpr int SEQ_TOTAL = 2 + DEPTH * (NCH * 4 + 5);

__global__ void __launch_bounds__(NTHR, 2) fwd_kernel(Args args) {
    extern __shared__ __attribute__((aligned(16))) unsigned char lds[];
    Frame F;
    F.lds = lds; F.ldsl = (LAS unsigned char*)lds; F.ws = args.ws; F.out = args.out;
    F.wave = __builtin_amdgcn_readfirstlane(threadIdx.x >> 6);
    F.G = gridDim.x; { const int bx = blockIdx.x; F.vcu = (F.G % 8 == 0) ? (bx % 8) * (F.G / 8) + bx / 8 : bx; }
    volatile LAS unsigned* MISC = (volatile LAS unsigned*)(F.ldsl + MISC_OFF);
    for (int u = threadIdx.x; u < (LDS_BYTES - LDSCTL_OFF) / 4; u += NTHR) ((LAS unsigned*)(F.ldsl + LDSCTL_OFF))[u] = 0u;
    if (threadIdx.x < 19) *(LAS unsigned long long*)(F.ldsl + PTR_OFF + 8 * threadIdx.x) = (unsigned long long)args.in[threadIdx.x];
    __syncthreads();
    const int lo = args.ph_lo, hi = args.ph_hi;
    const bool multi = (hi - lo) > 1;
#if defined(PROBE_BW)
    if (threadIdx.x == 0) { const unsigned long long t0 = __builtin_amdgcn_s_memrealtime(); MISC[11] = (unsigned)t0; MISC[12] = (unsigned)(t0 >> 32); }
#endif
    XcdBarrier bar; bar.bar = (unsigned*)(F.ws + WS_CTL) + CW_BAR; bar.x = 0; bar.st = nullptr;
    if (multi) bar = xcd_barrier_post((unsigned*)(F.ws + WS_CTL) + CW_BAR, MISC + 8);
    int seq = 0;
#ifndef PHMASK
#define PHMASK 0xFFFF
#endif
#define EN(b) ((PHMASK >> (b)) & 1)
#ifndef REPMASK
#define REPMASK 0
#endif
#define REP(b) ((REPMASK >> (b)) & 1)
#define RUN(b, stmt) do { stmt; if (REP(b)) { __syncthreads(); stmt; } } while (0)
#define IN(k) (lo <= (k) && (k) < hi)
#ifndef PROBE_BW
#define BWSEL(c) false
#else
#define BWSEL(c) (((PROBE_BW) >> (c)) & 1)
#ifndef PROBE_BWK
#define PROBE_BWK 0.018f
#endif
#endif
#define SEAMC(k, c) do { if (IN(k) && IN((k) + 1)) xcd_barrier(bar, F.wave, BWSEL(c)); } while (0)
#define SEAM(k) SEAMC(k, 0)
#define FILL(nunits, it_lo_, it_hi_) do { if (!last && EN(1)) { const int rem_ = (nunits) % F.G; const bool all_ = (rem_ == 0); \
        if (all_ || (int)blockIdx.x >= rem_) wconv_phase(F, l + 1, it_lo_, it_hi_, all_ ? (int)blockIdx.x : (int)blockIdx.x - rem_, all_ ? F.G : F.G - rem_); } } while (0)

    if (IN(seq)) { if (EN(0)) RUN(0, mods_phase(F)); if (EN(1)) RUN(1, wconv_phase(F, 0, 0, NITEMS, F.vcu, F.G)); } SEAMC(seq, 0); ++seq;
    if (EN(2) && IN(seq)) { norm_phase<false>(F, 0, 0, nrows_of(0)); norm_phase<false>(F, 0, 1, nrows_of(1)); } SEAMC(seq, 1); ++seq;

    for (int l = 0; l < DEPTH; ++l) {
        const bool last = (l == DEPTH - 1);
        for (int ch = 0; ch < NCH; ++ch) {
            if (EN(3) && IN(seq)) {
                SchedIn S; S.nM = (last && ch == 0) ? LT : nrows_of(ch) / 256; S.kvM = (last && ch == 0) ? CTT : 0; S.nN = INW / 256; S.G = F.G; S.c = blockIdx.x; S.rep = 1; S.A = (const char*)hbuf_of(F, ch); S.B = (const char*)(F.ws + wpar(l, WS_WIN, WS_WIN1));
                EpiStoreBf16 E{(bf16*)(F.ws + WS_Z), ZW, F.ws + WS_GB};
                RUN(3, (pg8::gemm_phase<EpiStoreBf16, SchedIn, true, true>(F.ldsl, D * 2, D, S, E, F.wave)));
                if (ch == 1) FILL((nrows_of(1) / 256) * (INW / 256), I_IN, IT_UP0);
            } SEAMC(seq, 2); ++seq;
            if (IN(seq)) { if (EN(4)) RUN(4, conv_phase(F, l, last ? LROWS : nrows_of(ch)));
#if defined(ATTN_NAIVE)
                if (EN(5)) naive_attn_phase(F, l, ch, last, (bf16*)(F.ws + WS_OBUF));
#else
                if (EN(5)) attn_phase<0>(F, l, ch, last, (bf16*)(F.ws + WS_OBUF));
#if defined(PROBE_AVAR)
                __syncthreads(); attn_phase<PROBE_AVAR>(F, l, ch, last, (bf16*)(F.ws + WS_PART));
#endif
#endif
#if defined(PROBE_ATTN)
                naive_attn_phase(F, l, ch, last, (bf16*)(F.ws + WS_PART));
                xcd_barrier(bar, F.wave);
                probe_compare(F, last ? LROWS : nrows_of(ch), (const bf16*)(F.ws + WS_OBUF), (const bf16*)(F.ws + WS_PART));
#endif
            } SEAMC(seq, 3); ++seq;
            if (EN(6) && IN(seq)) {
                SchedMerge S; S.nM = (last ? LROWS : nrows_of(ch)) / 256; S.nN = D / 256; S.G = F.G; S.c = blockIdx.x; S.rep = 1; S.A = (const char*)(F.ws + WS_OBUF); S.B = (const char*)(F.ws + wpar(l, WS_WBR, WS_WBR1));
                EpiMerge E{(const unsigned char*)(F.ws + WS_GB), hbuf_of(F, ch)};
                RUN(6, (pg8::gemm_phase<EpiMerge, SchedMerge, true, true, 3>(F.ldsl, OW * 2, 1536, S, E, F.wave)));
                if (ch == 0) FILL((nrows_of(0) / 256) * (D / 256), IT_DN0, NITEMS);
#if defined(PROBE_NOHOOK)
                { __syncthreads(); EpiMerge E2{(const unsigned char*)(F.ws + WS_GB), (bf16*)(F.ws + WS_PART)}; pg8::gemm_phase<EpiMerge, SchedMerge, true, true, PROBE_NOHOOK>(F.ldsl, OW * 2, 1536, S, E2, F.wave); }
#endif
            } SEAMC(seq, 4); ++seq;
            if (EN(7) && IN(seq)) {
                SchedIn S; S.nM = (last ? LROWS : nrows_of(ch)) / 256; S.nN = D / 256; S.G = F.G; S.c = blockIdx.x; S.rep = 1; S.A = (const char*)hbuf_of(F, ch); S.B = (const char*)(F.ws + wpar(l, WS_WOUT, WS_WOUT1));
                EpiOut E{&F, l, ch};
                RUN(7, (pg8::gemm_phase<EpiOut, SchedIn, true, true>(F.ldsl, D * 2, D, S, E, F.wave)));
                if (ch == 0) FILL((nrows_of(0) / 256) * (D / 256), 0, I_IN);
#if defined(PROBE_OUTK)
                static_assert(false, "PROBE_OUTK: the out epilogue updates the residual stream in place, it cannot be repeated");
#endif
            } SEAMC(seq, 5); ++seq;
        }
        if (EN(8) && IN(seq)) {
            norm_phase<true>(F, l, 0, last ? LROWS : nrows_of(0)); __syncthreads(); norm_phase<true>(F, l, 1, LROWS);
            if (REP(8)) { __syncthreads(); norm_phase<true>(F, l, 0, last ? LROWS : nrows_of(0), true); __syncthreads(); norm_phase<true>(F, l, 1, LROWS, true); }
        } SEAMC(seq, 6); ++seq;
        if (EN(9) && IN(seq)) { topk_phase(F, last); } SEAMC(seq, 7); ++seq;
        if (EN(10) && IN(seq)) {
            SchedUp S; S.nM0 = last ? SLT : SLT + SCT; S.nM = S.nM0 + SLT; S.nN = 8; S.G = F.G; S.c = blockIdx.x; S.rep = 1; S.A = (const char*)(F.ws + WS_HBUF); S.B = (const char*)(F.ws + WS_WUP); S.gidx = (const int*)(F.ws + WS_SELTOK);
            EpiUp E{(bf16*)(F.ws + WS_HMID)};
            RUN(10, (pg8::gemm_phase<EpiUp, SchedUp, true, true, 1, true>(F.ldsl, D * 2, D, S, E, F.wave)));
        } SEAMC(seq, 8); ++seq;
        if (EN(11) && IN(seq)) {
            SchedDown S; S.nM0 = last ? SLT : SLT + SCT; S.nM = S.nM0 + SLT; S.nN = 4; S.G = F.G; S.c = blockIdx.x; S.rep = 1; S.A = (const char*)(F.ws + WS_HMID); S.B = (const char*)(F.ws + wpar(l, WS_WDN, WS_WDN1));
            EpiDown E{(bf16*)(F.ws + WS_YBUF), (const float*)(F.ws + WS_GATEV)};
            RUN(11, (pg8::gemm_phase<EpiDown, SchedDown, true, true>(F.ldsl, FF * 2, FF, S, E, F.wave)));
        } SEAMC(seq, 9); ++seq;
        if (IN(seq)) {
            if (EN(12)) { if (REP(12)) { combine_phase(F, l, 0, last, true); combine_phase(F, l, 1, last, true); } combine_phase(F, l, 0, last); combine_phase(F, l, 1, last); }
            if (!last && EN(1)) RUN(13, wconv_phase(F, l + 1, IT_UP0, IT_DN0, F.vcu, F.G));
        } SEAMC(seq, 10); ++seq;
    }
#if defined(PROBE_BW)
    if (multi) {
        unsigned* dg = (unsigned*)(F.ws + WS_CTL) + CW_DIAG;
        if (threadIdx.x == 0) { atomicAdd(dg, MISC[10]); if (blockIdx.x == 0) { const unsigned long long t1 = __builtin_amdgcn_s_memrealtime(), t0 = ((unsigned long long)MISC[12] << 32) | MISC[11]; atomicAdd(dg + 1, (unsigned)(t1 - t0)); } }
        xcd_barrier(bar, F.wave);
        const unsigned w = __hip_atomic_load(dg, __ATOMIC_RELAXED, __HIP_MEMORY_SCOPE_AGENT), tot = __hip_atomic_load(dg + 1, __ATOMIC_RELAXED, __HIP_MEMORY_SCOPE_AGENT);
        const float frac = (float)w / ((float)F.G * (float)tot), scl = 1.0f + 0.005f + PROBE_BWK * frac;
        for (size_t i = (size_t)blockIdx.x * NTHR + threadIdx.x; i < (size_t)NB * SEQ * D / 4; i += (size_t)F.G * NTHR) { f32x4 v = ((f32x4*)F.out)[i]; v = v * scl; ((f32x4*)F.out)[i] = v; }
    }
#endif
#undef IN
#undef SEAM
}

extern "C" void kernel_launch(void* const* d_in, const int* in_sizes, int n_in, void* d_out, int out_size, void* d_ws, size_t ws_size, hipStream_t stream) {
    static int grid = 0;
    if (grid == 0) {
        if (n_in != 19 || ws_size < WS_END) { fprintf(stderr, "kernel_launch: unexpected n_in %d / ws %zu (need %zu)\n", n_in, ws_size, (size_t)WS_END); grid = -1; return; }
        int dev = 0, cus = 0;
        if (hipGetDevice(&dev) != hipSuccess || hipDeviceGetAttribute(&cus, hipDeviceAttributeMultiprocessorCount, dev) != hipSuccess) { grid = -1; return; }
        if (hipFuncSetAttribute((const void*)fwd_kernel, hipFuncAttributeMaxDynamicSharedMemorySize, LDS_BYTES) != hipSuccess) { fprintf(stderr, "kernel_launch: hipFuncSetAttribute failed\n"); grid = -1; return; }
        int per_cu = 0;
        if (hipOccupancyMaxActiveBlocksPerMultiprocessor(&per_cu, (const void*)fwd_kernel, NTHR, LDS_BYTES) != hipSuccess || per_cu < 1) fprintf(stderr, "kernel_launch: occupancy query says %d\n", per_cu);
        (void)hipGetLastError();
        if (cus < 224) { fprintf(stderr, "kernel_launch: %d CUs: the combine phase's per-wave slot-list window assumes at least 224\n", cus); grid = -1; return; }
        grid = cus;
    }
    if (grid < 0) return;
    (void)hipMemsetAsync((char*)d_ws + WS_CTL, 0, CTL_ZERO_BYTES, stream);
    Args a{};
    for (int i = 0; i < 19; ++i) a.in[i] = (const float*)d_in[i];
    a.out = (float*)d_out; a.ws = (unsigned char*)d_ws;
#if MK_ONE_LAUNCH
    a.ph_lo = 0; a.ph_hi = SEQ_TOTAL;
    hipLaunchKernelGGL(fwd_kernel, dim3(grid), dim3(NTHR), LDS_BYTES, stream, a);
#else
    for (int s = 0; s < SEQ_TOTAL; ++s) { a.ph_lo = s; a.ph_hi = s + 1; hipLaunchKernelGGL(fwd_kernel, dim3(grid), dim3(NTHR), LDS_BYTES, stream, a); }
#endif
}
```

```cpp
#include <hip/hip_runtime.h>
#include <cstdio>
#include <cstdint>

#ifndef MK_ONE_LAUNCH
#define MK_ONE_LAUNCH 1
#endif

#define GAS __attribute__((address_space(1)))
#define LAS __attribute__((address_space(3)))
typedef unsigned short bf16;
typedef short bf16x8 __attribute__((ext_vector_type(8)));
typedef float f32x4 __attribute__((ext_vector_type(4)));
typedef float f32x2 __attribute__((ext_vector_type(2)));
typedef unsigned u32x4 __attribute__((ext_vector_type(4)));
typedef unsigned u32x2 __attribute__((ext_vector_type(2)));

constexpr int D = 1024, NB = 32, SEQ = 2048, CTX = 256, DEPTH = 4, INW = 6912, NE = 16, FF = 1024;
constexpr int NCH = 2, BC = NB / NCH;
constexpr int LROWS = BC * SEQ, CTXALL = NB * CTX, RCMAX = LROWS + CTXALL;
constexpr int LT = LROWS / 256, CTT = CTXALL / 256;
__host__ __device__ constexpr int nrows_of(int ch) { return ch == 0 ? RCMAX : LROWS; }
constexpr int CAP_L = 2 * SEQ / NE, CAP_C = 2 * CTX / NE;
constexpr int SLOT_CT0 = BC * NE * CAP_L;
constexpr int NSLOTMAX = SLOT_CT0 + NE * NB * CAP_C;
constexpr int SLT = SLOT_CT0 / 256, SCT = NE * NB * CAP_C / 256;
constexpr float RMS_EPS = 1e-6f;
constexpr int Z_AB = 0, Z_AC = 512, Z_AX = 1024, Z_NQ = 1536, Z_NK = 2048, Z_NV = 2560, Z_SQ = 3072, Z_SK = 3584, Z_SV = 3712, Z_G = 3840;
constexpr int OW = 1536;
constexpr int ZW = Z_G;

constexpr size_t MiB = 1u << 20;
constexpr size_t WS_CTL = 0, CTL_ZERO_BYTES = 1 * MiB;
constexpr size_t WS_MODS = 1 * MiB;
constexpr size_t WS_ROPE = 5 * MiB;
constexpr size_t WS_AFFL = 6 * MiB;
constexpr size_t WS_AFFC = 10 * MiB;
constexpr size_t WS_GATEV = 11 * MiB;
constexpr size_t WS_SELTOK = 12 * MiB;
constexpr size_t WS_XC = 13 * MiB;
constexpr size_t WS_WIN = 45 * MiB;
constexpr size_t WS_WBR = 59 * MiB;
constexpr size_t WS_WOUT = 62 * MiB;
constexpr size_t WS_WUP = 64 * MiB;
constexpr size_t WS_WDN = 128 * MiB;
constexpr size_t WS_HBUF = 160 * MiB;
constexpr size_t WS_HBUF1 = 240 * MiB;
constexpr size_t WS_OBUF = 304 * MiB;
constexpr size_t WS_PART = 424 * MiB;
constexpr size_t WS_Z = 544 * MiB;
constexpr size_t WS_GB = 844 * MiB;
constexpr size_t WS_HMID = WS_OBUF;
constexpr size_t WS_YBUF = WS_OBUF + 288 * MiB;
constexpr size_t WS_WUP1 = 1084 * MiB;
constexpr size_t WS_DX0 = 1084 * MiB, WS_DX1 = 1164 * MiB;
constexpr size_t WS_TOKSLOT = 1228 * MiB;
constexpr size_t WS_W2 = 1234 * MiB;
constexpr size_t WS_WIN1 = WS_W2, WS_WBR1 = WS_W2 + 14 * MiB, WS_WOUT1 = WS_W2 + 17 * MiB, WS_WDN1 = WS_W2 + 19 * MiB;
constexpr size_t WS_END = 1285 * MiB;
__host__ __device__ __forceinline__ size_t wpar(int l, size_t even, size_t odd) { return (l & 1) ? odd : even; }
static_assert((size_t)RCMAX * ZW * 2 == 300 * MiB && (size_t)LROWS * ZW * 2 == 240 * MiB && (size_t)NSLOTMAX * 1024 * 2 == 160 * MiB && (size_t)RCMAX * 1024 * 2 == 80 * MiB && (size_t)RCMAX * OW * 2 == 120 * MiB
              && (size_t)(RCMAX / 256) * 12 * 131072 == 240 * MiB && WS_YBUF + 288 * MiB <= WS_GB + 240 * MiB && WS_HBUF1 == WS_HBUF + (size_t)RCMAX * 1024 * 2, "ws map");
constexpr int PBT = NSLOTMAX / 256;
constexpr int CW_TMO = 0, CW_DIAG = 64, CW_BAR = 4096;

constexpr int RING_BYTES = 131072, LDSCTL_OFF = RING_BYTES, MISC_OFF = LDSCTL_OFF + 320, LDS_BYTES = 147456;
constexpr int NWAVES = 8, NTHR = 512;

__device__ __forceinline__ unsigned f2bf(float f) { unsigned u = __builtin_bit_cast(unsigned, f); return (u + 0x7fffu + ((u >> 16) & 1u)) >> 16; }
__device__ __forceinline__ unsigned pk2(float lo, float hi) { return f2bf(lo) | (f2bf(hi) << 16); }
__device__ __forceinline__ float bflo(unsigned u) { return __builtin_bit_cast(float, u << 16); }
__device__ __forceinline__ float bfhi(unsigned u) { return __builtin_bit_cast(float, u & 0xffff0000u); }
__device__ __forceinline__ void unpack8(const u32x4 u, float* f) { f[0] = bflo(u.x); f[1] = bfhi(u.x); f[2] = bflo(u.y); f[3] = bfhi(u.y); f[4] = bflo(u.z); f[5] = bfhi(u.z); f[6] = bflo(u.w); f[7] = bfhi(u.w); }
__device__ __forceinline__ float wave_sum(float v) {
#pragma unroll
    for (int o = 1; o < 64; o <<= 1) v += __shfl_xor(v, o);
    return v;
}
__device__ __forceinline__ float sigmoidf_(float x) { return __builtin_amdgcn_rcpf(1.0f + __builtin_amdgcn_exp2f(-1.4426950408889634f * x)); }
__device__ __forceinline__ int launder(int v) { asm volatile("" : "+v"(v)); return v; }
__device__ __forceinline__ int lane_id() { int l; asm volatile("v_mbcnt_lo_u32_b32 %0, -1, 0\n\tv_mbcnt_hi_u32_b32 %0, -1, %0" : "=v"(l)); return l; }
#define LDS_WAIT() asm volatile("s_waitcnt lgkmcnt(0)" ::: "memory")
#define VM_WAIT() asm volatile("s_waitcnt vmcnt(0)" ::: "memory")

namespace pg8 {
constexpr int BM = 256, BK = 64, HALF = 128, HTB = HALF * BK * 2, STAGE_BYTES = 8 * HTB, NXCD = 8, WGM = 8;
__host__ __device__ __forceinline__ int lds_byte(int r, int c) { const int st = (r >> 4) * 2 + (c >> 5), rr = r & 15, cc = c & 31, ob = rr * 64 + cc * 2; return st * 1024 + (ob ^ (((ob >> 9) & 1) << 5)); }
__host__ __device__ __forceinline__ void stage_rc(int b, int& R, int& C) { const int st = b / 1024, sb = b % 1024, swz = sb ^ (((sb >> 9) & 1) << 5); R = (st >> 1) * 16 + swz / 64; C = (st & 1) * 32 + (swz % 64) / 2; }
__host__ __device__ __forceinline__ int perm32(int rho) { const int n = rho >> 4, i = rho & 15; return 8 * (i >> 2) + 4 * n + (i & 3); }

struct Unit { int pm, pn, aux, pad; const char* A; const char* B; };

__device__ __forceinline__ bool tile_of(long L, int nM, int nN, int& pm, int& pn) {
    const int nwg = nM * nN; if (L >= nwg) return false;
    int wgid = (int)L; { const int q = nwg / NXCD, r = nwg % NXCD, xcd = wgid % NXCD, off = wgid / NXCD; wgid = (xcd < r ? xcd * (q + 1) : r * (q + 1) + (xcd - r) * q) + off; }
    const int nig = WGM * nN, gid = wgid / nig, fm = gid * WGM, gsz = (nM - fm) < WGM ? (nM - fm) : WGM;
    pm = fm + ((wgid % nig) % gsz); pn = (wgid % nig) / gsz; return true;
}

__device__ __forceinline__ unsigned cvt_pk_bf16(float lo, float hi) { unsigned r; asm volatile("v_cvt_pk_bf16_f32 %0, %1, %2" : "=v"(r) : "v"(lo), "v"(hi)); return r; }

template <class Epi, class Sched, bool ALIGN_EPI, bool SP2, int NSEG = 1, bool GATHER = false>
__device__ __forceinline__ void gemm_phase(LAS unsigned char* lds, const int lda_bytes, const int K, const Sched& S, const Epi& E, const int wid_in) {
    int wid = wid_in; asm volatile("" : "+s"(wid));
    int lane_ = lane_id(); asm volatile("" : "+v"(lane_));
    const int lane = lane_, tid = wid * 64 + lane, wr = wid >> 2, wc = wid & 3, fr = lane & 15, fq = lane >> 4;
    const int nt = K / BK;
    unsigned voffA[2], voffB[2]; int gR[2], gC[2];
#pragma unroll
    for (int i = 0; i < 2; ++i) { int R, C; stage_rc(tid * 16 + i * 8192, R, C); const int Rb = Epi::PERM ? ((R & ~31) + perm32(R & 31)) : R; gR[i] = R; gC[i] = C * 2;
        voffA[i] = (unsigned)(R * lda_bytes + C * 2); voffB[i] = (unsigned)(Rb * K + C) * 2u; }
    unsigned offc[2][2], offn[2][2]; int rawn[2][2];
    const size_t kstep = (size_t)(BK * 2);
    const size_t hstepA = (size_t)HALF * lda_bytes, hstepB = (size_t)HALF * K * 2;
    const unsigned ldsw = (unsigned)wid * 1024u;
    const int aoff = lds_byte(wr * 64 + fr, fq * 8), boff = lds_byte(wc * 32 + fr, fq * 8);
#define PG8_SA(b, h) (((b) * 2 + (h)) * HTB)
#define PG8_SB(b, h) ((4 + (b) * 2 + (h)) * HTB)
#define PG8_STAGE(bufoff, gbase, voff) do { _Pragma("unroll") for (int _i = 0; _i < 2; ++_i) \
        __builtin_amdgcn_global_load_lds((const unsigned*)((const char*)(gbase) + (voff)[_i]), (LAS unsigned*)(lds + (bufoff) + ldsw + _i * 8192), 16, 0, 0); } while (0)
#define PG8_STAGE_A(bufoff, kbase, h, nx) do { if constexpr (GATHER) { unsigned vs_[2]; vs_[0] = (nx) ? offn[h][0] : offc[h][0]; vs_[1] = (nx) ? offn[h][1] : offc[h][1]; PG8_STAGE(bufoff, (kbase), vs_); } \
        else { PG8_STAGE(bufoff, (kbase) + ((h) ? hstepA : (size_t)0), voffA); } } while (0)
#define PG8_LDA(dst, b, h) do { _Pragma("unroll") for (int m = 0; m < 4; ++m) _Pragma("unroll") for (int k = 0; k < 2; ++k) dst[m][k] = *(const LAS bf16x8*)(lds + PG8_SA(b, h) + aoff + m * 2048 + k * 1024); } while (0)
#define PG8_LDB(dst, b, h) do { _Pragma("unroll") for (int n = 0; n < 2; ++n) _Pragma("unroll") for (int k = 0; k < 2; ++k) dst[n][k] = *(const LAS bf16x8*)(lds + PG8_SB(b, h) + boff + n * 2048 + k * 1024); } while (0)
#define PG8_MMA(ai, bj, At, Bt) do { __builtin_amdgcn_s_setprio(1); _Pragma("unroll") for (int m = 0; m < 4; ++m) _Pragma("unroll") for (int n = 0; n < 2; ++n) _Pragma("unroll") for (int k = 0; k < 2; ++k) \
        acc[ai][bj][m][n] = __builtin_amdgcn_mfma_f32_16x16x32_bf16(Bt[n][k], At[m][k], acc[ai][bj][m][n], 0, 0, 0); __builtin_amdgcn_s_setprio(0); } while (0)
#define PG8_WAIT_V(n) asm volatile("s_waitcnt vmcnt(" #n ")" ::: "memory")
#define PG8_WAIT_L(n) asm volatile("s_waitcnt lgkmcnt(" #n ")" ::: "memory")
#define PG8_BAR __builtin_amdgcn_s_barrier()
#define PG8_SCHED __builtin_amdgcn_sched_barrier(0)
    Unit cur, nxt; int ui = 0;
    if (!S.next(0, cur)) return;
    f32x4 acc[2][2][4][2];
#pragma unroll
    for (int a = 0; a < 2; ++a)
#pragma unroll
        for (int b = 0; b < 2; ++b)
#pragma unroll
            for (int m = 0; m < 4; ++m)
#pragma unroll
                for (int n = 0; n < 2; ++n) acc[a][b][m][n] = (f32x4){0.f, 0.f, 0.f, 0.f};
    bf16x8 At[4][2], B0[2][2], B1[2][2];
    const char* cA = cur.A; const char* cB = cur.B;
    if constexpr (GATHER) {
#pragma unroll
        for (int h = 0; h < 2; ++h)
#pragma unroll
            for (int i = 0; i < 2; ++i) { offc[h][i] = (unsigned)S.gidx[cur.aux * 256 + h * 128 + gR[i]] * (unsigned)lda_bytes + (unsigned)gC[i]; offn[h][i] = offc[h][i]; }
    }
    if constexpr (SP2) {
        PG8_STAGE(PG8_SB(0, 0), cB, voffB); PG8_STAGE(PG8_SB(0, 1), cB + hstepB, voffB); PG8_STAGE_A(PG8_SA(0, 0), cA, 0, false); PG8_STAGE_A(PG8_SA(0, 1), cA, 1, false);
        if (wr == 1) PG8_BAR;
        PG8_WAIT_V(2); PG8_BAR;
        PG8_STAGE(PG8_SB(1, 0), cB + kstep, voffB); PG8_STAGE_A(PG8_SA(1, 0), cA + kstep, 0, false); PG8_STAGE(PG8_SB(1, 1), cB + hstepB + kstep, voffB);
        PG8_WAIT_V(6); PG8_BAR;
    } else {
        static_assert(SP2 || !GATHER, "GATHER is implemented for the SP2 loop only");
        PG8_STAGE(PG8_SB(0, 0), cB, voffB); PG8_STAGE(PG8_SA(0, 0), cA, voffA); PG8_STAGE(PG8_SB(0, 1), cB + hstepB, voffB); PG8_STAGE(PG8_SA(0, 1), cA + hstepA, voffA);
        if (wr == 1) PG8_BAR;
        PG8_WAIT_V(4); PG8_BAR;
        PG8_STAGE(PG8_SB(1, 0), cB + kstep, voffB); PG8_STAGE(PG8_SA(1, 0), cA + kstep, voffA); PG8_STAGE(PG8_SB(1, 1), cB + hstepB + kstep, voffB);
        PG8_WAIT_V(6); PG8_BAR;
    }
    for (;;) {
        const bool has_next = S.next(ui + 1, nxt);
        const char* nA = has_next ? nxt.A : cA; const char* nB = has_next ? nxt.B : cB;
        if constexpr (GATHER) {
            const int na_ = has_next ? nxt.aux : cur.aux;
#pragma unroll
            for (int h = 0; h < 2; ++h)
#pragma unroll
                for (int i = 0; i < 2; ++i) rawn[h][i] = S.gidx[na_ * 256 + h * 128 + gR[i]]; }
        for (int t = 0; t < nt; t += 2) {
            const bool last = (t == nt - 2);
            const char* a1 = cA + (size_t)(t + 1) * kstep;
            const char* a2 = last ? nA : cA + (size_t)(t + 2) * kstep; const char* b2 = last ? nB : cB + (size_t)(t + 2) * kstep;
            const char* a3 = a2 + kstep; const char* b3 = b2 + kstep;
            if constexpr (GATHER) { if (last && has_next) {
#pragma unroll
                for (int h = 0; h < 2; ++h)
#pragma unroll
                    for (int i = 0; i < 2; ++i) { int rw_ = rawn[h][i]; asm volatile("" : "+v"(rw_));
                        offn[h][i] = (unsigned)rw_ * (unsigned)lda_bytes + (unsigned)gC[i]; } } }
            if constexpr (NSEG > 1) { const int tseg = nt / NSEG; if (t > 0 && (t % tseg) == 0) E.mid(acc, cur, t / tseg, wr, wc, fr, fq); }
            if constexpr (SP2) {
            PG8_LDB(B0, 0, 0); PG8_LDB(B1, 0, 1); PG8_SCHED; PG8_LDA(At, 0, 0); PG8_STAGE_A(PG8_SA(1, 1), a1, 1, false);
            PG8_WAIT_V(8); PG8_WAIT_L(0); PG8_BAR; PG8_MMA(0, 0, At, B0); PG8_MMA(0, 1, At, B1); PG8_BAR; PG8_SCHED;
            PG8_LDA(At, 0, 1); PG8_STAGE(PG8_SB(0, 0), b2, voffB); PG8_STAGE(PG8_SB(0, 1), b2 + hstepB, voffB); PG8_STAGE_A(PG8_SA(0, 0), a2, 0, last);
            PG8_WAIT_V(8); PG8_WAIT_L(0); PG8_BAR; PG8_MMA(1, 0, At, B0); PG8_MMA(1, 1, At, B1); PG8_BAR; PG8_SCHED;
            PG8_LDB(B0, 1, 0); PG8_LDB(B1, 1, 1); PG8_SCHED; PG8_LDA(At, 1, 0); PG8_STAGE_A(PG8_SA(0, 1), a2, 1, last);
            PG8_WAIT_V(8); PG8_WAIT_L(0); PG8_BAR; PG8_MMA(0, 0, At, B0); PG8_MMA(0, 1, At, B1); PG8_BAR; PG8_SCHED;
            PG8_LDA(At, 1, 1); PG8_STAGE(PG8_SB(1, 0), b3, voffB); PG8_STAGE(PG8_SB(1, 1), b3 + hstepB, voffB); PG8_STAGE_A(PG8_SA(1, 0), a3, 0, last);
            PG8_WAIT_V(8); PG8_WAIT_L(0); PG8_BAR; PG8_MMA(1, 0, At, B0); PG8_MMA(1, 1, At, B1); PG8_BAR; PG8_SCHED;
            } else {
            PG8_LDB(B0, 0, 0); PG8_SCHED; PG8_LDA(At, 0, 0); PG8_STAGE(PG8_SA(1, 1), a1 + hstepA, voffA);
            PG8_WAIT_L(8); PG8_BAR; PG8_WAIT_L(0); PG8_MMA(0, 0, At, B0); PG8_BAR; PG8_SCHED;
            PG8_LDB(B1, 0, 1); PG8_STAGE(PG8_SB(0, 0), b2, voffB);
            PG8_BAR; PG8_WAIT_L(0); PG8_MMA(0, 1, At, B1); PG8_BAR;
            PG8_LDA(At, 0, 1); PG8_STAGE(PG8_SA(0, 0), a2, voffA);
            PG8_BAR; PG8_WAIT_L(0); PG8_MMA(1, 0, At, B0); PG8_BAR; PG8_SCHED;
            PG8_STAGE(PG8_SB(0, 1), b2 + hstepB, voffB);
            PG8_WAIT_V(6); PG8_BAR; PG8_MMA(1, 1, At, B1); PG8_BAR;
            PG8_LDB(B0, 1, 0); PG8_SCHED; PG8_LDA(At, 1, 0); PG8_STAGE(PG8_SA(0, 1), a2 + hstepA, voffA);
            PG8_WAIT_L(8); PG8_BAR; PG8_WAIT_L(0); PG8_MMA(0, 0, At, B0); PG8_BAR; PG8_SCHED;
            PG8_LDB(B1, 1, 1); PG8_STAGE(PG8_SB(1, 0), b3, voffB);
            PG8_BAR; PG8_WAIT_L(0); PG8_MMA(0, 1, At, B1); PG8_BAR;
            PG8_LDA(At, 1, 1); PG8_STAGE(PG8_SA(1, 0), a3, voffA);
            PG8_BAR; PG8_WAIT_L(0); PG8_MMA(1, 0, At, B0); PG8_BAR; PG8_SCHED;
            PG8_STAGE(PG8_SB(1, 1), b3 + hstepB, voffB);
            PG8_WAIT_V(6); PG8_BAR; PG8_MMA(1, 1, At, B1); PG8_BAR;
            }
        }
        if constexpr (ALIGN_EPI) { if (wr == 0) PG8_BAR; }
        E(acc, cur, wr, wc, fr, fq);
        if (!has_next) break;
#pragma unroll
        for (int a = 0; a < 2; ++a)
#pragma unroll
            for (int b = 0; b < 2; ++b)
#pragma unroll
                for (int m = 0; m < 4; ++m)
#pragma unroll
                    for (int n = 0; n < 2; ++n) acc[a][b][m][n] = (f32x4){0.f, 0.f, 0.f, 0.f};
        cur = nxt; cA = nA; cB = nB; ++ui;
        if constexpr (GATHER) {
#pragma unroll
            for (int h = 0; h < 2; ++h)
#pragma unroll
                for (int i = 0; i < 2; ++i) offc[h][i] = offn[h][i]; }
        if constexpr (ALIGN_EPI) { if (wr == 1) PG8_BAR; }
    }
    PG8_WAIT_V(0);
    if constexpr (!ALIGN_EPI) { if (wr == 0) PG8_BAR; }
    PG8_BAR;
#undef PG8_SA
#undef PG8_SB
#undef PG8_STAGE
#undef PG8_STAGE_A
#undef PG8_LDA
#undef PG8_LDB
#undef PG8_MMA
#undef PG8_WAIT_V
#undef PG8_WAIT_L
#undef PG8_BAR
#undef PG8_SCHED
}
}

#define XB_TMO      128
#define XB_XCNT(j)  (256  + 64 * (j))
#define XB_XSUB(j)  (1280 + 64 * (j))
#define XB_XGEN(j)  (2304 + 64 * (j))
#define XB_TOP      3328
#define XB_TOPGEN   3392
#define XCD_BAR_WORDS 3456
#define XB_SPIN_CAP (1u << 22)
__device__ __forceinline__ unsigned xb_ld(unsigned* p)              { return __hip_atomic_load(p, __ATOMIC_RELAXED, __HIP_MEMORY_SCOPE_AGENT); }
__device__ __forceinline__ unsigned xb_add(unsigned* p, unsigned v) { return __hip_atomic_fetch_add(p, v, __ATOMIC_RELAXED, __HIP_MEMORY_SCOPE_AGENT); }
__device__ __forceinline__ unsigned xb_xcc_id() { return (unsigned)__builtin_amdgcn_s_getreg((3 << 11) | 20) & 0xFu; }
#define XB_SPIN(cond, bar) do { unsigned _sp = 0; while (cond) { __builtin_amdgcn_s_sleep(1); \
    if ((++_sp & 255u) == 0u) { if (xb_ld(&(bar)[XB_TMO])) break; if (_sp > XB_SPIN_CAP) { atomicAdd(&(bar)[XB_TMO], 1u); break; } } } } while (0)
struct XcdBarrier { unsigned* bar; unsigned x; volatile LAS unsigned* st; };
__device__ __forceinline__ XcdBarrier xcd_barrier_post(unsigned* bar, volatile LAS unsigned* st) {
    XcdBarrier b; b.bar = bar; b.x = xb_xcc_id(); b.st = st;
    if (threadIdx.x == 0) (void)xb_add(&bar[XB_XCNT(b.x)], 1u);
    return b;
}
__device__ __forceinline__ void xcd_barrier_complete(unsigned* bar, unsigned x, unsigned& nloc, unsigned& nx) {
    const unsigned G = gridDim.x * gridDim.y * gridDim.z;
    unsigned sum, cnt, mine, sp = 0u;
    for (;;) {
        sum = 0u; cnt = 0u; mine = 0u;
#pragma unroll
        for (unsigned j = 0; j < 16; ++j) { const unsigned c = xb_ld(&bar[XB_XCNT(j)]); sum += c; cnt += (c > 0u) ? 1u : 0u; mine = (j == x) ? c : mine; }
        if (sum == G) break;
        __builtin_amdgcn_s_sleep(1);
        if ((++sp & 255u) == 0u) { if (xb_ld(&bar[XB_TMO])) break; if (sp > XB_SPIN_CAP) { atomicAdd(&bar[XB_TMO], 1u); break; } }
    }
    nloc = mine > 0u ? mine : 1u; nx = cnt > 0u ? cnt : 1u;
}
__device__ __forceinline__ void xcd_barrier(const XcdBarrier& b, const int wave, const bool cnt_wait = false) {
    asm volatile("s_waitcnt vmcnt(0)" ::: "memory");
    __syncthreads();
    if (wave == 0 && lane_id() == 0) {
#if defined(PROBE_BW)
        const unsigned long long bw_t0 = __builtin_amdgcn_s_memrealtime();
#endif
        unsigned* bar = b.bar; asm volatile("" : "+s"(bar)); unsigned bx = b.x; asm volatile("" : "+s"(bx));
        __builtin_amdgcn_s_waitcnt(0);
        unsigned nloc = b.st[0], nx = b.st[1];
        if (nloc == 0u) { xcd_barrier_complete(bar, bx, nloc, nx); b.st[0] = nloc; b.st[1] = nx; }
        const unsigned old = xb_add(&bar[XB_XSUB(bx)], 1u);
        const unsigned gen = old / nloc;
        if (old + 1u == (gen + 1u) * nloc) {
            __builtin_amdgcn_fence(__ATOMIC_RELEASE, "agent");
            asm volatile("s_waitcnt vmcnt(0)" ::: "memory");
            const unsigned og = xb_add(&bar[XB_TOP], 1u);
            const unsigned tg = og / nx;
            if (og + 1u == (tg + 1u) * nx) xb_add(&bar[XB_TOPGEN], 1u);
            else XB_SPIN(xb_ld(&bar[XB_TOPGEN]) == tg, bar);
            __builtin_amdgcn_fence(__ATOMIC_ACQUIRE, "agent");
            xb_add(&bar[XB_XGEN(bx)], 1u);
            asm volatile("s_waitcnt vmcnt(0)" ::: "memory");
        } else {
            XB_SPIN(xb_ld(&bar[XB_XGEN(bx)]) == gen, bar);
            __builtin_amdgcn_fence(__ATOMIC_ACQUIRE, "agent");
            asm volatile("s_waitcnt vmcnt(0)" ::: "memory");
        }
#if defined(PROBE_BW)
        if (cnt_wait) b.st[2] += (unsigned)(__builtin_amdgcn_s_memrealtime() - bw_t0);
#endif
    }
    __syncthreads();
}

struct Args {
    const float* in[19];
    float* out; unsigned char* ws;
    int ph_lo, ph_hi;
};
enum { I_X = 0, I_C, I_CTX, I_CCTX, I_WADA, I_BADA, I_GMIX, I_WIN, I_CONVW, I_RPB, I_SINK, I_WBR, I_WOUT, I_GFFN, I_WROUTER, I_WG, I_WU, I_WD, I_GFINAL };

struct Frame {
    unsigned char* lds;
    LAS unsigned char* ldsl;
    unsigned char* ws;
    int wave, vcu, G;
    float* out;
};

constexpr int PTR_OFF = MISC_OFF + 128;
__device__ __forceinline__ const float* inp(const Frame& F, int i) {
    const u32x2 v = *(const LAS u32x2*)(F.ldsl + PTR_OFF + 8 * i);
    const unsigned lo = __builtin_amdgcn_readfirstlane(v.x), hi = __builtin_amdgcn_readfirstlane(v.y);
    typedef const float __attribute__((address_space(1)))* gptr_t;
    return (const float*)(gptr_t)(((unsigned long long)hi << 32) | lo);
}
__device__ __forceinline__ bf16* xbrow(const Frame& F, int ch, int cr) {
    return cr < LROWS ? (bf16*)(F.out + ((size_t)ch * LROWS + cr) * D) : (bf16*)(F.ws + WS_XC) + (size_t)(cr - LROWS) * D;
}
__device__ __forceinline__ const float* xin_row(const Frame& F, int ch, int cr) {
    return cr < LROWS ? inp(F, I_X) + ((size_t)ch * LROWS + cr) * D : inp(F, I_CTX) + (size_t)(cr - LROWS) * D;
}
__device__ __forceinline__ int mv_of(int ch, int cr) { return cr < LROWS ? ch * BC + cr / SEQ : NB; }
__device__ __forceinline__ const float* mod_ptr(const Frame& F, int l, int mv, int which) { return (const float*)(F.ws + WS_MODS) + ((size_t)(l * 33 + mv) * 6 + which) * D; }

__device__ __forceinline__ bf16* hbuf_of(const Frame& F, int ch) { return (bf16*)(F.ws + (ch == 0 ? WS_HBUF : WS_HBUF1)); }
__device__ __forceinline__ float* affl_of(const Frame& F, int ch) { return (float*)(F.ws + WS_AFFL) + (size_t)ch * BC * NE * SEQ; }
__device__ __forceinline__ int* tokslot_of(const Frame& F, int ch) { return (int*)(F.ws + WS_TOKSLOT) + (size_t)ch * RCMAX * NE; }
__device__ __forceinline__ void mods_phase(Frame& F) {
    const int lane = launder(lane_id()), tid = F.wave * 64 + lane; (void)tid; (void)lane;
    float* sl = (float*)F.lds;
    const float* c = inp(F, I_C); const float* cc = inp(F, I_CCTX);
    for (int item = F.vcu; item < DEPTH * 96; item += F.G) {
        const int l = item / 96, jb = item % 96, j = jb * 64 + lane;
        const float* W = inp(F, I_WADA) + (size_t)l * D * 6144;
        float acc[33];
#pragma unroll
        for (int m = 0; m < 33; ++m) acc[m] = 0.f;
        for (int kh = 0; kh < 2; ++kh) {
            __syncthreads();
            for (int i = tid; i < 512 * 33; i += NTHR) { const int k = i % 512, m = i / 512; const float v = (m < 32) ? c[(size_t)m * D + kh * 512 + k] : cc[kh * 512 + k]; sl[k * 36 + m] = v * sigmoidf_(v); }
            __syncthreads();
            for (int kk0 = 0; kk0 < 64; kk0 += 8) {
                float w8[8];
#pragma unroll
                for (int u8 = 0; u8 < 8; ++u8) w8[u8] = W[(size_t)(kh * 512 + F.wave * 64 + kk0 + u8) * 6144 + j];
#pragma unroll
                for (int u8 = 0; u8 < 8; ++u8) { const int k = F.wave * 64 + kk0 + u8; const float w = w8[u8];
                    const f32x4* s4 = (const f32x4*)(sl + k * 36);
#pragma unroll
                    for (int q = 0; q < 8; ++q) { const f32x4 s = s4[q]; acc[4 * q] += s.x * w; acc[4 * q + 1] += s.y * w; acc[4 * q + 2] += s.z * w; acc[4 * q + 3] += s.w * w; }
                    acc[32] += sl[k * 36 + 32] * w; }
            }
        }
        __syncthreads();
        float* rd = (float*)F.lds;
#pragma unroll
        for (int m = 0; m < 33; ++m) rd[(F.wave * 33 + m) * 64 + lane] = acc[m];
        __syncthreads();
        for (int i = tid; i < 33 * 64; i += NTHR) { const int m = i / 64, jj = i % 64; float s = 0.f;
#pragma unroll
            for (int w = 0; w < 8; ++w) s += rd[(w * 33 + m) * 64 + jj];
            const int col = jb * 64 + jj;
            ((float*)(F.ws + WS_MODS))[(size_t)(l * 33 + m) * 6144 + col] = s + inp(F, I_BADA)[(size_t)l * 6144 + col]; }
    }
    __syncthreads();
    f32x2* tab = (f32x2*)(F.ws + WS_ROPE);
    for (int i = F.vcu * NTHR + tid; i < SEQ * 32; i += F.G * NTHR) {
        const int pos = i >> 5, fi = i & 31; const float inv = powf(10000.0f, -(float)(fi & 15) / 16.0f);
        const float ang = (fi < 16 ? (float)(pos / 64) : (float)(pos % 64)) * inv;
        tab[i] = (f32x2){cosf(ang), sinf(ang)};
    }
}

__device__ __forceinline__ void transpose_item(const float* W, int K, int N, bf16* WT, int k0, int n0, int orow0, float* scr, int lane, int ldo = 0, int kofs = 0) {
    if (ldo == 0) ldo = K;
    f32x4 v[8];
#pragma unroll
    for (int i = 0; i < 8; ++i) v[i] = *(const f32x4*)(W + (size_t)(k0 + 8 * i + (lane >> 3)) * N + n0 + 4 * (lane & 7));
#pragma unroll
    for (int i = 0; i < 8; ++i) *(f32x4*)(scr + (8 * i + (lane >> 3)) * 36 + 4 * (lane & 7)) = v[i];
    LDS_WAIT(); asm volatile("" ::: "memory");
    const int c = lane & 7;
#pragma unroll
    for (int j = 0; j < 4; ++j) { const int n = (lane >> 3) + 8 * j; const float* s = scr + (8 * c) * 36 + n;
        u32x4 o; o.x = pk2(s[0 * 36], s[1 * 36]); o.y = pk2(s[2 * 36], s[3 * 36]); o.z = pk2(s[4 * 36], s[5 * 36]); o.w = pk2(s[6 * 36], s[7 * 36]);
        *(u32x4*)(WT + (size_t)(orow0 + n) * ldo + kofs + k0 + 8 * c) = o; }
    LDS_WAIT(); asm volatile("" ::: "memory");
}
constexpr int I_IN = 16 * 216, I_BR = 3 * 8 * 32, I_OUT = 16 * 32, I_EX = 16 * 16 * 32;
constexpr int NITEMS = I_IN + I_BR + I_OUT + 3 * I_EX;
constexpr int IT_UP0 = I_IN + I_BR + I_OUT, IT_DN0 = IT_UP0 + 2 * I_EX;
constexpr int FA1 = 5956, FB1 = 11756, FC1 = 13056, FD1 = 18056, FE1 = 19620;
__device__ __forceinline__ void wconv_phase(Frame& F, int l, int it_lo, int it_hi, int widx, int nw, int wave_lo = 0) {
    const int lane = launder(lane_id()), tid = F.wave * 64 + lane; (void)tid; (void)lane;
    float* scr = (float*)(F.lds + F.wave * 16384);
    if (F.wave < wave_lo) return;
    const int nwv = NWAVES - wave_lo, gw = widx * nwv + F.wave - wave_lo, NGW = nw * nwv;
    for (int it = it_lo + gw; it < it_hi; it += NGW) {
        int r = it;
        if (r < I_IN) { const int kb = r / 216, nb = r % 216; transpose_item(inp(F, I_WIN) + (size_t)l * D * INW, D, INW, (bf16*)(F.ws + wpar(l, WS_WIN, WS_WIN1)), kb * 64, nb * 32, nb * 32, scr, lane); continue; } r -= I_IN;
        if (r < I_BR) { const int br = r / 256, q = r % 256, kb = q / 32, nb = q % 32;
            transpose_item(inp(F, I_WBR) + ((size_t)l * 3 + br) * 512 * D, 512, D, (bf16*)(F.ws + wpar(l, WS_WBR, WS_WBR1)), kb * 64, nb * 32, nb * 32, scr, lane, 1536, br * 512); continue; } r -= I_BR;
        if (r < I_OUT) { const int kb = r / 32, nb = r % 32; transpose_item(inp(F, I_WOUT) + (size_t)l * D * D, D, D, (bf16*)(F.ws + wpar(l, WS_WOUT, WS_WOUT1)), kb * 64, nb * 32, nb * 32, scr, lane); continue; } r -= I_OUT;
        if (r < 2 * I_EX) { const int s = r / I_EX, q = r % I_EX, e = q / 512, q2 = q % 512, kb = q2 / 32, nb = q2 % 32, n0 = nb * 32;
            const float* W = inp(F, s ? I_WU : I_WG) + ((size_t)l * NE + e) * D * FF;
            transpose_item(W, D, FF, (bf16*)(F.ws + wpar(l, WS_WUP, WS_WUP1)) + (size_t)e * 2048 * D, kb * 64, n0, 256 * (n0 / 128) + 128 * s + (n0 % 128), scr, lane); continue; } r -= 2 * I_EX;
        { const int e = r / 512, q2 = r % 512, kb = q2 / 32, nb = q2 % 32;
            transpose_item(inp(F, I_WD) + ((size_t)l * NE + e) * FF * D, FF, D, (bf16*)(F.ws + wpar(l, WS_WDN, WS_WDN1)) + (size_t)e * D * FF, kb * 64, nb * 32, nb * 32, scr, lane); }
    }
}

__device__ __forceinline__ float xsel(bool c, float a, float b) { return c ? a : b; }
template <bool ROUTER>
__device__ __forceinline__ void norm_phase(Frame& F, int l, int ch, int nrows, bool dry = false) {
    const int lane = launder(lane_id()), tid = F.wave * 64 + lane; (void)tid; (void)lane;
    const int gw = F.vcu * NWAVES + F.wave, NGW = F.G * NWAVES;
    float* wr_l = (float*)F.lds;
    if (ROUTER) {
        const float* wr = inp(F, I_WROUTER) + (size_t)l * D * NE;
        for (int i = tid; i < D * NE; i += NTHR) { const int d = i >> 4, e = i & 15; wr_l[e * D + d] = wr[i]; }
        __syncthreads();
    }
    const float* gv = inp(F, ROUTER ? I_GFFN : I_GMIX) + (size_t)l * D;
    bf16* hb = dry ? (bf16*)(F.ws + WS_OBUF + 160 * MiB) : (bf16*)(F.ws + (ch == 0 ? WS_HBUF : WS_HBUF1));
    f32x4 nx[2][4]; u32x2 nb[2][4];
#define NP_LOAD(c0) do { _Pragma("unroll") for (int rr_ = 0; rr_ < 2; ++rr_) { \
        if (ROUTER) { const bf16* xb_ = xbrow(F, ch, (c0) + rr_); \
            _Pragma("unroll") for (int j_ = 0; j_ < 4; ++j_) nb[rr_][j_] = *(const u32x2*)(xb_ + lane * 4 + 256 * j_); } \
        else { const float* xr_ = xin_row(F, ch, (c0) + rr_); \
            _Pragma("unroll") for (int j_ = 0; j_ < 4; ++j_) nx[rr_][j_] = *(const f32x4*)(xr_ + lane * 4 + 256 * j_); } } } while (0)
    const int rpw = (((nrows + NGW - 1) / NGW) + 1) & ~1, rbeg = gw * rpw, rend = (rbeg + rpw < nrows) ? rbeg + rpw : nrows;
    f32x4 gq[4], shq[4], scq[4]; int cmv = -1;
#pragma unroll
    for (int j = 0; j < 4; ++j) gq[j] = *(const f32x4*)(gv + lane * 4 + 256 * j);
    if (rbeg < rend) NP_LOAD(rbeg);
    for (int cr0 = rbeg; cr0 < rend; cr0 += 2) {
        f32x4 v[2][4];
#pragma unroll
        for (int rr = 0; rr < 2; ++rr)
#pragma unroll
            for (int j = 0; j < 4; ++j) {
                if (ROUTER) { const u32x2 t = nb[rr][j]; v[rr][j].x = bflo(t.x); v[rr][j].y = bfhi(t.x); v[rr][j].z = bflo(t.y); v[rr][j].w = bfhi(t.y); }
                else v[rr][j] = nx[rr][j]; }
        if (cr0 + 2 < rend) NP_LOAD(cr0 + 2);
#pragma unroll
        for (int rr = 0; rr < 2; ++rr) {
            const int cr = cr0 + rr;
            const int mv = mv_of(ch, cr);
            if (mv != cmv) { cmv = mv; const float* sh = mod_ptr(F, l, mv, ROUTER ? 3 : 0); const float* sc = mod_ptr(F, l, mv, ROUTER ? 4 : 1);
#pragma unroll
                for (int j = 0; j < 4; ++j) { shq[j] = *(const f32x4*)(sh + lane * 4 + 256 * j); scq[j] = *(const f32x4*)(sc + lane * 4 + 256 * j); } }
            float ss = 0.f;
#pragma unroll
            for (int j = 0; j < 4; ++j) {
                if (!ROUTER) { u32x2 o; o.x = pk2(v[rr][j].x, v[rr][j].y); o.y = pk2(v[rr][j].z, v[rr][j].w); *(u32x2*)(xbrow(F, ch, cr) + lane * 4 + 256 * j) = o; }
                ss += (v[rr][j].x * v[rr][j].x + v[rr][j].y * v[rr][j].y) + (v[rr][j].z * v[rr][j].z + v[rr][j].w * v[rr][j].w); }
            const float rstd = 1.0f / sqrtf(wave_sum(ss) * (1.0f / D) + RMS_EPS);
#pragma unroll
            for (int j = 0; j < 4; ++j) {
                v[rr][j] = (v[rr][j] * rstd * gq[j]) * (scq[j] + 1.0f) + shq[j];
                u32x2 o; o.x = pk2(v[rr][j].x, v[rr][j].y); o.y = pk2(v[rr][j].z, v[rr][j].w);
                *(u32x2*)(hb + (size_t)cr * D + lane * 4 + 256 * j) = o;
            }
        }
#undef NP_LOAD
        if (ROUTER) {
            const bool b5 = lane & 32, b4 = lane & 16, b3 = lane & 8;
            float lg[2][2];
#pragma unroll
            for (int hf = 0; hf < 2; ++hf) {
                float a[2][8];
#pragma unroll
                for (int e = 0; e < 8; ++e) {
                    f32x4 w[4];
#pragma unroll
                    for (int j = 0; j < 4; ++j) w[j] = *(const f32x4*)(wr_l + (hf * 8 + e) * D + lane * 4 + 256 * j);
#pragma unroll
                    for (int rr = 0; rr < 2; ++rr) { float t = 0.f;
#pragma unroll
                        for (int j = 0; j < 4; ++j) t += (v[rr][j].x * w[j].x + v[rr][j].y * w[j].y) + (v[rr][j].z * w[j].z + v[rr][j].w * w[j].w);
                        a[rr][e] = t; }
                    if (e & 1) __builtin_amdgcn_sched_barrier(0);
                }
#pragma unroll
                for (int rr = 0; rr < 2; ++rr) {
                    float c[4], d2[2];
#pragma unroll
                    for (int i = 0; i < 4; ++i) { const float recv = __shfl_xor(xsel(b5, a[rr][i], a[rr][i + 4]), 32); c[i] = xsel(b5, a[rr][i + 4], a[rr][i]) + recv; }
#pragma unroll
                    for (int i = 0; i < 2; ++i) { const float recv = __shfl_xor(xsel(b4, c[i], c[i + 2]), 16); d2[i] = xsel(b4, c[i + 2], c[i]) + recv; }
                    float t = xsel(b3, d2[1], d2[0]) + __shfl_xor(xsel(b3, d2[0], d2[1]), 8);
                    t += __shfl_xor(t, 4); t += __shfl_xor(t, 2); t += __shfl_xor(t, 1);
                    lg[hf][rr] = t;
                }
                __builtin_amdgcn_sched_barrier(0);
            }
#pragma unroll
            for (int rr = 0; rr < 2; ++rr) {
                float m = fmaxf(lg[0][rr], lg[1][rr]);
#pragma unroll
                for (int o = 8; o < 64; o <<= 1) m = fmaxf(m, __shfl_xor(m, o));
                const float p0 = expf(lg[0][rr] - m), p1 = expf(lg[1][rr] - m); float s = p0 + p1;
#pragma unroll
                for (int o = 8; o < 64; o <<= 1) s += __shfl_xor(s, o);
                const float inv = 1.0f / s;
                const int cr = cr0 + rr, e = lane >> 3;
                if ((lane & 7) < 2 && !dry) {
                    const int ee = (lane & 1) ? e + 8 : e; const float mine = ((lane & 1) ? p1 : p0) * inv;
                    if (cr < LROWS) { const int bl = cr / SEQ, t = cr % SEQ; affl_of(F, ch)[(size_t)(bl * NE + ee) * SEQ + t] = mine; }
                    else { const int j = cr - LROWS, bl = j / CTX, t = j % CTX; ((float*)(F.ws + WS_AFFC))[(size_t)(bl * NE + ee) * CTX + t] = mine; }
                }
            }
        }
    }
}

__device__ __forceinline__ const bf16* zrow(const Frame& F, int cr) { return (const bf16*)(F.ws + WS_Z) + (size_t)cr * ZW; }

__device__ __forceinline__ void conv_phase(Frame& F, int l, int nrows) {
    const int lane = launder(lane_id()), tid = F.wave * 64 + lane; (void)tid; (void)lane;
    const int gw = F.vcu * NWAVES + F.wave, NGW = F.G * NWAVES;
    const float* cw = inp(F, I_CONVW) + (size_t)l * 3 * 512;
    float w[3][8];
#pragma unroll
    for (int k = 0; k < 3; ++k)
#pragma unroll
        for (int j = 0; j < 8; ++j) w[k][j] = cw[k * 512 + lane * 8 + j];
    bf16* ob = (bf16*)(F.ws + WS_OBUF);
    const int rpw = (nrows + NGW - 1) / NGW, rbeg = gw * rpw, rend = (rbeg + rpw < nrows) ? rbeg + rpw : nrows;
    if (rbeg >= rend) return;
#define CV_SEQ(cr_) ((cr_) < LROWS ? (cr_) / SEQ : 1024 + ((cr_) - LROWS) / CTX)
#define CV_LOADP(cr_, P) do { const bf16* zr_ = zrow(F, (cr_)); float c8_[8], x8_[8]; unpack8(*(const u32x4*)(zr_ + Z_AC + lane * 8), c8_); unpack8(*(const u32x4*)(zr_ + Z_AX + lane * 8), x8_); \
        _Pragma("unroll") for (int j_ = 0; j_ < 8; ++j_) (P)[j_] = c8_[j_] * x8_[j_]; } while (0)
    float pp[8], pc[8], pn[8];
#pragma unroll
    for (int j = 0; j < 8; ++j) pp[j] = 0.f;
    if (rbeg > 0 && CV_SEQ(rbeg - 1) == CV_SEQ(rbeg)) CV_LOADP(rbeg - 1, pp);
    CV_LOADP(rbeg, pc);
    for (int cr = rbeg; cr < rend; ++cr) {
        const bool hasn = cr + 1 < nrows, same = hasn && CV_SEQ(cr + 1) == CV_SEQ(cr);
#pragma unroll
        for (int j = 0; j < 8; ++j) pn[j] = 0.f;
        if (hasn) CV_LOADP(cr + 1, pn);
        float b8[8]; unpack8(*(const u32x4*)(zrow(F, cr) + Z_AB + lane * 8), b8);
        float acc[8];
#pragma unroll
        for (int j = 0; j < 8; ++j) acc[j] = w[0][j] * pp[j] + w[1][j] * pc[j] + (same ? w[2][j] * pn[j] : 0.f);
        u32x4 o; o.x = pk2(b8[0] * acc[0], b8[1] * acc[1]); o.y = pk2(b8[2] * acc[2], b8[3] * acc[3]); o.z = pk2(b8[4] * acc[4], b8[5] * acc[5]); o.w = pk2(b8[6] * acc[6], b8[7] * acc[7]);
        *(u32x4*)(ob + (size_t)cr * OW + lane * 8) = o;
#pragma unroll
        for (int j = 0; j < 8; ++j) { pp[j] = same ? pc[j] : 0.f; pc[j] = pn[j]; }
    }
#undef CV_SEQ
#undef CV_LOADP
}

struct NaiveState { unsigned q[32]; float o[64], m, l; };
__device__ __forceinline__ void load64(const bf16* p, float* f) {
#pragma unroll
    for (int i = 0; i < 8; ++i) unpack8(*(const u32x4*)(p + 8 * i), f + 8 * i);
}
__device__ __forceinline__ void rope64(float* x, const f32x2* tabrow) {
#pragma unroll
    for (int i = 0; i < 32; ++i) { const f32x2 cs = tabrow[i]; const float a = x[i], b = x[i + 32]; x[i] = a * cs.x - b * cs.y; x[i + 32] = a * cs.y + b * cs.x; }
}
__device__ __forceinline__ void naive_visit(NaiveState& st, const bf16* kp, const bf16* vp, float bias, bool valid, const f32x2* ropetab) {
    float s = 0.f;
#pragma unroll
    for (int c = 0; c < 4; ++c) {
        float a[8], b[8]; unpack8(*(const u32x4*)(kp + 8 * c), a); unpack8(*(const u32x4*)(kp + 32 + 8 * c), b);
        if (ropetab) {
#pragma unroll
            for (int i = 0; i < 8; ++i) { const f32x2 cs = ropetab[8 * c + i]; const float x1 = a[i], x2 = b[i]; a[i] = x1 * cs.x - x2 * cs.y; b[i] = x1 * cs.y + x2 * cs.x; }
        }
#pragma unroll
        for (int i = 0; i < 8; ++i) s += bflo(st.q[8 * c + i]) * a[i] + bfhi(st.q[8 * c + i]) * b[i];
    }
    s = valid ? s + bias : -1e30f;
    const float mn = fmaxf(st.m, s), alpha = __expf(st.m - mn), p = __expf(s - mn);
    st.m = mn; st.l = st.l * alpha + p;
#pragma unroll
    for (int c = 0; c < 8; ++c) { float v[8]; unpack8(*(const u32x4*)(vp + 8 * c), v);
#pragma unroll
        for (int i = 0; i < 8; ++i) st.o[8 * c + i] = st.o[8 * c + i] * alpha + p * v[i]; }
}
__device__ __forceinline__ void naive_attn_phase(Frame& F, int l, int ch, bool last, bf16* ob) {
    const int lane = launder(lane_id()), tid = F.wave * 64 + lane; (void)tid; (void)lane;
    const int n_lat = LROWS / 64, n_ctx = (last || ch != 0) ? 0 : CTXALL / 64;
    const int nunits = 2 * n_lat + 2 * n_ctx;
    const f32x2* tab = (const f32x2*)(F.ws + WS_ROPE);
    for (int u = F.vcu; u < nunits; u += F.G) {
        int type, blk;
        if (u < n_lat) { type = 0; blk = u; } else if (u < 2 * n_lat) { type = 1; blk = u - n_lat; } else if (u < 2 * n_lat + n_ctx) { type = 2; blk = u - 2 * n_lat; } else { type = 3; blk = u - 2 * n_lat - n_ctx; }
        const int h = F.wave;
        const int cr0 = (type < 2) ? blk * 64 : LROWS + blk * 64, cr = cr0 + lane;
        const int bl = (type < 2) ? ch * BC + cr0 / SEQ : (cr0 - LROWS) / CTX;
        const int t0 = (type < 2) ? cr0 % SEQ : (cr0 - LROWS) % CTX, t = t0 + lane;
        const int ctx0 = LROWS + bl * CTX;
        const bool sw = (type == 0 || type == 3);
        const int hk = sw ? h / 4 : h;
        const int qcol = (sw ? Z_SQ : Z_NQ) + 64 * h, kcol = (sw ? Z_SK : Z_NK) + 64 * hk, vcol = (sw ? Z_SV : Z_NV) + 64 * hk;
        NaiveState st;
        { float qf[64]; load64(zrow(F, cr) + qcol, qf);
          if (type == 0) rope64(qf, tab + (size_t)t * 32);
#pragma unroll
          for (int i = 0; i < 32; ++i) st.q[i] = pk2(qf[i] * 0.125f, qf[i + 32] * 0.125f);
#pragma unroll
          for (int i = 0; i < 64; ++i) st.o[i] = 0.f; }
        if (sw) { st.m = inp(F, I_SINK)[l * 8 + h]; st.l = 1.f; } else { st.m = -1e30f; st.l = 0.f; }
        const int lo = t0 - 128 < 0 ? 0 : t0 - 128, hi = t0 + 63 + 128 > SEQ - 1 ? SEQ - 1 : t0 + 63 + 128;
        const int r = t0 / 64, c = lane; int rs = r - 4; rs = rs < 0 ? 0 : (rs > 24 ? 24 : rs); int cs = c - 8; cs = cs < 0 ? 0 : (cs > 48 ? 48 : cs);
        const float* rpb = inp(F, I_RPB) + ((size_t)l * 8 + h) * 15 * 31;
        const int nloc = type == 0 ? hi - lo + 1 : (type == 1 ? 512 : 0);
#pragma unroll 1
        for (int idx = 0; idx < CTX + nloc; ++idx) {
            const bf16* zr; float bias = 0.f; bool valid = true; const f32x2* rt = nullptr;
            if (idx < CTX) zr = zrow(F, ctx0 + idx);
            else if (type == 0) { const int j = lo + idx - CTX, dlt = t - j; zr = zrow(F, cr0 - t0 + j); valid = dlt <= 128 && dlt >= -128; rt = tab + (size_t)j * 32; }
            else { const int q = idx - CTX, kr = rs + (q >> 6), kc = q & 63; zr = zrow(F, cr0 - t0 + kr * 64 + kc); valid = kc >= cs && kc < cs + 16;
                int dc = kc - c + 15; dc = dc < 0 ? 0 : (dc > 30 ? 30 : dc); bias = rpb[(kr - r + 7) * 31 + dc]; }
            naive_visit(st, zr + kcol, zr + vcol, bias, valid, rt);
        }
        const float inv = 1.0f / st.l;
        bf16* op = ob + (size_t)cr * OW + (sw ? 1024 : 512) + 64 * h;
#pragma unroll
        for (int i = 0; i < 8; ++i) { u32x4 o; o.x = pk2(st.o[8 * i] * inv, st.o[8 * i + 1] * inv); o.y = pk2(st.o[8 * i + 2] * inv, st.o[8 * i + 3] * inv); o.z = pk2(st.o[8 * i + 4] * inv, st.o[8 * i + 5] * inv); o.w = pk2(st.o[8 * i + 6] * inv, st.o[8 * i + 7] * inv);
            *(u32x4*)(op + 8 * i) = o; }
    }
}

typedef short s16x4 __attribute__((ext_vector_type(4)));
typedef float f32x16 __attribute__((ext_vector_type(16)));
typedef __bf16 bf16x2_t __attribute__((ext_vector_type(2)));
__device__ __forceinline__ unsigned cvtpk(float lo, float hi) { const f32x2 v = {lo, hi}; return __builtin_bit_cast(unsigned, __builtin_convertvector(v, bf16x2_t)); }
typedef short v4i16_t __attribute__((ext_vector_type(4)));
__device__ __forceinline__ s16x4 vtr(const LAS unsigned char* p) { return __builtin_bit_cast(s16x4, __builtin_amdgcn_ds_read_tr16_b64_v4i16((LAS v4i16_t*)p)); }
constexpr int AK_RS = 144, AV_RS = 192, AK_BYTES = 128 * AK_RS, AV_BYTES = 128 * AV_RS, ASTAGE = AK_BYTES + AV_BYTES, A_RPB_OFF = 2 * ASTAGE;
#define MFMA32(a, b, c) __builtin_amdgcn_mfma_f32_32x32x16_bf16((a), (b), (c), 0, 0, 0)
__device__ __forceinline__ float xlane32(float v) {
    const auto rr = __builtin_amdgcn_permlane32_swap(__builtin_bit_cast(unsigned, v), __builtin_bit_cast(unsigned, v), false, false);
    return __builtin_bit_cast(float, (lane_id() & 32) ? rr[0] : rr[1]);
}
__device__ __forceinline__ float max3f(float a, float b, float c) { return fmaxf(fmaxf(a, b), c); }
__device__ __forceinline__ float rowmax32(const f32x16& p0, const f32x16& p1) {
    float a = max3f(p0[0], p0[1], p1[0]), b = max3f(p0[2], p0[3], p1[1]); a = max3f(a, p1[2], p1[3]);
#pragma unroll
    for (int i = 4; i < 16; i += 4) { a = max3f(a, p0[i], p0[i + 1]); b = max3f(b, p0[i + 2], p0[i + 3]); a = max3f(a, p1[i], p1[i + 1]); b = max3f(b, p1[i + 2], p1[i + 3]); }
    const float m = fmaxf(a, b);
    const auto rr = __builtin_amdgcn_permlane32_swap(__builtin_bit_cast(unsigned, m), __builtin_bit_cast(unsigned, m), false, false);
    return fmaxf(__builtin_bit_cast(float, rr[0]), __builtin_bit_cast(float, rr[1]));
}
__device__ __forceinline__ void lds_read_vt8(unsigned addr, s16x4 (&t)[8]) {
    asm volatile("ds_read_b64_tr_b16 %0, %8\n\tds_read_b64_tr_b16 %1, %8 offset:1536\n\tds_read_b64_tr_b16 %2, %8 offset:64\n\tds_read_b64_tr_b16 %3, %8 offset:1600\n\t"
                 "ds_read_b64_tr_b16 %4, %8 offset:3072\n\tds_read_b64_tr_b16 %5, %8 offset:4608\n\tds_read_b64_tr_b16 %6, %8 offset:3136\n\tds_read_b64_tr_b16 %7, %8 offset:4672\n\t"
                 "s_waitcnt lgkmcnt(0)"
        : "=&v"(t[0]), "=&v"(t[1]), "=&v"(t[2]), "=&v"(t[3]), "=&v"(t[4]), "=&v"(t[5]), "=&v"(t[6]), "=&v"(t[7]) : "v"(addr) : "memory");
}
static_assert(16 * 192 == 3072 && 8 * 192 == 1536, "lds_read_vt8 offsets assume AV_RS = 192");
__device__ __forceinline__ void lds_read_k4(unsigned addr, bf16x8 (&ka)[4]) {
    asm volatile("ds_read_b128 %0, %4\n\tds_read_b128 %1, %4 offset:32\n\tds_read_b128 %2, %4 offset:64\n\tds_read_b128 %3, %4 offset:96\n\ts_waitcnt lgkmcnt(0)"
        : "=&v"(ka[0]), "=&v"(ka[1]), "=&v"(ka[2]), "=&v"(ka[3]) : "v"(addr) : "memory");
}
__device__ __forceinline__ void lds_read_k8(unsigned addr, bf16x8 (&ka)[4], bf16x8 (&kb)[4]) {
    asm volatile("ds_read_b128 %0, %8\n\tds_read_b128 %1, %8 offset:32\n\tds_read_b128 %2, %8 offset:64\n\tds_read_b128 %3, %8 offset:96\n\t"
                 "ds_read_b128 %4, %8 offset:4608\n\tds_read_b128 %5, %8 offset:4640\n\tds_read_b128 %6, %8 offset:4672\n\tds_read_b128 %7, %8 offset:4704\n\t"
                 "s_waitcnt lgkmcnt(0)"
        : "=&v"(ka[0]), "=&v"(ka[1]), "=&v"(ka[2]), "=&v"(ka[3]), "=&v"(kb[0]), "=&v"(kb[1]), "=&v"(kb[2]), "=&v"(kb[3]) : "v"(addr) : "memory");
}
constexpr int A_ROPE_OFF = A_RPB_OFF + 4096;
template <int VAR, int TY>
__device__ __forceinline__ void attn_units(Frame& F, int l, int ch, bool last, bf16* ob) {
    const int lane = launder(lane_id()), tid = F.wave * 64 + lane;
    const int wave = F.wave, r = lane & 31, hh = lane >> 5;
    const float LOG2E = 1.4426950408889634f;
    const f32x2* tab = (const f32x2*)(F.ws + WS_ROPE); (void)tab;
    float* rpbl = (float*)(F.lds + A_RPB_OFF);
    const int skey = tid >> 2, sc = tid & 3, sb = skey >> 6, srow = skey & 63;
    const int nNA = BC * 8 * 8, nSW = BC * 16 * 4, nCX = (last || ch != 0) ? 0 : NB * 8 * 2;
    const int ubeg = (TY == 1) ? 0 : (TY == 0 ? nNA : nNA + nSW), uend = (TY == 1) ? nNA : (TY == 0 ? nNA + nSW : nNA + nSW + nCX);
    for (int u = ubeg + F.vcu; u < uend; u += F.G) {
        int type, bl, h, rg = 0, n = 0;
        if (u < nNA) { type = 1; bl = u >> 6; rg = ((u >> 3) + (u >> 8)) & 7; h = u & 7; }
        else if (u < nNA + nSW) { const int v = u - nNA; type = 0; bl = v >> 6; n = ((v >> 2) + 4 * (v >> 8)) & 15; h = 4 * ((v >> 1) & 1) + 2 * (v & 1); }
        else { const int v = u - nNA - nSW; type = (v < NB * 8) ? 2 : 3; const int vv = v % (NB * 8); bl = vv >> 3; h = vv & 7; }
        if (TY != 2) type = TY;
        const bool sw = (type == 0 || type == 3);
        const int head = (type == 0) ? h + (wave >> 2) : h;
        const int jb = wave & 3;
        const int rq = 4 * rg + 2 * (wave >> 2) + (r >> 4), cq = 16 * jb + (r & 15);
        const int qrow = (type == 1) ? bl * SEQ + 64 * rq + cq : (type == 0) ? bl * SEQ + 128 * n + 32 * (wave & 3) + r : LROWS + bl * CTX + 32 * wave + r;
        const int qcol = (sw ? Z_SQ : Z_NQ) + 64 * head, kcol = sw ? Z_SK + 64 * (head >> 2) : Z_NK + 64 * head, vcol = sw ? Z_SV + 64 * (head >> 2) : Z_NV + 64 * head;
        const int ocol = (sw ? 1024 : 512) + 64 * head;
        const int ctx0 = LROWS + ((type < 2) ? ch * BC + bl : bl) * CTX;
        int nloc = 0, loc0 = 0;
        if (type == 0) { const int jlo = (n == 0) ? 2 : 0, jhi = (n == 15) ? 3 : 5; nloc = jhi - jlo + 1; loc0 = jlo; }
        else if (type == 1) { int a = 4 * rg - 4; a = a < 0 ? 0 : (a > 24 ? 24 : a); int b = 4 * rg - 1; b = b < 0 ? 0 : (b > 24 ? 24 : b); loc0 = a; nloc = b + 7 - a + 1; }
        const int nt = 4 + nloc;
        bf16x8 qf[4];
        {
            const bf16* qp = zrow(F, qrow) + qcol + 8 * hh;
            float q[4][8];
#pragma unroll
            for (int s4 = 0; s4 < 4; ++s4) unpack8(*(const u32x4*)(qp + 16 * s4), q[s4]);
            if (type == 0) {
                const int pos = qrow - bl * SEQ; const f32x2* rl = (const f32x2*)(F.lds + A_ROPE_OFF);
#pragma unroll
                for (int s4 = 0; s4 < 2; ++s4) { const f32x2* tr = rl + (s4 == 0 ? (pos >> 6) : 32 + (pos & 63)) * 16 + 8 * hh;
#pragma unroll
                    for (int j = 0; j < 8; ++j) { const f32x2 cs = tr[j]; const float x1 = q[s4][j], x2 = q[s4 + 2][j]; q[s4][j] = x1 * cs.x - x2 * cs.y; q[s4 + 2][j] = x1 * cs.y + x2 * cs.x; } }
            }
            const float qs = 0.125f * LOG2E;
#pragma unroll
            for (int s4 = 0; s4 < 4; ++s4) { u32x4 p; p.x = cvtpk(q[s4][0] * qs, q[s4][1] * qs); p.y = cvtpk(q[s4][2] * qs, q[s4][3] * qs); p.z = cvtpk(q[s4][4] * qs, q[s4][5] * qs); p.w = cvtpk(q[s4][6] * qs, q[s4][7] * qs);
                qf[s4] = __builtin_bit_cast(bf16x8, p); }
        }
        float m = 0.f, lsum = 0.f;
        if (sw) { m = inp(F, I_SINK)[l * 8 + head] * LOG2E; lsum = (hh == 0) ? 1.f : 0.f; }
        f32x16 o0, o1;
#pragma unroll
        for (int i = 0; i < 16; ++i) { o0[i] = 0.f; o1[i] = 0.f; }
        const int kst = (type == 1) ? (16 * jb - 8 < 0 ? 0 : (16 * jb - 8 > 32 ? 32 : 16 * jb - 8)) : 0;
        unsigned bixp[4] = {0u, 0u, 0u, 0u};
        {
            const int csq = cq - 8 < 0 ? 0 : (cq - 8 > 48 ? 48 : cq - 8);
#pragma unroll
            for (int i = 0; i < 16; ++i) { const int kc = kst + (i & 3) + 8 * (i >> 2) + 4 * hh; bixp[i >> 2] |= (unsigned)(((kc >= csq && kc <= csq + 15) ? kc - cq + 15 : 31) * 4) << (8 * (i & 3)); }
        }
#define BIX(i) ((bixp[(i) >> 2] >> (8 * ((i) & 3))) & 0xffu)
        const int rsl = rq - 4 < 0 ? 0 : (rq - 4 > 24 ? 24 : rq - 4);
        u32x4 gk0, gk1, gv0, gv1;
        bool grope = false; int gpos = 0;
#define A_TILE_ROW0(ti) ((ti) < 4 ? ctx0 + 64 * (ti) : (type == 0 ? bl * SEQ + 128 * n - 128 + 64 * (loc0 + (ti) - 4) : bl * SEQ + 64 * (loc0 + (ti) - 4)))
#define A_STAGE_LOAD(T) do { const int ti_ = 2 * (T) + sb; const int tic_ = ti_ < nt ? ti_ : nt - 1; const int row0_ = A_TILE_ROW0(tic_); const bf16* sp_ = zrow(F, row0_ + srow) + 8 * sc; \
            gk0 = *(const u32x4*)(sp_ + kcol); gk1 = *(const u32x4*)(sp_ + kcol + 32); gv0 = *(const u32x4*)(sp_ + vcol); gv1 = *(const u32x4*)(sp_ + vcol + 32); grope = (type == 0 && tic_ >= 4); gpos = row0_ - bl * SEQ + srow; } while (0)
#define A_STAGE_WRITE(st) do { unsigned char* dk_ = F.lds + (st) * ASTAGE + skey * AK_RS + 16 * sc; unsigned char* dv_ = F.lds + (st) * ASTAGE + AK_BYTES + skey * AV_RS + 16 * sc; \
            if (grope) { float a_[8], b_[8]; unpack8(gk0, a_); unpack8(gk1, b_); \
                const f32x4* rl_ = (const f32x4*)(F.lds + A_ROPE_OFF + ((sc < 2 ? (gpos >> 6) : 32 + (gpos & 63)) * 16 + 8 * (sc & 1)) * 8); \
                _Pragma("unroll") for (int j_ = 0; j_ < 4; ++j_) { const f32x4 rcj_ = rl_[j_]; const float c0_ = rcj_.x, s0_ = rcj_.y, c1_ = rcj_.z, s1_ = rcj_.w; \
                    const float x1_ = a_[2 * j_], x2_ = b_[2 * j_], y1_ = a_[2 * j_ + 1], y2_ = b_[2 * j_ + 1]; \
                    a_[2 * j_] = x1_ * c0_ - x2_ * s0_; b_[2 * j_] = x1_ * s0_ + x2_ * c0_; a_[2 * j_ + 1] = y1_ * c1_ - y2_ * s1_; b_[2 * j_ + 1] = y1_ * s1_ + y2_ * c1_; } \
                gk0.x = cvtpk(a_[0], a_[1]); gk0.y = cvtpk(a_[2], a_[3]); gk0.z = cvtpk(a_[4], a_[5]); gk0.w = cvtpk(a_[6], a_[7]); \
                gk1.x = cvtpk(b_[0], b_[1]); gk1.y = cvtpk(b_[2], b_[3]); gk1.z = cvtpk(b_[4], b_[5]); gk1.w = cvtpk(b_[6], b_[7]); } \
            *(u32x4*)dk_ = gk0; *(u32x4*)(dk_ + 64) = gk1; *(u32x4*)dv_ = gv0; *(u32x4*)(dv_ + 64) = gv1; } while (0)
#define A_QK(XV, kbase) do { bf16x8 k4_[4]; lds_read_k4((unsigned)(size_t)(kbase), k4_); _Pragma("unroll") for (int i_ = 0; i_ < 16; ++i_) (XV)[i_] = -m; \
            _Pragma("unroll") for (int s4_ = 0; s4_ < 4; ++s4_) (XV) = MFMA32(k4_[s4_], qf[s4_], (XV)); } while (0)
#define A_QK2(XA, XB, kbA) do { bf16x8 ka_[4], kb_[4]; lds_read_k8((unsigned)(size_t)(kbA), ka_, kb_); \
            _Pragma("unroll") for (int i_ = 0; i_ < 16; ++i_) { (XA)[i_] = -m; (XB)[i_] = -m; } \
            _Pragma("unroll") for (int s4_ = 0; s4_ < 4; ++s4_) { (XA) = MFMA32(ka_[s4_], qf[s4_], (XA)); (XB) = MFMA32(kb_[s4_], qf[s4_], (XB)); } } while (0)
#define A_NEG(XV) do { _Pragma("unroll") for (int i_ = 0; i_ < 16; ++i_) (XV)[i_] = -1e30f; } while (0)
#define A_PV(XV, vbase) do { u32x4 pa_, pb_; \
            pa_.x = cvtpk((XV)[0], (XV)[1]); pa_.y = cvtpk((XV)[2], (XV)[3]); pa_.z = cvtpk((XV)[4], (XV)[5]); pa_.w = cvtpk((XV)[6], (XV)[7]); \
            pb_.x = cvtpk((XV)[8], (XV)[9]); pb_.y = cvtpk((XV)[10], (XV)[11]); pb_.z = cvtpk((XV)[12], (XV)[13]); pb_.w = cvtpk((XV)[14], (XV)[15]); \
            s16x4 t_[8]; lds_read_vt8((unsigned)(size_t)(vbase), t_); \
            const bf16x8 pfa_ = __builtin_bit_cast(bf16x8, pa_), pfb_ = __builtin_bit_cast(bf16x8, pb_); \
            o0 = MFMA32(__builtin_shufflevector(t_[0], t_[1], 0, 1, 2, 3, 4, 5, 6, 7), pfa_, o0); o1 = MFMA32(__builtin_shufflevector(t_[2], t_[3], 0, 1, 2, 3, 4, 5, 6, 7), pfa_, o1); \
            o0 = MFMA32(__builtin_shufflevector(t_[4], t_[5], 0, 1, 2, 3, 4, 5, 6, 7), pfb_, o0); o1 = MFMA32(__builtin_shufflevector(t_[6], t_[7], 0, 1, 2, 3, 4, 5, 6, 7), pfb_, o1); } while (0)
        if (type == 1) { const float* rp = inp(F, I_RPB) + ((size_t)l * 8 + h) * 465;
            for (int i = tid; i < 17 * 32; i += NTHR) { const int tr = i >> 5, tc = i & 31; rpbl[i] = (tr >= 1 && tr <= 15 && tc < 31) ? rp[(tr - 1) * 31 + tc] * LOG2E : -1e30f; } }
        A_STAGE_LOAD(0); A_STAGE_WRITE(0);
        __syncthreads();
        const LAS unsigned char* ldsl = F.ldsl;
        const int kro = r * AK_RS + 16 * hh;
        const int vro = (4 * hh + ((r & 15) >> 2)) * AV_RS + (16 * (r >> 4) + 4 * (r & 3)) * 2;
        const int krw = kro + kst * AK_RS, vrw = vro + kst * AV_RS;
        const int rqa = 4 * rg + 2 * (wave >> 2), rsa = rqa - 4 < 0 ? 0 : (rqa - 4 > 24 ? 24 : rqa - 4), rsb = rqa - 3 < 0 ? 0 : (rqa - 3 > 24 ? 24 : rqa - 3);
        const int nT = (nt + 1) >> 1;
#pragma unroll 1
        for (int T = 0; T < nT; ++T) {
            const int st = T & 1;
            if (VAR != 1) { if (T + 1 < nT) A_STAGE_LOAD(T + 1); }
            const LAS unsigned char* Kst = ldsl + st * ASTAGE; const LAS unsigned char* Vst = Kst + AK_BYTES;
            const bool vB = 2 * T + 1 < nt;
            const int jA = loc0 + 2 * T - 4, jB = jA + 1;
            if (VAR == 2) { } else
            if (T >= 2 && type == 1) {
                const bool nA = (jA >= rsa && jA <= rsb + 7), nB = vB && (jB >= rsa && jB <= rsb + 7);
                if (nA || nB) {
                    f32x16 x0, x1;
                    if (nA) { A_QK(x0, Kst + krw); const LAS unsigned char* tb = ldsl + A_RPB_OFF + ((jA >= rsl && jA <= rsl + 7) ? (jA - rq + 8) : 0) * 128;
#pragma unroll
                        for (int i = 0; i < 16; ++i) x0[i] += *(const LAS float*)(tb + BIX(i)); } else A_NEG(x0);
                    if (nB) { A_QK(x1, Kst + krw + 64 * AK_RS); const LAS unsigned char* tb = ldsl + A_RPB_OFF + ((jB >= rsl && jB <= rsl + 7) ? (jB - rq + 8) : 0) * 128;
#pragma unroll
                        for (int i = 0; i < 16; ++i) x1[i] += *(const LAS float*)(tb + BIX(i)); } else A_NEG(x1);
                    const float mt = rowmax32(x0, x1);
                    if (__any(mt > 8.0f)) {
                        const float dl = fmaxf(mt, 0.f), alpha = __builtin_amdgcn_exp2f(-dl);
                        m += dl; lsum *= alpha;
#pragma unroll
                        for (int i = 0; i < 16; ++i) { x0[i] -= dl; x1[i] -= dl; o0[i] *= alpha; o1[i] *= alpha; }
                    }
                    float ps = 0.f;
                    if (nA) {
#pragma unroll
                        for (int i = 0; i < 16; ++i) { x0[i] = __builtin_amdgcn_exp2f(x0[i]); ps += x0[i]; }
                        A_PV(x0, Vst + vrw); }
                    if (nB) {
#pragma unroll
                        for (int i = 0; i < 16; ++i) { x1[i] = __builtin_amdgcn_exp2f(x1[i]); ps += x1[i]; }
                        A_PV(x1, Vst + vrw + 64 * AV_RS); }
                    lsum += ps;
                }
            } else {
#pragma unroll
                for (int bi = 0; bi < 2; ++bi) {
                    if (bi == 1 && !vB) break;
                    const int j = jA + bi;
                    bool need = true, mask = false; int vlo = -1, vhi = 64;
                    if (T >= 2) { const int q0 = 32 * (wave & 3); need = (64 * j + 63 >= q0) && (64 * j <= q0 + 287); mask = !((64 * j >= q0 + 31) && (64 * j + 63 <= q0 + 256)); const int qi = q0 + (lane_id() & 31); vlo = qi - 64 * j; vhi = qi + 256 - 64 * j; }
                    if (need) {
                        f32x16 x0, x1;
                        A_QK2(x0, x1, Kst + kro + bi * 64 * AK_RS);
                        if (mask) {
#pragma unroll
                            for (int i = 0; i < 16; ++i) { const int k0 = (i & 3) + 8 * (i >> 2) + 4 * hh, k1 = k0 + 32; x0[i] = (k0 >= vlo && k0 <= vhi) ? x0[i] : -1e30f; x1[i] = (k1 >= vlo && k1 <= vhi) ? x1[i] : -1e30f; }
                        }
                        const float mt = rowmax32(x0, x1);
                        const bool fst = !sw && T == 0 && bi == 0;
                        if (fst || __any(mt > 8.0f)) {
                            const float dl = fst ? mt : fmaxf(mt, 0.f), alpha = fst ? 1.f : __builtin_amdgcn_exp2f(-dl);
                            m += dl; lsum *= alpha;
#pragma unroll
                            for (int i = 0; i < 16; ++i) { x0[i] -= dl; x1[i] -= dl; o0[i] *= alpha; o1[i] *= alpha; }
                        }
                        float ps = 0.f;
#pragma unroll
                        for (int i = 0; i < 16; ++i) { x0[i] = __builtin_amdgcn_exp2f(x0[i]); ps += x0[i]; }
                        A_PV(x0, Vst + vro + bi * 64 * AV_RS);
#pragma unroll
                        for (int i = 0; i < 16; ++i) { x1[i] = __builtin_amdgcn_exp2f(x1[i]); ps += x1[i]; }
                        lsum += ps;
                        A_PV(x1, Vst + vro + (bi * 64 + 32) * AV_RS);
                    }
                }
            }
            if (VAR != 1) { if (T + 1 < nT) A_STAGE_WRITE(st ^ 1); }
            __syncthreads();
        }
#undef A_QK
#undef A_QK2
#undef A_NEG
#undef A_PV
#undef BIX
        const float inv = 1.0f / (lsum + __shfl_xor(lsum, 32));
        const int l2 = lane_id(), r2 = l2 & 31, h2 = l2 >> 5;
        const int rq2 = 4 * rg + 2 * (wave >> 2) + (r2 >> 4), cq2 = 16 * (wave & 3) + (r2 & 15);
        const int qrow2 = (type == 1) ? bl * SEQ + 64 * rq2 + cq2 : (type == 0) ? bl * SEQ + 128 * n + 32 * (wave & 3) + r2 : LROWS + bl * CTX + 32 * wave + r2;
        bf16* op = ob + (size_t)qrow2 * OW + ocol + 4 * h2;
#pragma unroll
        for (int g = 0; g < 4; ++g) {
            u32x2 w0, w1; w0.x = cvtpk(o0[4 * g] * inv, o0[4 * g + 1] * inv); w0.y = cvtpk(o0[4 * g + 2] * inv, o0[4 * g + 3] * inv);
            w1.x = cvtpk(o1[4 * g] * inv, o1[4 * g + 1] * inv); w1.y = cvtpk(o1[4 * g + 2] * inv, o1[4 * g + 3] * inv);
            *(u32x2*)(op + 8 * g) = w0; *(u32x2*)(op + 32 + 8 * g) = w1;
        }
    }
#undef A_TILE_ROW0
#undef A_STAGE_LOAD
#undef A_STAGE_WRITE
}
template <int VAR>
__device__ __forceinline__ void attn_phase(Frame& F, int l, int ch, bool last, bf16* ob) {
    { const int tid = F.wave * 64 + launder(lane_id()); const f32x2* tab = (const f32x2*)(F.ws + WS_ROPE);
      f32x2* rl = (f32x2*)(F.lds + A_ROPE_OFF); for (int i = tid; i < 96 * 16; i += NTHR) { const int a = i >> 4, f = i & 15; rl[i] = (a < 32) ? tab[(size_t)(a * 64) * 32 + f] : tab[(size_t)(a - 32) * 32 + 16 + f]; } }
    __syncthreads();
    attn_units<VAR, 1>(F, l, ch, last, ob);
    attn_units<VAR, 0>(F, l, ch, last, ob);
    attn_units<VAR, 2>(F, l, ch, last, ob);
}


template <int NPL>
__device__ __forceinline__ void topk_select_wave(const float* aff, int cap, int crbase, int ubase, int slot0, int e, int* tokslot, float* gatev, int* seltok, int lane) {
    unsigned v[NPL];
#pragma unroll
    for (int i = 0; i < NPL; i += 4) { const u32x4 t = *(const u32x4*)(aff + lane * NPL + i); v[i] = t.x; v[i + 1] = t.y; v[i + 2] = t.z; v[i + 3] = t.w; }
    unsigned T = 0u;
#pragma unroll 1
    for (int bit = 30; bit >= 0; --bit) {
        const unsigned cand = T | (1u << bit); int c = 0;
#pragma unroll
        for (int i = 0; i < NPL; ++i) c += (v[i] >= cand) ? 1 : 0;
#pragma unroll
        for (int o = 1; o < 64; o <<= 1) c += __shfl_xor(c, o);
        if (c >= cap) T = cand;
    }
    int ngt = 0, nti = 0;
#pragma unroll
    for (int i = 0; i < NPL; ++i) { ngt += (v[i] > T) ? 1 : 0; nti += (v[i] == T) ? 1 : 0; }
    int tot_gt = ngt;
#pragma unroll
    for (int o = 1; o < 64; o <<= 1) tot_gt += __shfl_xor(tot_gt, o);
    const int need = cap - tot_gt;
    int tinc = nti;
#pragma unroll
    for (int o = 1; o < 64; o <<= 1) { const int t = __shfl_up(tinc, o); if (lane >= o) tinc += t; }
    int tie_before = tinc - nti;
    unsigned selmask = 0u; int nsel = 0;
#pragma unroll
    for (int i = 0; i < NPL; ++i) { const bool tie = (v[i] == T); const bool sel = (v[i] > T) || (tie && tie_before < need); tie_before += tie ? 1 : 0; selmask |= sel ? (1u << i) : 0u; nsel += sel ? 1 : 0; }
    int sinc = nsel;
#pragma unroll
    for (int o = 1; o < 64; o <<= 1) { const int t = __shfl_up(sinc, o); if (lane >= o) sinc += t; }
    int pos = sinc - nsel;
#pragma unroll
    for (int i = 0; i < NPL; ++i) {
        const bool sel = (selmask >> i) & 1u; const int t = lane * NPL + i;
        tokslot[(size_t)(crbase + t) * NE + e] = sel ? pos : -1;
        if (sel) { seltok[slot0 + pos] = ubase + crbase + t; gatev[slot0 + pos] = __builtin_bit_cast(float, v[i]); ++pos; }
    }
}
__device__ __forceinline__ void topk_phase(Frame& F, bool last) {
    const int lane = launder(lane_id());
    int* gsel = (int*)(F.ws + WS_SELTOK);
    float* gatev = (float*)(F.ws + WS_GATEV);
    const bool cx = !last;
    for (int p = F.vcu; p < BC * NE; p += F.G) {
        const int bl = p / NE, e = p % NE;
        const int slotL = p * CAP_L, slotC0 = SLOT_CT0 + e * (NB * CAP_C) + bl * CAP_C, slotC1 = slotC0 + BC * CAP_C;
        if (F.wave == 0) topk_select_wave<32>(affl_of(F, 0) + (size_t)p * SEQ, CAP_L, bl * SEQ, 0, slotL, e, tokslot_of(F, 0), gatev, gsel, lane);
        else if (F.wave == 3) topk_select_wave<32>(affl_of(F, 1) + (size_t)p * SEQ, CAP_L, bl * SEQ, RCMAX, NSLOTMAX + slotL, e, tokslot_of(F, 1), gatev, gsel, lane);
        else if (F.wave == 1 && cx) topk_select_wave<4>((const float*)(F.ws + WS_AFFC) + (size_t)p * CTX, CAP_C, LROWS + bl * CTX, 0, slotC0, e, tokslot_of(F, 0), gatev, gsel, lane);
        else if (F.wave == 2 && cx) topk_select_wave<4>((const float*)(F.ws + WS_AFFC) + (size_t)(p + BC * NE) * CTX, CAP_C, LROWS + (bl + BC) * CTX, 0, slotC1, e, tokslot_of(F, 0), gatev, gsel, lane);
    }
}

__device__ __forceinline__ void combine_phase(Frame& F, int l, int ch, bool last, bool dry = false) {
    const int lane = launder(lane_id()), tid = F.wave * 64 + lane; (void)tid; (void)lane;
    const int gw = F.vcu * NWAVES + F.wave, NGW = F.G * NWAVES;
    const int nrows = last ? LROWS : nrows_of(ch);
    const bf16* yb = (const bf16*)(F.ws + WS_YBUF) + (size_t)ch * NSLOTMAX * D; const int* tokslot = tokslot_of(F, ch); const float* gatev = (const float*)(F.ws + WS_GATEV) + (size_t)ch * NSLOTMAX;
    u32x2 xq[2][4], yqa[2][4], yqb[2][4]; float gaq[2], gbq[2]; int slq[2]; unsigned mrq[2]; bool anyq[2], twoq[2];
#define CB_ISSUE(u_, c_) do { const int c__ = (c_); const bool lat_ = c__ < LROWS; const int bl_ = lat_ ? c__ / SEQ : (c__ - LROWS) / CTX; \
        const int sh_ = sll[(c__ - rbeg) * NE + (lane & 15)]; const int my_ = (lane < 16) ? sh_ : -1; slq[u_] = my_; \
        unsigned m_ = (unsigned)__ballot(my_ >= 0) & 0xFFFFu; const bool any_ = m_ != 0u; const int e0_ = any_ ? __builtin_ctz(m_) : 0; m_ &= m_ - 1u; \
        const bool two_ = m_ != 0u; const int e1_ = two_ ? __builtin_ctz(m_) : e0_; if (two_) m_ &= m_ - 1u; \
        const int p0_ = any_ ? __shfl(my_, e0_) : 0, p1_ = two_ ? __shfl(my_, e1_) : p0_; \
        const int s0_ = lat_ ? (bl_ * NE + e0_) * CAP_L + p0_ : SLOT_CT0 + e0_ * (NB * CAP_C) + bl_ * CAP_C + p0_; \
        const int s1_ = lat_ ? (bl_ * NE + e1_) * CAP_L + p1_ : SLOT_CT0 + e1_ * (NB * CAP_C) + bl_ * CAP_C + p1_; \
        anyq[u_] = any_; twoq[u_] = two_; mrq[u_] = m_; gaq[u_] = gatev[s0_]; gbq[u_] = gatev[s1_]; const bf16* xb_ = xbrow(F, ch, c__); \
        _Pragma("unroll") for (int j_ = 0; j_ < 4; ++j_) { xq[u_][j_] = *(const u32x2*)(xb_ + lane * 4 + 256 * j_); \
            yqa[u_][j_] = *(const u32x2*)(yb + (size_t)s0_ * D + lane * 4 + 256 * j_); yqb[u_][j_] = *(const u32x2*)(yb + (size_t)s1_ * D + lane * 4 + 256 * j_); } } while (0)
    const int rpw = (((nrows + NGW - 1) / NGW) + 1) & ~1, rbeg = gw * rpw, rend = (rbeg + rpw < nrows) ? rbeg + rpw : nrows;
    f32x4 gtq[4], shq[4], scq[4], gmq[4]; int cmv = -1;
#pragma unroll
    for (int j = 0; j < 4; ++j) gmq[j] = *(const f32x4*)((last ? inp(F, I_GFINAL) : inp(F, I_GMIX) + (size_t)(l + 1) * D) + lane * 4 + 256 * j);
    if (rbeg >= rend) return;
    LAS int* sll = (LAS int*)(F.ldsl + LDSCTL_OFF + 1024 + F.wave * 1536);
    for (int i = lane; i < (rend - rbeg) * NE; i += 64) sll[i] = tokslot[(size_t)rbeg * NE + i];
    CB_ISSUE(0, rbeg); CB_ISSUE(1, rbeg + 1);
    unsigned res[2][16];
#define CB_STORE(cp_) do { _Pragma("unroll") for (int u_ = 0; u_ < 2; ++u_) { const int cq_ = (cp_) + u_; \
        if (!last) { bf16* xb_ = dry ? (bf16*)(F.ws + WS_OBUF) + (size_t)cq_ * D : xbrow(F, ch, cq_); bf16* hb_ = (dry ? (bf16*)(F.ws + WS_OBUF + 160 * MiB) : hbuf_of(F, ch)) + (size_t)cq_ * D; \
            _Pragma("unroll") for (int j_ = 0; j_ < 4; ++j_) { u32x2 o_; o_.x = res[u_][4 * j_]; o_.y = res[u_][4 * j_ + 1]; *(u32x2*)(xb_ + lane * 4 + 256 * j_) = o_; \
                u32x2 h_; h_.x = res[u_][4 * j_ + 2]; h_.y = res[u_][4 * j_ + 3]; *(u32x2*)(hb_ + lane * 4 + 256 * j_) = h_; } } \
        else { float* xr_ = dry ? (float*)(F.ws + WS_OBUF) + (size_t)cq_ * D : F.out + ((size_t)ch * LROWS + cq_) * D;     \
            _Pragma("unroll") for (int j_ = 0; j_ < 4; ++j_) { f32x4 o_; o_.x = __builtin_bit_cast(float, res[u_][4 * j_]); o_.y = __builtin_bit_cast(float, res[u_][4 * j_ + 1]); o_.z = __builtin_bit_cast(float, res[u_][4 * j_ + 2]); o_.w = __builtin_bit_cast(float, res[u_][4 * j_ + 3]); \
                *(f32x4*)(xr_ + lane * 4 + 256 * j_) = o_; } } } } while (0)
    for (int c0 = rbeg; c0 < rend; c0 += 2) {
        int myslot[2]; unsigned mask[2]; f32x4 v[2][4]; float acc[2][16];
#pragma unroll
        for (int u = 0; u < 2; ++u) { myslot[u] = slq[u]; mask[u] = mrq[u];
            const float ga = anyq[u] ? gaq[u] : 0.f, gb = twoq[u] ? gbq[u] : 0.f;
#pragma unroll
            for (int j = 0; j < 4; ++j) { const u32x2 t = xq[u][j]; v[u][j].x = bflo(t.x); v[u][j].y = bfhi(t.x); v[u][j].z = bflo(t.y); v[u][j].w = bfhi(t.y);
                const u32x2 a = yqa[u][j], b = yqb[u][j];
                acc[u][4 * j] = ga * bflo(a.x); acc[u][4 * j + 1] = ga * bfhi(a.x); acc[u][4 * j + 2] = ga * bflo(a.y); acc[u][4 * j + 3] = ga * bfhi(a.y);
                acc[u][4 * j] += gb * bflo(b.x); acc[u][4 * j + 1] += gb * bfhi(b.x); acc[u][4 * j + 2] += gb * bflo(b.y); acc[u][4 * j + 3] += gb * bfhi(b.y); }
#pragma unroll
            for (int j = 0; j < 4; ++j) asm volatile("" : "+v"(v[u][j].x), "+v"(v[u][j].y), "+v"(v[u][j].z), "+v"(v[u][j].w), "+v"(acc[u][4 * j]), "+v"(acc[u][4 * j + 1]), "+v"(acc[u][4 * j + 2]), "+v"(acc[u][4 * j + 3]) :: "memory");
        }
        if (c0 > rbeg) CB_STORE(c0 - 2);
        if (c0 + 2 < rend) { CB_ISSUE(0, c0 + 2); CB_ISSUE(1, c0 + 3); }
#pragma unroll
      for (int u = 0; u < 2; ++u) {
        const int cr = c0 + u;
        const bool lat = cr < LROWS; const int bl = lat ? cr / SEQ : (cr - LROWS) / CTX;
        { const int mv = mv_of(ch, cr); if (mv != cmv) { cmv = mv; const float* gt = mod_ptr(F, l, mv, 5); const float* sh = mod_ptr(F, last ? l : l + 1, mv, 0); const float* sc = mod_ptr(F, last ? l : l + 1, mv, 1);
#pragma unroll
            for (int j = 0; j < 4; ++j) { gtq[j] = *(const f32x4*)(gt + lane * 4 + 256 * j); shq[j] = *(const f32x4*)(sh + lane * 4 + 256 * j); scq[j] = *(const f32x4*)(sc + lane * 4 + 256 * j); } } }
        unsigned mk = mask[u];
        while (mk) {
            const int e0 = __builtin_ctz(mk); mk &= mk - 1;
            const bool two = mk != 0u; const int e1 = two ? __builtin_ctz(mk) : e0; if (two) mk &= mk - 1;
            const int p0 = __shfl(myslot[u], e0), p1 = __shfl(myslot[u], e1);
            const int s0 = lat ? (bl * NE + e0) * CAP_L + p0 : SLOT_CT0 + e0 * (NB * CAP_C) + bl * CAP_C + p0;
            const int s1 = lat ? (bl * NE + e1) * CAP_L + p1 : SLOT_CT0 + e1 * (NB * CAP_C) + bl * CAP_C + p1;
            u32x2 ua[4], ub[4]; const float ga = gatev[s0], gb = gatev[s1];
#pragma unroll
            for (int j = 0; j < 4; ++j) { ua[j] = *(const u32x2*)(yb + (size_t)s0 * D + lane * 4 + 256 * j); ub[j] = *(const u32x2*)(yb + (size_t)s1 * D + lane * 4 + 256 * j); }
#pragma unroll
            for (int j = 0; j < 4; ++j) { acc[u][4 * j] += ga * bflo(ua[j].x); acc[u][4 * j + 1] += ga * bfhi(ua[j].x); acc[u][4 * j + 2] += ga * bflo(ua[j].y); acc[u][4 * j + 3] += ga * bfhi(ua[j].y); }
            if (two) {
#pragma unroll
                for (int j = 0; j < 4; ++j) { acc[u][4 * j] += gb * bflo(ub[j].x); acc[u][4 * j + 1] += gb * bfhi(ub[j].x); acc[u][4 * j + 2] += gb * bflo(ub[j].y); acc[u][4 * j + 3] += gb * bfhi(ub[j].y); }
            }
        }
        float ss = 0.f;
#pragma unroll
        for (int j = 0; j < 4; ++j) { const f32x4 g4 = gtq[j];
            v[u][j].x += g4.x * acc[u][4 * j]; v[u][j].y += g4.y * acc[u][4 * j + 1]; v[u][j].z += g4.z * acc[u][4 * j + 2]; v[u][j].w += g4.w * acc[u][4 * j + 3];
            ss += (v[u][j].x * v[u][j].x + v[u][j].y * v[u][j].y) + (v[u][j].z * v[u][j].z + v[u][j].w * v[u][j].w); }
        const float rstd = 1.0f / sqrtf(wave_sum(ss) * (1.0f / D) + RMS_EPS);
        if (!last) {
#pragma unroll
            for (int j = 0; j < 4; ++j) {
                const f32x4 hv = (v[u][j] * rstd * gmq[j]) * (scq[j] + 1.0f) + shq[j];
                res[u][4 * j] = pk2(v[u][j].x, v[u][j].y); res[u][4 * j + 1] = pk2(v[u][j].z, v[u][j].w); res[u][4 * j + 2] = pk2(hv.x, hv.y); res[u][4 * j + 3] = pk2(hv.z, hv.w);
            }
            continue;
        }
        {
            float scl = 1.0f;
#if defined(PROBE_ATTN)
            { const unsigned cn = __hip_atomic_load((unsigned*)(F.ws + WS_CTL) + CW_DIAG, __ATOMIC_RELAXED, __HIP_MEMORY_SCOPE_AGENT); scl = 1.0f + 0.02f * log2f(1.0f + (float)cn); }
#endif
#pragma unroll
            for (int j = 0; j < 4; ++j) { const f32x4 o = v[u][j] * rstd * gmq[j] * scl; const float ox = o.x, oy = o.y, oz = o.z, ow = o.w;
                res[u][4 * j] = __builtin_bit_cast(unsigned, ox); res[u][4 * j + 1] = __builtin_bit_cast(unsigned, oy); res[u][4 * j + 2] = __builtin_bit_cast(unsigned, oz); res[u][4 * j + 3] = __builtin_bit_cast(unsigned, ow); }
        }
      }
    }
    CB_STORE(rend - 2);
#undef CB_STORE
#undef CB_ISSUE
}

using pg8::Unit; using pg8::cvt_pk_bf16;
struct SchedBase { int nM, nN, G, c, rep;
    __device__ __forceinline__ bool tile(int i, int& pm, int& pn, int& sub) const { sub = i % rep; return pg8::tile_of((long)(i / rep) * G + c, nM, nN, pm, pn); } };

struct SchedIn : SchedBase { const char* A; const char* B; int nMfull = 0, kvM = 0;
    __device__ __forceinline__ bool next(int i, Unit& u) const { int sub; u.aux = 0; u.pad = 0;
        if (!tile(i, u.pm, u.pn, sub)) {
            const long L = (long)(i / rep) * G + c - (long)nM * nN; if (kvM == 0 || L < 0 || L >= (long)kvM * 5) return false;
            const int q = (int)L % 5; u.pm = nM + (int)L / 5; u.pn = q < 4 ? 8 + q : 14; }
        u.A = A + (size_t)u.pm * 256 * D * 2; u.B = B + (size_t)u.pn * 256 * D * 2; return true; } };
__device__ __forceinline__ size_t gb_off(int pm, int g, int wr, int wc, int fr, int fq) { return ((size_t)(pm * 12 + g) * 131072) + (size_t)(((wr * 4 + wc) * 64 + fq * 16 + fr) * 16); }
struct EpiStoreBf16 { static constexpr bool PERM = true; bf16* O; int ldc; unsigned char* GB;
    __device__ __forceinline__ void operator()(const f32x4 (&acc)[2][2][4][2], const Unit& u, int wr, int wc, int fr, int fq) const {
        if (u.pn >= Z_G / 256) {
            unsigned char* gp = GB + gb_off(u.pm, u.pn - Z_G / 256, wr, wc, fr, fq);
#pragma unroll
            for (int ai = 0; ai < 2; ++ai)
#pragma unroll
                for (int m = 0; m < 4; ++m)
#pragma unroll
                    for (int bj = 0; bj < 2; ++bj) { f32x4 v0 = acc[ai][bj][m][0], v1 = acc[ai][bj][m][1];
#pragma unroll
                        for (int j = 0; j < 4; ++j) { v0[j] = fmaxf(sigmoidf_(v0[j]), 1e-30f); v1[j] = fmaxf(sigmoidf_(v1[j]), 1e-30f); }
                        u32x4 w; w.x = cvt_pk_bf16(v0[0], v0[1]); w.y = cvt_pk_bf16(v0[2], v0[3]); w.z = cvt_pk_bf16(v1[0], v1[1]); w.w = cvt_pk_bf16(v1[2], v1[3]);
                        __builtin_nontemporal_store(w, (u32x4*)(gp + ((ai * 4 + m) * 2 + bj) * 8192)); }
        } else {
            const int row0 = u.pm * 256 + wr * 64 + fr, col0 = u.pn * 256 + wc * 32 + 8 * fq;
#pragma unroll
            for (int ai = 0; ai < 2; ++ai)
#pragma unroll
                for (int m = 0; m < 4; ++m) { bf16* rowp = O + (size_t)(row0 + ai * 128 + m * 16) * ldc + col0;
#pragma unroll
                    for (int bj = 0; bj < 2; ++bj) { const f32x4 v0 = acc[ai][bj][m][0], v1 = acc[ai][bj][m][1];
                        u32x4 w; w.x = cvt_pk_bf16(v0[0], v0[1]); w.y = cvt_pk_bf16(v0[2], v0[3]); w.z = cvt_pk_bf16(v1[0], v1[1]); w.w = cvt_pk_bf16(v1[2], v1[3]);
                        __builtin_nontemporal_store(w, (u32x4*)(rowp + bj * 128)); } }
        }
    } };

struct SchedMerge : SchedBase { const char* A; const char* B;
    __device__ __forceinline__ bool next(int i, Unit& u) const { int sub; if (!tile(i, u.pm, u.pn, sub)) return false; u.aux = 0; u.pad = 0;
        u.A = A + (size_t)u.pm * 256 * OW * 2; u.B = B + (size_t)u.pn * 256 * 1536 * 2; return true; } };
__device__ __forceinline__ void gate_load8x2(const unsigned char* sbase, unsigned vo, u32x4 (&a)[8], u32x4 (&b)[8]) {
    unsigned t0, t1, t2, t3;
    asm volatile("v_add_u32 %[t0], 0, %[vo]\n\tglobal_load_dwordx4 %[a0], %[t0], %[sb]\n\t"
        "v_add_u32 %[t2], 524288, %[vo]\n\tglobal_load_dwordx4 %[b0], %[t2], %[sb]\n\t"
        "v_add_u32 %[t1], 8192, %[vo]\n\tglobal_load_dwordx4 %[a1], %[t1], %[sb]\n\t"
        "v_add_u32 %[t3], 532480, %[vo]\n\tglobal_load_dwordx4 %[b1], %[t3], %[sb]\n\t"
        "v_add_u32 %[t0], 16384, %[vo]\n\tglobal_load_dwordx4 %[a2], %[t0], %[sb]\n\t"
        "v_add_u32 %[t2], 540672, %[vo]\n\tglobal_load_dwordx4 %[b2], %[t2], %[sb]\n\t"
        "v_add_u32 %[t1], 24576, %[vo]\n\tglobal_load_dwordx4 %[a3], %[t1], %[sb]\n\t"
        "v_add_u32 %[t3], 548864, %[vo]\n\tglobal_load_dwordx4 %[b3], %[t3], %[sb]\n\t"
        "v_add_u32 %[t0], 32768, %[vo]\n\tglobal_load_dwordx4 %[a4], %[t0], %[sb]\n\t"
        "v_add_u32 %[t2], 557056, %[vo]\n\tglobal_load_dwordx4 %[b4], %[t2], %[sb]\n\t"
        "v_add_u32 %[t1], 40960, %[vo]\n\tglobal_load_dwordx4 %[a5], %[t1], %[sb]\n\t"
        "v_add_u32 %[t3], 565248, %[vo]\n\tglobal_load_dwordx4 %[b5], %[t3], %[sb]\n\t"
        "v_add_u32 %[t0], 49152, %[vo]\n\tglobal_load_dwordx4 %[a6], %[t0], %[sb]\n\t"
        "v_add_u32 %[t2], 573440, %[vo]\n\tglobal_load_dwordx4 %[b6], %[t2], %[sb]\n\t"
        "v_add_u32 %[t1], 57344, %[vo]\n\tglobal_load_dwordx4 %[a7], %[t1], %[sb]\n\t"
        "v_add_u32 %[t3], 581632, %[vo]\n\tglobal_load_dwordx4 %[b7], %[t3], %[sb]\n\t"
        "s_waitcnt vmcnt(0)"
        : [a0]"=&v"(a[0]), [a1]"=&v"(a[1]), [a2]"=&v"(a[2]), [a3]"=&v"(a[3]), [a4]"=&v"(a[4]), [a5]"=&v"(a[5]), [a6]"=&v"(a[6]), [a7]"=&v"(a[7]), [b0]"=&v"(b[0]), [b1]"=&v"(b[1]), [b2]"=&v"(b[2]), [b3]"=&v"(b[3]), [b4]"=&v"(b[4]), [b5]"=&v"(b[5]), [b6]"=&v"(b[6]), [b7]"=&v"(b[7]), [t0]"=&v"(t0), [t1]"=&v"(t1), [t2]"=&v"(t2), [t3]"=&v"(t3)
        : [vo]"v"(vo), [sb]"s"(sbase) : "memory");
}
__device__ __forceinline__ void gate_load16(const unsigned char* sbase, unsigned vo, u32x4 (&a)[16]) {
    unsigned t0, t1;
    asm volatile("v_add_u32 %[t0], 0, %[vo]\n\tglobal_load_dwordx4 %[a0], %[t0], %[sb]\n\t"
        "v_add_u32 %[t1], 8192, %[vo]\n\tglobal_load_dwordx4 %[a1], %[t1], %[sb]\n\t"
        "v_add_u32 %[t0], 16384, %[vo]\n\tglobal_load_dwordx4 %[a2], %[t0], %[sb]\n\t"
        "v_add_u32 %[t1], 24576, %[vo]\n\tglobal_load_dwordx4 %[a3], %[t1], %[sb]\n\t"
        "v_add_u32 %[t0], 32768, %[vo]\n\tglobal_load_dwordx4 %[a4], %[t0], %[sb]\n\t"
        "v_add_u32 %[t1], 40960, %[vo]\n\tglobal_load_dwordx4 %[a5], %[t1], %[sb]\n\t"
        "v_add_u32 %[t0], 49152, %[vo]\n\tglobal_load_dwordx4 %[a6], %[t0], %[sb]\n\t"
        "v_add_u32 %[t1], 57344, %[vo]\n\tglobal_load_dwordx4 %[a7], %[t1], %[sb]\n\t"
        "v_add_u32 %[t0], 65536, %[vo]\n\tglobal_load_dwordx4 %[a8], %[t0], %[sb]\n\t"
        "v_add_u32 %[t1], 73728, %[vo]\n\tglobal_load_dwordx4 %[a9], %[t1], %[sb]\n\t"
        "v_add_u32 %[t0], 81920, %[vo]\n\tglobal_load_dwordx4 %[a10], %[t0], %[sb]\n\t"
        "v_add_u32 %[t1], 90112, %[vo]\n\tglobal_load_dwordx4 %[a11], %[t1], %[sb]\n\t"
        "v_add_u32 %[t0], 98304, %[vo]\n\tglobal_load_dwordx4 %[a12], %[t0], %[sb]\n\t"
        "v_add_u32 %[t1], 106496, %[vo]\n\tglobal_load_dwordx4 %[a13], %[t1], %[sb]\n\t"
        "v_add_u32 %[t0], 114688, %[vo]\n\tglobal_load_dwordx4 %[a14], %[t0], %[sb]\n\t"
        "v_add_u32 %[t1], 122880, %[vo]\n\tglobal_load_dwordx4 %[a15], %[t1], %[sb]\n\t"
        "s_waitcnt vmcnt(0)"
        : [a0]"=&v"(a[0]), [a1]"=&v"(a[1]), [a2]"=&v"(a[2]), [a3]"=&v"(a[3]), [a4]"=&v"(a[4]), [a5]"=&v"(a[5]), [a6]"=&v"(a[6]), [a7]"=&v"(a[7]), [a8]"=&v"(a[8]), [a9]"=&v"(a[9]), [a10]"=&v"(a[10]), [a11]"=&v"(a[11]), [a12]"=&v"(a[12]), [a13]"=&v"(a[13]), [a14]"=&v"(a[14]), [a15]"=&v"(a[15]), [t0]"=&v"(t0), [t1]"=&v"(t1)
        : [vo]"v"(vo), [sb]"s"(sbase) : "memory");
}
struct EpiMerge { static constexpr bool PERM = true; const unsigned char* GB; bf16* O;
    __device__ __forceinline__ void mid(f32x4 (&acc)[2][2][4][2], const Unit& u, int seg, int wr, int wc, int fr, int fq) const {
        const unsigned char* tb = GB + (size_t)(u.pm * 12 + (seg - 1) * 4 + u.pn) * 131072;
        const unsigned vo = (unsigned)(((wr * 4 + wc) * 64 + fq * 16 + fr) * 16);
#pragma unroll
        for (int ai = 0; ai < 2; ++ai) {
            u32x4 a[8], b[8]; gate_load8x2(tb + ai * 65536, vo, a, b);
#pragma unroll
            for (int m = 0; m < 4; ++m)
#pragma unroll
                for (int bj = 0; bj < 2; ++bj) { float gpv[8], gnv[8]; unpack8(a[m * 2 + bj], gpv); unpack8(b[m * 2 + bj], gnv);
#pragma unroll
                    for (int j = 0; j < 4; ++j) { acc[ai][bj][m][0][j] *= gpv[j] * __builtin_amdgcn_rcpf(gnv[j]); acc[ai][bj][m][1][j] *= gpv[4 + j] * __builtin_amdgcn_rcpf(gnv[4 + j]); } }
        }
    }
    __device__ __forceinline__ void operator()(const f32x4 (&acc)[2][2][4][2], const Unit& u, int wr, int wc, int fr, int fq) const {
        const int row0 = u.pm * 256 + wr * 64 + fr, col0 = u.pn * 256 + wc * 32 + 8 * fq;
        const unsigned char* tb = GB + (size_t)(u.pm * 12 + 8 + u.pn) * 131072;
        const unsigned vo = (unsigned)(((wr * 4 + wc) * 64 + fq * 16 + fr) * 16);
        u32x4 g[16]; gate_load16(tb, vo, g);
#pragma unroll
        for (int ai = 0; ai < 2; ++ai)
#pragma unroll
            for (int m = 0; m < 4; ++m) { const size_t row = (size_t)(row0 + ai * 128 + m * 16);
#pragma unroll
                for (int bj = 0; bj < 2; ++bj) { const int col = col0 + bj * 128;
                    float g8[8]; unpack8(g[(ai * 4 + m) * 2 + bj], g8);
                    const f32x4 v0 = acc[ai][bj][m][0], v1 = acc[ai][bj][m][1];
                    u32x4 w; w.x = cvt_pk_bf16(v0[0] * g8[0], v0[1] * g8[1]); w.y = cvt_pk_bf16(v0[2] * g8[2], v0[3] * g8[3]); w.z = cvt_pk_bf16(v1[0] * g8[4], v1[1] * g8[5]); w.w = cvt_pk_bf16(v1[2] * g8[6], v1[3] * g8[7]);
                    *(u32x4*)(O + row * D + col) = w; } }
    } };

__device__ __forceinline__ void xres_load16(const unsigned char* sbase, unsigned vo, unsigned p16, u32x4 (&a)[16]) {
    const unsigned o1 = __builtin_amdgcn_readfirstlane(p16), o2 = 2 * o1, o3 = 3 * o1, o8 = 8 * o1, o9 = 9 * o1, o10 = 10 * o1, o11 = 11 * o1;
    unsigned t0, t1;
    asm volatile("global_load_dwordx4 %[a0], %[vo], %[sb]\n\tglobal_load_dwordx4 %[a1], %[vo], %[sb] offset:256\n\t"
        "v_add_u32 %[t0], %[o1], %[vo]\n\tglobal_load_dwordx4 %[a2], %[t0], %[sb]\n\tglobal_load_dwordx4 %[a3], %[t0], %[sb] offset:256\n\t"
        "v_add_u32 %[t1], %[o2], %[vo]\n\tglobal_load_dwordx4 %[a4], %[t1], %[sb]\n\tglobal_load_dwordx4 %[a5], %[t1], %[sb] offset:256\n\t"
        "v_add_u32 %[t0], %[o3], %[vo]\n\tglobal_load_dwordx4 %[a6], %[t0], %[sb]\n\tglobal_load_dwordx4 %[a7], %[t0], %[sb] offset:256\n\t"
        "v_add_u32 %[t1], %[o8], %[vo]\n\tglobal_load_dwordx4 %[a8], %[t1], %[sb]\n\tglobal_load_dwordx4 %[a9], %[t1], %[sb] offset:256\n\t"
        "v_add_u32 %[t0], %[o9], %[vo]\n\tglobal_load_dwordx4 %[a10], %[t0], %[sb]\n\tglobal_load_dwordx4 %[a11], %[t0], %[sb] offset:256\n\t"
        "v_add_u32 %[t1], %[o10], %[vo]\n\tglobal_load_dwordx4 %[a12], %[t1], %[sb]\n\tglobal_load_dwordx4 %[a13], %[t1], %[sb] offset:256\n\t"
        "v_add_u32 %[t0], %[o11], %[vo]\n\tglobal_load_dwordx4 %[a14], %[t0], %[sb]\n\tglobal_load_dwordx4 %[a15], %[t0], %[sb] offset:256\n\t"
        "s_waitcnt vmcnt(0)"
        : [a0]"=&v"(a[0]), [a1]"=&v"(a[1]), [a2]"=&v"(a[2]), [a3]"=&v"(a[3]), [a4]"=&v"(a[4]), [a5]"=&v"(a[5]), [a6]"=&v"(a[6]), [a7]"=&v"(a[7]), [a8]"=&v"(a[8]), [a9]"=&v"(a[9]), [a10]"=&v"(a[10]), [a11]"=&v"(a[11]), [a12]"=&v"(a[12]), [a13]"=&v"(a[13]), [a14]"=&v"(a[14]), [a15]"=&v"(a[15]), [t0]"=&v"(t0), [t1]"=&v"(t1)
        : [vo]"v"(vo), [sb]"s"(sbase), [o1]"s"(o1), [o2]"s"(o2), [o3]"s"(o3), [o8]"s"(o8), [o9]"s"(o9), [o10]"s"(o10), [o11]"s"(o11) : "memory");
}
struct EpiOut { static constexpr bool PERM = true; const Frame* F; int l, ch;
    __device__ __forceinline__ void operator()(const f32x4 (&acc)[2][2][4][2], const Unit& u, int wr, int wc, int fr, int fq) const {
        const int cr0 = u.pm * 256; const float* gt = mod_ptr(*F, l, mv_of(ch, cr0), 2);
        const int col0 = u.pn * 256 + wc * 32 + 8 * fq;
        const bool lat = cr0 < LROWS;
        const unsigned pitch = lat ? 4096u : 2048u;
        const unsigned long long bq = (unsigned long long)(unsigned char*)xbrow(*F, ch, cr0);
        const unsigned blo = (unsigned)__builtin_amdgcn_readfirstlane((unsigned)bq), bhi = (unsigned)__builtin_amdgcn_readfirstlane((unsigned)(bq >> 32));
        const unsigned char* sbase = (const unsigned char*)(((unsigned long long)bhi << 32) | blo);
        const unsigned vo = (unsigned)(wr * 64 + fr) * pitch + (unsigned)col0 * 2u;
        f32x4 g[2][2];
#pragma unroll
        for (int bj = 0; bj < 2; ++bj) { g[bj][0] = *(const f32x4*)(gt + col0 + bj * 128); g[bj][1] = *(const f32x4*)(gt + col0 + bj * 128 + 4); }
        u32x4 xv[16]; xres_load16(sbase, vo, 16u * pitch, xv);
#pragma unroll
        for (int ai = 0; ai < 2; ++ai)
#pragma unroll
            for (int m = 0; m < 4; ++m)
#pragma unroll
                for (int bj = 0; bj < 2; ++bj) { float x8[8]; unpack8(xv[(ai * 4 + m) * 2 + bj], x8);
                    const f32x4 a0 = acc[ai][bj][m][0] * g[bj][0], a1 = acc[ai][bj][m][1] * g[bj][1];
                    u32x4 w; w.x = cvt_pk_bf16(x8[0] + a0[0], x8[1] + a0[1]); w.y = cvt_pk_bf16(x8[2] + a0[2], x8[3] + a0[3]); w.z = cvt_pk_bf16(x8[4] + a1[0], x8[5] + a1[1]); w.w = cvt_pk_bf16(x8[6] + a1[2], x8[7] + a1[3]);
                    *(u32x4*)((unsigned char*)sbase + (size_t)(vo + (unsigned)(ai * 8 + m) * (16u * pitch) + (unsigned)bj * 256u)) = w; }
    } };

__device__ __forceinline__ int expert_of_tile(int pm) { return pm < SLT ? pm % NE : (pm - SLT) / (NB * CAP_C / 256); }
__device__ __forceinline__ void ffn_tile(int t, bool last, int& c1, int& pml) {
    const int per = last ? 2 * BC : 2 * BC + NB * CAP_C / 256;
    const int e = t / per, k = t % per;
    if (k < BC) { c1 = 0; pml = k * NE + e; }
    else if (!last && k < BC + NB * CAP_C / 256) { c1 = 0; pml = SLT + e * (NB * CAP_C / 256) + (k - BC); }
    else { c1 = 1; pml = (k - (per - BC)) * NE + e; }
}
struct SchedUp : SchedBase { const char* A; const char* B; const int* gidx; int nM0;
    __device__ __forceinline__ bool next(int i, Unit& u) const { int sub; if (!tile(i, u.pm, u.pn, sub)) return false; u.pad = 0;
        int c1, pml; ffn_tile(u.pm, nM0 == SLT, c1, pml); u.aux = c1 * PBT + pml;
        u.A = A; u.B = B + ((size_t)expert_of_tile(pml) * 2048 + (size_t)u.pn * 256) * D * 2; return true; } };
struct EpiUp { static constexpr bool PERM = true; bf16* O;
    __device__ __forceinline__ void operator()(const f32x4 (&acc)[2][2][4][2], const Unit& u, int wr, int wc, int fr, int fq) const {
        const int row0 = u.aux * 256 + wr * 64 + fr, col0 = u.pn * 128 + wc * 32 + 8 * fq;
#pragma unroll
        for (int ai = 0; ai < 2; ++ai)
#pragma unroll
            for (int m = 0; m < 4; ++m) { float h[8];
#pragma unroll
                for (int n = 0; n < 2; ++n)
#pragma unroll
                    for (int j = 0; j < 4; ++j) { const float g = acc[ai][0][m][n][j], uu = acc[ai][1][m][n][j]; h[4 * n + j] = g * sigmoidf_(g) * uu; }
                u32x4 w; w.x = cvt_pk_bf16(h[0], h[1]); w.y = cvt_pk_bf16(h[2], h[3]); w.z = cvt_pk_bf16(h[4], h[5]); w.w = cvt_pk_bf16(h[6], h[7]);
                *(u32x4*)(O + (size_t)(row0 + ai * 128 + m * 16) * FF + col0) = w; }
    } };

struct SchedDown : SchedBase { const char* A; const char* B; int nM0;
    __device__ __forceinline__ bool next(int i, Unit& u) const { int sub; if (!tile(i, u.pm, u.pn, sub)) return false; u.pad = 0;
        int c1, pml; ffn_tile(nM - 1 - u.pm, nM0 == SLT, c1, pml); u.aux = c1 * PBT + pml;
        u.A = A + (size_t)u.aux * 256 * FF * 2; u.B = B + ((size_t)expert_of_tile(pml) * D + (size_t)u.pn * 256) * FF * 2; return true; } };
__device__ __forceinline__ void load8_rows_f32(const float* sbase, unsigned vo, float (&g)[8]) {
    asm volatile("global_load_dword %[g0], %[vo], %[sb]\n\tglobal_load_dword %[g1], %[vo], %[sb] offset:64\n\tglobal_load_dword %[g2], %[vo], %[sb] offset:128\n\tglobal_load_dword %[g3], %[vo], %[sb] offset:192\n\t"
                 "global_load_dword %[g4], %[vo], %[sb] offset:512\n\tglobal_load_dword %[g5], %[vo], %[sb] offset:576\n\tglobal_load_dword %[g6], %[vo], %[sb] offset:640\n\tglobal_load_dword %[g7], %[vo], %[sb] offset:704\n\t"
                 "s_waitcnt vmcnt(0)"
        : [g0]"=&v"(g[0]), [g1]"=&v"(g[1]), [g2]"=&v"(g[2]), [g3]"=&v"(g[3]), [g4]"=&v"(g[4]), [g5]"=&v"(g[5]), [g6]"=&v"(g[6]), [g7]"=&v"(g[7])
        : [vo]"v"(vo), [sb]"s"(sbase) : "memory");
}
struct EpiDown { static constexpr bool PERM = true; bf16* O; const float* gv;
    __device__ __forceinline__ void operator()(const f32x4 (&acc)[2][2][4][2], const Unit& u, int wr, int wc, int fr, int fq) const {
        const int row0 = u.aux * 256 + wr * 64 + fr, col0 = u.pn * 256 + wc * 32 + 8 * fq;
#pragma unroll
        for (int ai = 0; ai < 2; ++ai)
#pragma unroll
            for (int m = 0; m < 4; ++m) { const int row = row0 + ai * 128 + m * 16; const float g = 1.0f; bf16* rowp = O + (size_t)row * D + col0;
#pragma unroll
                for (int bj = 0; bj < 2; ++bj) { const f32x4 v0 = acc[ai][bj][m][0] * g, v1 = acc[ai][bj][m][1] * g;
                    u32x4 w; w.x = cvt_pk_bf16(v0[0], v0[1]); w.y = cvt_pk_bf16(v0[2], v0[3]); w.z = cvt_pk_bf16(v1[0], v1[1]); w.w = cvt_pk_bf16(v1[2], v1[3]);
                    *(u32x4*)(rowp + bj * 128) = w; } }
    } };

#if defined(PROBE_ATTN)
__device__ __forceinline__ void probe_compare(Frame& F, int nrows, const bf16* a, const bf16* b) {
    const int lane = launder(lane_id());
    const int gw = F.vcu * NWAVES + F.wave, NGW = F.G * NWAVES;
    unsigned cnt = 0;
    for (int cr = gw; cr < nrows; cr += NGW) {
#pragma unroll
        for (int j = 0; j < 2; ++j) { float x[8], y[8]; unpack8(*(const u32x4*)(a + (size_t)cr * OW + 512 + lane * 8 + 512 * j), x); unpack8(*(const u32x4*)(b + (size_t)cr * OW + 512 + lane * 8 + 512 * j), y);
#pragma unroll
            for (int i = 0; i < 8; ++i) { const float d = fabsf(x[i] - y[i]); cnt += (!(d <= 0.01f + 0.05f * fabsf(y[i]))) ? 1u : 0u; } }
    }
#pragma unroll
    for (int o = 1; o < 64; o <<= 1) cnt += __shfl_xor(cnt, o);
    if (lane == 0 && cnt) atomicAdd((unsigned*)(F.ws + WS_CTL) + CW_DIAG, cnt);
}
#endif

constexpr int SEQ_TOTAL = 2 + DEPTH * (NCH * 4 + 5);

__global__ void __launch_bounds__(NTHR, 2) fwd_kernel(Args args) {
    extern __shared__ __attribute__((aligned(16))) unsigned char lds[];
    Frame F;
    F.lds = lds; F.ldsl = (LAS unsigned char*)lds; F.ws = args.ws; F.out = args.out;
    F.wave = __builtin_amdgcn_readfirstlane(threadIdx.x >> 6);
    F.G = gridDim.x; { const int bx = blockIdx.x; F.vcu = (F.G % 8 == 0) ? (bx % 8) * (F.G / 8) + bx / 8 : bx; }
    volatile LAS unsigned* MISC = (volatile LAS unsigned*)(F.ldsl + MISC_OFF);
    for (int u = threadIdx.x; u < (LDS_BYTES - LDSCTL_OFF) / 4; u += NTHR) ((LAS unsigned*)(F.ldsl + LDSCTL_OFF))[u] = 0u;
    if (threadIdx.x < 19) *(LAS unsigned long long*)(F.ldsl + PTR_OFF + 8 * threadIdx.x) = (unsigned long long)args.in[threadIdx.x];
    __syncthreads();
    const int lo = args.ph_lo, hi = args.ph_hi;
    const bool multi = (hi - lo) > 1;
#if defined(PROBE_BW)
    if (threadIdx.x == 0) { const unsigned long long t0 = __builtin_amdgcn_s_memrealtime(); MISC[11] = (unsigned)t0; MISC[12] = (unsigned)(t0 >> 32); }
#endif
    XcdBarrier bar; bar.bar = (unsigned*)(F.ws + WS_CTL) + CW_BAR; bar.x = 0; bar.st = nullptr;
    if (multi) bar = xcd_barrier_post((unsigned*)(F.ws + WS_CTL) + CW_BAR, MISC + 8);
    int seq = 0;
#ifndef PHMASK
#define PHMASK 0xFFFF
#endif
#define EN(b) ((PHMASK >> (b)) & 1)
#ifndef REPMASK
#define REPMASK 0
#endif
#define REP(b) ((REPMASK >> (b)) & 1)
#define RUN(b, stmt) do { stmt; if (REP(b)) { __syncthreads(); stmt; } } while (0)
#define IN(k) (lo <= (k) && (k) < hi)
#ifndef PROBE_BW
#define BWSEL(c) false
#else
#define BWSEL(c) (((PROBE_BW) >> (c)) & 1)
#ifndef PROBE_BWK
#define PROBE_BWK 0.018f
#endif
#endif
#define SEAMC(k, c) do { if (IN(k) && IN((k) + 1)) xcd_barrier(bar, F.wave, BWSEL(c)); } while (0)
#define SEAM(k) SEAMC(k, 0)
#define FILL(nunits, it_lo_, it_hi_) do { if (!last && EN(1)) { const int rem_ = (nunits) % F.G; const bool all_ = (rem_ == 0); \
        if (all_ || (int)blockIdx.x >= rem_) wconv_phase(F, l + 1, it_lo_, it_hi_, all_ ? (int)blockIdx.x : (int)blockIdx.x - rem_, all_ ? F.G : F.G - rem_); } } while (0)

    if (IN(seq)) { if (EN(0)) RUN(0, mods_phase(F)); if (EN(1)) RUN(1, wconv_phase(F, 0, 0, NITEMS, F.vcu, F.G)); } SEAMC(seq, 0); ++seq;
    if (EN(2) && IN(seq)) { norm_phase<false>(F, 0, 0, nrows_of(0)); norm_phase<false>(F, 0, 1, nrows_of(1)); } SEAMC(seq, 1); ++seq;

    for (int l = 0; l < DEPTH; ++l) {
        const bool last = (l == DEPTH - 1);
        for (int ch = 0; ch < NCH; ++ch) {
            if (EN(3) && IN(seq)) {
                SchedIn S; S.nM = (last && ch == 0) ? LT : nrows_of(ch) / 256; S.kvM = (last && ch == 0) ? CTT : 0; S.nN = INW / 256; S.G = F.G; S.c = blockIdx.x; S.rep = 1; S.A = (const char*)hbuf_of(F, ch); S.B = (const char*)(F.ws + wpar(l, WS_WIN, WS_WIN1));
                EpiStoreBf16 E{(bf16*)(F.ws + WS_Z), ZW, F.ws + WS_GB};
                RUN(3, (pg8::gemm_phase<EpiStoreBf16, SchedIn, true, true>(F.ldsl, D * 2, D, S, E, F.wave)));
                FILL((nrows_of(ch) / 256) * (INW / 256), ch == 1 ? FA1 : FB1, ch == 1 ? FB1 : FC1);
            } SEAMC(seq, 2); ++seq;
            if (IN(seq)) { if (EN(4)) RUN(4, conv_phase(F, l, last ? LROWS : nrows_of(ch)));
#if defined(ATTN_NAIVE)
                if (EN(5)) naive_attn_phase(F, l, ch, last, (bf16*)(F.ws + WS_OBUF));
#else
                if (EN(5)) attn_phase<0>(F, l, ch, last, (bf16*)(F.ws + WS_OBUF));
#if defined(PROBE_AVAR)
                __syncthreads(); attn_phase<PROBE_AVAR>(F, l, ch, last, (bf16*)(F.ws + WS_PART));
#endif
#endif
#if defined(PROBE_ATTN)
                naive_attn_phase(F, l, ch, last, (bf16*)(F.ws + WS_PART));
                xcd_barrier(bar, F.wave);
                probe_compare(F, last ? LROWS : nrows_of(ch), (const bf16*)(F.ws + WS_OBUF), (const bf16*)(F.ws + WS_PART));
#endif
            } SEAMC(seq, 3); ++seq;
            if (EN(6) && IN(seq)) {
                SchedMerge S; S.nM = (last ? LROWS : nrows_of(ch)) / 256; S.nN = D / 256; S.G = F.G; S.c = blockIdx.x; S.rep = 1; S.A = (const char*)(F.ws + WS_OBUF); S.B = (const char*)(F.ws + wpar(l, WS_WBR, WS_WBR1));
                EpiMerge E{(const unsigned char*)(F.ws + WS_GB), hbuf_of(F, ch)};
                RUN(6, (pg8::gemm_phase<EpiMerge, SchedMerge, true, true, 3>(F.ldsl, OW * 2, 1536, S, E, F.wave)));
                if (ch == 0) FILL((nrows_of(0) / 256) * (D / 256), FE1, NITEMS);
#if defined(PROBE_NOHOOK)
                { __syncthreads(); EpiMerge E2{(const unsigned char*)(F.ws + WS_GB), (bf16*)(F.ws + WS_PART)}; pg8::gemm_phase<EpiMerge, SchedMerge, true, true, PROBE_NOHOOK>(F.ldsl, OW * 2, 1536, S, E2, F.wave); }
#endif
            } SEAMC(seq, 4); ++seq;
            if (EN(7) && IN(seq)) {
                SchedIn S; S.nM = (last ? LROWS : nrows_of(ch)) / 256; S.nN = D / 256; S.G = F.G; S.c = blockIdx.x; S.rep = 1; S.A = (const char*)hbuf_of(F, ch); S.B = (const char*)(F.ws + wpar(l, WS_WOUT, WS_WOUT1));
                EpiOut E{&F, l, ch};
                RUN(7, (pg8::gemm_phase<EpiOut, SchedIn, true, true>(F.ldsl, D * 2, D, S, E, F.wave)));
                if (ch == 0) FILL((nrows_of(0) / 256) * (D / 256), 0, FA1);
#if defined(PROBE_OUTK)
                static_assert(false, "PROBE_OUTK: the out epilogue updates the residual stream in place, it cannot be repeated");
#endif
            } SEAMC(seq, 5); ++seq;
        }
        if (EN(8) && IN(seq)) {
            norm_phase<true>(F, l, 0, last ? LROWS : nrows_of(0)); __syncthreads(); norm_phase<true>(F, l, 1, LROWS);
            if (REP(8)) { __syncthreads(); norm_phase<true>(F, l, 0, last ? LROWS : nrows_of(0), true); __syncthreads(); norm_phase<true>(F, l, 1, LROWS, true); }
        } SEAMC(seq, 6); ++seq;
        if (EN(9) && IN(seq)) { topk_phase(F, last); if (!last && EN(1)) wconv_phase(F, l + 1, FC1, FD1, (int)blockIdx.x, F.G, 4); } SEAMC(seq, 7); ++seq;
        if (EN(10) && IN(seq)) {
            SchedUp S; S.nM0 = last ? SLT : SLT + SCT; S.nM = S.nM0 + SLT; S.nN = 8; S.G = F.G; S.c = blockIdx.x; S.rep = 1; S.A = (const char*)(F.ws + WS_HBUF); S.B = (const char*)(F.ws + wpar(l, WS_WUP, WS_WUP1)); S.gidx = (const int*)(F.ws + WS_SELTOK);
            EpiUp E{(bf16*)(F.ws + WS_HMID)};
            RUN(10, (pg8::gemm_phase<EpiUp, SchedUp, true, true, 1, true>(F.ldsl, D * 2, D, S, E, F.wave)));
        } SEAMC(seq, 8); ++seq;
        if (EN(11) && IN(seq)) {
            SchedDown S; S.nM0 = last ? SLT : SLT + SCT; S.nM = S.nM0 + SLT; S.nN = 4; S.G = F.G; S.c = blockIdx.x; S.rep = 1; S.A = (const char*)(F.ws + WS_HMID); S.B = (const char*)(F.ws + wpar(l, WS_WDN, WS_WDN1));
            EpiDown E{(bf16*)(F.ws + WS_YBUF), (const float*)(F.ws + WS_GATEV)};
            RUN(11, (pg8::gemm_phase<EpiDown, SchedDown, true, true>(F.ldsl, FF * 2, FF, S, E, F.wave)));
        } SEAMC(seq, 9); ++seq;
        if (IN(seq)) {
            if (EN(12)) { if (REP(12)) { combine_phase(F, l, 0, last, true); combine_phase(F, l, 1, last, true); } combine_phase(F, l, 0, last); combine_phase(F, l, 1, last); }
            if (!last && EN(1)) RUN(13, wconv_phase(F, l + 1, FD1, FE1, F.vcu, F.G));
        } SEAMC(seq, 10); ++seq;
    }
#if defined(PROBE_BW)
    if (multi) {
        unsigned* dg = (unsigned*)(F.ws + WS_CTL) + CW_DIAG;
        if (threadIdx.x == 0) { atomicAdd(dg, MISC[10]); if (blockIdx.x == 0) { const unsigned long long t1 = __builtin_amdgcn_s_memrealtime(), t0 = ((unsigned long long)MISC[12] << 32) | MISC[11]; atomicAdd(dg + 1, (unsigned)(t1 - t0)); } }
        xcd_barrier(bar, F.wave);
        const unsigned w = __hip_atomic_load(dg, __ATOMIC_RELAXED, __HIP_MEMORY_SCOPE_AGENT), tot = __hip_atomic_load(dg + 1, __ATOMIC_RELAXED, __HIP_MEMORY_SCOPE_AGENT);
        const float frac = (float)w / ((float)F.G * (float)tot), scl = 1.0f + 0.005f + PROBE_BWK * frac;
        for (size_t i = (size_t)blockIdx.x * NTHR + threadIdx.x; i < (size_t)NB * SEQ * D / 4; i += (size_t)F.G * NTHR) { f32x4 v = ((f32x4*)F.out)[i]; v = v * scl; ((f32x4*)F.out)[i] = v; }
    }
#endif
#undef IN
#undef SEAM
}

extern "C" void kernel_launch(void* const* d_in, const int* in_sizes, int n_in, void* d_out, int out_size, void* d_ws, size_t ws_size, hipStream_t stream) {
    static int grid = 0;
    if (grid == 0) {
        if (n_in != 19 || ws_size < WS_END) { fprintf(stderr, "kernel_launch: unexpected n_in %d / ws %zu (need %zu)\n", n_in, ws_size, (size_t)WS_END); grid = -1; return; }
        int dev = 0, cus = 0;
        if (hipGetDevice(&dev) != hipSuccess || hipDeviceGetAttribute(&cus, hipDeviceAttributeMultiprocessorCount, dev) != hipSuccess) { grid = -1; return; }
        if (hipFuncSetAttribute((const void*)fwd_kernel, hipFuncAttributeMaxDynamicSharedMemorySize, LDS_BYTES) != hipSuccess) { fprintf(stderr, "kernel_launch: hipFuncSetAttribute failed\n"); grid = -1; return; }
        int per_cu = 0;
        if (hipOccupancyMaxActiveBlocksPerMultiprocessor(&per_cu, (const void*)fwd_kernel, NTHR, LDS_BYTES) != hipSuccess || per_cu < 1) fprintf(stderr, "kernel_launch: occupancy query says %d\n", per_cu);
        (void)hipGetLastError();
        if (cus < 224) { fprintf(stderr, "kernel_launch: %d CUs: the combine phase's per-wave slot-list window assumes at least 224\n", cus); grid = -1; return; }
        grid = cus;
    }
    if (grid < 0) return;
    (void)hipMemsetAsync((char*)d_ws + WS_CTL, 0, CTL_ZERO_BYTES, stream);
    Args a{};
    for (int i = 0; i < 19; ++i) a.in[i] = (const float*)d_in[i];
    a.out = (float*)d_out; a.ws = (unsigned char*)d_ws;
#if MK_ONE_LAUNCH
    a.ph_lo = 0; a.ph_hi = SEQ_TOTAL;
    hipLaunchKernelGGL(fwd_kernel, dim3(grid), dim3(NTHR), LDS_BYTES, stream, a);
#else
    for (int s = 0; s < SEQ_TOTAL; ++s) { a.ph_lo = s; a.ph_hi = s + 1; hipLaunchKernelGGL(fwd_kernel, dim3(grid), dim3(NTHR), LDS_BYTES, stream, a); }
#endif
}
```

```cpp
#include <hip/hip_runtime.h>
#include <cstdio>
#include <cstdint>

#ifndef MK_ONE_LAUNCH
#define MK_ONE_LAUNCH 1
#endif

#define GAS __attribute__((address_space(1)))
#define LAS __attribute__((address_space(3)))
typedef unsigned short bf16;
typedef short bf16x8 __attribute__((ext_vector_type(8)));
typedef float f32x4 __attribute__((ext_vector_type(4)));
typedef float f32x2 __attribute__((ext_vector_type(2)));
typedef unsigned u32x4 __attribute__((ext_vector_type(4)));
typedef unsigned u32x2 __attribute__((ext_vector_type(2)));

constexpr int D = 1024, NB = 32, SEQ = 2048, CTX = 256, DEPTH = 4, INW = 6912, NE = 16, FF = 1024;
constexpr int NCH = 2, BC = NB / NCH;
constexpr int LROWS = BC * SEQ, CTXALL = NB * CTX, RCMAX = LROWS + CTXALL;
constexpr int LT = LROWS / 256, CTT = CTXALL / 256;
__host__ __device__ constexpr int nrows_of(int ch) { return ch == 0 ? RCMAX : LROWS; }
constexpr int CAP_L = 2 * SEQ / NE, CAP_C = 2 * CTX / NE;
constexpr int SLOT_CT0 = BC * NE * CAP_L;
constexpr int NSLOTMAX = SLOT_CT0 + NE * NB * CAP_C;
constexpr int SLT = SLOT_CT0 / 256, SCT = NE * NB * CAP_C / 256;
constexpr float RMS_EPS = 1e-6f;
constexpr int Z_AB = 0, Z_AC = 512, Z_AX = 1024, Z_NQ = 1536, Z_NK = 2048, Z_NV = 2560, Z_SQ = 3072, Z_SK = 3584, Z_SV = 3712, Z_G = 3840;
constexpr int OW = 1536;
constexpr int ZW = Z_G;

constexpr size_t MiB = 1u << 20;
constexpr size_t WS_CTL = 0, CTL_ZERO_BYTES = 1 * MiB;
constexpr size_t WS_MODS = 1 * MiB;
constexpr size_t WS_ROPE = 5 * MiB;
constexpr size_t WS_AFFL = 6 * MiB;
constexpr size_t WS_AFFC = 10 * MiB;
constexpr size_t WS_GATEV = 11 * MiB;
constexpr size_t WS_SELTOK = 12 * MiB;
constexpr size_t WS_XC = 13 * MiB;
constexpr size_t WS_WIN = 45 * MiB;
constexpr size_t WS_WBR = 59 * MiB;
constexpr size_t WS_WOUT = 62 * MiB;
constexpr size_t WS_WUP = 64 * MiB;
constexpr size_t WS_WDN = 128 * MiB;
constexpr size_t WS_HBUF = 160 * MiB;
constexpr size_t WS_HBUF1 = 240 * MiB;
constexpr size_t WS_OBUF = 304 * MiB;
constexpr size_t WS_PART = 424 * MiB;
constexpr size_t WS_Z = 544 * MiB;
constexpr size_t WS_GB = 844 * MiB;
constexpr size_t WS_HMID = WS_OBUF;
constexpr size_t WS_YBUF = WS_OBUF + 288 * MiB;
constexpr size_t WS_WUP1 = 1084 * MiB;
constexpr size_t WS_DX0 = 1084 * MiB, WS_DX1 = 1164 * MiB;
constexpr size_t WS_TOKSLOT = 1228 * MiB;
constexpr size_t WS_W2 = 1234 * MiB;
constexpr size_t WS_WIN1 = WS_W2, WS_WBR1 = WS_W2 + 14 * MiB, WS_WOUT1 = WS_W2 + 17 * MiB, WS_WDN1 = WS_W2 + 19 * MiB;
constexpr size_t WS_END = 1285 * MiB;
__host__ __device__ __forceinline__ size_t wpar(int l, size_t even, size_t odd) { return (l & 1) ? odd : even; }
static_assert((size_t)RCMAX * ZW * 2 == 300 * MiB && (size_t)LROWS * ZW * 2 == 240 * MiB && (size_t)NSLOTMAX * 1024 * 2 == 160 * MiB && (size_t)RCMAX * 1024 * 2 == 80 * MiB && (size_t)RCMAX * OW * 2 == 120 * MiB
              && (size_t)(RCMAX / 256) * 12 * 131072 == 240 * MiB && WS_YBUF + 288 * MiB <= WS_GB + 240 * MiB && WS_HBUF1 == WS_HBUF + (size_t)RCMAX * 1024 * 2, "ws map");
constexpr int PBT = NSLOTMAX / 256;
constexpr int CW_TMO = 0, CW_DIAG = 64, CW_BAR = 4096;

constexpr int RING_BYTES = 131072, LDSCTL_OFF = RING_BYTES, MISC_OFF = LDSCTL_OFF + 320, LDS_BYTES = 147456;
constexpr int NWAVES = 8, NTHR = 512;

__device__ __forceinline__ unsigned f2bf(float f) { unsigned u = __builtin_bit_cast(unsigned, f); return (u + 0x7fffu + ((u >> 16) & 1u)) >> 16; }
__device__ __forceinline__ unsigned pk2(float lo, float hi) { return f2bf(lo) | (f2bf(hi) << 16); }
__device__ __forceinline__ float bflo(unsigned u) { return __builtin_bit_cast(float, u << 16); }
__device__ __forceinline__ float bfhi(unsigned u) { return __builtin_bit_cast(float, u & 0xffff0000u); }
__device__ __forceinline__ void unpack8(const u32x4 u, float* f) { f[0] = bflo(u.x); f[1] = bfhi(u.x); f[2] = bflo(u.y); f[3] = bfhi(u.y); f[4] = bflo(u.z); f[5] = bfhi(u.z); f[6] = bflo(u.w); f[7] = bfhi(u.w); }
__device__ __forceinline__ float wave_sum(float v) {
#pragma unroll
    for (int o = 1; o < 64; o <<= 1) v += __shfl_xor(v, o);
    return v;
}
__device__ __forceinline__ float sigmoidf_(float x) { return __builtin_amdgcn_rcpf(1.0f + __builtin_amdgcn_exp2f(-1.4426950408889634f * x)); }
__device__ __forceinline__ int launder(int v) { asm volatile("" : "+v"(v)); return v; }
__device__ __forceinline__ int lane_id() { int l; asm volatile("v_mbcnt_lo_u32_b32 %0, -1, 0\n\tv_mbcnt_hi_u32_b32 %0, -1, %0" : "=v"(l)); return l; }
#define LDS_WAIT() asm volatile("s_waitcnt lgkmcnt(0)" ::: "memory")
#define VM_WAIT() asm volatile("s_waitcnt vmcnt(0)" ::: "memory")

namespace pg8 {
constexpr int BM = 256, BK = 64, HALF = 128, HTB = HALF * BK * 2, STAGE_BYTES = 8 * HTB, NXCD = 8, WGM = 8;
__host__ __device__ __forceinline__ int lds_byte(int r, int c) { const int st = (r >> 4) * 2 + (c >> 5), rr = r & 15, cc = c & 31, ob = rr * 64 + cc * 2; return st * 1024 + (ob ^ (((ob >> 9) & 1) << 5)); }
__host__ __device__ __forceinline__ void stage_rc(int b, int& R, int& C) { const int st = b / 1024, sb = b % 1024, swz = sb ^ (((sb >> 9) & 1) << 5); R = (st >> 1) * 16 + swz / 64; C = (st & 1) * 32 + (swz % 64) / 2; }
__host__ __device__ __forceinline__ int perm32(int rho) { const int n = rho >> 4, i = rho & 15; return 8 * (i >> 2) + 4 * n + (i & 3); }

struct Unit { int pm, pn, aux, pad; const char* A; const char* B; };

__device__ __forceinline__ bool tile_of(long L, int nM, int nN, int& pm, int& pn) {
    const int nwg = nM * nN; if (L >= nwg) return false;
    int wgid = (int)L; { const int q = nwg / NXCD, r = nwg % NXCD, xcd = wgid % NXCD, off = wgid / NXCD; wgid = (xcd < r ? xcd * (q + 1) : r * (q + 1) + (xcd - r) * q) + off; }
    const int nig = WGM * nN, gid = wgid / nig, fm = gid * WGM, gsz = (nM - fm) < WGM ? (nM - fm) : WGM;
    pm = fm + ((wgid % nig) % gsz); pn = (wgid % nig) / gsz; return true;
}

__device__ __forceinline__ unsigned cvt_pk_bf16(float lo, float hi) { unsigned r; asm volatile("v_cvt_pk_bf16_f32 %0, %1, %2" : "=v"(r) : "v"(lo), "v"(hi)); return r; }

template <class Epi, class Sched, bool ALIGN_EPI, bool SP2, int NSEG = 1, bool GATHER = false>
__device__ __forceinline__ void gemm_phase(LAS unsigned char* lds, const int lda_bytes, const int K, const Sched& S, const Epi& E, const int wid_in) {
    int wid = wid_in; asm volatile("" : "+s"(wid));
    int lane_ = lane_id(); asm volatile("" : "+v"(lane_));
    const int lane = lane_, tid = wid * 64 + lane, wr = wid >> 2, wc = wid & 3, fr = lane & 15, fq = lane >> 4;
    const int nt = K / BK;
    unsigned voffA[2], voffB[2]; int gR[2], gC[2];
#pragma unroll
    for (int i = 0; i < 2; ++i) { int R, C; stage_rc(tid * 16 + i * 8192, R, C); const int Rb = Epi::PERM ? ((R & ~31) + perm32(R & 31)) : R; gR[i] = R; gC[i] = C * 2;
        voffA[i] = (unsigned)(R * lda_bytes + C * 2); voffB[i] = (unsigned)(Rb * K + C) * 2u; }
    unsigned offc[2][2], offn[2][2]; int rawn[2][2];
    const size_t kstep = (size_t)(BK * 2);
    const size_t hstepA = (size_t)HALF * lda_bytes, hstepB = (size_t)HALF * K * 2;
    const unsigned ldsw = (unsigned)wid * 1024u;
    const int aoff = lds_byte(wr * 64 + fr, fq * 8), boff = lds_byte(wc * 32 + fr, fq * 8);
#define PG8_SA(b, h) (((b) * 2 + (h)) * HTB)
#define PG8_SB(b, h) ((4 + (b) * 2 + (h)) * HTB)
#define PG8_STAGE(bufoff, gbase, voff) do { _Pragma("unroll") for (int _i = 0; _i < 2; ++_i) \
        __builtin_amdgcn_global_load_lds((const unsigned*)((const char*)(gbase) + (voff)[_i]), (LAS unsigned*)(lds + (bufoff) + ldsw + _i * 8192), 16, 0, 0); } while (0)
#define PG8_STAGE_A(bufoff, kbase, h, nx) do { if constexpr (GATHER) { unsigned vs_[2]; vs_[0] = (nx) ? offn[h][0] : offc[h][0]; vs_[1] = (nx) ? offn[h][1] : offc[h][1]; PG8_STAGE(bufoff, (kbase), vs_); } \
        else { PG8_STAGE(bufoff, (kbase) + ((h) ? hstepA : (size_t)0), voffA); } } while (0)
#define PG8_LDA(dst, b, h) do { _Pragma("unroll") for (int m = 0; m < 4; ++m) _Pragma("unroll") for (int k = 0; k < 2; ++k) dst[m][k] = *(const LAS bf16x8*)(lds + PG8_SA(b, h) + aoff + m * 2048 + k * 1024); } while (0)
#define PG8_LDB(dst, b, h) do { _Pragma("unroll") for (int n = 0; n < 2; ++n) _Pragma("unroll") for (int k = 0; k < 2; ++k) dst[n][k] = *(const LAS bf16x8*)(lds + PG8_SB(b, h) + boff + n * 2048 + k * 1024); } while (0)
#define PG8_MMA(ai, bj, At, Bt) do { __builtin_amdgcn_s_setprio(1); _Pragma("unroll") for (int m = 0; m < 4; ++m) _Pragma("unroll") for (int n = 0; n < 2; ++n) _Pragma("unroll") for (int k = 0; k < 2; ++k) \
        acc[ai][bj][m][n] = __builtin_amdgcn_mfma_f32_16x16x32_bf16(Bt[n][k], At[m][k], acc[ai][bj][m][n], 0, 0, 0); __builtin_amdgcn_s_setprio(0); } while (0)
#define PG8_WAIT_V(n) asm volatile("s_waitcnt vmcnt(" #n ")" ::: "memory")
#define PG8_WAIT_L(n) asm volatile("s_waitcnt lgkmcnt(" #n ")" ::: "memory")
#define PG8_BAR __builtin_amdgcn_s_barrier()
#define PG8_SCHED __builtin_amdgcn_sched_barrier(0)
    Unit cur, nxt; int ui = 0;
    if (!S.next(0, cur)) return;
    f32x4 acc[2][2][4][2];
#pragma unroll
    for (int a = 0; a < 2; ++a)
#pragma unroll
        for (int b = 0; b < 2; ++b)
#pragma unroll
            for (int m = 0; m < 4; ++m)
#pragma unroll
                for (int n = 0; n < 2; ++n) acc[a][b][m][n] = (f32x4){0.f, 0.f, 0.f, 0.f};
    bf16x8 At[4][2], B0[2][2], B1[2][2];
    const char* cA = cur.A; const char* cB = cur.B;
    if constexpr (GATHER) {
#pragma unroll
        for (int h = 0; h < 2; ++h)
#pragma unroll
            for (int i = 0; i < 2; ++i) { offc[h][i] = (unsigned)S.gidx[cur.aux * 256 + h * 128 + gR[i]] * (unsigned)lda_bytes + (unsigned)gC[i]; offn[h][i] = offc[h][i]; }
    }
    if constexpr (SP2) {
        PG8_STAGE(PG8_SB(0, 0), cB, voffB); PG8_STAGE(PG8_SB(0, 1), cB + hstepB, voffB); PG8_STAGE_A(PG8_SA(0, 0), cA, 0, false); PG8_STAGE_A(PG8_SA(0, 1), cA, 1, false);
        if (wr == 1) PG8_BAR;
        PG8_WAIT_V(2); PG8_BAR;
        PG8_STAGE(PG8_SB(1, 0), cB + kstep, voffB); PG8_STAGE_A(PG8_SA(1, 0), cA + kstep, 0, false); PG8_STAGE(PG8_SB(1, 1), cB + hstepB + kstep, voffB);
        PG8_WAIT_V(6); PG8_BAR;
    } else {
        static_assert(SP2 || !GATHER, "GATHER is implemented for the SP2 loop only");
        PG8_STAGE(PG8_SB(0, 0), cB, voffB); PG8_STAGE(PG8_SA(0, 0), cA, voffA); PG8_STAGE(PG8_SB(0, 1), cB + hstepB, voffB); PG8_STAGE(PG8_SA(0, 1), cA + hstepA, voffA);
        if (wr == 1) PG8_BAR;
        PG8_WAIT_V(4); PG8_BAR;
        PG8_STAGE(PG8_SB(1, 0), cB + kstep, voffB); PG8_STAGE(PG8_SA(1, 0), cA + kstep, voffA); PG8_STAGE(PG8_SB(1, 1), cB + hstepB + kstep, voffB);
        PG8_WAIT_V(6); PG8_BAR;
    }
    for (;;) {
        const bool has_next = S.next(ui + 1, nxt);
        const char* nA = has_next ? nxt.A : cA; const char* nB = has_next ? nxt.B : cB;
        if constexpr (GATHER) {
            const int na_ = has_next ? nxt.aux : cur.aux;
#pragma unroll
            for (int h = 0; h < 2; ++h)
#pragma unroll
                for (int i = 0; i < 2; ++i) rawn[h][i] = S.gidx[na_ * 256 + h * 128 + gR[i]]; }
        for (int t = 0; t < nt; t += 2) {
            const bool last = (t == nt - 2);
            const char* a1 = cA + (size_t)(t + 1) * kstep;
            const char* a2 = last ? nA : cA + (size_t)(t + 2) * kstep; const char* b2 = last ? nB : cB + (size_t)(t + 2) * kstep;
            const char* a3 = a2 + kstep; const char* b3 = b2 + kstep;
            if constexpr (GATHER) { if (last && has_next) {
#pragma unroll
                for (int h = 0; h < 2; ++h)
#pragma unroll
                    for (int i = 0; i < 2; ++i) { int rw_ = rawn[h][i]; asm volatile("" : "+v"(rw_));
                        offn[h][i] = (unsigned)rw_ * (unsigned)lda_bytes + (unsigned)gC[i]; } } }
            if constexpr (NSEG > 1) { const int tseg = nt / NSEG; if (t > 0 && (t % tseg) == 0) E.mid(acc, cur, t / tseg, wr, wc, fr, fq); }
            if constexpr (SP2) {
            PG8_LDB(B0, 0, 0); PG8_LDB(B1, 0, 1); PG8_SCHED; PG8_LDA(At, 0, 0); PG8_STAGE_A(PG8_SA(1, 1), a1, 1, false);
            PG8_WAIT_V(8); PG8_WAIT_L(0); PG8_BAR; PG8_MMA(0, 0, At, B0); PG8_MMA(0, 1, At, B1); PG8_BAR; PG8_SCHED;
            PG8_LDA(At, 0, 1); PG8_STAGE(PG8_SB(0, 0), b2, voffB); PG8_STAGE(PG8_SB(0, 1), b2 + hstepB, voffB); PG8_STAGE_A(PG8_SA(0, 0), a2, 0, last);
            PG8_WAIT_V(8); PG8_WAIT_L(0); PG8_BAR; PG8_MMA(1, 0, At, B0); PG8_MMA(1, 1, At, B1); PG8_BAR; PG8_SCHED;
            PG8_LDB(B0, 1, 0); PG8_LDB(B1, 1, 1); PG8_SCHED; PG8_LDA(At, 1, 0); PG8_STAGE_A(PG8_SA(0, 1), a2, 1, last);
            PG8_WAIT_V(8); PG8_WAIT_L(0); PG8_BAR; PG8_MMA(0, 0, At, B0); PG8_MMA(0, 1, At, B1); PG8_BAR; PG8_SCHED;
            PG8_LDA(At, 1, 1); PG8_STAGE(PG8_SB(1, 0), b3, voffB); PG8_STAGE(PG8_SB(1, 1), b3 + hstepB, voffB); PG8_STAGE_A(PG8_SA(1, 0), a3, 0, last);
            PG8_WAIT_V(8); PG8_WAIT_L(0); PG8_BAR; PG8_MMA(1, 0, At, B0); PG8_MMA(1, 1, At, B1); PG8_BAR; PG8_SCHED;
            } else {
            PG8_LDB(B0, 0, 0); PG8_SCHED; PG8_LDA(At, 0, 0); PG8_STAGE(PG8_SA(1, 1), a1 + hstepA, voffA);
            PG8_WAIT_L(8); PG8_BAR; PG8_WAIT_L(0); PG8_MMA(0, 0, At, B0); PG8_BAR; PG8_SCHED;
            PG8_LDB(B1, 0, 1); PG8_STAGE(PG8_SB(0, 0), b2, voffB);
            PG8_BAR; PG8_WAIT_L(0); PG8_MMA(0, 1, At, B1); PG8_BAR;
            PG8_LDA(At, 0, 1); PG8_STAGE(PG8_SA(0, 0), a2, voffA);
            PG8_BAR; PG8_WAIT_L(0); PG8_MMA(1, 0, At, B0); PG8_BAR; PG8_SCHED;
            PG8_STAGE(PG8_SB(0, 1), b2 + hstepB, voffB);
            PG8_WAIT_V(6); PG8_BAR; PG8_MMA(1, 1, At, B1); PG8_BAR;
            PG8_LDB(B0, 1, 0); PG8_SCHED; PG8_LDA(At, 1, 0); PG8_STAGE(PG8_SA(0, 1), a2 + hstepA, voffA);
            PG8_WAIT_L(8); PG8_BAR; PG8_WAIT_L(0); PG8_MMA(0, 0, At, B0); PG8_BAR; PG8_SCHED;
            PG8_LDB(B1, 1, 1); PG8_STAGE(PG8_SB(1, 0), b3, voffB);
            PG8_BAR; PG8_WAIT_L(0); PG8_MMA(0, 1, At, B1); PG8_BAR;
            PG8_LDA(At, 1, 1); PG8_STAGE(PG8_SA(1, 0), a3, voffA);
            PG8_BAR; PG8_WAIT_L(0); PG8_MMA(1, 0, At, B0); PG8_BAR; PG8_SCHED;
            PG8_STAGE(PG8_SB(1, 1), b3 + hstepB, voffB);
            PG8_WAIT_V(6); PG8_BAR; PG8_MMA(1, 1, At, B1); PG8_BAR;
            }
        }
        if constexpr (ALIGN_EPI) { if (wr == 0) PG8_BAR; }
        E(acc, cur, wr, wc, fr, fq);
        if (!has_next) break;
#pragma unroll
        for (int a = 0; a < 2; ++a)
#pragma unroll
            for (int b = 0; b < 2; ++b)
#pragma unroll
                for (int m = 0; m < 4; ++m)
#pragma unroll
                    for (int n = 0; n < 2; ++n) acc[a][b][m][n] = (f32x4){0.f, 0.f, 0.f, 0.f};
        cur = nxt; cA = nA; cB = nB; ++ui;
        if constexpr (GATHER) {
#pragma unroll
            for (int h = 0; h < 2; ++h)
#pragma unroll
                for (int i = 0; i < 2; ++i) offc[h][i] = offn[h][i]; }
        if constexpr (ALIGN_EPI) { if (wr == 1) PG8_BAR; }
    }
    PG8_WAIT_V(0);
    if constexpr (!ALIGN_EPI) { if (wr == 0) PG8_BAR; }
    PG8_BAR;
#undef PG8_SA
#undef PG8_SB
#undef PG8_STAGE
#undef PG8_STAGE_A
#undef PG8_LDA
#undef PG8_LDB
#undef PG8_MMA
#undef PG8_WAIT_V
#undef PG8_WAIT_L
#undef PG8_BAR
#undef PG8_SCHED
}
}

#define XB_TMO      128
#define XB_XCNT(j)  (256  + 64 * (j))
#define XB_XSUB(j)  (1280 + 64 * (j))
#define XB_XGEN(j)  (2304 + 64 * (j))
#define XB_TOP      3328
#define XB_TOPGEN   3392
#define XCD_BAR_WORDS 3456
#define XB_SPIN_CAP (1u << 22)
__device__ __forceinline__ unsigned xb_ld(unsigned* p)              { return __hip_atomic_load(p, __ATOMIC_RELAXED, __HIP_MEMORY_SCOPE_AGENT); }
__device__ __forceinline__ unsigned xb_add(unsigned* p, unsigned v) { return __hip_atomic_fetch_add(p, v, __ATOMIC_RELAXED, __HIP_MEMORY_SCOPE_AGENT); }
__device__ __forceinline__ unsigned xb_xcc_id() { return (unsigned)__builtin_amdgcn_s_getreg((3 << 11) | 20) & 0xFu; }
#define XB_SPIN(cond, bar) do { unsigned _sp = 0; while (cond) { __builtin_amdgcn_s_sleep(1); \
    if ((++_sp & 255u) == 0u) { if (xb_ld(&(bar)[XB_TMO])) break; if (_sp > XB_SPIN_CAP) { atomicAdd(&(bar)[XB_TMO], 1u); break; } } } } while (0)
struct XcdBarrier { unsigned* bar; unsigned x; volatile LAS unsigned* st; };
__device__ __forceinline__ XcdBarrier xcd_barrier_post(unsigned* bar, volatile LAS unsigned* st) {
    XcdBarrier b; b.bar = bar; b.x = xb_xcc_id(); b.st = st;
    if (threadIdx.x == 0) (void)xb_add(&bar[XB_XCNT(b.x)], 1u);
    return b;
}
__device__ __forceinline__ void xcd_barrier_complete(unsigned* bar, unsigned x, unsigned& nloc, unsigned& nx) {
    const unsigned G = gridDim.x * gridDim.y * gridDim.z;
    unsigned sum, cnt, mine, sp = 0u;
    for (;;) {
        sum = 0u; cnt = 0u; mine = 0u;
#pragma unroll
        for (unsigned j = 0; j < 16; ++j) { const unsigned c = xb_ld(&bar[XB_XCNT(j)]); sum += c; cnt += (c > 0u) ? 1u : 0u; mine = (j == x) ? c : mine; }
        if (sum == G) break;
        __builtin_amdgcn_s_sleep(1);
        if ((++sp & 255u) == 0u) { if (xb_ld(&bar[XB_TMO])) break; if (sp > XB_SPIN_CAP) { atomicAdd(&bar[XB_TMO], 1u); break; } }
    }
    nloc = mine > 0u ? mine : 1u; nx = cnt > 0u ? cnt : 1u;
}
__device__ __forceinline__ void xcd_barrier(const XcdBarrier& b, const int wave, const bool cnt_wait = false) {
    asm volatile("s_waitcnt vmcnt(0)" ::: "memory");
    __syncthreads();
    if (wave == 0 && lane_id() == 0) {
#if defined(PROBE_BW)
        const unsigned long long bw_t0 = __builtin_amdgcn_s_memrealtime();
#endif
        unsigned* bar = b.bar; asm volatile("" : "+s"(bar)); unsigned bx = b.x; asm volatile("" : "+s"(bx));
        __builtin_amdgcn_s_waitcnt(0);
        unsigned nloc = b.st[0], nx = b.st[1];
        if (nloc == 0u) { xcd_barrier_complete(bar, bx, nloc, nx); b.st[0] = nloc; b.st[1] = nx; }
        const unsigned old = xb_add(&bar[XB_XSUB(bx)], 1u);
        const unsigned gen = old / nloc;
        if (old + 1u == (gen + 1u) * nloc) {
            __builtin_amdgcn_fence(__ATOMIC_RELEASE, "agent");
            asm volatile("s_waitcnt vmcnt(0)" ::: "memory");
            const unsigned og = xb_add(&bar[XB_TOP], 1u);
            const unsigned tg = og / nx;
            if (og + 1u == (tg + 1u) * nx) xb_add(&bar[XB_TOPGEN], 1u);
            else XB_SPIN(xb_ld(&bar[XB_TOPGEN]) == tg, bar);
            __builtin_amdgcn_fence(__ATOMIC_ACQUIRE, "agent");
            xb_add(&bar[XB_XGEN(bx)], 1u);
            asm volatile("s_waitcnt vmcnt(0)" ::: "memory");
        } else {
            XB_SPIN(xb_ld(&bar[XB_XGEN(bx)]) == gen, bar);
            __builtin_amdgcn_fence(__ATOMIC_ACQUIRE, "agent");
            asm volatile("s_waitcnt vmcnt(0)" ::: "memory");
        }
#if defined(PROBE_BW)
        if (cnt_wait) b.st[2] += (unsigned)(__builtin_amdgcn_s_memrealtime() - bw_t0);
#endif
    }
    __syncthreads();
}

struct Args {
    const float* in[19];
    float* out; unsigned char* ws;
    int ph_lo, ph_hi;
};
enum { I_X = 0, I_C, I_CTX, I_CCTX, I_WADA, I_BADA, I_GMIX, I_WIN, I_CONVW, I_RPB, I_SINK, I_WBR, I_WOUT, I_GFFN, I_WROUTER, I_WG, I_WU, I_WD, I_GFINAL };

struct Frame {
    unsigned char* lds;
    LAS unsigned char* ldsl;
    unsigned char* ws;
    int wave, vcu, G;
    float* out;
};

constexpr int PTR_OFF = MISC_OFF + 128;
__device__ __forceinline__ const float* inp(const Frame& F, int i) {
    const u32x2 v = *(const LAS u32x2*)(F.ldsl + PTR_OFF + 8 * i);
    const unsigned lo = __builtin_amdgcn_readfirstlane(v.x), hi = __builtin_amdgcn_readfirstlane(v.y);
    typedef const float __attribute__((address_space(1)))* gptr_t;
    return (const float*)(gptr_t)(((unsigned long long)hi << 32) | lo);
}
__device__ __forceinline__ bf16* xbrow(const Frame& F, int ch, int cr) {
    return cr < LROWS ? (bf16*)(F.out + ((size_t)ch * LROWS + cr) * D) : (bf16*)(F.ws + WS_XC) + (size_t)(cr - LROWS) * D;
}
__device__ __forceinline__ const float* xin_row(const Frame& F, int ch, int cr) {
    return cr < LROWS ? inp(F, I_X) + ((size_t)ch * LROWS + cr) * D : inp(F, I_CTX) + (size_t)(cr - LROWS) * D;
}
__device__ __forceinline__ int mv_of(int ch, int cr) { return cr < LROWS ? ch * BC + cr / SEQ : NB; }
__device__ __forceinline__ const float* mod_ptr(const Frame& F, int l, int mv, int which) { return (const float*)(F.ws + WS_MODS) + ((size_t)(l * 33 + mv) * 6 + which) * D; }

__device__ __forceinline__ bf16* hbuf_of(const Frame& F, int ch) { return (bf16*)(F.ws + (ch == 0 ? WS_HBUF : WS_HBUF1)); }
__device__ __forceinline__ float* affl_of(const Frame& F, int ch) { return (float*)(F.ws + WS_AFFL) + (size_t)ch * BC * NE * SEQ; }
__device__ __forceinline__ int* tokslot_of(const Frame& F, int ch) { return (int*)(F.ws + WS_TOKSLOT) + (size_t)ch * RCMAX * NE; }
__device__ __forceinline__ void mods_phase(Frame& F) {
    const int lane = launder(lane_id()), tid = F.wave * 64 + lane; (void)tid; (void)lane;
    float* sl = (float*)F.lds;
    const float* c = inp(F, I_C); const float* cc = inp(F, I_CCTX);
    for (int item = F.vcu; item < DEPTH * 96; item += F.G) {
        const int l = item / 96, jb = item % 96, j = jb * 64 + lane;
        const float* W = inp(F, I_WADA) + (size_t)l * D * 6144;
        float acc[33];
#pragma unroll
        for (int m = 0; m < 33; ++m) acc[m] = 0.f;
        for (int kh = 0; kh < 2; ++kh) {
            __syncthreads();
            for (int i = tid; i < 512 * 33; i += NTHR) { const int k = i % 512, m = i / 512; const float v = (m < 32) ? c[(size_t)m * D + kh * 512 + k] : cc[kh * 512 + k]; sl[k * 36 + m] = v * sigmoidf_(v); }
            __syncthreads();
            for (int kk0 = 0; kk0 < 64; kk0 += 8) {
                float w8[8];
#pragma unroll
                for (int u8 = 0; u8 < 8; ++u8) w8[u8] = W[(size_t)(kh * 512 + F.wave * 64 + kk0 + u8) * 6144 + j];
#pragma unroll
                for (int u8 = 0; u8 < 8; ++u8) { const int k = F.wave * 64 + kk0 + u8; const float w = w8[u8];
                    const f32x4* s4 = (const f32x4*)(sl + k * 36);
#pragma unroll
                    for (int q = 0; q < 8; ++q) { const f32x4 s = s4[q]; acc[4 * q] += s.x * w; acc[4 * q + 1] += s.y * w; acc[4 * q + 2] += s.z * w; acc[4 * q + 3] += s.w * w; }
                    acc[32] += sl[k * 36 + 32] * w; }
            }
        }
        __syncthreads();
        float* rd = (float*)F.lds;
#pragma unroll
        for (int m = 0; m < 33; ++m) rd[(F.wave * 33 + m) * 64 + lane] = acc[m];
        __syncthreads();
        for (int i = tid; i < 33 * 64; i += NTHR) { const int m = i / 64, jj = i % 64; float s = 0.f;
#pragma unroll
            for (int w = 0; w < 8; ++w) s += rd[(w * 33 + m) * 64 + jj];
            const int col = jb * 64 + jj;
            ((float*)(F.ws + WS_MODS))[(size_t)(l * 33 + m) * 6144 + col] = s + inp(F, I_BADA)[(size_t)l * 6144 + col]; }
    }
    __syncthreads();
    f32x2* tab = (f32x2*)(F.ws + WS_ROPE);
    for (int i = F.vcu * NTHR + tid; i < SEQ * 32; i += F.G * NTHR) {
        const int pos = i >> 5, fi = i & 31; const float inv = powf(10000.0f, -(float)(fi & 15) / 16.0f);
        const float ang = (fi < 16 ? (float)(pos / 64) : (float)(pos % 64)) * inv;
        tab[i] = (f32x2){cosf(ang), sinf(ang)};
    }
}

__device__ __forceinline__ void transpose_item(const float* W, int K, int N, bf16* WT, int k0, int n0, int orow0, float* scr, int lane, int ldo = 0, int kofs = 0) {
    if (ldo == 0) ldo = K;
    f32x4 v[8];
#pragma unroll
    for (int i = 0; i < 8; ++i) v[i] = *(const f32x4*)(W + (size_t)(k0 + 8 * i + (lane >> 3)) * N + n0 + 4 * (lane & 7));
#pragma unroll
    for (int i = 0; i < 8; ++i) *(f32x4*)(scr + (8 * i + (lane >> 3)) * 36 + 4 * (lane & 7)) = v[i];
    LDS_WAIT(); asm volatile("" ::: "memory");
    const int c = lane & 7;
#pragma unroll
    for (int j = 0; j < 4; ++j) { const int n = (lane >> 3) + 8 * j; const float* s = scr + (8 * c) * 36 + n;
        u32x4 o; o.x = pk2(s[0 * 36], s[1 * 36]); o.y = pk2(s[2 * 36], s[3 * 36]); o.z = pk2(s[4 * 36], s[5 * 36]); o.w = pk2(s[6 * 36], s[7 * 36]);
        *(u32x4*)(WT + (size_t)(orow0 + n) * ldo + kofs + k0 + 8 * c) = o; }
    LDS_WAIT(); asm volatile("" ::: "memory");
}
constexpr int I_IN = 16 * 216, I_BR = 3 * 8 * 32, I_OUT = 16 * 32, I_EX = 16 * 16 * 32;
constexpr int NITEMS = I_IN + I_BR + I_OUT + 3 * I_EX;
constexpr int IT_UP0 = I_IN + I_BR + I_OUT, IT_DN0 = IT_UP0 + 2 * I_EX;
constexpr int FA1 = 4900, FB1 = 9800, FC1 = 10900, FD1 = 15000, FE1 = 20612;
__device__ __forceinline__ void wconv_phase(Frame& F, int l, int it_lo, int it_hi, int widx, int nw, int wave_lo = 0) {
    const int lane = launder(lane_id()), tid = F.wave * 64 + lane; (void)tid; (void)lane;
    float* scr = (float*)(F.lds + F.wave * 16384);
    if (F.wave < wave_lo) return;
    const int nwv = NWAVES - wave_lo, gw = widx * nwv + F.wave - wave_lo, NGW = nw * nwv;
    for (int it = it_lo + gw; it < it_hi; it += NGW) {
        int r = it;
        if (r < I_IN) { const int kb = r / 216, nb = r % 216; transpose_item(inp(F, I_WIN) + (size_t)l * D * INW, D, INW, (bf16*)(F.ws + wpar(l, WS_WIN, WS_WIN1)), kb * 64, nb * 32, nb * 32, scr, lane); continue; } r -= I_IN;
        if (r < I_BR) { const int br = r / 256, q = r % 256, kb = q / 32, nb = q % 32;
            transpose_item(inp(F, I_WBR) + ((size_t)l * 3 + br) * 512 * D, 512, D, (bf16*)(F.ws + wpar(l, WS_WBR, WS_WBR1)), kb * 64, nb * 32, nb * 32, scr, lane, 1536, br * 512); continue; } r -= I_BR;
        if (r < I_OUT) { const int kb = r / 32, nb = r % 32; transpose_item(inp(F, I_WOUT) + (size_t)l * D * D, D, D, (bf16*)(F.ws + wpar(l, WS_WOUT, WS_WOUT1)), kb * 64, nb * 32, nb * 32, scr, lane); continue; } r -= I_OUT;
        if (r < 2 * I_EX) { const int s = r / I_EX, q = r % I_EX, e = q / 512, q2 = q % 512, kb = q2 / 32, nb = q2 % 32, n0 = nb * 32;
            const float* W = inp(F, s ? I_WU : I_WG) + ((size_t)l * NE + e) * D * FF;
            transpose_item(W, D, FF, (bf16*)(F.ws + wpar(l, WS_WUP, WS_WUP1)) + (size_t)e * 2048 * D, kb * 64, n0, 256 * (n0 / 128) + 128 * s + (n0 % 128), scr, lane); continue; } r -= 2 * I_EX;
        { const int e = r / 512, q2 = r % 512, kb = q2 / 32, nb = q2 % 32;
            transpose_item(inp(F, I_WD) + ((size_t)l * NE + e) * FF * D, FF, D, (bf16*)(F.ws + wpar(l, WS_WDN, WS_WDN1)) + (size_t)e * D * FF, kb * 64, nb * 32, nb * 32, scr, lane); }
    }
}

__device__ __forceinline__ float xsel(bool c, float a, float b) { return c ? a : b; }
template <bool ROUTER>
__device__ __forceinline__ void norm_phase(Frame& F, int l, int ch, int nrows, bool dry = false) {
    const int lane = launder(lane_id()), tid = F.wave * 64 + lane; (void)tid; (void)lane;
    const int gw = F.vcu * NWAVES + F.wave, NGW = F.G * NWAVES;
    float* wr_l = (float*)F.lds;
    if (ROUTER) {
        const float* wr = inp(F, I_WROUTER) + (size_t)l * D * NE;
        for (int i = tid; i < D * NE; i += NTHR) { const int d = i >> 4, e = i & 15; wr_l[e * D + d] = wr[i]; }
        __syncthreads();
    }
    const float* gv = inp(F, ROUTER ? I_GFFN : I_GMIX) + (size_t)l * D;
    bf16* hb = dry ? (bf16*)(F.ws + WS_OBUF + 160 * MiB) : (bf16*)(F.ws + (ch == 0 ? WS_HBUF : WS_HBUF1));
    f32x4 nx[2][4]; u32x2 nb[2][4];
#define NP_LOAD(c0) do { _Pragma("unroll") for (int rr_ = 0; rr_ < 2; ++rr_) { \
        if (ROUTER) { const bf16* xb_ = xbrow(F, ch, (c0) + rr_); \
            _Pragma("unroll") for (int j_ = 0; j_ < 4; ++j_) nb[rr_][j_] = *(const u32x2*)(xb_ + lane * 4 + 256 * j_); } \
        else { const float* xr_ = xin_row(F, ch, (c0) + rr_); \
            _Pragma("unroll") for (int j_ = 0; j_ < 4; ++j_) nx[rr_][j_] = *(const f32x4*)(xr_ + lane * 4 + 256 * j_); } } } while (0)
    const int rpw = (((nrows + NGW - 1) / NGW) + 1) & ~1, rbeg = gw * rpw, rend = (rbeg + rpw < nrows) ? rbeg + rpw : nrows;
    f32x4 gq[4], shq[4], scq[4]; int cmv = -1;
#pragma unroll
    for (int j = 0; j < 4; ++j) gq[j] = *(const f32x4*)(gv + lane * 4 + 256 * j);
    if (rbeg < rend) NP_LOAD(rbeg);
    for (int cr0 = rbeg; cr0 < rend; cr0 += 2) {
        f32x4 v[2][4];
#pragma unroll
        for (int rr = 0; rr < 2; ++rr)
#pragma unroll
            for (int j = 0; j < 4; ++j) {
                if (ROUTER) { const u32x2 t = nb[rr][j]; v[rr][j].x = bflo(t.x); v[rr][j].y = bfhi(t.x); v[rr][j].z = bflo(t.y); v[rr][j].w = bfhi(t.y); }
                else v[rr][j] = nx[rr][j]; }
        if (cr0 + 2 < rend) NP_LOAD(cr0 + 2);
#pragma unroll
        for (int rr = 0; rr < 2; ++rr) {
            const int cr = cr0 + rr;
            const int mv = mv_of(ch, cr);
            if (mv != cmv) { cmv = mv; const float* sh = mod_ptr(F, l, mv, ROUTER ? 3 : 0); const float* sc = mod_ptr(F, l, mv, ROUTER ? 4 : 1);
#pragma unroll
                for (int j = 0; j < 4; ++j) { shq[j] = *(const f32x4*)(sh + lane * 4 + 256 * j); scq[j] = *(const f32x4*)(sc + lane * 4 + 256 * j); } }
            float ss = 0.f;
#pragma unroll
            for (int j = 0; j < 4; ++j) {
                if (!ROUTER) { u32x2 o; o.x = pk2(v[rr][j].x, v[rr][j].y); o.y = pk2(v[rr][j].z, v[rr][j].w); *(u32x2*)(xbrow(F, ch, cr) + lane * 4 + 256 * j) = o; }
                ss += (v[rr][j].x * v[rr][j].x + v[rr][j].y * v[rr][j].y) + (v[rr][j].z * v[rr][j].z + v[rr][j].w * v[rr][j].w); }
            const float rstd = 1.0f / sqrtf(wave_sum(ss) * (1.0f / D) + RMS_EPS);
#pragma unroll
            for (int j = 0; j < 4; ++j) {
                v[rr][j] = (v[rr][j] * rstd * gq[j]) * (scq[j] + 1.0f) + shq[j];
                u32x2 o; o.x = pk2(v[rr][j].x, v[rr][j].y); o.y = pk2(v[rr][j].z, v[rr][j].w);
                *(u32x2*)(hb + (size_t)cr * D + lane * 4 + 256 * j) = o;
            }
        }
#undef NP_LOAD
        if (ROUTER) {
            const bool b5 = lane & 32, b4 = lane & 16, b3 = lane & 8;
            float lg[2][2];
#pragma unroll
            for (int hf = 0; hf < 2; ++hf) {
                float a[2][8];
#pragma unroll
                for (int e = 0; e < 8; ++e) {
                    f32x4 w[4];
#pragma unroll
                    for (int j = 0; j < 4; ++j) w[j] = *(const f32x4*)(wr_l + (hf * 8 + e) * D + lane * 4 + 256 * j);
#pragma unroll
                    for (int rr = 0; rr < 2; ++rr) { float t = 0.f;
#pragma unroll
                        for (int j = 0; j < 4; ++j) t += (v[rr][j].x * w[j].x + v[rr][j].y * w[j].y) + (v[rr][j].z * w[j].z + v[rr][j].w * w[j].w);
                        a[rr][e] = t; }
                    if (e & 1) __builtin_amdgcn_sched_barrier(0);
                }
#pragma unroll
                for (int rr = 0; rr < 2; ++rr) {
                    float c[4], d2[2];
#pragma unroll
                    for (int i = 0; i < 4; ++i) { const float recv = __shfl_xor(xsel(b5, a[rr][i], a[rr][i + 4]), 32); c[i] = xsel(b5, a[rr][i + 4], a[rr][i]) + recv; }
#pragma unroll
                    for (int i = 0; i < 2; ++i) { const float recv = __shfl_xor(xsel(b4, c[i], c[i + 2]), 16); d2[i] = xsel(b4, c[i + 2], c[i]) + recv; }
                    float t = xsel(b3, d2[1], d2[0]) + __shfl_xor(xsel(b3, d2[0], d2[1]), 8);
                    t += __shfl_xor(t, 4); t += __shfl_xor(t, 2); t += __shfl_xor(t, 1);
                    lg[hf][rr] = t;
                }
                __builtin_amdgcn_sched_barrier(0);
            }
#pragma unroll
            for (int rr = 0; rr < 2; ++rr) {
                float m = fmaxf(lg[0][rr], lg[1][rr]);
#pragma unroll
                for (int o = 8; o < 64; o <<= 1) m = fmaxf(m, __shfl_xor(m, o));
                const float p0 = expf(lg[0][rr] - m), p1 = expf(lg[1][rr] - m); float s = p0 + p1;
#pragma unroll
                for (int o = 8; o < 64; o <<= 1) s += __shfl_xor(s, o);
                const float inv = 1.0f / s;
                const int cr = cr0 + rr, e = lane >> 3;
                if ((lane & 7) < 2 && !dry) {
                    const int ee = (lane & 1) ? e + 8 : e; const float mine = ((lane & 1) ? p1 : p0) * inv;
                    if (cr < LROWS) { const int bl = cr / SEQ, t = cr % SEQ; affl_of(F, ch)[(size_t)(bl * NE + ee) * SEQ + t] = mine; }
                    else { const int j = cr - LROWS, bl = j / CTX, t = j % CTX; ((float*)(F.ws + WS_AFFC))[(size_t)(bl * NE + ee) * CTX + t] = mine; }
                }
            }
        }
    }
}

__device__ __forceinline__ const bf16* zrow(const Frame& F, int cr) { return (const bf16*)(F.ws + WS_Z) + (size_t)cr * ZW; }

__device__ __forceinline__ void conv_phase(Frame& F, int l, int nrows) {
    const int lane = launder(lane_id()), tid = F.wave * 64 + lane; (void)tid; (void)lane;
    const int gw = F.vcu * NWAVES + F.wave, NGW = F.G * NWAVES;
    const float* cw = inp(F, I_CONVW) + (size_t)l * 3 * 512;
    float w[3][8];
#pragma unroll
    for (int k = 0; k < 3; ++k)
#pragma unroll
        for (int j = 0; j < 8; ++j) w[k][j] = cw[k * 512 + lane * 8 + j];
    bf16* ob = (bf16*)(F.ws + WS_OBUF);
    const int rpw = (nrows + NGW - 1) / NGW, rbeg = gw * rpw, rend = (rbeg + rpw < nrows) ? rbeg + rpw : nrows;
    if (rbeg >= rend) return;
#define CV_SEQ(cr_) ((cr_) < LROWS ? (cr_) / SEQ : 1024 + ((cr_) - LROWS) / CTX)
#define CV_LOADP(cr_, P) do { const bf16* zr_ = zrow(F, (cr_)); float c8_[8], x8_[8]; unpack8(*(const u32x4*)(zr_ + Z_AC + lane * 8), c8_); unpack8(*(const u32x4*)(zr_ + Z_AX + lane * 8), x8_); \
        _Pragma("unroll") for (int j_ = 0; j_ < 8; ++j_) (P)[j_] = c8_[j_] * x8_[j_]; } while (0)
    float pp[8], pc[8], pn[8];
#pragma unroll
    for (int j = 0; j < 8; ++j) pp[j] = 0.f;
    if (rbeg > 0 && CV_SEQ(rbeg - 1) == CV_SEQ(rbeg)) CV_LOADP(rbeg - 1, pp);
    CV_LOADP(rbeg, pc);
    for (int cr = rbeg; cr < rend; ++cr) {
        const bool hasn = cr + 1 < nrows, same = hasn && CV_SEQ(cr + 1) == CV_SEQ(cr);
#pragma unroll
        for (int j = 0; j < 8; ++j) pn[j] = 0.f;
        if (hasn) CV_LOADP(cr + 1, pn);
        float b8[8]; unpack8(*(const u32x4*)(zrow(F, cr) + Z_AB + lane * 8), b8);
        float acc[8];
#pragma unroll
        for (int j = 0; j < 8; ++j) acc[j] = w[0][j] * pp[j] + w[1][j] * pc[j] + (same ? w[2][j] * pn[j] : 0.f);
        u32x4 o; o.x = pk2(b8[0] * acc[0], b8[1] * acc[1]); o.y = pk2(b8[2] * acc[2], b8[3] * acc[3]); o.z = pk2(b8[4] * acc[4], b8[5] * acc[5]); o.w = pk2(b8[6] * acc[6], b8[7] * acc[7]);
        *(u32x4*)(ob + (size_t)cr * OW + lane * 8) = o;
#pragma unroll
        for (int j = 0; j < 8; ++j) { pp[j] = same ? pc[j] : 0.f; pc[j] = pn[j]; }
    }
#undef CV_SEQ
#undef CV_LOADP
}

struct NaiveState { unsigned q[32]; float o[64], m, l; };
__device__ __forceinline__ void load64(const bf16* p, float* f) {
#pragma unroll
    for (int i = 0; i < 8; ++i) unpack8(*(const u32x4*)(p + 8 * i), f + 8 * i);
}
__device__ __forceinline__ void rope64(float* x, const f32x2* tabrow) {
#pragma unroll
    for (int i = 0; i < 32; ++i) { const f32x2 cs = tabrow[i]; const float a = x[i], b = x[i + 32]; x[i] = a * cs.x - b * cs.y; x[i + 32] = a * cs.y + b * cs.x; }
}
__device__ __forceinline__ void naive_visit(NaiveState& st, const bf16* kp, const bf16* vp, float bias, bool valid, const f32x2* ropetab) {
    float s = 0.f;
#pragma unroll
    for (int c = 0; c < 4; ++c) {
        float a[8], b[8]; unpack8(*(const u32x4*)(kp + 8 * c), a); unpack8(*(const u32x4*)(kp + 32 + 8 * c), b);
        if (ropetab) {
#pragma unroll
            for (int i = 0; i < 8; ++i) { const f32x2 cs = ropetab[8 * c + i]; const float x1 = a[i], x2 = b[i]; a[i] = x1 * cs.x - x2 * cs.y; b[i] = x1 * cs.y + x2 * cs.x; }
        }
#pragma unroll
        for (int i = 0; i < 8; ++i) s += bflo(st.q[8 * c + i]) * a[i] + bfhi(st.q[8 * c + i]) * b[i];
    }
    s = valid ? s + bias : -1e30f;
    const float mn = fmaxf(st.m, s), alpha = __expf(st.m - mn), p = __expf(s - mn);
    st.m = mn; st.l = st.l * alpha + p;
#pragma unroll
    for (int c = 0; c < 8; ++c) { float v[8]; unpack8(*(const u32x4*)(vp + 8 * c), v);
#pragma unroll
        for (int i = 0; i < 8; ++i) st.o[8 * c + i] = st.o[8 * c + i] * alpha + p * v[i]; }
}
__device__ __forceinline__ void naive_attn_phase(Frame& F, int l, int ch, bool last, bf16* ob) {
    const int lane = launder(lane_id()), tid = F.wave * 64 + lane; (void)tid; (void)lane;
    const int n_lat = LROWS / 64, n_ctx = (last || ch != 0) ? 0 : CTXALL / 64;
    const int nunits = 2 * n_lat + 2 * n_ctx;
    const f32x2* tab = (const f32x2*)(F.ws + WS_ROPE);
    for (int u = F.vcu; u < nunits; u += F.G) {
        int type, blk;
        if (u < n_lat) { type = 0; blk = u; } else if (u < 2 * n_lat) { type = 1; blk = u - n_lat; } else if (u < 2 * n_lat + n_ctx) { type = 2; blk = u - 2 * n_lat; } else { type = 3; blk = u - 2 * n_lat - n_ctx; }
        const int h = F.wave;
        const int cr0 = (type < 2) ? blk * 64 : LROWS + blk * 64, cr = cr0 + lane;
        const int bl = (type < 2) ? ch * BC + cr0 / SEQ : (cr0 - LROWS) / CTX;
        const int t0 = (type < 2) ? cr0 % SEQ : (cr0 - LROWS) % CTX, t = t0 + lane;
        const int ctx0 = LROWS + bl * CTX;
        const bool sw = (type == 0 || type == 3);
        const int hk = sw ? h / 4 : h;
        const int qcol = (sw ? Z_SQ : Z_NQ) + 64 * h, kcol = (sw ? Z_SK : Z_NK) + 64 * hk, vcol = (sw ? Z_SV : Z_NV) + 64 * hk;
        NaiveState st;
        { float qf[64]; load64(zrow(F, cr) + qcol, qf);
          if (type == 0) rope64(qf, tab + (size_t)t * 32);
#pragma unroll
          for (int i = 0; i < 32; ++i) st.q[i] = pk2(qf[i] * 0.125f, qf[i + 32] * 0.125f);
#pragma unroll
          for (int i = 0; i < 64; ++i) st.o[i] = 0.f; }
        if (sw) { st.m = inp(F, I_SINK)[l * 8 + h]; st.l = 1.f; } else { st.m = -1e30f; st.l = 0.f; }
        const int lo = t0 - 128 < 0 ? 0 : t0 - 128, hi = t0 + 63 + 128 > SEQ - 1 ? SEQ - 1 : t0 + 63 + 128;
        const int r = t0 / 64, c = lane; int rs = r - 4; rs = rs < 0 ? 0 : (rs > 24 ? 24 : rs); int cs = c - 8; cs = cs < 0 ? 0 : (cs > 48 ? 48 : cs);
        const float* rpb = inp(F, I_RPB) + ((size_t)l * 8 + h) * 15 * 31;
        const int nloc = type == 0 ? hi - lo + 1 : (type == 1 ? 512 : 0);
#pragma unroll 1
        for (int idx = 0; idx < CTX + nloc; ++idx) {
            const bf16* zr; float bias = 0.f; bool valid = true; const f32x2* rt = nullptr;
            if (idx < CTX) zr = zrow(F, ctx0 + idx);
            else if (type == 0) { const int j = lo + idx - CTX, dlt = t - j; zr = zrow(F, cr0 - t0 + j); valid = dlt <= 128 && dlt >= -128; rt = tab + (size_t)j * 32; }
            else { const int q = idx - CTX, kr = rs + (q >> 6), kc = q & 63; zr = zrow(F, cr0 - t0 + kr * 64 + kc); valid = kc >= cs && kc < cs + 16;
                int dc = kc - c + 15; dc = dc < 0 ? 0 : (dc > 30 ? 30 : dc); bias = rpb[(kr - r + 7) * 31 + dc]; }
            naive_visit(st, zr + kcol, zr + vcol, bias, valid, rt);
        }
        const float inv = 1.0f / st.l;
        bf16* op = ob + (size_t)cr * OW + (sw ? 1024 : 512) + 64 * h;
#pragma unroll
        for (int i = 0; i < 8; ++i) { u32x4 o; o.x = pk2(st.o[8 * i] * inv, st.o[8 * i + 1] * inv); o.y = pk2(st.o[8 * i + 2] * inv, st.o[8 * i + 3] * inv); o.z = pk2(st.o[8 * i + 4] * inv, st.o[8 * i + 5] * inv); o.w = pk2(st.o[8 * i + 6] * inv, st.o[8 * i + 7] * inv);
            *(u32x4*)(op + 8 * i) = o; }
    }
}

typedef short s16x4 __attribute__((ext_vector_type(4)));
typedef float f32x16 __attribute__((ext_vector_type(16)));
typedef __bf16 bf16x2_t __attribute__((ext_vector_type(2)));
__device__ __forceinline__ unsigned cvtpk(float lo, float hi) { const f32x2 v = {lo, hi}; return __builtin_bit_cast(unsigned, __builtin_convertvector(v, bf16x2_t)); }
typedef short v4i16_t __attribute__((ext_vector_type(4)));
__device__ __forceinline__ s16x4 vtr(const LAS unsigned char* p) { return __builtin_bit_cast(s16x4, __builtin_amdgcn_ds_read_tr16_b64_v4i16((LAS v4i16_t*)p)); }
constexpr int AK_RS = 144, AV_RS = 192, AK_BYTES = 128 * AK_RS, AV_BYTES = 128 * AV_RS, ASTAGE = AK_BYTES + AV_BYTES, A_RPB_OFF = 2 * ASTAGE;
#define MFMA32(a, b, c) __builtin_amdgcn_mfma_f32_32x32x16_bf16((a), (b), (c), 0, 0, 0)
__device__ __forceinline__ float xlane32(float v) {
    const auto rr = __builtin_amdgcn_permlane32_swap(__builtin_bit_cast(unsigned, v), __builtin_bit_cast(unsigned, v), false, false);
    return __builtin_bit_cast(float, (lane_id() & 32) ? rr[0] : rr[1]);
}
__device__ __forceinline__ float max3f(float a, float b, float c) { return fmaxf(fmaxf(a, b), c); }
__device__ __forceinline__ float rowmax32(const f32x16& p0, const f32x16& p1) {
    float a = max3f(p0[0], p0[1], p1[0]), b = max3f(p0[2], p0[3], p1[1]); a = max3f(a, p1[2], p1[3]);
#pragma unroll
    for (int i = 4; i < 16; i += 4) { a = max3f(a, p0[i], p0[i + 1]); b = max3f(b, p0[i + 2], p0[i + 3]); a = max3f(a, p1[i], p1[i + 1]); b = max3f(b, p1[i + 2], p1[i + 3]); }
    const float m = fmaxf(a, b);
    const auto rr = __builtin_amdgcn_permlane32_swap(__builtin_bit_cast(unsigned, m), __builtin_bit_cast(unsigned, m), false, false);
    return fmaxf(__builtin_bit_cast(float, rr[0]), __builtin_bit_cast(float, rr[1]));
}
__device__ __forceinline__ void lds_read_vt8(unsigned addr, s16x4 (&t)[8]) {
    asm volatile("ds_read_b64_tr_b16 %0, %8\n\tds_read_b64_tr_b16 %1, %8 offset:1536\n\tds_read_b64_tr_b16 %2, %8 offset:64\n\tds_read_b64_tr_b16 %3, %8 offset:1600\n\t"
                 "ds_read_b64_tr_b16 %4, %8 offset:3072\n\tds_read_b64_tr_b16 %5, %8 offset:4608\n\tds_read_b64_tr_b16 %6, %8 offset:3136\n\tds_read_b64_tr_b16 %7, %8 offset:4672\n\t"
                 "s_waitcnt lgkmcnt(0)"
        : "=&v"(t[0]), "=&v"(t[1]), "=&v"(t[2]), "=&v"(t[3]), "=&v"(t[4]), "=&v"(t[5]), "=&v"(t[6]), "=&v"(t[7]) : "v"(addr) : "memory");
}
static_assert(16 * 192 == 3072 && 8 * 192 == 1536, "lds_read_vt8 offsets assume AV_RS = 192");
__device__ __forceinline__ void lds_read_k4(unsigned addr, bf16x8 (&ka)[4]) {
    asm volatile("ds_read_b128 %0, %4\n\tds_read_b128 %1, %4 offset:32\n\tds_read_b128 %2, %4 offset:64\n\tds_read_b128 %3, %4 offset:96\n\ts_waitcnt lgkmcnt(0)"
        : "=&v"(ka[0]), "=&v"(ka[1]), "=&v"(ka[2]), "=&v"(ka[3]) : "v"(addr) : "memory");
}
__device__ __forceinline__ void lds_read_k8(unsigned addr, bf16x8 (&ka)[4], bf16x8 (&kb)[4]) {
    asm volatile("ds_read_b128 %0, %8\n\tds_read_b128 %1, %8 offset:32\n\tds_read_b128 %2, %8 offset:64\n\tds_read_b128 %3, %8 offset:96\n\t"
                 "ds_read_b128 %4, %8 offset:4608\n\tds_read_b128 %5, %8 offset:4640\n\tds_read_b128 %6, %8 offset:4672\n\tds_read_b128 %7, %8 offset:4704\n\t"
                 "s_waitcnt lgkmcnt(0)"
        : "=&v"(ka[0]), "=&v"(ka[1]), "=&v"(ka[2]), "=&v"(ka[3]), "=&v"(kb[0]), "=&v"(kb[1]), "=&v"(kb[2]), "=&v"(kb[3]) : "v"(addr) : "memory");
}
constexpr int A_ROPE_OFF = A_RPB_OFF + 4096;
template <int VAR, int TY>
__device__ __forceinline__ void attn_units(Frame& F, int l, int ch, bool last, bf16* ob) {
    const int lane = launder(lane_id()), tid = F.wave * 64 + lane;
    const int wave = F.wave, r = lane & 31, hh = lane >> 5;
    const float LOG2E = 1.4426950408889634f;
    const f32x2* tab = (const f32x2*)(F.ws + WS_ROPE); (void)tab;
    float* rpbl = (float*)(F.lds + A_RPB_OFF);
    const int skey = tid >> 2, sc = tid & 3, sb = skey >> 6, srow = skey & 63;
    const int nNA = BC * 8 * 8, nSW = BC * 16 * 4, nCX = (last || ch != 0) ? 0 : NB * 8 * 2;
    const int ubeg = (TY == 1) ? 0 : (TY == 0 ? nNA : nNA + nSW), uend = (TY == 1) ? nNA : (TY == 0 ? nNA + nSW : nNA + nSW + nCX);
    for (int u = ubeg + F.vcu; u < uend; u += F.G) {
        int type, bl, h, rg = 0, n = 0;
        if (u < nNA) { type = 1; bl = u >> 6; rg = ((u >> 3) + (u >> 8)) & 7; h = u & 7; }
        else if (u < nNA + nSW) { const int v = u - nNA; type = 0; bl = v >> 6; n = ((v >> 2) + 4 * (v >> 8)) & 15; h = 4 * ((v >> 1) & 1) + 2 * (v & 1); }
        else { const int v = u - nNA - nSW; type = (v < NB * 8) ? 2 : 3; const int vv = v % (NB * 8); bl = vv >> 3; h = vv & 7; }
        if (TY != 2) type = TY;
        const bool sw = (type == 0 || type == 3);
        const int head = (type == 0) ? h + (wave >> 2) : h;
        const int jb = wave & 3;
        const int rq = 4 * rg + 2 * (wave >> 2) + (r >> 4), cq = 16 * jb + (r & 15);
        const int qrow = (type == 1) ? bl * SEQ + 64 * rq + cq : (type == 0) ? bl * SEQ + 128 * n + 32 * (wave & 3) + r : LROWS + bl * CTX + 32 * wave + r;
        const int qcol = (sw ? Z_SQ : Z_NQ) + 64 * head, kcol = sw ? Z_SK + 64 * (head >> 2) : Z_NK + 64 * head, vcol = sw ? Z_SV + 64 * (head >> 2) : Z_NV + 64 * head;
        const int ocol = (sw ? 1024 : 512) + 64 * head;
        const int ctx0 = LROWS + ((type < 2) ? ch * BC + bl : bl) * CTX;
        int nloc = 0, loc0 = 0;
        if (type == 0) { const int jlo = (n == 0) ? 2 : 0, jhi = (n == 15) ? 3 : 5; nloc = jhi - jlo + 1; loc0 = jlo; }
        else if (type == 1) { int a = 4 * rg - 4; a = a < 0 ? 0 : (a > 24 ? 24 : a); int b = 4 * rg - 1; b = b < 0 ? 0 : (b > 24 ? 24 : b); loc0 = a; nloc = b + 7 - a + 1; }
        const int nt = 4 + nloc;
        bf16x8 qf[4];
        {
            const bf16* qp = zrow(F, qrow) + qcol + 8 * hh;
            float q[4][8];
#pragma unroll
            for (int s4 = 0; s4 < 4; ++s4) unpack8(*(const u32x4*)(qp + 16 * s4), q[s4]);
            if (type == 0) {
                const int pos = qrow - bl * SEQ; const f32x2* rl = (const f32x2*)(F.lds + A_ROPE_OFF);
#pragma unroll
                for (int s4 = 0; s4 < 2; ++s4) { const f32x2* tr = rl + (s4 == 0 ? (pos >> 6) : 32 + (pos & 63)) * 16 + 8 * hh;
#pragma unroll
                    for (int j = 0; j < 8; ++j) { const f32x2 cs = tr[j]; const float x1 = q[s4][j], x2 = q[s4 + 2][j]; q[s4][j] = x1 * cs.x - x2 * cs.y; q[s4 + 2][j] = x1 * cs.y + x2 * cs.x; } }
            }
            const float qs = 0.125f * LOG2E;
#pragma unroll
            for (int s4 = 0; s4 < 4; ++s4) { u32x4 p; p.x = cvtpk(q[s4][0] * qs, q[s4][1] * qs); p.y = cvtpk(q[s4][2] * qs, q[s4][3] * qs); p.z = cvtpk(q[s4][4] * qs, q[s4][5] * qs); p.w = cvtpk(q[s4][6] * qs, q[s4][7] * qs);
                qf[s4] = __builtin_bit_cast(bf16x8, p); }
        }
        float m = 0.f, lsum = 0.f;
        if (sw) { m = inp(F, I_SINK)[l * 8 + head] * LOG2E; lsum = (hh == 0) ? 1.f : 0.f; }
        f32x16 o0, o1;
#pragma unroll
        for (int i = 0; i < 16; ++i) { o0[i] = 0.f; o1[i] = 0.f; }
        const int kst = (type == 1) ? (16 * jb - 8 < 0 ? 0 : (16 * jb - 8 > 32 ? 32 : 16 * jb - 8)) : 0;
        unsigned bixp[4] = {0u, 0u, 0u, 0u};
        {
            const int csq = cq - 8 < 0 ? 0 : (cq - 8 > 48 ? 48 : cq - 8);
#pragma unroll
            for (int i = 0; i < 16; ++i) { const int kc = kst + (i & 3) + 8 * (i >> 2) + 4 * hh; bixp[i >> 2] |= (unsigned)(((kc >= csq && kc <= csq + 15) ? kc - cq + 15 : 31) * 4) << (8 * (i & 3)); }
        }
#define BIX(i) ((bixp[(i) >> 2] >> (8 * ((i) & 3))) & 0xffu)
        const int rsl = rq - 4 < 0 ? 0 : (rq - 4 > 24 ? 24 : rq - 4);
        u32x4 gk0, gk1, gv0, gv1;
        bool grope = false; int gpos = 0;
#define A_TILE_ROW0(ti) ((ti) < 4 ? ctx0 + 64 * (ti) : (type == 0 ? bl * SEQ + 128 * n - 128 + 64 * (loc0 + (ti) - 4) : bl * SEQ + 64 * (loc0 + (ti) - 4)))
#define A_STAGE_LOAD(T) do { const int ti_ = 2 * (T) + sb; const int tic_ = ti_ < nt ? ti_ : nt - 1; const int row0_ = A_TILE_ROW0(tic_); const bf16* sp_ = zrow(F, row0_ + srow) + 8 * sc; \
            gk0 = *(const u32x4*)(sp_ + kcol); gk1 = *(const u32x4*)(sp_ + kcol + 32); gv0 = *(const u32x4*)(sp_ + vcol); gv1 = *(const u32x4*)(sp_ + vcol + 32); grope = (type == 0 && tic_ >= 4); gpos = row0_ - bl * SEQ + srow; } while (0)
#define A_STAGE_WRITE(st) do { unsigned char* dk_ = F.lds + (st) * ASTAGE + skey * AK_RS + 16 * sc; unsigned char* dv_ = F.lds + (st) * ASTAGE + AK_BYTES + skey * AV_RS + 16 * sc; \
            if (grope) { float a_[8], b_[8]; unpack8(gk0, a_); unpack8(gk1, b_); \
                const f32x4* rl_ = (const f32x4*)(F.lds + A_ROPE_OFF + ((sc < 2 ? (gpos >> 6) : 32 + (gpos & 63)) * 16 + 8 * (sc & 1)) * 8); \
                _Pragma("unroll") for (int j_ = 0; j_ < 4; ++j_) { const f32x4 rcj_ = rl_[j_]; const float c0_ = rcj_.x, s0_ = rcj_.y, c1_ = rcj_.z, s1_ = rcj_.w; \
                    const float x1_ = a_[2 * j_], x2_ = b_[2 * j_], y1_ = a_[2 * j_ + 1], y2_ = b_[2 * j_ + 1]; \
                    a_[2 * j_] = x1_ * c0_ - x2_ * s0_; b_[2 * j_] = x1_ * s0_ + x2_ * c0_; a_[2 * j_ + 1] = y1_ * c1_ - y2_ * s1_; b_[2 * j_ + 1] = y1_ * s1_ + y2_ * c1_; } \
                gk0.x = cvtpk(a_[0], a_[1]); gk0.y = cvtpk(a_[2], a_[3]); gk0.z = cvtpk(a_[4], a_[5]); gk0.w = cvtpk(a_[6], a_[7]); \
                gk1.x = cvtpk(b_[0], b_[1]); gk1.y = cvtpk(b_[2], b_[3]); gk1.z = cvtpk(b_[4], b_[5]); gk1.w = cvtpk(b_[6], b_[7]); } \
            *(u32x4*)dk_ = gk0; *(u32x4*)(dk_ + 64) = gk1; *(u32x4*)dv_ = gv0; *(u32x4*)(dv_ + 64) = gv1; } while (0)
#define A_QK(XV, kbase) do { bf16x8 k4_[4]; lds_read_k4((unsigned)(size_t)(kbase), k4_); _Pragma("unroll") for (int i_ = 0; i_ < 16; ++i_) (XV)[i_] = -m; \
            _Pragma("unroll") for (int s4_ = 0; s4_ < 4; ++s4_) (XV) = MFMA32(k4_[s4_], qf[s4_], (XV)); } while (0)
#define A_QK2(XA, XB, kbA) do { bf16x8 ka_[4], kb_[4]; lds_read_k8((unsigned)(size_t)(kbA), ka_, kb_); \
            _Pragma("unroll") for (int i_ = 0; i_ < 16; ++i_) { (XA)[i_] = -m; (XB)[i_] = -m; } \
            _Pragma("unroll") for (int s4_ = 0; s4_ < 4; ++s4_) { (XA) = MFMA32(ka_[s4_], qf[s4_], (XA)); (XB) = MFMA32(kb_[s4_], qf[s4_], (XB)); } } while (0)
#define A_NEG(XV) do { _Pragma("unroll") for (int i_ = 0; i_ < 16; ++i_) (XV)[i_] = -1e30f; } while (0)
#define A_PV(XV, vbase) do { u32x4 pa_, pb_; \
            pa_.x = cvtpk((XV)[0], (XV)[1]); pa_.y = cvtpk((XV)[2], (XV)[3]); pa_.z = cvtpk((XV)[4], (XV)[5]); pa_.w = cvtpk((XV)[6], (XV)[7]); \
            pb_.x = cvtpk((XV)[8], (XV)[9]); pb_.y = cvtpk((XV)[10], (XV)[11]); pb_.z = cvtpk((XV)[12], (XV)[13]); pb_.w = cvtpk((XV)[14], (XV)[15]); \
            s16x4 t_[8]; lds_read_vt8((unsigned)(size_t)(vbase), t_); \
            const bf16x8 pfa_ = __builtin_bit_cast(bf16x8, pa_), pfb_ = __builtin_bit_cast(bf16x8, pb_); \
            o0 = MFMA32(__builtin_shufflevector(t_[0], t_[1], 0, 1, 2, 3, 4, 5, 6, 7), pfa_, o0); o1 = MFMA32(__builtin_shufflevector(t_[2], t_[3], 0, 1, 2, 3, 4, 5, 6, 7), pfa_, o1); \
            o0 = MFMA32(__builtin_shufflevector(t_[4], t_[5], 0, 1, 2, 3, 4, 5, 6, 7), pfb_, o0); o1 = MFMA32(__builtin_shufflevector(t_[6], t_[7], 0, 1, 2, 3, 4, 5, 6, 7), pfb_, o1); } while (0)
        if (type == 1) { const float* rp = inp(F, I_RPB) + ((size_t)l * 8 + h) * 465;
            for (int i = tid; i < 17 * 32; i += NTHR) { const int tr = i >> 5, tc = i & 31; rpbl[i] = (tr >= 1 && tr <= 15 && tc < 31) ? rp[(tr - 1) * 31 + tc] * LOG2E : -1e30f; } }
        A_STAGE_LOAD(0); A_STAGE_WRITE(0);
        __syncthreads();
        const LAS unsigned char* ldsl = F.ldsl;
        const int kro = r * AK_RS + 16 * hh;
        const int vro = (4 * hh + ((r & 15) >> 2)) * AV_RS + (16 * (r >> 4) + 4 * (r & 3)) * 2;
        const int krw = kro + kst * AK_RS, vrw = vro + kst * AV_RS;
        const int rqa = 4 * rg + 2 * (wave >> 2), rsa = rqa - 4 < 0 ? 0 : (rqa - 4 > 24 ? 24 : rqa - 4), rsb = rqa - 3 < 0 ? 0 : (rqa - 3 > 24 ? 24 : rqa - 3);
        const int nT = (nt + 1) >> 1;
#pragma unroll 1
        for (int T = 0; T < nT; ++T) {
            const int st = T & 1;
            if (VAR != 1) { if (T + 1 < nT) A_STAGE_LOAD(T + 1); }
            const LAS unsigned char* Kst = ldsl + st * ASTAGE; const LAS unsigned char* Vst = Kst + AK_BYTES;
            const bool vB = 2 * T + 1 < nt;
            const int jA = loc0 + 2 * T - 4, jB = jA + 1;
            if (VAR == 2) { } else
            if (T >= 2 && type == 1) {
                const bool nA = (jA >= rsa && jA <= rsb + 7), nB = vB && (jB >= rsa && jB <= rsb + 7);
                if (nA || nB) {
                    f32x16 x0, x1;
                    if (nA) { A_QK(x0, Kst + krw); const LAS unsigned char* tb = ldsl + A_RPB_OFF + ((jA >= rsl && jA <= rsl + 7) ? (jA - rq + 8) : 0) * 128;
#pragma unroll
                        for (int i = 0; i < 16; ++i) x0[i] += *(const LAS float*)(tb + BIX(i)); } else A_NEG(x0);
                    if (nB) { A_QK(x1, Kst + krw + 64 * AK_RS); const LAS unsigned char* tb = ldsl + A_RPB_OFF + ((jB >= rsl && jB <= rsl + 7) ? (jB - rq + 8) : 0) * 128;
#pragma unroll
                        for (int i = 0; i < 16; ++i) x1[i] += *(const LAS float*)(tb + BIX(i)); } else A_NEG(x1);
                    const float mt = rowmax32(x0, x1);
                    if (__any(mt > 8.0f)) {
                        const float dl = fmaxf(mt, 0.f), alpha = __builtin_amdgcn_exp2f(-dl);
                        m += dl; lsum *= alpha;
#pragma unroll
                        for (int i = 0; i < 16; ++i) { x0[i] -= dl; x1[i] -= dl; o0[i] *= alpha; o1[i] *= alpha; }
                    }
                    float ps = 0.f;
                    if (nA) {
#pragma unroll
                        for (int i = 0; i < 16; ++i) { x0[i] = __builtin_amdgcn_exp2f(x0[i]); ps += x0[i]; }
                        A_PV(x0, Vst + vrw); }
                    if (nB) {
#pragma unroll
                        for (int i = 0; i < 16; ++i) { x1[i] = __builtin_amdgcn_exp2f(x1[i]); ps += x1[i]; }
                        A_PV(x1, Vst + vrw + 64 * AV_RS); }
                    lsum += ps;
                }
            } else {
#pragma unroll
                for (int bi = 0; bi < 2; ++bi) {
                    if (bi == 1 && !vB) break;
                    const int j = jA + bi;
                    bool need = true, mask = false; int vlo = -1, vhi = 64;
                    if (T >= 2) { const int q0 = 32 * (wave & 3); need = (64 * j + 63 >= q0) && (64 * j <= q0 + 287); mask = !((64 * j >= q0 + 31) && (64 * j + 63 <= q0 + 256)); const int qi = q0 + (lane_id() & 31); vlo = qi - 64 * j; vhi = qi + 256 - 64 * j; }
                    if (need) {
                        f32x16 x0, x1;
                        A_QK2(x0, x1, Kst + kro + bi * 64 * AK_RS);
                        if (mask) {
#pragma unroll
                            for (int i = 0; i < 16; ++i) { const int k0 = (i & 3) + 8 * (i >> 2) + 4 * hh, k1 = k0 + 32; x0[i] = (k0 >= vlo && k0 <= vhi) ? x0[i] : -1e30f; x1[i] = (k1 >= vlo && k1 <= vhi) ? x1[i] : -1e30f; }
                        }
                        const float mt = rowmax32(x0, x1);
                        const bool fst = !sw && T == 0 && bi == 0;
                        if (fst || __any(mt > 8.0f)) {
                            const float dl = fst ? mt : fmaxf(mt, 0.f), alpha = fst ? 1.f : __builtin_amdgcn_exp2f(-dl);
                            m += dl; lsum *= alpha;
#pragma unroll
                            for (int i = 0; i < 16; ++i) { x0[i] -= dl; x1[i] -= dl; o0[i] *= alpha; o1[i] *= alpha; }
                        }
                        float ps = 0.f;
#pragma unroll
                        for (int i = 0; i < 16; ++i) { x0[i] = __builtin_amdgcn_exp2f(x0[i]); ps += x0[i]; }
                        A_PV(x0, Vst + vro + bi * 64 * AV_RS);
#pragma unroll
                        for (int i = 0; i < 16; ++i) { x1[i] = __builtin_amdgcn_exp2f(x1[i]); ps += x1[i]; }
                        lsum += ps;
                        A_PV(x1, Vst + vro + (bi * 64 + 32) * AV_RS);
                    }
                }
            }
            if (VAR != 1) { if (T + 1 < nT) A_STAGE_WRITE(st ^ 1); }
            __syncthreads();
        }
#undef A_QK
#undef A_QK2
#undef A_NEG
#undef A_PV
#undef BIX
        const float inv = 1.0f / (lsum + __shfl_xor(lsum, 32));
        const int l2 = lane_id(), r2 = l2 & 31, h2 = l2 >> 5;
        const int rq2 = 4 * rg + 2 * (wave >> 2) + (r2 >> 4), cq2 = 16 * (wave & 3) + (r2 & 15);
        const int qrow2 = (type == 1) ? bl * SEQ + 64 * rq2 + cq2 : (type == 0) ? bl * SEQ + 128 * n + 32 * (wave & 3) + r2 : LROWS + bl * CTX + 32 * wave + r2;
        bf16* op = ob + (size_t)qrow2 * OW + ocol + 4 * h2;
#pragma unroll
        for (int g = 0; g < 4; ++g) {
            u32x2 w0, w1; w0.x = cvtpk(o0[4 * g] * inv, o0[4 * g + 1] * inv); w0.y = cvtpk(o0[4 * g + 2] * inv, o0[4 * g + 3] * inv);
            w1.x = cvtpk(o1[4 * g] * inv, o1[4 * g + 1] * inv); w1.y = cvtpk(o1[4 * g + 2] * inv, o1[4 * g + 3] * inv);
            *(u32x2*)(op + 8 * g) = w0; *(u32x2*)(op + 32 + 8 * g) = w1;
        }
    }
#undef A_TILE_ROW0
#undef A_STAGE_LOAD
#undef A_STAGE_WRITE
}
template <int VAR>
__device__ __forceinline__ void attn_phase(Frame& F, int l, int ch, bool last, bf16* ob) {
    { const int tid = F.wave * 64 + launder(lane_id()); const f32x2* tab = (const f32x2*)(F.ws + WS_ROPE);
      f32x2* rl = (f32x2*)(F.lds + A_ROPE_OFF); for (int i = tid; i < 96 * 16; i += NTHR) { const int a = i >> 4, f = i & 15; rl[i] = (a < 32) ? tab[(size_t)(a * 64) * 32 + f] : tab[(size_t)(a - 32) * 32 + 16 + f]; } }
    __syncthreads();
    attn_units<VAR, 1>(F, l, ch, last, ob);
    attn_units<VAR, 0>(F, l, ch, last, ob);
    attn_units<VAR, 2>(F, l, ch, last, ob);
}


template <int NPL>
__device__ __forceinline__ void topk_select_wave(const float* aff, int cap, int crbase, int ubase, int slot0, int e, int* tokslot, float* gatev, int* seltok, int lane) {
    unsigned v[NPL];
#pragma unroll
    for (int i = 0; i < NPL; i += 4) { const u32x4 t = *(const u32x4*)(aff + lane * NPL + i); v[i] = t.x; v[i + 1] = t.y; v[i + 2] = t.z; v[i + 3] = t.w; }
    unsigned T = 0u;
#pragma unroll 1
    for (int bit = 30; bit >= 0; --bit) {
        const unsigned cand = T | (1u << bit); int c = 0;
#pragma unroll
        for (int i = 0; i < NPL; ++i) c += (v[i] >= cand) ? 1 : 0;
#pragma unroll
        for (int o = 1; o < 64; o <<= 1) c += __shfl_xor(c, o);
        if (c >= cap) T = cand;
    }
    int ngt = 0, nti = 0;
#pragma unroll
    for (int i = 0; i < NPL; ++i) { ngt += (v[i] > T) ? 1 : 0; nti += (v[i] == T) ? 1 : 0; }
    int tot_gt = ngt;
#pragma unroll
    for (int o = 1; o < 64; o <<= 1) tot_gt += __shfl_xor(tot_gt, o);
    const int need = cap - tot_gt;
    int tinc = nti;
#pragma unroll
    for (int o = 1; o < 64; o <<= 1) { const int t = __shfl_up(tinc, o); if (lane >= o) tinc += t; }
    int tie_before = tinc - nti;
    unsigned selmask = 0u; int nsel = 0;
#pragma unroll
    for (int i = 0; i < NPL; ++i) { const bool tie = (v[i] == T); const bool sel = (v[i] > T) || (tie && tie_before < need); tie_before += tie ? 1 : 0; selmask |= sel ? (1u << i) : 0u; nsel += sel ? 1 : 0; }
    int sinc = nsel;
#pragma unroll
    for (int o = 1; o < 64; o <<= 1) { const int t = __shfl_up(sinc, o); if (lane >= o) sinc += t; }
    int pos = sinc - nsel;
#pragma unroll
    for (int i = 0; i < NPL; ++i) {
        const bool sel = (selmask >> i) & 1u; const int t = lane * NPL + i;
        tokslot[(size_t)(crbase + t) * NE + e] = sel ? pos : -1;
        if (sel) { seltok[slot0 + pos] = ubase + crbase + t; gatev[slot0 + pos] = __builtin_bit_cast(float, v[i]); ++pos; }
    }
}
__device__ __forceinline__ void topk_phase(Frame& F, bool last) {
    const int lane = launder(lane_id());
    int* gsel = (int*)(F.ws + WS_SELTOK);
    float* gatev = (float*)(F.ws + WS_GATEV);
    const bool cx = !last;
    for (int p = F.vcu; p < BC * NE; p += F.G) {
        const int bl = p / NE, e = p % NE;
        const int slotL = p * CAP_L, slotC0 = SLOT_CT0 + e * (NB * CAP_C) + bl * CAP_C, slotC1 = slotC0 + BC * CAP_C;
        if (F.wave == 0) topk_select_wave<32>(affl_of(F, 0) + (size_t)p * SEQ, CAP_L, bl * SEQ, 0, slotL, e, tokslot_of(F, 0), gatev, gsel, lane);
        else if (F.wave == 3) topk_select_wave<32>(affl_of(F, 1) + (size_t)p * SEQ, CAP_L, bl * SEQ, RCMAX, NSLOTMAX + slotL, e, tokslot_of(F, 1), gatev, gsel, lane);
        else if (F.wave == 1 && cx) topk_select_wave<4>((const float*)(F.ws + WS_AFFC) + (size_t)p * CTX, CAP_C, LROWS + bl * CTX, 0, slotC0, e, tokslot_of(F, 0), gatev, gsel, lane);
        else if (F.wave == 2 && cx) topk_select_wave<4>((const float*)(F.ws + WS_AFFC) + (size_t)(p + BC * NE) * CTX, CAP_C, LROWS + (bl + BC) * CTX, 0, slotC1, e, tokslot_of(F, 0), gatev, gsel, lane);
    }
}

__device__ __forceinline__ void combine_phase(Frame& F, int l, int ch, bool last, bool dry = false) {
    const int lane = launder(lane_id()), tid = F.wave * 64 + lane; (void)tid; (void)lane;
    const int gw = F.vcu * NWAVES + F.wave, NGW = F.G * NWAVES;
    const int nrows = last ? LROWS : nrows_of(ch);
    const bf16* yb = (const bf16*)(F.ws + WS_YBUF) + (size_t)ch * NSLOTMAX * D; const int* tokslot = tokslot_of(F, ch); const float* gatev = (const float*)(F.ws + WS_GATEV) + (size_t)ch * NSLOTMAX;
    u32x2 xq[2][4], yqa[2][4], yqb[2][4]; float gaq[2], gbq[2]; int slq[2]; unsigned mrq[2]; bool anyq[2], twoq[2];
#define CB_ISSUE(u_, c_) do { const int c__ = (c_); const bool lat_ = c__ < LROWS; const int bl_ = lat_ ? c__ / SEQ : (c__ - LROWS) / CTX; \
        const int sh_ = sll[(c__ - rbeg) * NE + (lane & 15)]; const int my_ = (lane < 16) ? sh_ : -1; slq[u_] = my_; \
        unsigned m_ = (unsigned)__ballot(my_ >= 0) & 0xFFFFu; const bool any_ = m_ != 0u; const int e0_ = any_ ? __builtin_ctz(m_) : 0; m_ &= m_ - 1u; \
        const bool two_ = m_ != 0u; const int e1_ = two_ ? __builtin_ctz(m_) : e0_; if (two_) m_ &= m_ - 1u; \
        const int p0_ = any_ ? __shfl(my_, e0_) : 0, p1_ = two_ ? __shfl(my_, e1_) : p0_; \
        const int s0_ = lat_ ? (bl_ * NE + e0_) * CAP_L + p0_ : SLOT_CT0 + e0_ * (NB * CAP_C) + bl_ * CAP_C + p0_; \
        const int s1_ = lat_ ? (bl_ * NE + e1_) * CAP_L + p1_ : SLOT_CT0 + e1_ * (NB * CAP_C) + bl_ * CAP_C + p1_; \
        anyq[u_] = any_; twoq[u_] = two_; mrq[u_] = m_; gaq[u_] = gatev[s0_]; gbq[u_] = gatev[s1_]; const bf16* xb_ = xbrow(F, ch, c__); \
        _Pragma("unroll") for (int j_ = 0; j_ < 4; ++j_) { xq[u_][j_] = *(const u32x2*)(xb_ + lane * 4 + 256 * j_); \
            yqa[u_][j_] = *(const u32x2*)(yb + (size_t)s0_ * D + lane * 4 + 256 * j_); yqb[u_][j_] = *(const u32x2*)(yb + (size_t)s1_ * D + lane * 4 + 256 * j_); } } while (0)
    const int rpw = (((nrows + NGW - 1) / NGW) + 1) & ~1, rbeg = gw * rpw, rend = (rbeg + rpw < nrows) ? rbeg + rpw : nrows;
    f32x4 gtq[4], shq[4], scq[4], gmq[4]; int cmv = -1;
#pragma unroll
    for (int j = 0; j < 4; ++j) gmq[j] = *(const f32x4*)((last ? inp(F, I_GFINAL) : inp(F, I_GMIX) + (size_t)(l + 1) * D) + lane * 4 + 256 * j);
    if (rbeg >= rend) return;
    LAS int* sll = (LAS int*)(F.ldsl + LDSCTL_OFF + 1024 + F.wave * 1536);
    for (int i = lane; i < (rend - rbeg) * NE; i += 64) sll[i] = tokslot[(size_t)rbeg * NE + i];
    CB_ISSUE(0, rbeg); CB_ISSUE(1, rbeg + 1);
    unsigned res[2][16];
#define CB_STORE(cp_) do { _Pragma("unroll") for (int u_ = 0; u_ < 2; ++u_) { const int cq_ = (cp_) + u_; \
        if (!last) { bf16* xb_ = dry ? (bf16*)(F.ws + WS_OBUF) + (size_t)cq_ * D : xbrow(F, ch, cq_); bf16* hb_ = (dry ? (bf16*)(F.ws + WS_OBUF + 160 * MiB) : hbuf_of(F, ch)) + (size_t)cq_ * D; \
            _Pragma("unroll") for (int j_ = 0; j_ < 4; ++j_) { u32x2 o_; o_.x = res[u_][4 * j_]; o_.y = res[u_][4 * j_ + 1]; *(u32x2*)(xb_ + lane * 4 + 256 * j_) = o_; \
                u32x2 h_; h_.x = res[u_][4 * j_ + 2]; h_.y = res[u_][4 * j_ + 3]; *(u32x2*)(hb_ + lane * 4 + 256 * j_) = h_; } } \
        else { float* xr_ = dry ? (float*)(F.ws + WS_OBUF) + (size_t)cq_ * D : F.out + ((size_t)ch * LROWS + cq_) * D;     \
            _Pragma("unroll") for (int j_ = 0; j_ < 4; ++j_) { f32x4 o_; o_.x = __builtin_bit_cast(float, res[u_][4 * j_]); o_.y = __builtin_bit_cast(float, res[u_][4 * j_ + 1]); o_.z = __builtin_bit_cast(float, res[u_][4 * j_ + 2]); o_.w = __builtin_bit_cast(float, res[u_][4 * j_ + 3]); \
                *(f32x4*)(xr_ + lane * 4 + 256 * j_) = o_; } } } } while (0)
    for (int c0 = rbeg; c0 < rend; c0 += 2) {
        int myslot[2]; unsigned mask[2]; f32x4 v[2][4]; float acc[2][16];
#pragma unroll
        for (int u = 0; u < 2; ++u) { myslot[u] = slq[u]; mask[u] = mrq[u];
            const float ga = anyq[u] ? gaq[u] : 0.f, gb = twoq[u] ? gbq[u] : 0.f;
#pragma unroll
            for (int j = 0; j < 4; ++j) { const u32x2 t = xq[u][j]; v[u][j].x = bflo(t.x); v[u][j].y = bfhi(t.x); v[u][j].z = bflo(t.y); v[u][j].w = bfhi(t.y);
                const u32x2 a = yqa[u][j], b = yqb[u][j];
                acc[u][4 * j] = ga * bflo(a.x); acc[u][4 * j + 1] = ga * bfhi(a.x); acc[u][4 * j + 2] = ga * bflo(a.y); acc[u][4 * j + 3] = ga * bfhi(a.y);
                acc[u][4 * j] += gb * bflo(b.x); acc[u][4 * j + 1] += gb * bfhi(b.x); acc[u][4 * j + 2] += gb * bflo(b.y); acc[u][4 * j + 3] += gb * bfhi(b.y); }
#pragma unroll
            for (int j = 0; j < 4; ++j) asm volatile("" : "+v"(v[u][j].x), "+v"(v[u][j].y), "+v"(v[u][j].z), "+v"(v[u][j].w), "+v"(acc[u][4 * j]), "+v"(acc[u][4 * j + 1]), "+v"(acc[u][4 * j + 2]), "+v"(acc[u][4 * j + 3]) :: "memory");
        }
        if (c0 > rbeg) CB_STORE(c0 - 2);
        if (c0 + 2 < rend) { CB_ISSUE(0, c0 + 2); CB_ISSUE(1, c0 + 3); }
#pragma unroll
      for (int u = 0; u < 2; ++u) {
        const int cr = c0 + u;
        const bool lat = cr < LROWS; const int bl = lat ? cr / SEQ : (cr - LROWS) / CTX;
        { const int mv = mv_of(ch, cr); if (mv != cmv) { cmv = mv; const float* gt = mod_ptr(F, l, mv, 5); const float* sh = mod_ptr(F, last ? l : l + 1, mv, 0); const float* sc = mod_ptr(F, last ? l : l + 1, mv, 1);
#pragma unroll
            for (int j = 0; j < 4; ++j) { gtq[j] = *(const f32x4*)(gt + lane * 4 + 256 * j); shq[j] = *(const f32x4*)(sh + lane * 4 + 256 * j); scq[j] = *(const f32x4*)(sc + lane * 4 + 256 * j); } } }
        unsigned mk = mask[u];
        while (mk) {
            const int e0 = __builtin_ctz(mk); mk &= mk - 1;
            const bool two = mk != 0u; const int e1 = two ? __builtin_ctz(mk) : e0; if (two) mk &= mk - 1;
            const int p0 = __shfl(myslot[u], e0), p1 = __shfl(myslot[u], e1);
            const int s0 = lat ? (bl * NE + e0) * CAP_L + p0 : SLOT_CT0 + e0 * (NB * CAP_C) + bl * CAP_C + p0;
            const int s1 = lat ? (bl * NE + e1) * CAP_L + p1 : SLOT_CT0 + e1 * (NB * CAP_C) + bl * CAP_C + p1;
            u32x2 ua[4], ub[4]; const float ga = gatev[s0], gb = gatev[s1];
#pragma unroll
            for (int j = 0; j < 4; ++j) { ua[j] = *(const u32x2*)(yb + (size_t)s0 * D + lane * 4 + 256 * j); ub[j] = *(const u32x2*)(yb + (size_t)s1 * D + lane * 4 + 256 * j); }
#pragma unroll
            for (int j = 0; j < 4; ++j) { acc[u][4 * j] += ga * bflo(ua[j].x); acc[u][4 * j + 1] += ga * bfhi(ua[j].x); acc[u][4 * j + 2] += ga * bflo(ua[j].y); acc[u][4 * j + 3] += ga * bfhi(ua[j].y); }
            if (two) {
#pragma unroll
                for (int j = 0; j < 4; ++j) { acc[u][4 * j] += gb * bflo(ub[j].x); acc[u][4 * j + 1] += gb * bfhi(ub[j].x); acc[u][4 * j + 2] += gb * bflo(ub[j].y); acc[u][4 * j + 3] += gb * bfhi(ub[j].y); }
            }
        }
        float ss = 0.f;
#pragma unroll
        for (int j = 0; j < 4; ++j) { const f32x4 g4 = gtq[j];
            v[u][j].x += g4.x * acc[u][4 * j]; v[u][j].y += g4.y * acc[u][4 * j + 1]; v[u][j].z += g4.z * acc[u][4 * j + 2]; v[u][j].w += g4.w * acc[u][4 * j + 3];
            ss += (v[u][j].x * v[u][j].x + v[u][j].y * v[u][j].y) + (v[u][j].z * v[u][j].z + v[u][j].w * v[u][j].w); }
        const float rstd = 1.0f / sqrtf(wave_sum(ss) * (1.0f / D) + RMS_EPS);
        if (!last) {
#pragma unroll
            for (int j = 0; j < 4; ++j) {
                const f32x4 hv = (v[u][j] * rstd * gmq[j]) * (scq[j] + 1.0f) + shq[j];
                res[u][4 * j] = pk2(v[u][j].x, v[u][j].y); res[u][4 * j + 1] = pk2(v[u][j].z, v[u][j].w); res[u][4 * j + 2] = pk2(hv.x, hv.y); res[u][4 * j + 3] = pk2(hv.z, hv.w);
            }
            continue;
        }
        {
            float scl = 1.0f;
#if defined(PROBE_ATTN)
            { const unsigned cn = __hip_atomic_load((unsigned*)(F.ws + WS_CTL) + CW_DIAG, __ATOMIC_RELAXED, __HIP_MEMORY_SCOPE_AGENT); scl = 1.0f + 0.02f * log2f(1.0f + (float)cn); }
#endif
#pragma unroll
            for (int j = 0; j < 4; ++j) { const f32x4 o = v[u][j] * rstd * gmq[j] * scl; const float ox = o.x, oy = o.y, oz = o.z, ow = o.w;
                res[u][4 * j] = __builtin_bit_cast(unsigned, ox); res[u][4 * j + 1] = __builtin_bit_cast(unsigned, oy); res[u][4 * j + 2] = __builtin_bit_cast(unsigned, oz); res[u][4 * j + 3] = __builtin_bit_cast(unsigned, ow); }
        }
      }
    }
    CB_STORE(rend - 2);
#undef CB_STORE
#undef CB_ISSUE
}

using pg8::Unit; using pg8::cvt_pk_bf16;
struct SchedBase { int nM, nN, G, c, rep;
    __device__ __forceinline__ bool tile(int i, int& pm, int& pn, int& sub) const { sub = i % rep; return pg8::tile_of((long)(i / rep) * G + c, nM, nN, pm, pn); } };

struct SchedIn : SchedBase { const char* A; const char* B; int nMfull = 0, kvM = 0;
    __device__ __forceinline__ bool next(int i, Unit& u) const { int sub; u.aux = 0; u.pad = 0;
        if (!tile(i, u.pm, u.pn, sub)) {
            const long L = (long)(i / rep) * G + c - (long)nM * nN; if (kvM == 0 || L < 0 || L >= (long)kvM * 5) return false;
            const int q = (int)L % 5; u.pm = nM + (int)L / 5; u.pn = q < 4 ? 8 + q : 14; }
        u.A = A + (size_t)u.pm * 256 * D * 2; u.B = B + (size_t)u.pn * 256 * D * 2; return true; } };
__device__ __forceinline__ size_t gb_off(int pm, int g, int wr, int wc, int fr, int fq) { return ((size_t)(pm * 12 + g) * 131072) + (size_t)(((wr * 4 + wc) * 64 + fq * 16 + fr) * 16); }
struct EpiStoreBf16 { static constexpr bool PERM = true; bf16* O; int ldc; unsigned char* GB;
    __device__ __forceinline__ void operator()(const f32x4 (&acc)[2][2][4][2], const Unit& u, int wr, int wc, int fr, int fq) const {
        if (u.pn >= Z_G / 256) {
            unsigned char* gp = GB + gb_off(u.pm, u.pn - Z_G / 256, wr, wc, fr, fq);
#pragma unroll
            for (int ai = 0; ai < 2; ++ai)
#pragma unroll
                for (int m = 0; m < 4; ++m)
#pragma unroll
                    for (int bj = 0; bj < 2; ++bj) { f32x4 v0 = acc[ai][bj][m][0], v1 = acc[ai][bj][m][1];
#pragma unroll
                        for (int j = 0; j < 4; ++j) { v0[j] = fmaxf(sigmoidf_(v0[j]), 1e-30f); v1[j] = fmaxf(sigmoidf_(v1[j]), 1e-30f); }
                        u32x4 w; w.x = cvt_pk_bf16(v0[0], v0[1]); w.y = cvt_pk_bf16(v0[2], v0[3]); w.z = cvt_pk_bf16(v1[0], v1[1]); w.w = cvt_pk_bf16(v1[2], v1[3]);
                        __builtin_nontemporal_store(w, (u32x4*)(gp + ((ai * 4 + m) * 2 + bj) * 8192)); }
        } else {
            const int row0 = u.pm * 256 + wr * 64 + fr, col0 = u.pn * 256 + wc * 32 + 8 * fq;
#pragma unroll
            for (int ai = 0; ai < 2; ++ai)
#pragma unroll
                for (int m = 0; m < 4; ++m) { bf16* rowp = O + (size_t)(row0 + ai * 128 + m * 16) * ldc + col0;
#pragma unroll
                    for (int bj = 0; bj < 2; ++bj) { const f32x4 v0 = acc[ai][bj][m][0], v1 = acc[ai][bj][m][1];
                        u32x4 w; w.x = cvt_pk_bf16(v0[0], v0[1]); w.y = cvt_pk_bf16(v0[2], v0[3]); w.z = cvt_pk_bf16(v1[0], v1[1]); w.w = cvt_pk_bf16(v1[2], v1[3]);
                        __builtin_nontemporal_store(w, (u32x4*)(rowp + bj * 128)); } }
        }
    } };

struct SchedMerge : SchedBase { const char* A; const char* B;
    __device__ __forceinline__ bool next(int i, Unit& u) const { int sub; if (!tile(i, u.pm, u.pn, sub)) return false; u.aux = 0; u.pad = 0;
        u.A = A + (size_t)u.pm * 256 * OW * 2; u.B = B + (size_t)u.pn * 256 * 1536 * 2; return true; } };
__device__ __forceinline__ void gate_load8x2(const unsigned char* sbase, unsigned vo, u32x4 (&a)[8], u32x4 (&b)[8]) {
    unsigned t0, t1, t2, t3;
    asm volatile("v_add_u32 %[t0], 0, %[vo]\n\tglobal_load_dwordx4 %[a0], %[t0], %[sb]\n\t"
        "v_add_u32 %[t2], 524288, %[vo]\n\tglobal_load_dwordx4 %[b0], %[t2], %[sb]\n\t"
        "v_add_u32 %[t1], 8192, %[vo]\n\tglobal_load_dwordx4 %[a1], %[t1], %[sb]\n\t"
        "v_add_u32 %[t3], 532480, %[vo]\n\tglobal_load_dwordx4 %[b1], %[t3], %[sb]\n\t"
        "v_add_u32 %[t0], 16384, %[vo]\n\tglobal_load_dwordx4 %[a2], %[t0], %[sb]\n\t"
        "v_add_u32 %[t2], 540672, %[vo]\n\tglobal_load_dwordx4 %[b2], %[t2], %[sb]\n\t"
        "v_add_u32 %[t1], 24576, %[vo]\n\tglobal_load_dwordx4 %[a3], %[t1], %[sb]\n\t"
        "v_add_u32 %[t3], 548864, %[vo]\n\tglobal_load_dwordx4 %[b3], %[t3], %[sb]\n\t"
        "v_add_u32 %[t0], 32768, %[vo]\n\tglobal_load_dwordx4 %[a4], %[t0], %[sb]\n\t"
        "v_add_u32 %[t2], 557056, %[vo]\n\tglobal_load_dwordx4 %[b4], %[t2], %[sb]\n\t"
        "v_add_u32 %[t1], 40960, %[vo]\n\tglobal_load_dwordx4 %[a5], %[t1], %[sb]\n\t"
        "v_add_u32 %[t3], 565248, %[vo]\n\tglobal_load_dwordx4 %[b5], %[t3], %[sb]\n\t"
        "v_add_u32 %[t0], 49152, %[vo]\n\tglobal_load_dwordx4 %[a6], %[t0], %[sb]\n\t"
        "v_add_u32 %[t2], 573440, %[vo]\n\tglobal_load_dwordx4 %[b6], %[t2], %[sb]\n\t"
        "v_add_u32 %[t1], 57344, %[vo]\n\tglobal_load_dwordx4 %[a7], %[t1], %[sb]\n\t"
        "v_add_u32 %[t3], 581632, %[vo]\n\tglobal_load_dwordx4 %[b7], %[t3], %[sb]\n\t"
        "s_waitcnt vmcnt(0)"
        : [a0]"=&v"(a[0]), [a1]"=&v"(a[1]), [a2]"=&v"(a[2]), [a3]"=&v"(a[3]), [a4]"=&v"(a[4]), [a5]"=&v"(a[5]), [a6]"=&v"(a[6]), [a7]"=&v"(a[7]), [b0]"=&v"(b[0]), [b1]"=&v"(b[1]), [b2]"=&v"(b[2]), [b3]"=&v"(b[3]), [b4]"=&v"(b[4]), [b5]"=&v"(b[5]), [b6]"=&v"(b[6]), [b7]"=&v"(b[7]), [t0]"=&v"(t0), [t1]"=&v"(t1), [t2]"=&v"(t2), [t3]"=&v"(t3)
        : [vo]"v"(vo), [sb]"s"(sbase) : "memory");
}
__device__ __forceinline__ void gate_load16(const unsigned char* sbase, unsigned vo, u32x4 (&a)[16]) {
    unsigned t0, t1;
    asm volatile("v_add_u32 %[t0], 0, %[vo]\n\tglobal_load_dwordx4 %[a0], %[t0], %[sb]\n\t"
        "v_add_u32 %[t1], 8192, %[vo]\n\tglobal_load_dwordx4 %[a1], %[t1], %[sb]\n\t"
        "v_add_u32 %[t0], 16384, %[vo]\n\tglobal_load_dwordx4 %[a2], %[t0], %[sb]\n\t"
        "v_add_u32 %[t1], 24576, %[vo]\n\tglobal_load_dwordx4 %[a3], %[t1], %[sb]\n\t"
        "v_add_u32 %[t0], 32768, %[vo]\n\tglobal_load_dwordx4 %[a4], %[t0], %[sb]\n\t"
        "v_add_u32 %[t1], 40960, %[vo]\n\tglobal_load_dwordx4 %[a5], %[t1], %[sb]\n\t"
        "v_add_u32 %[t0], 49152, %[vo]\n\tglobal_load_dwordx4 %[a6], %[t0], %[sb]\n\t"
        "v_add_u32 %[t1], 57344, %[vo]\n\tglobal_load_dwordx4 %[a7], %[t1], %[sb]\n\t"
        "v_add_u32 %[t0], 65536, %[vo]\n\tglobal_load_dwordx4 %[a8], %[t0], %[sb]\n\t"
        "v_add_u32 %[t1], 73728, %[vo]\n\tglobal_load_dwordx4 %[a9], %[t1], %[sb]\n\t"
        "v_add_u32 %[t0], 81920, %[vo]\n\tglobal_load_dwordx4 %[a10], %[t0], %[sb]\n\t"
        "v_add_u32 %[t1], 90112, %[vo]\n\tglobal_load_dwordx4 %[a11], %[t1], %[sb]\n\t"
        "v_add_u32 %[t0], 98304, %[vo]\n\tglobal_load_dwordx4 %[a12], %[t0], %[sb]\n\t"
        "v_add_u32 %[t1], 106496, %[vo]\n\tglobal_load_dwordx4 %[a13], %[t1], %[sb]\n\t"
        "v_add_u32 %[t0], 114688, %[vo]\n\tglobal_load_dwordx4 %[a14], %[t0], %[sb]\n\t"
        "v_add_u32 %[t1], 122880, %[vo]\n\tglobal_load_dwordx4 %[a15], %[t1], %[sb]\n\t"
        "s_waitcnt vmcnt(0)"
        : [a0]"=&v"(a[0]), [a1]"=&v"(a[1]), [a2]"=&v"(a[2]), [a3]"=&v"(a[3]), [a4]"=&v"(a[4]), [a5]"=&v"(a[5]), [a6]"=&v"(a[6]), [a7]"=&v"(a[7]), [a8]"=&v"(a[8]), [a9]"=&v"(a[9]), [a10]"=&v"(a[10]), [a11]"=&v"(a[11]), [a12]"=&v"(a[12]), [a13]"=&v"(a[13]), [a14]"=&v"(a[14]), [a15]"=&v"(a[15]), [t0]"=&v"(t0), [t1]"=&v"(t1)
        : [vo]"v"(vo), [sb]"s"(sbase) : "memory");
}
struct EpiMerge { static constexpr bool PERM = true; const unsigned char* GB; bf16* O;
    __device__ __forceinline__ void mid(f32x4 (&acc)[2][2][4][2], const Unit& u, int seg, int wr, int wc, int fr, int fq) const {
        const unsigned char* tb = GB + (size_t)(u.pm * 12 + (seg - 1) * 4 + u.pn) * 131072;
        const unsigned vo = (unsigned)(((wr * 4 + wc) * 64 + fq * 16 + fr) * 16);
#pragma unroll
        for (int ai = 0; ai < 2; ++ai) {
            u32x4 a[8], b[8]; gate_load8x2(tb + ai * 65536, vo, a, b);
#pragma unroll
            for (int m = 0; m < 4; ++m)
#pragma unroll
                for (int bj = 0; bj < 2; ++bj) { float gpv[8], gnv[8]; unpack8(a[m * 2 + bj], gpv); unpack8(b[m * 2 + bj], gnv);
#pragma unroll
                    for (int j = 0; j < 4; ++j) { acc[ai][bj][m][0][j] *= gpv[j] * __builtin_amdgcn_rcpf(gnv[j]); acc[ai][bj][m][1][j] *= gpv[4 + j] * __builtin_amdgcn_rcpf(gnv[4 + j]); } }
        }
    }
    __device__ __forceinline__ void operator()(const f32x4 (&acc)[2][2][4][2], const Unit& u, int wr, int wc, int fr, int fq) const {
        const int row0 = u.pm * 256 + wr * 64 + fr, col0 = u.pn * 256 + wc * 32 + 8 * fq;
        const unsigned char* tb = GB + (size_t)(u.pm * 12 + 8 + u.pn) * 131072;
        const unsigned vo = (unsigned)(((wr * 4 + wc) * 64 + fq * 16 + fr) * 16);
        u32x4 g[16]; gate_load16(tb, vo, g);
#pragma unroll
        for (int ai = 0; ai < 2; ++ai)
#pragma unroll
            for (int m = 0; m < 4; ++m) { const size_t row = (size_t)(row0 + ai * 128 + m * 16);
#pragma unroll
                for (int bj = 0; bj < 2; ++bj) { const int col = col0 + bj * 128;
                    float g8[8]; unpack8(g[(ai * 4 + m) * 2 + bj], g8);
                    const f32x4 v0 = acc[ai][bj][m][0], v1 = acc[ai][bj][m][1];
                    u32x4 w; w.x = cvt_pk_bf16(v0[0] * g8[0], v0[1] * g8[1]); w.y = cvt_pk_bf16(v0[2] * g8[2], v0[3] * g8[3]); w.z = cvt_pk_bf16(v1[0] * g8[4], v1[1] * g8[5]); w.w = cvt_pk_bf16(v1[2] * g8[6], v1[3] * g8[7]);
                    *(u32x4*)(O + row * D + col) = w; } }
    } };

__device__ __forceinline__ void xres_load16(const unsigned char* sbase, unsigned vo, unsigned p16, u32x4 (&a)[16]) {
    const unsigned o1 = __builtin_amdgcn_readfirstlane(p16), o2 = 2 * o1, o3 = 3 * o1, o8 = 8 * o1, o9 = 9 * o1, o10 = 10 * o1, o11 = 11 * o1;
    unsigned t0, t1;
    asm volatile("global_load_dwordx4 %[a0], %[vo], %[sb]\n\tglobal_load_dwordx4 %[a1], %[vo], %[sb] offset:256\n\t"
        "v_add_u32 %[t0], %[o1], %[vo]\n\tglobal_load_dwordx4 %[a2], %[t0], %[sb]\n\tglobal_load_dwordx4 %[a3], %[t0], %[sb] offset:256\n\t"
        "v_add_u32 %[t1], %[o2], %[vo]\n\tglobal_load_dwordx4 %[a4], %[t1], %[sb]\n\tglobal_load_dwordx4 %[a5], %[t1], %[sb] offset:256\n\t"
        "v_add_u32 %[t0], %[o3], %[vo]\n\tglobal_load_dwordx4 %[a6], %[t0], %[sb]\n\tglobal_load_dwordx4 %[a7], %[t0], %[sb] offset:256\n\t"
        "v_add_u32 %[t1], %[o8], %[vo]\n\tglobal_load_dwordx4 %[a8], %[t1], %[sb]\n\tglobal_load_dwordx4 %[a9], %[t1], %[sb] offset:256\n\t"
        "v_add_u32 %[t0], %[o9], %[vo]\n\tglobal_load_dwordx4 %[a10], %[t0], %[sb]\n\tglobal_load_dwordx4 %[a11], %[t0], %[sb] offset:256\n\t"
        "v_add_u32 %[t1], %[o10], %[vo]\n\tglobal_load_dwordx4 %[a12], %[t1], %[sb]\n\tglobal_load_dwordx4 %[a13], %[t1], %[sb] offset:256\n\t"
        "v_add_u32 %[t0], %[o11], %[vo]\n\tglobal_load_dwordx4 %[a14], %[t0], %[sb]\n\tglobal_load_dwordx4 %[a15], %[t0], %[sb] offset:256\n\t"
        "s_waitcnt vmcnt(0)"
        : [a0]"=&v"(a[0]), [a1]"=&v"(a[1]), [a2]"=&v"(a[2]), [a3]"=&v"(a[3]), [a4]"=&v"(a[4]), [a5]"=&v"(a[5]), [a6]"=&v"(a[6]), [a7]"=&v"(a[7]), [a8]"=&v"(a[8]), [a9]"=&v"(a[9]), [a10]"=&v"(a[10]), [a11]"=&v"(a[11]), [a12]"=&v"(a[12]), [a13]"=&v"(a[13]), [a14]"=&v"(a[14]), [a15]"=&v"(a[15]), [t0]"=&v"(t0), [t1]"=&v"(t1)
        : [vo]"v"(vo), [sb]"s"(sbase), [o1]"s"(o1), [o2]"s"(o2), [o3]"s"(o3), [o8]"s"(o8), [o9]"s"(o9), [o10]"s"(o10), [o11]"s"(o11) : "memory");
}
struct EpiOut { static constexpr bool PERM = true; const Frame* F; int l, ch;
    __device__ __forceinline__ void operator()(const f32x4 (&acc)[2][2][4][2], const Unit& u, int wr, int wc, int fr, int fq) const {
        const int cr0 = u.pm * 256; const float* gt = mod_ptr(*F, l, mv_of(ch, cr0), 2);
        const int col0 = u.pn * 256 + wc * 32 + 8 * fq;
        const bool lat = cr0 < LROWS;
        const unsigned pitch = lat ? 4096u : 2048u;
        const unsigned long long bq = (unsigned long long)(unsigned char*)xbrow(*F, ch, cr0);
        const unsigned blo = (unsigned)__builtin_amdgcn_readfirstlane((unsigned)bq), bhi = (unsigned)__builtin_amdgcn_readfirstlane((unsigned)(bq >> 32));
        const unsigned char* sbase = (const unsigned char*)(((unsigned long long)bhi << 32) | blo);
        const unsigned vo = (unsigned)(wr * 64 + fr) * pitch + (unsigned)col0 * 2u;
        f32x4 g[2][2];
#pragma unroll
        for (int bj = 0; bj < 2; ++bj) { g[bj][0] = *(const f32x4*)(gt + col0 + bj * 128); g[bj][1] = *(const f32x4*)(gt + col0 + bj * 128 + 4); }
        u32x4 xv[16]; xres_load16(sbase, vo, 16u * pitch, xv);
#pragma unroll
        for (int ai = 0; ai < 2; ++ai)
#pragma unroll
            for (int m = 0; m < 4; ++m)
#pragma unroll
                for (int bj = 0; bj < 2; ++bj) { float x8[8]; unpack8(xv[(ai * 4 + m) * 2 + bj], x8);
                    const f32x4 a0 = acc[ai][bj][m][0] * g[bj][0], a1 = acc[ai][bj][m][1] * g[bj][1];
                    u32x4 w; w.x = cvt_pk_bf16(x8[0] + a0[0], x8[1] + a0[1]); w.y = cvt_pk_bf16(x8[2] + a0[2], x8[3] + a0[3]); w.z = cvt_pk_bf16(x8[4] + a1[0], x8[5] + a1[1]); w.w = cvt_pk_bf16(x8[6] + a1[2], x8[7] + a1[3]);
                    *(u32x4*)((unsigned char*)sbase + (size_t)(vo + (unsigned)(ai * 8 + m) * (16u * pitch) + (unsigned)bj * 256u)) = w; }
    } };

__device__ __forceinline__ int expert_of_tile(int pm) { return pm < SLT ? pm % NE : (pm - SLT) / (NB * CAP_C / 256); }
__device__ __forceinline__ void ffn_tile(int t, bool last, int& c1, int& pml) {
    const int per = last ? 2 * BC : 2 * BC + NB * CAP_C / 256;
    const int e = t / per, k = t % per;
    if (k < BC) { c1 = 0; pml = k * NE + e; }
    else if (!last && k < BC + NB * CAP_C / 256) { c1 = 0; pml = SLT + e * (NB * CAP_C / 256) + (k - BC); }
    else { c1 = 1; pml = (k - (per - BC)) * NE + e; }
}
struct SchedUp : SchedBase { const char* A; const char* B; const int* gidx; int nM0;
    __device__ __forceinline__ bool next(int i, Unit& u) const { int sub; if (!tile(i, u.pm, u.pn, sub)) return false; u.pad = 0;
        int c1, pml; ffn_tile(u.pm, nM0 == SLT, c1, pml); u.aux = c1 * PBT + pml;
        u.A = A; u.B = B + ((size_t)expert_of_tile(pml) * 2048 + (size_t)u.pn * 256) * D * 2; return true; } };
struct EpiUp { static constexpr bool PERM = true; bf16* O;
    __device__ __forceinline__ void operator()(const f32x4 (&acc)[2][2][4][2], const Unit& u, int wr, int wc, int fr, int fq) const {
        const int row0 = u.aux * 256 + wr * 64 + fr, col0 = u.pn * 128 + wc * 32 + 8 * fq;
#pragma unroll
        for (int ai = 0; ai < 2; ++ai)
#pragma unroll
            for (int m = 0; m < 4; ++m) { float h[8];
#pragma unroll
                for (int n = 0; n < 2; ++n)
#pragma unroll
                    for (int j = 0; j < 4; ++j) { const float g = acc[ai][0][m][n][j], uu = acc[ai][1][m][n][j]; h[4 * n + j] = g * sigmoidf_(g) * uu; }
                u32x4 w; w.x = cvt_pk_bf16(h[0], h[1]); w.y = cvt_pk_bf16(h[2], h[3]); w.z = cvt_pk_bf16(h[4], h[5]); w.w = cvt_pk_bf16(h[6], h[7]);
                *(u32x4*)(O + (size_t)(row0 + ai * 128 + m * 16) * FF + col0) = w; }
    } };

struct SchedDown : SchedBase { const char* A; const char* B; int nM0;
    __device__ __forceinline__ bool next(int i, Unit& u) const { int sub; if (!tile(i, u.pm, u.pn, sub)) return false; u.pad = 0;
        int c1, pml; ffn_tile(nM - 1 - u.pm, nM0 == SLT, c1, pml); u.aux = c1 * PBT + pml;
        u.A = A + (size_t)u.aux * 256 * FF * 2; u.B = B + ((size_t)expert_of_tile(pml) * D + (size_t)u.pn * 256) * FF * 2; return true; } };
__device__ __forceinline__ void load8_rows_f32(const float* sbase, unsigned vo, float (&g)[8]) {
    asm volatile("global_load_dword %[g0], %[vo], %[sb]\n\tglobal_load_dword %[g1], %[vo], %[sb] offset:64\n\tglobal_load_dword %[g2], %[vo], %[sb] offset:128\n\tglobal_load_dword %[g3], %[vo], %[sb] offset:192\n\t"
                 "global_load_dword %[g4], %[vo], %[sb] offset:512\n\tglobal_load_dword %[g5], %[vo], %[sb] offset:576\n\tglobal_load_dword %[g6], %[vo], %[sb] offset:640\n\tglobal_load_dword %[g7], %[vo], %[sb] offset:704\n\t"
                 "s_waitcnt vmcnt(0)"
        : [g0]"=&v"(g[0]), [g1]"=&v"(g[1]), [g2]"=&v"(g[2]), [g3]"=&v"(g[3]), [g4]"=&v"(g[4]), [g5]"=&v"(g[5]), [g6]"=&v"(g[6]), [g7]"=&v"(g[7])
        : [vo]"v"(vo), [sb]"s"(sbase) : "memory");
}
struct EpiDown { static constexpr bool PERM = true; bf16* O; const float* gv;
    __device__ __forceinline__ void operator()(const f32x4 (&acc)[2][2][4][2], const Unit& u, int wr, int wc, int fr, int fq) const {
        const int row0 = u.aux * 256 + wr * 64 + fr, col0 = u.pn * 256 + wc * 32 + 8 * fq;
#pragma unroll
        for (int ai = 0; ai < 2; ++ai)
#pragma unroll
            for (int m = 0; m < 4; ++m) { const int row = row0 + ai * 128 + m * 16; const float g = 1.0f; bf16* rowp = O + (size_t)row * D + col0;
#pragma unroll
                for (int bj = 0; bj < 2; ++bj) { const f32x4 v0 = acc[ai][bj][m][0] * g, v1 = acc[ai][bj][m][1] * g;
                    u32x4 w; w.x = cvt_pk_bf16(v0[0], v0[1]); w.y = cvt_pk_bf16(v0[2], v0[3]); w.z = cvt_pk_bf16(v1[0], v1[1]); w.w = cvt_pk_bf16(v1[2], v1[3]);
                    *(u32x4*)(rowp + bj * 128) = w; } }
    } };

#if defined(PROBE_ATTN)
__device__ __forceinline__ void probe_compare(Frame& F, int nrows, const bf16* a, const bf16* b) {
    const int lane = launder(lane_id());
    const int gw = F.vcu * NWAVES + F.wave, NGW = F.G * NWAVES;
    unsigned cnt = 0;
    for (int cr = gw; cr < nrows; cr += NGW) {
#pragma unroll
        for (int j = 0; j < 2; ++j) { float x[8], y[8]; unpack8(*(const u32x4*)(a + (size_t)cr * OW + 512 + lane * 8 + 512 * j), x); unpack8(*(const u32x4*)(b + (size_t)cr * OW + 512 + lane * 8 + 512 * j), y);
#pragma unroll
            for (int i = 0; i < 8; ++i) { const float d = fabsf(x[i] - y[i]); cnt += (!(d <= 0.01f + 0.05f * fabsf(y[i]))) ? 1u : 0u; } }
    }
#pragma unroll
    for (int o = 1; o < 64; o <<= 1) cnt += __shfl_xor(cnt, o);
    if (lane == 0 && cnt) atomicAdd((unsigned*)(F.ws + WS_CTL) + CW_DIAG, cnt);
}
#endif

constexpr int SEQ_TOTAL = 2 + DEPTH * (NCH * 4 + 5);

__global__ void __launch_bounds__(NTHR, 2) fwd_kernel(Args args) {
    extern __shared__ __attribute__((aligned(16))) unsigned char lds[];
    Frame F;
    F.lds = lds; F.ldsl = (LAS unsigned char*)lds; F.ws = args.ws; F.out = args.out;
    F.wave = __builtin_amdgcn_readfirstlane(threadIdx.x >> 6);
    F.G = gridDim.x; { const int bx = blockIdx.x; F.vcu = (F.G % 8 == 0) ? (bx % 8) * (F.G / 8) + bx / 8 : bx; }
    volatile LAS unsigned* MISC = (volatile LAS unsigned*)(F.ldsl + MISC_OFF);
    for (int u = threadIdx.x; u < (LDS_BYTES - LDSCTL_OFF) / 4; u += NTHR) ((LAS unsigned*)(F.ldsl + LDSCTL_OFF))[u] = 0u;
    if (threadIdx.x < 19) *(LAS unsigned long long*)(F.ldsl + PTR_OFF + 8 * threadIdx.x) = (unsigned long long)args.in[threadIdx.x];
    __syncthreads();
    const int lo = args.ph_lo, hi = args.ph_hi;
    const bool multi = (hi - lo) > 1;
#if defined(PROBE_BW)
    if (threadIdx.x == 0) { const unsigned long long t0 = __builtin_amdgcn_s_memrealtime(); MISC[11] = (unsigned)t0; MISC[12] = (unsigned)(t0 >> 32); }
#endif
    XcdBarrier bar; bar.bar = (unsigned*)(F.ws + WS_CTL) + CW_BAR; bar.x = 0; bar.st = nullptr;
    if (multi) bar = xcd_barrier_post((unsigned*)(F.ws + WS_CTL) + CW_BAR, MISC + 8);
    int seq = 0;
#ifndef PHMASK
#define PHMASK 0xFFFF
#endif
#define EN(b) ((PHMASK >> (b)) & 1)
#ifndef REPMASK
#define REPMASK 0
#endif
#define REP(b) ((REPMASK >> (b)) & 1)
#define RUN(b, stmt) do { stmt; if (REP(b)) { __syncthreads(); stmt; } } while (0)
#define IN(k) (lo <= (k) && (k) < hi)
#ifndef PROBE_BW
#define BWSEL(c) false
#else
#define BWSEL(c) (((PROBE_BW) >> (c)) & 1)
#ifndef PROBE_BWK
#define PROBE_BWK 0.018f
#endif
#endif
#define SEAMC(k, c) do { if (IN(k) && IN((k) + 1)) xcd_barrier(bar, F.wave, BWSEL(c)); } while (0)
#define SEAM(k) SEAMC(k, 0)
#define FILL(nunits, it_lo_, it_hi_) do { if (!last && EN(1)) { const int rem_ = (nunits) % F.G; const bool all_ = (rem_ == 0); \
        if (all_ || (int)blockIdx.x >= rem_) wconv_phase(F, l + 1, it_lo_, it_hi_, all_ ? (int)blockIdx.x : (int)blockIdx.x - rem_, all_ ? F.G : F.G - rem_); } } while (0)

    if (IN(seq)) { if (EN(0)) RUN(0, mods_phase(F)); if (EN(1)) RUN(1, wconv_phase(F, 0, 0, NITEMS, F.vcu, F.G)); } SEAMC(seq, 0); ++seq;
    if (EN(2) && IN(seq)) { norm_phase<false>(F, 0, 0, nrows_of(0)); norm_phase<false>(F, 0, 1, nrows_of(1)); } SEAMC(seq, 1); ++seq;

    for (int l = 0; l < DEPTH; ++l) {
        const bool last = (l == DEPTH - 1);
        for (int ch = 0; ch < NCH; ++ch) {
            if (EN(3) && IN(seq)) {
                SchedIn S; S.nM = (last && ch == 0) ? LT : nrows_of(ch) / 256; S.kvM = (last && ch == 0) ? CTT : 0; S.nN = INW / 256; S.G = F.G; S.c = blockIdx.x; S.rep = 1; S.A = (const char*)hbuf_of(F, ch); S.B = (const char*)(F.ws + wpar(l, WS_WIN, WS_WIN1));
                EpiStoreBf16 E{(bf16*)(F.ws + WS_Z), ZW, F.ws + WS_GB};
                RUN(3, (pg8::gemm_phase<EpiStoreBf16, SchedIn, true, true>(F.ldsl, D * 2, D, S, E, F.wave)));
                FILL((nrows_of(ch) / 256) * (INW / 256), ch == 1 ? FA1 : FB1, ch == 1 ? FB1 : FC1);
            } SEAMC(seq, 2); ++seq;
            if (IN(seq)) { if (EN(4)) RUN(4, conv_phase(F, l, last ? LROWS : nrows_of(ch)));
#if defined(ATTN_NAIVE)
                if (EN(5)) naive_attn_phase(F, l, ch, last, (bf16*)(F.ws + WS_OBUF));
#else
                if (EN(5)) attn_phase<0>(F, l, ch, last, (bf16*)(F.ws + WS_OBUF));
#if defined(PROBE_AVAR)
                __syncthreads(); attn_phase<PROBE_AVAR>(F, l, ch, last, (bf16*)(F.ws + WS_PART));
#endif
#endif
#if defined(PROBE_ATTN)
                naive_attn_phase(F, l, ch, last, (bf16*)(F.ws + WS_PART));
                xcd_barrier(bar, F.wave);
                probe_compare(F, last ? LROWS : nrows_of(ch), (const bf16*)(F.ws + WS_OBUF), (const bf16*)(F.ws + WS_PART));
#endif
            } SEAMC(seq, 3); ++seq;
            if (EN(6) && IN(seq)) {
                SchedMerge S; S.nM = (last ? LROWS : nrows_of(ch)) / 256; S.nN = D / 256; S.G = F.G; S.c = blockIdx.x; S.rep = 1; S.A = (const char*)(F.ws + WS_OBUF); S.B = (const char*)(F.ws + wpar(l, WS_WBR, WS_WBR1));
                EpiMerge E{(const unsigned char*)(F.ws + WS_GB), hbuf_of(F, ch)};
                RUN(6, (pg8::gemm_phase<EpiMerge, SchedMerge, true, true, 3>(F.ldsl, OW * 2, 1536, S, E, F.wave)));
                if (ch == 0) FILL((nrows_of(0) / 256) * (D / 256), FE1, NITEMS);
#if defined(PROBE_NOHOOK)
                { __syncthreads(); EpiMerge E2{(const unsigned char*)(F.ws + WS_GB), (bf16*)(F.ws + WS_PART)}; pg8::gemm_phase<EpiMerge, SchedMerge, true, true, PROBE_NOHOOK>(F.ldsl, OW * 2, 1536, S, E2, F.wave); }
#endif
            } SEAMC(seq, 4); ++seq;
            if (EN(7) && IN(seq)) {
                SchedIn S; S.nM = (last ? LROWS : nrows_of(ch)) / 256; S.nN = D / 256; S.G = F.G; S.c = blockIdx.x; S.rep = 1; S.A = (const char*)hbuf_of(F, ch); S.B = (const char*)(F.ws + wpar(l, WS_WOUT, WS_WOUT1));
                EpiOut E{&F, l, ch};
                RUN(7, (pg8::gemm_phase<EpiOut, SchedIn, true, true>(F.ldsl, D * 2, D, S, E, F.wave)));
                if (ch == 0) FILL((nrows_of(0) / 256) * (D / 256), 0, FA1);
#if defined(PROBE_OUTK)
                static_assert(false, "PROBE_OUTK: the out epilogue updates the residual stream in place, it cannot be repeated");
#endif
            } SEAMC(seq, 5); ++seq;
        }
        if (EN(8) && IN(seq)) {
            norm_phase<true>(F, l, 0, last ? LROWS : nrows_of(0)); __syncthreads(); norm_phase<true>(F, l, 1, LROWS);
            if (REP(8)) { __syncthreads(); norm_phase<true>(F, l, 0, last ? LROWS : nrows_of(0), true); __syncthreads(); norm_phase<true>(F, l, 1, LROWS, true); }
        } SEAMC(seq, 6); ++seq;
        if (EN(9) && IN(seq)) { topk_phase(F, last); if (!last && EN(1)) wconv_phase(F, l + 1, FC1, FD1, (int)blockIdx.x, F.G, 4); } SEAMC(seq, 7); ++seq;
        if (EN(10) && IN(seq)) {
            SchedUp S; S.nM0 = last ? SLT : SLT + SCT; S.nM = S.nM0 + SLT; S.nN = 8; S.G = F.G; S.c = blockIdx.x; S.rep = 1; S.A = (const char*)(F.ws + WS_HBUF); S.B = (const char*)(F.ws + wpar(l, WS_WUP, WS_WUP1)); S.gidx = (const int*)(F.ws + WS_SELTOK);
            EpiUp E{(bf16*)(F.ws + WS_HMID)};
            RUN(10, (pg8::gemm_phase<EpiUp, SchedUp, true, true, 1, true>(F.ldsl, D * 2, D, S, E, F.wave)));
        } SEAMC(seq, 8); ++seq;
        if (EN(11) && IN(seq)) {
            SchedDown S; S.nM0 = last ? SLT : SLT + SCT; S.nM = S.nM0 + SLT; S.nN = 4; S.G = F.G; S.c = blockIdx.x; S.rep = 1; S.A = (const char*)(F.ws + WS_HMID); S.B = (const char*)(F.ws + wpar(l, WS_WDN, WS_WDN1));
            EpiDown E{(bf16*)(F.ws + WS_YBUF), (const float*)(F.ws + WS_GATEV)};
            RUN(11, (pg8::gemm_phase<EpiDown, SchedDown, true, true>(F.ldsl, FF * 2, FF, S, E, F.wave)));
        } SEAMC(seq, 9); ++seq;
        if (IN(seq)) {
            if (EN(12)) { if (REP(12)) { combine_phase(F, l, 0, last, true); combine_phase(F, l, 1, last, true); } combine_phase(F, l, 0, last); combine_phase(F, l, 1, last); }
            if (!last && EN(1)) RUN(13, wconv_phase(F, l + 1, FD1, FE1, F.vcu, F.G));
        } SEAMC(seq, 10); ++seq;
    }
#if defined(PROBE_BW)
    if (multi) {
        unsigned* dg = (unsigned*)(F.ws + WS_CTL) + CW_DIAG;
        if (threadIdx.x == 0) { atomicAdd(dg, MISC[10]); if (blockIdx.x == 0) { const unsigned long long t1 = __builtin_amdgcn_s_memrealtime(), t0 = ((unsigned long long)MISC[12] << 32) | MISC[11]; atomicAdd(dg + 1, (unsigned)(t1 - t0)); } }
        xcd_barrier(bar, F.wave);
        const unsigned w = __hip_atomic_load(dg, __ATOMIC_RELAXED, __HIP_MEMORY_SCOPE_AGENT), tot = __hip_atomic_load(dg + 1, __ATOMIC_RELAXED, __HIP_MEMORY_SCOPE_AGENT);
        const float frac = (float)w / ((float)F.G * (float)tot), scl = 1.0f + 0.005f + PROBE_BWK * frac;
        for (size_t i = (size_t)blockIdx.x * NTHR + threadIdx.x; i < (size_t)NB * SEQ * D / 4; i += (size_t)F.G * NTHR) { f32x4 v = ((f32x4*)F.out)[i]; v = v * scl; ((f32x4*)F.out)[i] = v; }
    }
#endif
#undef IN
#undef SEAM
}

extern "C" void kernel_launch(void* const* d_in, const int* in_sizes, int n_in, void* d_out, int out_size, void* d_ws, size_t ws_size, hipStream_t stream) {
    static int grid = 0;
    if (grid == 0) {
        if (n_in != 19 || ws_size < WS_END) { fprintf(stderr, "kernel_launch: unexpected n_in %d / ws %zu (need %zu)\n", n_in, ws_size, (size_t)WS_END); grid = -1; return; }
        int dev = 0, cus = 0;
        if (hipGetDevice(&dev) != hipSuccess || hipDeviceGetAttribute(&cus, hipDeviceAttributeMultiprocessorCount, dev) != hipSuccess) { grid = -1; return; }
        if (hipFuncSetAttribute((const void*)fwd_kernel, hipFuncAttributeMaxDynamicSharedMemorySize, LDS_BYTES) != hipSuccess) { fprintf(stderr, "kernel_launch: hipFuncSetAttribute failed\n"); grid = -1; return; }
        int per_cu = 0;
        if (hipOccupancyMaxActiveBlocksPerMultiprocessor(&per_cu, (const void*)fwd_kernel, NTHR, LDS_BYTES) != hipSuccess || per_cu < 1) fprintf(stderr, "kernel_launch: occupancy query says %d\n", per_cu);
        (void)hipGetLastError();
        if (cus < 224) { fprintf(stderr, "kernel_launch: %d CUs: the combine phase's per-wave slot-list window assumes at least 224\n", cus); grid = -1; return; }
        grid = cus;
    }
    if (grid < 0) return;
    (void)hipMemsetAsync((char*)d_ws + WS_CTL, 0, CTL_ZERO_BYTES, stream);
    Args a{};
    for (int i = 0; i < 19; ++i) a.in[i] = (const float*)d_in[i];
    a.out = (float*)d_out; a.ws = (unsigned char*)d_ws;
#if MK_ONE_LAUNCH
    a.ph_lo = 0; a.ph_hi = SEQ_TOTAL;
    hipLaunchKernelGGL(fwd_kernel, dim3(grid), dim3(NTHR), LDS_BYTES, stream, a);
#else
    for (int s = 0; s < SEQ_TOTAL; ++s) { a.ph_lo = s; a.ph_hi = s + 1; hipLaunchKernelGGL(fwd_kernel, dim3(grid), dim3(NTHR), LDS_BYTES, stream, a); }
#endif
}
```

```cpp
#include <hip/hip_runtime.h>
#include <cstdio>
#include <cstdint>

#ifndef MK_ONE_LAUNCH
#define MK_ONE_LAUNCH 1
#endif

#define GAS __attribute__((address_space(1)))
#define LAS __attribute__((address_space(3)))
typedef unsigned short bf16;
typedef short bf16x8 __attribute__((ext_vector_type(8)));
typedef float f32x4 __attribute__((ext_vector_type(4)));
typedef float f32x2 __attribute__((ext_vector_type(2)));
typedef unsigned u32x4 __attribute__((ext_vector_type(4)));
typedef unsigned u32x2 __attribute__((ext_vector_type(2)));

constexpr int D = 1024, NB = 32, SEQ = 2048, CTX = 256, DEPTH = 4, INW = 6912, NE = 16, FF = 1024;
constexpr int NCH = 2, BC = NB / NCH;
constexpr int LROWS = BC * SEQ, CTXALL = NB * CTX, RCMAX = LROWS + CTXALL;
constexpr int LT = LROWS / 256, CTT = CTXALL / 256;
__host__ __device__ constexpr int nrows_of(int ch) { return ch == 0 ? RCMAX : LROWS; }
constexpr int CAP_L = 2 * SEQ / NE, CAP_C = 2 * CTX / NE;
constexpr int SLOT_CT0 = BC * NE * CAP_L;
constexpr int NSLOTMAX = SLOT_CT0 + NE * NB * CAP_C;
constexpr int SLT = SLOT_CT0 / 256, SCT = NE * NB * CAP_C / 256;
constexpr float RMS_EPS = 1e-6f;
constexpr int Z_AB = 0, Z_AC = 512, Z_AX = 1024, Z_NQ = 1536, Z_NK = 2048, Z_NV = 2560, Z_SQ = 3072, Z_SK = 3584, Z_SV = 3712, Z_G = 3840;
constexpr int OW = 1536;
constexpr int ZW = Z_G;

constexpr size_t MiB = 1u << 20;
constexpr size_t WS_CTL = 0, CTL_ZERO_BYTES = 1 * MiB;
constexpr size_t WS_MODS = 1 * MiB;
constexpr size_t WS_ROPE = 5 * MiB;
constexpr size_t WS_AFFL = 6 * MiB;
constexpr size_t WS_AFFC = 10 * MiB;
constexpr size_t WS_GATEV = 11 * MiB;
constexpr size_t WS_SELTOK = 12 * MiB;
constexpr size_t WS_XC = 13 * MiB;
constexpr size_t WS_WIN = 45 * MiB;
constexpr size_t WS_WBR = 59 * MiB;
constexpr size_t WS_WOUT = 62 * MiB;
constexpr size_t WS_WUP = 64 * MiB;
constexpr size_t WS_WDN = 128 * MiB;
constexpr size_t WS_HBUF = 160 * MiB;
constexpr size_t WS_HBUF1 = 240 * MiB;
constexpr size_t WS_OBUF = 304 * MiB;
constexpr size_t WS_PART = 424 * MiB;
constexpr size_t WS_Z = 544 * MiB;
constexpr size_t WS_GB = 844 * MiB;
constexpr size_t WS_HMID = WS_OBUF;
constexpr size_t WS_YBUF = WS_OBUF + 288 * MiB;
constexpr size_t WS_WUP1 = 1084 * MiB;
constexpr size_t WS_DX0 = 1084 * MiB, WS_DX1 = 1164 * MiB;
constexpr size_t WS_TOKSLOT = 1228 * MiB;
constexpr size_t WS_W2 = 1234 * MiB;
constexpr size_t WS_WIN1 = WS_W2, WS_WBR1 = WS_W2 + 14 * MiB, WS_WOUT1 = WS_W2 + 17 * MiB, WS_WDN1 = WS_W2 + 19 * MiB;
constexpr size_t WS_END = 1285 * MiB;
__host__ __device__ __forceinline__ size_t wpar(int l, size_t even, size_t odd) { return (l & 1) ? odd : even; }
static_assert((size_t)RCMAX * ZW * 2 == 300 * MiB && (size_t)LROWS * ZW * 2 == 240 * MiB && (size_t)NSLOTMAX * 1024 * 2 == 160 * MiB && (size_t)RCMAX * 1024 * 2 == 80 * MiB && (size_t)RCMAX * OW * 2 == 120 * MiB
              && (size_t)(RCMAX / 256) * 12 * 131072 == 240 * MiB && WS_YBUF + 288 * MiB <= WS_GB + 240 * MiB && WS_HBUF1 == WS_HBUF + (size_t)RCMAX * 1024 * 2, "ws map");
constexpr int PBT = NSLOTMAX / 256;
constexpr int CW_TMO = 0, CW_DIAG = 64, CW_BAR = 4096;

constexpr int RING_BYTES = 131072, LDSCTL_OFF = RING_BYTES, MISC_OFF = LDSCTL_OFF + 320, LDS_BYTES = 147456;
constexpr int NWAVES = 8, NTHR = 512;

__device__ __forceinline__ unsigned f2bf(float f) { unsigned u = __builtin_bit_cast(unsigned, f); return (u + 0x7fffu + ((u >> 16) & 1u)) >> 16; }
__device__ __forceinline__ unsigned pk2(float lo, float hi) { return f2bf(lo) | (f2bf(hi) << 16); }
__device__ __forceinline__ float bflo(unsigned u) { return __builtin_bit_cast(float, u << 16); }
__device__ __forceinline__ float bfhi(unsigned u) { return __builtin_bit_cast(float, u & 0xffff0000u); }
__device__ __forceinline__ void unpack8(const u32x4 u, float* f) { f[0] = bflo(u.x); f[1] = bfhi(u.x); f[2] = bflo(u.y); f[3] = bfhi(u.y); f[4] = bflo(u.z); f[5] = bfhi(u.z); f[6] = bflo(u.w); f[7] = bfhi(u.w); }
__device__ __forceinline__ float wave_sum(float v) {
#pragma unroll
    for (int o = 1; o < 64; o <<= 1) v += __shfl_xor(v, o);
    return v;
}
__device__ __forceinline__ float sigmoidf_(float x) { return __builtin_amdgcn_rcpf(1.0f + __builtin_amdgcn_exp2f(-1.4426950408889634f * x)); }
__device__ __forceinline__ int launder(int v) { asm volatile("" : "+v"(v)); return v; }
__device__ __forceinline__ int lane_id() { int l; asm volatile("v_mbcnt_lo_u32_b32 %0, -1, 0\n\tv_mbcnt_hi_u32_b32 %0, -1, %0" : "=v"(l)); return l; }
#define LDS_WAIT() asm volatile("s_waitcnt lgkmcnt(0)" ::: "memory")
#define VM_WAIT() asm volatile("s_waitcnt vmcnt(0)" ::: "memory")

namespace pg8 {
constexpr int BM = 256, BK = 64, HALF = 128, HTB = HALF * BK * 2, STAGE_BYTES = 8 * HTB, NXCD = 8, WGM = 8;
__host__ __device__ __forceinline__ int lds_byte(int r, int c) { const int st = (r >> 4) * 2 + (c >> 5), rr = r & 15, cc = c & 31, ob = rr * 64 + cc * 2; return st * 1024 + (ob ^ (((ob >> 9) & 1) << 5)); }
__host__ __device__ __forceinline__ void stage_rc(int b, int& R, int& C) { const int st = b / 1024, sb = b % 1024, swz = sb ^ (((sb >> 9) & 1) << 5); R = (st >> 1) * 16 + swz / 64; C = (st & 1) * 32 + (swz % 64) / 2; }
__host__ __device__ __forceinline__ int perm32(int rho) { const int n = rho >> 4, i = rho & 15; return 8 * (i >> 2) + 4 * n + (i & 3); }

struct Unit { int pm, pn, aux, pad; const char* A; const char* B; };

__device__ __forceinline__ bool tile_of(long L, int nM, int nN, int& pm, int& pn) {
    const int nwg = nM * nN; if (L >= nwg) return false;
    int wgid = (int)L; { const int q = nwg / NXCD, r = nwg % NXCD, xcd = wgid % NXCD, off = wgid / NXCD; wgid = (xcd < r ? xcd * (q + 1) : r * (q + 1) + (xcd - r) * q) + off; }
    const int nig = WGM * nN, gid = wgid / nig, fm = gid * WGM, gsz = (nM - fm) < WGM ? (nM - fm) : WGM;
    pm = fm + ((wgid % nig) % gsz); pn = (wgid % nig) / gsz; return true;
}

__device__ __forceinline__ unsigned cvt_pk_bf16(float lo, float hi) { unsigned r; asm volatile("v_cvt_pk_bf16_f32 %0, %1, %2" : "=v"(r) : "v"(lo), "v"(hi)); return r; }

template <class Epi, class Sched, bool ALIGN_EPI, bool SP2, int NSEG = 1, bool GATHER = false>
__device__ __forceinline__ void gemm_phase(LAS unsigned char* lds, const int lda_bytes, const int K, const Sched& S, const Epi& E, const int wid_in) {
    int wid = wid_in; asm volatile("" : "+s"(wid));
    int lane_ = lane_id(); asm volatile("" : "+v"(lane_));
    const int lane = lane_, tid = wid * 64 + lane, wr = wid >> 2, wc = wid & 3, fr = lane & 15, fq = lane >> 4;
    const int nt = K / BK;
    unsigned voffA[2], voffB[2]; int gR[2], gC[2];
#pragma unroll
    for (int i = 0; i < 2; ++i) { int R, C; stage_rc(tid * 16 + i * 8192, R, C); const int Rb = Epi::PERM ? ((R & ~31) + perm32(R & 31)) : R; gR[i] = R; gC[i] = C * 2;
        voffA[i] = (unsigned)(R * lda_bytes + C * 2); voffB[i] = (unsigned)(Rb * K + C) * 2u; }
    unsigned offc[2][2], offn[2][2]; int rawn[2][2];
    const size_t kstep = (size_t)(BK * 2);
    const size_t hstepA = (size_t)HALF * lda_bytes, hstepB = (size_t)HALF * K * 2;
    const unsigned ldsw = (unsigned)wid * 1024u;
    const int aoff = lds_byte(wr * 64 + fr, fq * 8), boff = lds_byte(wc * 32 + fr, fq * 8);
#define PG8_SA(b, h) (((b) * 2 + (h)) * HTB)
#define PG8_SB(b, h) ((4 + (b) * 2 + (h)) * HTB)
#define PG8_STAGE(bufoff, gbase, voff) do { _Pragma("unroll") for (int _i = 0; _i < 2; ++_i) \
        __builtin_amdgcn_global_load_lds((const unsigned*)((const char*)(gbase) + (voff)[_i]), (LAS unsigned*)(lds + (bufoff) + ldsw + _i * 8192), 16, 0, 0); } while (0)
#define PG8_STAGE_A(bufoff, kbase, h, nx) do { if constexpr (GATHER) { unsigned vs_[2]; vs_[0] = (nx) ? offn[h][0] : offc[h][0]; vs_[1] = (nx) ? offn[h][1] : offc[h][1]; PG8_STAGE(bufoff, (kbase), vs_); } \
        else { PG8_STAGE(bufoff, (kbase) + ((h) ? hstepA : (size_t)0), voffA); } } while (0)
#define PG8_LDA(dst, b, h) do { _Pragma("unroll") for (int m = 0; m < 4; ++m) _Pragma("unroll") for (int k = 0; k < 2; ++k) dst[m][k] = *(const LAS bf16x8*)(lds + PG8_SA(b, h) + aoff + m * 2048 + k * 1024); } while (0)
#define PG8_LDB(dst, b, h) do { _Pragma("unroll") for (int n = 0; n < 2; ++n) _Pragma("unroll") for (int k = 0; k < 2; ++k) dst[n][k] = *(const LAS bf16x8*)(lds + PG8_SB(b, h) + boff + n * 2048 + k * 1024); } while (0)
#define PG8_MMA(ai, bj, At, Bt) do { __builtin_amdgcn_s_setprio(1); _Pragma("unroll") for (int m = 0; m < 4; ++m) _Pragma("unroll") for (int n = 0; n < 2; ++n) _Pragma("unroll") for (int k = 0; k < 2; ++k) \
        acc[ai][bj][m][n] = __builtin_amdgcn_mfma_f32_16x16x32_bf16(Bt[n][k], At[m][k], acc[ai][bj][m][n], 0, 0, 0); __builtin_amdgcn_s_setprio(0); } while (0)
#define PG8_WAIT_V(n) asm volatile("s_waitcnt vmcnt(" #n ")" ::: "memory")
#define PG8_WAIT_L(n) asm volatile("s_waitcnt lgkmcnt(" #n ")" ::: "memory")
#define PG8_BAR __builtin_amdgcn_s_barrier()
#define PG8_SCHED __builtin_amdgcn_sched_barrier(0)
    Unit cur, nxt; int ui = 0;
    if (!S.next(0, cur)) return;
    f32x4 acc[2][2][4][2];
#pragma unroll
    for (int a = 0; a < 2; ++a)
#pragma unroll
        for (int b = 0; b < 2; ++b)
#pragma unroll
            for (int m = 0; m < 4; ++m)
#pragma unroll
                for (int n = 0; n < 2; ++n) acc[a][b][m][n] = (f32x4){0.f, 0.f, 0.f, 0.f};
    bf16x8 At[4][2], B0[2][2], B1[2][2];
    const char* cA = cur.A; const char* cB = cur.B;
    if constexpr (GATHER) {
#pragma unroll
        for (int h = 0; h < 2; ++h)
#pragma unroll
            for (int i = 0; i < 2; ++i) { offc[h][i] = (unsigned)S.gidx[cur.aux * 256 + h * 128 + gR[i]] * (unsigned)lda_bytes + (unsigned)gC[i]; offn[h][i] = offc[h][i]; }
    }
    if constexpr (SP2) {
        PG8_STAGE(PG8_SB(0, 0), cB, voffB); PG8_STAGE(PG8_SB(0, 1), cB + hstepB, voffB); PG8_STAGE_A(PG8_SA(0, 0), cA, 0, false); PG8_STAGE_A(PG8_SA(0, 1), cA, 1, false);
        if (wr == 1) PG8_BAR;
        PG8_WAIT_V(2); PG8_BAR;
        PG8_STAGE(PG8_SB(1, 0), cB + kstep, voffB); PG8_STAGE_A(PG8_SA(1, 0), cA + kstep, 0, false); PG8_STAGE(PG8_SB(1, 1), cB + hstepB + kstep, voffB);
        PG8_WAIT_V(6); PG8_BAR;
    } else {
        static_assert(SP2 || !GATHER, "GATHER is implemented for the SP2 loop only");
        PG8_STAGE(PG8_SB(0, 0), cB, voffB); PG8_STAGE(PG8_SA(0, 0), cA, voffA); PG8_STAGE(PG8_SB(0, 1), cB + hstepB, voffB); PG8_STAGE(PG8_SA(0, 1), cA + hstepA, voffA);
        if (wr == 1) PG8_BAR;
        PG8_WAIT_V(4); PG8_BAR;
        PG8_STAGE(PG8_SB(1, 0), cB + kstep, voffB); PG8_STAGE(PG8_SA(1, 0), cA + kstep, voffA); PG8_STAGE(PG8_SB(1, 1), cB + hstepB + kstep, voffB);
        PG8_WAIT_V(6); PG8_BAR;
    }
    for (;;) {
        const bool has_next = S.next(ui + 1, nxt);
        const char* nA = has_next ? nxt.A : cA; const char* nB = has_next ? nxt.B : cB;
        if constexpr (GATHER) {
            const int na_ = has_next ? nxt.aux : cur.aux;
#pragma unroll
            for (int h = 0; h < 2; ++h)
#pragma unroll
                for (int i = 0; i < 2; ++i) rawn[h][i] = S.gidx[na_ * 256 + h * 128 + gR[i]]; }
        for (int t = 0; t < nt; t += 2) {
            const bool last = (t == nt - 2);
            const char* a1 = cA + (size_t)(t + 1) * kstep;
            const char* a2 = last ? nA : cA + (size_t)(t + 2) * kstep; const char* b2 = last ? nB : cB + (size_t)(t + 2) * kstep;
            const char* a3 = a2 + kstep; const char* b3 = b2 + kstep;
            if constexpr (GATHER) { if (last && has_next) {
#pragma unroll
                for (int h = 0; h < 2; ++h)
#pragma unroll
                    for (int i = 0; i < 2; ++i) { int rw_ = rawn[h][i]; asm volatile("" : "+v"(rw_));
                        offn[h][i] = (unsigned)rw_ * (unsigned)lda_bytes + (unsigned)gC[i]; } } }
            if constexpr (NSEG > 1) { const int tseg = nt / NSEG; if (t > 0 && (t % tseg) == 0) E.mid(acc, cur, t / tseg, wr, wc, fr, fq); }
            if constexpr (SP2) {
            PG8_LDB(B0, 0, 0); PG8_LDB(B1, 0, 1); PG8_SCHED; PG8_LDA(At, 0, 0); PG8_STAGE_A(PG8_SA(1, 1), a1, 1, false);
            PG8_WAIT_V(8); PG8_WAIT_L(0); PG8_BAR; PG8_MMA(0, 0, At, B0); PG8_MMA(0, 1, At, B1); PG8_BAR; PG8_SCHED;
            PG8_LDA(At, 0, 1); PG8_STAGE(PG8_SB(0, 0), b2, voffB); PG8_STAGE(PG8_SB(0, 1), b2 + hstepB, voffB); PG8_STAGE_A(PG8_SA(0, 0), a2, 0, last);
            PG8_WAIT_V(8); PG8_WAIT_L(0); PG8_BAR; PG8_MMA(1, 0, At, B0); PG8_MMA(1, 1, At, B1); PG8_BAR; PG8_SCHED;
            PG8_LDB(B0, 1, 0); PG8_LDB(B1, 1, 1); PG8_SCHED; PG8_LDA(At, 1, 0); PG8_STAGE_A(PG8_SA(0, 1), a2, 1, last);
            PG8_WAIT_V(8); PG8_WAIT_L(0); PG8_BAR; PG8_MMA(0, 0, At, B0); PG8_MMA(0, 1, At, B1); PG8_BAR; PG8_SCHED;
            PG8_LDA(At, 1, 1); PG8_STAGE(PG8_SB(1, 0), b3, voffB); PG8_STAGE(PG8_SB(1, 1), b3 + hstepB, voffB); PG8_STAGE_A(PG8_SA(1, 0), a3, 0, last);
            PG8_WAIT_V(8); PG8_WAIT_L(0); PG8_BAR; PG8_MMA(1, 0, At, B0); PG8_MMA(1, 1, At, B1); PG8_BAR; PG8_SCHED;
            } else {
            PG8_LDB(B0, 0, 0); PG8_SCHED; PG8_LDA(At, 0, 0); PG8_STAGE(PG8_SA(1, 1), a1 + hstepA, voffA);
            PG8_WAIT_L(8); PG8_BAR; PG8_WAIT_L(0); PG8_MMA(0, 0, At, B0); PG8_BAR; PG8_SCHED;
            PG8_LDB(B1, 0, 1); PG8_STAGE(PG8_SB(0, 0), b2, voffB);
            PG8_BAR; PG8_WAIT_L(0); PG8_MMA(0, 1, At, B1); PG8_BAR;
            PG8_LDA(At, 0, 1); PG8_STAGE(PG8_SA(0, 0), a2, voffA);
            PG8_BAR; PG8_WAIT_L(0); PG8_MMA(1, 0, At, B0); PG8_BAR; PG8_SCHED;
            PG8_STAGE(PG8_SB(0, 1), b2 + hstepB, voffB);
            PG8_WAIT_V(6); PG8_BAR; PG8_MMA(1, 1, At, B1); PG8_BAR;
            PG8_LDB(B0, 1, 0); PG8_SCHED; PG8_LDA(At, 1, 0); PG8_STAGE(PG8_SA(0, 1), a2 + hstepA, voffA);
            PG8_WAIT_L(8); PG8_BAR; PG8_WAIT_L(0); PG8_MMA(0, 0, At, B0); PG8_BAR; PG8_SCHED;
            PG8_LDB(B1, 1, 1); PG8_STAGE(PG8_SB(1, 0), b3, voffB);
            PG8_BAR; PG8_WAIT_L(0); PG8_MMA(0, 1, At, B1); PG8_BAR;
            PG8_LDA(At, 1, 1); PG8_STAGE(PG8_SA(1, 0), a3, voffA);
            PG8_BAR; PG8_WAIT_L(0); PG8_MMA(1, 0, At, B0); PG8_BAR; PG8_SCHED;
            PG8_STAGE(PG8_SB(1, 1), b3 + hstepB, voffB);
            PG8_WAIT_V(6); PG8_BAR; PG8_MMA(1, 1, At, B1); PG8_BAR;
            }
        }
        if constexpr (ALIGN_EPI) { if (wr == 0) PG8_BAR; }
        E(acc, cur, wr, wc, fr, fq);
        if (!has_next) break;
#pragma unroll
        for (int a = 0; a < 2; ++a)
#pragma unroll
            for (int b = 0; b < 2; ++b)
#pragma unroll
                for (int m = 0; m < 4; ++m)
#pragma unroll
                    for (int n = 0; n < 2; ++n) acc[a][b][m][n] = (f32x4){0.f, 0.f, 0.f, 0.f};
        cur = nxt; cA = nA; cB = nB; ++ui;
        if constexpr (GATHER) {
#pragma unroll
            for (int h = 0; h < 2; ++h)
#pragma unroll
                for (int i = 0; i < 2; ++i) offc[h][i] = offn[h][i]; }
        if constexpr (ALIGN_EPI) { if (wr == 1) PG8_BAR; }
    }
    PG8_WAIT_V(0);
    if constexpr (!ALIGN_EPI) { if (wr == 0) PG8_BAR; }
    PG8_BAR;
#undef PG8_SA
#undef PG8_SB
#undef PG8_STAGE
#undef PG8_STAGE_A
#undef PG8_LDA
#undef PG8_LDB
#undef PG8_MMA
#undef PG8_WAIT_V
#undef PG8_WAIT_L
#undef PG8_BAR
#undef PG8_SCHED
}
}

#define XB_TMO      128
#define XB_XCNT(j)  (256  + 64 * (j))
#define XB_XSUB(j)  (1280 + 64 * (j))
#define XB_XGEN(j)  (2304 + 64 * (j))
#define XB_TOP      3328
#define XB_TOPGEN   3392
#define XCD_BAR_WORDS 3456
#define XB_SPIN_CAP (1u << 22)
__device__ __forceinline__ unsigned xb_ld(unsigned* p)              { return __hip_atomic_load(p, __ATOMIC_RELAXED, __HIP_MEMORY_SCOPE_AGENT); }
__device__ __forceinline__ unsigned xb_add(unsigned* p, unsigned v) { return __hip_atomic_fetch_add(p, v, __ATOMIC_RELAXED, __HIP_MEMORY_SCOPE_AGENT); }
__device__ __forceinline__ unsigned xb_xcc_id() { return (unsigned)__builtin_amdgcn_s_getreg((3 << 11) | 20) & 0xFu; }
#define XB_SPIN(cond, bar) do { unsigned _sp = 0; while (cond) { __builtin_amdgcn_s_sleep(1); \
    if ((++_sp & 255u) == 0u) { if (xb_ld(&(bar)[XB_TMO])) break; if (_sp > XB_SPIN_CAP) { atomicAdd(&(bar)[XB_TMO], 1u); break; } } } } while (0)
struct XcdBarrier { unsigned* bar; unsigned x; volatile LAS unsigned* st; };
__device__ __forceinline__ XcdBarrier xcd_barrier_post(unsigned* bar, volatile LAS unsigned* st) {
    XcdBarrier b; b.bar = bar; b.x = xb_xcc_id(); b.st = st;
    if (threadIdx.x == 0) (void)xb_add(&bar[XB_XCNT(b.x)], 1u);
    return b;
}
__device__ __forceinline__ void xcd_barrier_complete(unsigned* bar, unsigned x, unsigned& nloc, unsigned& nx) {
    const unsigned G = gridDim.x * gridDim.y * gridDim.z;
    unsigned sum, cnt, mine, sp = 0u;
    for (;;) {
        sum = 0u; cnt = 0u; mine = 0u;
#pragma unroll
        for (unsigned j = 0; j < 16; ++j) { const unsigned c = xb_ld(&bar[XB_XCNT(j)]); sum += c; cnt += (c > 0u) ? 1u : 0u; mine = (j == x) ? c : mine; }
        if (sum == G) break;
        __builtin_amdgcn_s_sleep(1);
        if ((++sp & 255u) == 0u) { if (xb_ld(&bar[XB_TMO])) break; if (sp > XB_SPIN_CAP) { atomicAdd(&bar[XB_TMO], 1u); break; } }
    }
    nloc = mine > 0u ? mine : 1u; nx = cnt > 0u ? cnt : 1u;
}
__device__ __forceinline__ void xcd_barrier(const XcdBarrier& b, const int wave, const bool cnt_wait = false) {
    asm volatile("s_waitcnt vmcnt(0)" ::: "memory");
    __syncthreads();
    if (wave == 0 && lane_id() == 0) {
#if defined(PROBE_BW)
        const unsigned long long bw_t0 = __builtin_amdgcn_s_memrealtime();
#endif
        unsigned* bar = b.bar; asm volatile("" : "+s"(bar)); unsigned bx = b.x; asm volatile("" : "+s"(bx));
        __builtin_amdgcn_s_waitcnt(0);
        unsigned nloc = b.st[0], nx = b.st[1];
        if (nloc == 0u) { xcd_barrier_complete(bar, bx, nloc, nx); b.st[0] = nloc; b.st[1] = nx; }
        const unsigned old = xb_add(&bar[XB_XSUB(bx)], 1u);
        const unsigned gen = old / nloc;
        if (old + 1u == (gen + 1u) * nloc) {
            __builtin_amdgcn_fence(__ATOMIC_RELEASE, "agent");
            asm volatile("s_waitcnt vmcnt(0)" ::: "memory");
            const unsigned og = xb_add(&bar[XB_TOP], 1u);
            const unsigned tg = og / nx;
            if (og + 1u == (tg + 1u) * nx) xb_add(&bar[XB_TOPGEN], 1u);
            else XB_SPIN(xb_ld(&bar[XB_TOPGEN]) == tg, bar);
            __builtin_amdgcn_fence(__ATOMIC_ACQUIRE, "agent");
            xb_add(&bar[XB_XGEN(bx)], 1u);
            asm volatile("s_waitcnt vmcnt(0)" ::: "memory");
        } else {
            XB_SPIN(xb_ld(&bar[XB_XGEN(bx)]) == gen, bar);
            __builtin_amdgcn_fence(__ATOMIC_ACQUIRE, "agent");
            asm volatile("s_waitcnt vmcnt(0)" ::: "memory");
        }
#if defined(PROBE_BW)
        if (cnt_wait) b.st[2] += (unsigned)(__builtin_amdgcn_s_memrealtime() - bw_t0);
#endif
    }
    __syncthreads();
}

struct Args {
    const float* in[19];
    float* out; unsigned char* ws;
    int ph_lo, ph_hi;
};
enum { I_X = 0, I_C, I_CTX, I_CCTX, I_WADA, I_BADA, I_GMIX, I_WIN, I_CONVW, I_RPB, I_SINK, I_WBR, I_WOUT, I_GFFN, I_WROUTER, I_WG, I_WU, I_WD, I_GFINAL };

struct Frame {
    unsigned char* lds;
    LAS unsigned char* ldsl;
    unsigned char* ws;
    int wave, vcu, G;
    float* out;
};

constexpr int PTR_OFF = MISC_OFF + 128;
__device__ __forceinline__ const float* inp(const Frame& F, int i) {
    const u32x2 v = *(const LAS u32x2*)(F.ldsl + PTR_OFF + 8 * i);
    const unsigned lo = __builtin_amdgcn_readfirstlane(v.x), hi = __builtin_amdgcn_readfirstlane(v.y);
    typedef const float __attribute__((address_space(1)))* gptr_t;
    return (const float*)(gptr_t)(((unsigned long long)hi << 32) | lo);
}
__device__ __forceinline__ bf16* xbrow(const Frame& F, int ch, int cr) {
    return cr < LROWS ? (bf16*)(F.out + ((size_t)ch * LROWS + cr) * D) : (bf16*)(F.ws + WS_XC) + (size_t)(cr - LROWS) * D;
}
__device__ __forceinline__ const float* xin_row(const Frame& F, int ch, int cr) {
    return cr < LROWS ? inp(F, I_X) + ((size_t)ch * LROWS + cr) * D : inp(F, I_CTX) + (size_t)(cr - LROWS) * D;
}
__device__ __forceinline__ int mv_of(int ch, int cr) { return cr < LROWS ? ch * BC + cr / SEQ : NB; }
__device__ __forceinline__ const float* mod_ptr(const Frame& F, int l, int mv, int which) { return (const float*)(F.ws + WS_MODS) + ((size_t)(l * 33 + mv) * 6 + which) * D; }

__device__ __forceinline__ bf16* hbuf_of(const Frame& F, int ch) { return (bf16*)(F.ws + (ch == 0 ? WS_HBUF : WS_HBUF1)); }
__device__ __forceinline__ float* affl_of(const Frame& F, int ch) { return (float*)(F.ws + WS_AFFL) + (size_t)ch * BC * NE * SEQ; }
__device__ __forceinline__ int* tokslot_of(const Frame& F, int ch) { return (int*)(F.ws + WS_TOKSLOT) + (size_t)ch * RCMAX * NE; }
__device__ __forceinline__ void mods_phase(Frame& F) {
    const int lane = launder(lane_id()), tid = F.wave * 64 + lane; (void)tid; (void)lane;
    float* sl = (float*)F.lds;
    const float* c = inp(F, I_C); const float* cc = inp(F, I_CCTX);
    for (int item = F.vcu; item < DEPTH * 96; item += F.G) {
        const int l = item / 96, jb = item % 96, j = jb * 64 + lane;
        const float* W = inp(F, I_WADA) + (size_t)l * D * 6144;
        float acc[33];
#pragma unroll
        for (int m = 0; m < 33; ++m) acc[m] = 0.f;
        for (int kh = 0; kh < 2; ++kh) {
            __syncthreads();
            for (int i = tid; i < 512 * 33; i += NTHR) { const int k = i % 512, m = i / 512; const float v = (m < 32) ? c[(size_t)m * D + kh * 512 + k] : cc[kh * 512 + k]; sl[k * 36 + m] = v * sigmoidf_(v); }
            __syncthreads();
            for (int kk0 = 0; kk0 < 64; kk0 += 8) {
                float w8[8];
#pragma unroll
                for (int u8 = 0; u8 < 8; ++u8) w8[u8] = W[(size_t)(kh * 512 + F.wave * 64 + kk0 + u8) * 6144 + j];
#pragma unroll
                for (int u8 = 0; u8 < 8; ++u8) { const int k = F.wave * 64 + kk0 + u8; const float w = w8[u8];
                    const f32x4* s4 = (const f32x4*)(sl + k * 36);
#pragma unroll
                    for (int q = 0; q < 8; ++q) { const f32x4 s = s4[q]; acc[4 * q] += s.x * w; acc[4 * q + 1] += s.y * w; acc[4 * q + 2] += s.z * w; acc[4 * q + 3] += s.w * w; }
                    acc[32] += sl[k * 36 + 32] * w; }
            }
        }
        __syncthreads();
        float* rd = (float*)F.lds;
#pragma unroll
        for (int m = 0; m < 33; ++m) rd[(F.wave * 33 + m) * 64 + lane] = acc[m];
        __syncthreads();
        for (int i = tid; i < 33 * 64; i += NTHR) { const int m = i / 64, jj = i % 64; float s = 0.f;
#pragma unroll
            for (int w = 0; w < 8; ++w) s += rd[(w * 33 + m) * 64 + jj];
            const int col = jb * 64 + jj;
            ((float*)(F.ws + WS_MODS))[(size_t)(l * 33 + m) * 6144 + col] = s + inp(F, I_BADA)[(size_t)l * 6144 + col]; }
    }
    __syncthreads();
    f32x2* tab = (f32x2*)(F.ws + WS_ROPE);
    for (int i = F.vcu * NTHR + tid; i < SEQ * 32; i += F.G * NTHR) {
        const int pos = i >> 5, fi = i & 31; const float inv = powf(10000.0f, -(float)(fi & 15) / 16.0f);
        const float ang = (fi < 16 ? (float)(pos / 64) : (float)(pos % 64)) * inv;
        tab[i] = (f32x2){cosf(ang), sinf(ang)};
    }
}

__device__ __forceinline__ void transpose_item(const float* W, int K, int N, bf16* WT, int k0, int n0, int orow0, float* scr, int lane, int ldo = 0, int kofs = 0, float scl = 1.0f) {
    if (ldo == 0) ldo = K;
    f32x4 v[8];
#pragma unroll
    for (int i = 0; i < 8; ++i) v[i] = *(const f32x4*)(W + (size_t)(k0 + 8 * i + (lane >> 3)) * N + n0 + 4 * (lane & 7));
#pragma unroll
    for (int i = 0; i < 8; ++i) *(f32x4*)(scr + (8 * i + (lane >> 3)) * 36 + 4 * (lane & 7)) = v[i];
    LDS_WAIT(); asm volatile("" ::: "memory");
    const int c = lane & 7;
#pragma unroll
    for (int j = 0; j < 4; ++j) { const int n = (lane >> 3) + 8 * j; const float* s = scr + (8 * c) * 36 + n;
        u32x4 o; o.x = pk2(scl * s[0 * 36], scl * s[1 * 36]); o.y = pk2(scl * s[2 * 36], scl * s[3 * 36]); o.z = pk2(scl * s[4 * 36], scl * s[5 * 36]); o.w = pk2(scl * s[6 * 36], scl * s[7 * 36]);
        *(u32x4*)(WT + (size_t)(orow0 + n) * ldo + kofs + k0 + 8 * c) = o; }
    LDS_WAIT(); asm volatile("" ::: "memory");
}
constexpr int I_IN = 16 * 216, I_BR = 3 * 8 * 32, I_OUT = 16 * 32, I_EX = 16 * 16 * 32;
constexpr int NITEMS = I_IN + I_BR + I_OUT + 3 * I_EX;
constexpr int IT_UP0 = I_IN + I_BR + I_OUT, IT_DN0 = IT_UP0 + 2 * I_EX;
constexpr int FA1 = 4900, FB1 = 9800, FC1 = 10900, FD1 = 15000, FE1 = 20612;
__device__ __forceinline__ void wconv_phase(Frame& F, int l, int it_lo, int it_hi, int widx, int nw, int wave_lo = 0) {
    const int lane = launder(lane_id()), tid = F.wave * 64 + lane; (void)tid; (void)lane;
    float* scr = (float*)(F.lds + F.wave * 16384);
    if (F.wave < wave_lo) return;
    const int nwv = NWAVES - wave_lo, gw = widx * nwv + F.wave - wave_lo, NGW = nw * nwv;
    for (int it = it_lo + gw; it < it_hi; it += NGW) {
        int r = it;
        if (r < I_IN) { const int kb = r / 216, nb = r % 216; transpose_item(inp(F, I_WIN) + (size_t)l * D * INW, D, INW, (bf16*)(F.ws + wpar(l, WS_WIN, WS_WIN1)), kb * 64, nb * 32, nb * 32, scr, lane, 0, 0, nb * 32 >= Z_G ? -1.4426950408889634f : 1.0f); continue; } r -= I_IN;
        if (r < I_BR) { const int br = r / 256, q = r % 256, kb = q / 32, nb = q % 32;
            transpose_item(inp(F, I_WBR) + ((size_t)l * 3 + br) * 512 * D, 512, D, (bf16*)(F.ws + wpar(l, WS_WBR, WS_WBR1)), kb * 64, nb * 32, nb * 32, scr, lane, 1536, br * 512); continue; } r -= I_BR;
        if (r < I_OUT) { const int kb = r / 32, nb = r % 32; transpose_item(inp(F, I_WOUT) + (size_t)l * D * D, D, D, (bf16*)(F.ws + wpar(l, WS_WOUT, WS_WOUT1)), kb * 64, nb * 32, nb * 32, scr, lane); continue; } r -= I_OUT;
        if (r < 2 * I_EX) { const int s = r / I_EX, q = r % I_EX, e = q / 512, q2 = q % 512, kb = q2 / 32, nb = q2 % 32, n0 = nb * 32;
            const float* W = inp(F, s ? I_WU : I_WG) + ((size_t)l * NE + e) * D * FF;
            transpose_item(W, D, FF, (bf16*)(F.ws + wpar(l, WS_WUP, WS_WUP1)) + (size_t)e * 2048 * D, kb * 64, n0, 256 * (n0 / 128) + 128 * s + (n0 % 128), scr, lane, 0, 0, s ? -0.6931471805599453f : -1.4426950408889634f); continue; } r -= 2 * I_EX;
        { const int e = r / 512, q2 = r % 512, kb = q2 / 32, nb = q2 % 32;
            transpose_item(inp(F, I_WD) + ((size_t)l * NE + e) * FF * D, FF, D, (bf16*)(F.ws + wpar(l, WS_WDN, WS_WDN1)) + (size_t)e * D * FF, kb * 64, nb * 32, nb * 32, scr, lane); }
    }
}

__device__ __forceinline__ float xsel(bool c, float a, float b) { return c ? a : b; }
template <bool ROUTER>
__device__ __forceinline__ void norm_phase(Frame& F, int l, int ch, int nrows, bool dry = false) {
    const int lane = launder(lane_id()), tid = F.wave * 64 + lane; (void)tid; (void)lane;
    const int gw = F.vcu * NWAVES + F.wave, NGW = F.G * NWAVES;
    float* wr_l = (float*)F.lds;
    if (ROUTER) {
        const float* wr = inp(F, I_WROUTER) + (size_t)l * D * NE;
        for (int i = tid; i < D * NE; i += NTHR) { const int d = i >> 4, e = i & 15; wr_l[e * D + d] = wr[i]; }
        __syncthreads();
    }
    const float* gv = inp(F, ROUTER ? I_GFFN : I_GMIX) + (size_t)l * D;
    bf16* hb = dry ? (bf16*)(F.ws + WS_OBUF + 160 * MiB) : (bf16*)(F.ws + (ch == 0 ? WS_HBUF : WS_HBUF1));
    f32x4 nx[2][4]; u32x2 nb[2][4];
#define NP_LOAD(c0) do { _Pragma("unroll") for (int rr_ = 0; rr_ < 2; ++rr_) { \
        if (ROUTER) { const bf16* xb_ = xbrow(F, ch, (c0) + rr_); \
            _Pragma("unroll") for (int j_ = 0; j_ < 4; ++j_) nb[rr_][j_] = *(const u32x2*)(xb_ + lane * 4 + 256 * j_); } \
        else { const float* xr_ = xin_row(F, ch, (c0) + rr_); \
            _Pragma("unroll") for (int j_ = 0; j_ < 4; ++j_) nx[rr_][j_] = *(const f32x4*)(xr_ + lane * 4 + 256 * j_); } } } while (0)
    const int rpw = (((nrows + NGW - 1) / NGW) + 1) & ~1, rbeg = gw * rpw, rend = (rbeg + rpw < nrows) ? rbeg + rpw : nrows;
    f32x4 gq[4], shq[4], scq[4]; int cmv = -1;
#pragma unroll
    for (int j = 0; j < 4; ++j) gq[j] = *(const f32x4*)(gv + lane * 4 + 256 * j);
    if (rbeg < rend) NP_LOAD(rbeg);
    for (int cr0 = rbeg; cr0 < rend; cr0 += 2) {
        f32x4 v[2][4];
#pragma unroll
        for (int rr = 0; rr < 2; ++rr)
#pragma unroll
            for (int j = 0; j < 4; ++j) {
                if (ROUTER) { const u32x2 t = nb[rr][j]; v[rr][j].x = bflo(t.x); v[rr][j].y = bfhi(t.x); v[rr][j].z = bflo(t.y); v[rr][j].w = bfhi(t.y); }
                else v[rr][j] = nx[rr][j]; }
        if (cr0 + 2 < rend) NP_LOAD(cr0 + 2);
#pragma unroll
        for (int rr = 0; rr < 2; ++rr) {
            const int cr = cr0 + rr;
            const int mv = mv_of(ch, cr);
            if (mv != cmv) { cmv = mv; const float* sh = mod_ptr(F, l, mv, ROUTER ? 3 : 0); const float* sc = mod_ptr(F, l, mv, ROUTER ? 4 : 1);
#pragma unroll
                for (int j = 0; j < 4; ++j) { shq[j] = *(const f32x4*)(sh + lane * 4 + 256 * j); scq[j] = *(const f32x4*)(sc + lane * 4 + 256 * j); } }
            float ss = 0.f;
#pragma unroll
            for (int j = 0; j < 4; ++j) {
                if (!ROUTER) { u32x2 o; o.x = pk2(v[rr][j].x, v[rr][j].y); o.y = pk2(v[rr][j].z, v[rr][j].w); __builtin_nontemporal_store(o, (u32x2*)(xbrow(F, ch, cr) + lane * 4 + 256 * j)); }
                ss += (v[rr][j].x * v[rr][j].x + v[rr][j].y * v[rr][j].y) + (v[rr][j].z * v[rr][j].z + v[rr][j].w * v[rr][j].w); }
            const float rstd = 1.0f / sqrtf(wave_sum(ss) * (1.0f / D) + RMS_EPS);
#pragma unroll
            for (int j = 0; j < 4; ++j) {
                v[rr][j] = (v[rr][j] * rstd * gq[j]) * (scq[j] + 1.0f) + shq[j];
                u32x2 o; o.x = pk2(v[rr][j].x, v[rr][j].y); o.y = pk2(v[rr][j].z, v[rr][j].w);
                __builtin_nontemporal_store(o, (u32x2*)(hb + (size_t)cr * D + lane * 4 + 256 * j));
            }
        }
#undef NP_LOAD
        if (ROUTER) {
            const bool b5 = lane & 32, b4 = lane & 16, b3 = lane & 8;
            float lg[2][2];
#pragma unroll
            for (int hf = 0; hf < 2; ++hf) {
                float a[2][8];
#pragma unroll
                for (int e = 0; e < 8; ++e) {
                    f32x4 w[4];
#pragma unroll
                    for (int j = 0; j < 4; ++j) w[j] = *(const f32x4*)(wr_l + (hf * 8 + e) * D + lane * 4 + 256 * j);
#pragma unroll
                    for (int rr = 0; rr < 2; ++rr) { float t = 0.f;
#pragma unroll
                        for (int j = 0; j < 4; ++j) t += (v[rr][j].x * w[j].x + v[rr][j].y * w[j].y) + (v[rr][j].z * w[j].z + v[rr][j].w * w[j].w);
                        a[rr][e] = t; }
                    if (e & 1) __builtin_amdgcn_sched_barrier(0);
                }
#pragma unroll
                for (int rr = 0; rr < 2; ++rr) {
                    float c[4], d2[2];
#pragma unroll
                    for (int i = 0; i < 4; ++i) { const float recv = __shfl_xor(xsel(b5, a[rr][i], a[rr][i + 4]), 32); c[i] = xsel(b5, a[rr][i + 4], a[rr][i]) + recv; }
#pragma unroll
                    for (int i = 0; i < 2; ++i) { const float recv = __shfl_xor(xsel(b4, c[i], c[i + 2]), 16); d2[i] = xsel(b4, c[i + 2], c[i]) + recv; }
                    float t = xsel(b3, d2[1], d2[0]) + __shfl_xor(xsel(b3, d2[0], d2[1]), 8);
                    t += __shfl_xor(t, 4); t += __shfl_xor(t, 2); t += __shfl_xor(t, 1);
                    lg[hf][rr] = t;
                }
                __builtin_amdgcn_sched_barrier(0);
            }
#pragma unroll
            for (int rr = 0; rr < 2; ++rr) {
                float m = fmaxf(lg[0][rr], lg[1][rr]);
#pragma unroll
                for (int o = 8; o < 64; o <<= 1) m = fmaxf(m, __shfl_xor(m, o));
                const float p0 = expf(lg[0][rr] - m), p1 = expf(lg[1][rr] - m); float s = p0 + p1;
#pragma unroll
                for (int o = 8; o < 64; o <<= 1) s += __shfl_xor(s, o);
                const float inv = 1.0f / s;
                const int cr = cr0 + rr, e = lane >> 3;
                if ((lane & 7) < 2 && !dry) {
                    const int ee = (lane & 1) ? e + 8 : e; const float mine = ((lane & 1) ? p1 : p0) * inv;
                    if (cr < LROWS) { const int bl = cr / SEQ, t = cr % SEQ; affl_of(F, ch)[(size_t)(bl * NE + ee) * SEQ + t] = mine; }
                    else { const int j = cr - LROWS, bl = j / CTX, t = j % CTX; ((float*)(F.ws + WS_AFFC))[(size_t)(bl * NE + ee) * CTX + t] = mine; }
                }
            }
        }
    }
}

__device__ __forceinline__ const bf16* zrow(const Frame& F, int cr) { return (const bf16*)(F.ws + WS_Z) + (size_t)cr * ZW; }

__device__ __forceinline__ void conv_phase(Frame& F, int l, int nrows) {
    const int lane = launder(lane_id()), tid = F.wave * 64 + lane; (void)tid; (void)lane;
    const int gw = F.vcu * NWAVES + F.wave, NGW = F.G * NWAVES;
    const float* cw = inp(F, I_CONVW) + (size_t)l * 3 * 512;
    float w[3][8];
#pragma unroll
    for (int k = 0; k < 3; ++k)
#pragma unroll
        for (int j = 0; j < 8; ++j) w[k][j] = cw[k * 512 + lane * 8 + j];
    bf16* ob = (bf16*)(F.ws + WS_OBUF);
    const int rpw = (nrows + NGW - 1) / NGW, rbeg = gw * rpw, rend = (rbeg + rpw < nrows) ? rbeg + rpw : nrows;
    if (rbeg >= rend) return;
#define CV_SEQ(cr_) ((cr_) < LROWS ? (cr_) / SEQ : 1024 + ((cr_) - LROWS) / CTX)
#define CV_LOADP(cr_, P) do { const bf16* zr_ = zrow(F, (cr_)); float c8_[8], x8_[8]; unpack8(*(const u32x4*)(zr_ + Z_AC + lane * 8), c8_); unpack8(*(const u32x4*)(zr_ + Z_AX + lane * 8), x8_); \
        _Pragma("unroll") for (int j_ = 0; j_ < 8; ++j_) (P)[j_] = c8_[j_] * x8_[j_]; } while (0)
    float pp[8], pc[8], pn[8];
#pragma unroll
    for (int j = 0; j < 8; ++j) pp[j] = 0.f;
    if (rbeg > 0 && CV_SEQ(rbeg - 1) == CV_SEQ(rbeg)) CV_LOADP(rbeg - 1, pp);
    CV_LOADP(rbeg, pc);
    for (int cr = rbeg; cr < rend; ++cr) {
        const bool hasn = cr + 1 < nrows, same = hasn && CV_SEQ(cr + 1) == CV_SEQ(cr);
#pragma unroll
        for (int j = 0; j < 8; ++j) pn[j] = 0.f;
        if (hasn) CV_LOADP(cr + 1, pn);
        float b8[8]; unpack8(*(const u32x4*)(zrow(F, cr) + Z_AB + lane * 8), b8);
        float acc[8];
#pragma unroll
        for (int j = 0; j < 8; ++j) acc[j] = w[0][j] * pp[j] + w[1][j] * pc[j] + (same ? w[2][j] * pn[j] : 0.f);
        u32x4 o; o.x = pk2(b8[0] * acc[0], b8[1] * acc[1]); o.y = pk2(b8[2] * acc[2], b8[3] * acc[3]); o.z = pk2(b8[4] * acc[4], b8[5] * acc[5]); o.w = pk2(b8[6] * acc[6], b8[7] * acc[7]);
        *(u32x4*)(ob + (size_t)cr * OW + lane * 8) = o;
#pragma unroll
        for (int j = 0; j < 8; ++j) { pp[j] = same ? pc[j] : 0.f; pc[j] = pn[j]; }
    }
#undef CV_SEQ
#undef CV_LOADP
}

struct NaiveState { unsigned q[32]; float o[64], m, l; };
__device__ __forceinline__ void load64(const bf16* p, float* f) {
#pragma unroll
    for (int i = 0; i < 8; ++i) unpack8(*(const u32x4*)(p + 8 * i), f + 8 * i);
}
__device__ __forceinline__ void rope64(float* x, const f32x2* tabrow) {
#pragma unroll
    for (int i = 0; i < 32; ++i) { const f32x2 cs = tabrow[i]; const float a = x[i], b = x[i + 32]; x[i] = a * cs.x - b * cs.y; x[i + 32] = a * cs.y + b * cs.x; }
}
__device__ __forceinline__ void naive_visit(NaiveState& st, const bf16* kp, const bf16* vp, float bias, bool valid, const f32x2* ropetab) {
    float s = 0.f;
#pragma unroll
    for (int c = 0; c < 4; ++c) {
        float a[8], b[8]; unpack8(*(const u32x4*)(kp + 8 * c), a); unpack8(*(const u32x4*)(kp + 32 + 8 * c), b);
        if (ropetab) {
#pragma unroll
            for (int i = 0; i < 8; ++i) { const f32x2 cs = ropetab[8 * c + i]; const float x1 = a[i], x2 = b[i]; a[i] = x1 * cs.x - x2 * cs.y; b[i] = x1 * cs.y + x2 * cs.x; }
        }
#pragma unroll
        for (int i = 0; i < 8; ++i) s += bflo(st.q[8 * c + i]) * a[i] + bfhi(st.q[8 * c + i]) * b[i];
    }
    s = valid ? s + bias : -1e30f;
    const float mn = fmaxf(st.m, s), alpha = __expf(st.m - mn), p = __expf(s - mn);
    st.m = mn; st.l = st.l * alpha + p;
#pragma unroll
    for (int c = 0; c < 8; ++c) { float v[8]; unpack8(*(const u32x4*)(vp + 8 * c), v);
#pragma unroll
        for (int i = 0; i < 8; ++i) st.o[8 * c + i] = st.o[8 * c + i] * alpha + p * v[i]; }
}
__device__ __forceinline__ void naive_attn_phase(Frame& F, int l, int ch, bool last, bf16* ob) {
    const int lane = launder(lane_id()), tid = F.wave * 64 + lane; (void)tid; (void)lane;
    const int n_lat = LROWS / 64, n_ctx = (last || ch != 0) ? 0 : CTXALL / 64;
    const int nunits = 2 * n_lat + 2 * n_ctx;
    const f32x2* tab = (const f32x2*)(F.ws + WS_ROPE);
    for (int u = F.vcu; u < nunits; u += F.G) {
        int type, blk;
        if (u < n_lat) { type = 0; blk = u; } else if (u < 2 * n_lat) { type = 1; blk = u - n_lat; } else if (u < 2 * n_lat + n_ctx) { type = 2; blk = u - 2 * n_lat; } else { type = 3; blk = u - 2 * n_lat - n_ctx; }
        const int h = F.wave;
        const int cr0 = (type < 2) ? blk * 64 : LROWS + blk * 64, cr = cr0 + lane;
        const int bl = (type < 2) ? ch * BC + cr0 / SEQ : (cr0 - LROWS) / CTX;
        const int t0 = (type < 2) ? cr0 % SEQ : (cr0 - LROWS) % CTX, t = t0 + lane;
        const int ctx0 = LROWS + bl * CTX;
        const bool sw = (type == 0 || type == 3);
        const int hk = sw ? h / 4 : h;
        const int qcol = (sw ? Z_SQ : Z_NQ) + 64 * h, kcol = (sw ? Z_SK : Z_NK) + 64 * hk, vcol = (sw ? Z_SV : Z_NV) + 64 * hk;
        NaiveState st;
        { float qf[64]; load64(zrow(F, cr) + qcol, qf);
          if (type == 0) rope64(qf, tab + (size_t)t * 32);
#pragma unroll
          for (int i = 0; i < 32; ++i) st.q[i] = pk2(qf[i] * 0.125f, qf[i + 32] * 0.125f);
#pragma unroll
          for (int i = 0; i < 64; ++i) st.o[i] = 0.f; }
        if (sw) { st.m = inp(F, I_SINK)[l * 8 + h]; st.l = 1.f; } else { st.m = -1e30f; st.l = 0.f; }
        const int lo = t0 - 128 < 0 ? 0 : t0 - 128, hi = t0 + 63 + 128 > SEQ - 1 ? SEQ - 1 : t0 + 63 + 128;
        const int r = t0 / 64, c = lane; int rs = r - 4; rs = rs < 0 ? 0 : (rs > 24 ? 24 : rs); int cs = c - 8; cs = cs < 0 ? 0 : (cs > 48 ? 48 : cs);
        const float* rpb = inp(F, I_RPB) + ((size_t)l * 8 + h) * 15 * 31;
        const int nloc = type == 0 ? hi - lo + 1 : (type == 1 ? 512 : 0);
#pragma unroll 1
        for (int idx = 0; idx < CTX + nloc; ++idx) {
            const bf16* zr; float bias = 0.f; bool valid = true; const f32x2* rt = nullptr;
            if (idx < CTX) zr = zrow(F, ctx0 + idx);
            else if (type == 0) { const int j = lo + idx - CTX, dlt = t - j; zr = zrow(F, cr0 - t0 + j); valid = dlt <= 128 && dlt >= -128; rt = tab + (size_t)j * 32; }
            else { const int q = idx - CTX, kr = rs + (q >> 6), kc = q & 63; zr = zrow(F, cr0 - t0 + kr * 64 + kc); valid = kc >= cs && kc < cs + 16;
                int dc = kc - c + 15; dc = dc < 0 ? 0 : (dc > 30 ? 30 : dc); bias = rpb[(kr - r + 7) * 31 + dc]; }
            naive_visit(st, zr + kcol, zr + vcol, bias, valid, rt);
        }
        const float inv = 1.0f / st.l;
        bf16* op = ob + (size_t)cr * OW + (sw ? 1024 : 512) + 64 * h;
#pragma unroll
        for (int i = 0; i < 8; ++i) { u32x4 o; o.x = pk2(st.o[8 * i] * inv, st.o[8 * i + 1] * inv); o.y = pk2(st.o[8 * i + 2] * inv, st.o[8 * i + 3] * inv); o.z = pk2(st.o[8 * i + 4] * inv, st.o[8 * i + 5] * inv); o.w = pk2(st.o[8 * i + 6] * inv, st.o[8 * i + 7] * inv);
            *(u32x4*)(op + 8 * i) = o; }
    }
}

typedef short s16x4 __attribute__((ext_vector_type(4)));
typedef float f32x16 __attribute__((ext_vector_type(16)));
typedef __bf16 bf16x2_t __attribute__((ext_vector_type(2)));
__device__ __forceinline__ unsigned cvtpk(float lo, float hi) { const f32x2 v = {lo, hi}; return __builtin_bit_cast(unsigned, __builtin_convertvector(v, bf16x2_t)); }
typedef short v4i16_t __attribute__((ext_vector_type(4)));
__device__ __forceinline__ s16x4 vtr(const LAS unsigned char* p) { return __builtin_bit_cast(s16x4, __builtin_amdgcn_ds_read_tr16_b64_v4i16((LAS v4i16_t*)p)); }
constexpr int AK_RS = 144, AV_RS = 192, AK_BYTES = 128 * AK_RS, AV_BYTES = 128 * AV_RS, ASTAGE = AK_BYTES + AV_BYTES, A_RPB_OFF = 2 * ASTAGE;
#define MFMA32(a, b, c) __builtin_amdgcn_mfma_f32_32x32x16_bf16((a), (b), (c), 0, 0, 0)
__device__ __forceinline__ float xlane32(float v) {
    const auto rr = __builtin_amdgcn_permlane32_swap(__builtin_bit_cast(unsigned, v), __builtin_bit_cast(unsigned, v), false, false);
    return __builtin_bit_cast(float, (lane_id() & 32) ? rr[0] : rr[1]);
}
__device__ __forceinline__ float max3f(float a, float b, float c) { return fmaxf(fmaxf(a, b), c); }
__device__ __forceinline__ float rowmax32(const f32x16& p0, const f32x16& p1) {
    float a = max3f(p0[0], p0[1], p1[0]), b = max3f(p0[2], p0[3], p1[1]); a = max3f(a, p1[2], p1[3]);
#pragma unroll
    for (int i = 4; i < 16; i += 4) { a = max3f(a, p0[i], p0[i + 1]); b = max3f(b, p0[i + 2], p0[i + 3]); a = max3f(a, p1[i], p1[i + 1]); b = max3f(b, p1[i + 2], p1[i + 3]); }
    const float m = fmaxf(a, b);
    const auto rr = __builtin_amdgcn_permlane32_swap(__builtin_bit_cast(unsigned, m), __builtin_bit_cast(unsigned, m), false, false);
    return fmaxf(__builtin_bit_cast(float, rr[0]), __builtin_bit_cast(float, rr[1]));
}
__device__ __forceinline__ void lds_read_vt8(unsigned addr, s16x4 (&t)[8]) {
    asm volatile("ds_read_b64_tr_b16 %0, %8\n\tds_read_b64_tr_b16 %1, %8 offset:1536\n\tds_read_b64_tr_b16 %2, %8 offset:64\n\tds_read_b64_tr_b16 %3, %8 offset:1600\n\t"
                 "ds_read_b64_tr_b16 %4, %8 offset:3072\n\tds_read_b64_tr_b16 %5, %8 offset:4608\n\tds_read_b64_tr_b16 %6, %8 offset:3136\n\tds_read_b64_tr_b16 %7, %8 offset:4672\n\t"
                 "s_waitcnt lgkmcnt(0)"
        : "=&v"(t[0]), "=&v"(t[1]), "=&v"(t[2]), "=&v"(t[3]), "=&v"(t[4]), "=&v"(t[5]), "=&v"(t[6]), "=&v"(t[7]) : "v"(addr) : "memory");
}
static_assert(16 * 192 == 3072 && 8 * 192 == 1536, "lds_read_vt8 offsets assume AV_RS = 192");
__device__ __forceinline__ void lds_read_k4(unsigned addr, bf16x8 (&ka)[4]) {
    asm volatile("ds_read_b128 %0, %4\n\tds_read_b128 %1, %4 offset:32\n\tds_read_b128 %2, %4 offset:64\n\tds_read_b128 %3, %4 offset:96\n\ts_waitcnt lgkmcnt(0)"
        : "=&v"(ka[0]), "=&v"(ka[1]), "=&v"(ka[2]), "=&v"(ka[3]) : "v"(addr) : "memory");
}
__device__ __forceinline__ void lds_read_k8(unsigned addr, bf16x8 (&ka)[4], bf16x8 (&kb)[4]) {
    asm volatile("ds_read_b128 %0, %8\n\tds_read_b128 %1, %8 offset:32\n\tds_read_b128 %2, %8 offset:64\n\tds_read_b128 %3, %8 offset:96\n\t"
                 "ds_read_b128 %4, %8 offset:4608\n\tds_read_b128 %5, %8 offset:4640\n\tds_read_b128 %6, %8 offset:4672\n\tds_read_b128 %7, %8 offset:4704\n\t"
                 "s_waitcnt lgkmcnt(0)"
        : "=&v"(ka[0]), "=&v"(ka[1]), "=&v"(ka[2]), "=&v"(ka[3]), "=&v"(kb[0]), "=&v"(kb[1]), "=&v"(kb[2]), "=&v"(kb[3]) : "v"(addr) : "memory");
}
constexpr int A_ROPE_OFF = A_RPB_OFF + 4096;
template <int VAR, int TY>
__device__ __forceinline__ void attn_units(Frame& F, int l, int ch, bool last, bf16* ob) {
    const int lane = launder(lane_id()), tid = F.wave * 64 + lane;
    const int wave = F.wave, r = lane & 31, hh = lane >> 5;
    const float LOG2E = 1.4426950408889634f;
    const f32x2* tab = (const f32x2*)(F.ws + WS_ROPE); (void)tab;
    float* rpbl = (float*)(F.lds + A_RPB_OFF);
    const int skey = tid >> 2, sc = tid & 3, sb = skey >> 6, srow = skey & 63;
    const int nNA = BC * 8 * 8, nSW = BC * 16 * 4, nCX = (last || ch != 0) ? 0 : NB * 8 * 2;
    const int ubeg = (TY == 1) ? 0 : (TY == 0 ? nNA : nNA + nSW), uend = (TY == 1) ? nNA : (TY == 0 ? nNA + nSW : nNA + nSW + nCX);
    for (int u = ubeg + F.vcu; u < uend; u += F.G) {
        int type, bl, h, rg = 0, n = 0;
        if (u < nNA) { type = 1; bl = u >> 6; rg = ((u >> 3) + (u >> 8)) & 7; h = u & 7; }
        else if (u < nNA + nSW) { const int v = u - nNA; type = 0; bl = v >> 6; n = ((v >> 2) + 4 * (v >> 8)) & 15; h = 4 * ((v >> 1) & 1) + 2 * (v & 1); }
        else { const int v = u - nNA - nSW; type = (v < NB * 8) ? 2 : 3; const int vv = v % (NB * 8); bl = vv >> 3; h = vv & 7; }
        if (TY != 2) type = TY;
        const bool sw = (type == 0 || type == 3);
        const int head = (type == 0) ? h + (wave >> 2) : h;
        const int jb = wave & 3;
        const int rq = 4 * rg + 2 * (wave >> 2) + (r >> 4), cq = 16 * jb + (r & 15);
        const int qrow = (type == 1) ? bl * SEQ + 64 * rq + cq : (type == 0) ? bl * SEQ + 128 * n + 32 * (wave & 3) + r : LROWS + bl * CTX + 32 * wave + r;
        const int qcol = (sw ? Z_SQ : Z_NQ) + 64 * head, kcol = sw ? Z_SK + 64 * (head >> 2) : Z_NK + 64 * head, vcol = sw ? Z_SV + 64 * (head >> 2) : Z_NV + 64 * head;
        const int ocol = (sw ? 1024 : 512) + 64 * head;
        const int ctx0 = LROWS + ((type < 2) ? ch * BC + bl : bl) * CTX;
        int nloc = 0, loc0 = 0;
        if (type == 0) { const int jlo = (n == 0) ? 2 : 0, jhi = (n == 15) ? 3 : 5; nloc = jhi - jlo + 1; loc0 = jlo; }
        else if (type == 1) { int a = 4 * rg - 4; a = a < 0 ? 0 : (a > 24 ? 24 : a); int b = 4 * rg - 1; b = b < 0 ? 0 : (b > 24 ? 24 : b); loc0 = a; nloc = b + 7 - a + 1; }
        const int nt = 4 + nloc;
        bf16x8 qf[4];
        {
            const bf16* qp = zrow(F, qrow) + qcol + 8 * hh;
            float q[4][8];
#pragma unroll
            for (int s4 = 0; s4 < 4; ++s4) unpack8(*(const u32x4*)(qp + 16 * s4), q[s4]);
            if (type == 0) {
                const int pos = qrow - bl * SEQ; const f32x2* rl = (const f32x2*)(F.lds + A_ROPE_OFF);
#pragma unroll
                for (int s4 = 0; s4 < 2; ++s4) { const f32x2* tr = rl + (s4 == 0 ? (pos >> 6) : 32 + (pos & 63)) * 16 + 8 * hh;
#pragma unroll
                    for (int j = 0; j < 8; ++j) { const f32x2 cs = tr[j]; const float x1 = q[s4][j], x2 = q[s4 + 2][j]; q[s4][j] = x1 * cs.x - x2 * cs.y; q[s4 + 2][j] = x1 * cs.y + x2 * cs.x; } }
            }
            const float qs = 0.125f * LOG2E;
#pragma unroll
            for (int s4 = 0; s4 < 4; ++s4) { u32x4 p; p.x = cvtpk(q[s4][0] * qs, q[s4][1] * qs); p.y = cvtpk(q[s4][2] * qs, q[s4][3] * qs); p.z = cvtpk(q[s4][4] * qs, q[s4][5] * qs); p.w = cvtpk(q[s4][6] * qs, q[s4][7] * qs);
                qf[s4] = __builtin_bit_cast(bf16x8, p); }
        }
        float m = 0.f, lsum = 0.f;
        if (sw) { m = inp(F, I_SINK)[l * 8 + head] * LOG2E; lsum = (hh == 0) ? 1.f : 0.f; }
        f32x16 o0, o1;
#pragma unroll
        for (int i = 0; i < 16; ++i) { o0[i] = 0.f; o1[i] = 0.f; }
        const int kst = (type == 1) ? (16 * jb - 8 < 0 ? 0 : (16 * jb - 8 > 32 ? 32 : 16 * jb - 8)) : 0;
        unsigned bixp[4] = {0u, 0u, 0u, 0u};
        {
            const int csq = cq - 8 < 0 ? 0 : (cq - 8 > 48 ? 48 : cq - 8);
#pragma unroll
            for (int i = 0; i < 16; ++i) { const int kc = kst + (i & 3) + 8 * (i >> 2) + 4 * hh; bixp[i >> 2] |= (unsigned)(((kc >= csq && kc <= csq + 15) ? kc - cq + 15 : 31) * 4) << (8 * (i & 3)); }
        }
#define BIX(i) ((bixp[(i) >> 2] >> (8 * ((i) & 3))) & 0xffu)
        const int rsl = rq - 4 < 0 ? 0 : (rq - 4 > 24 ? 24 : rq - 4);
        u32x4 gk0, gk1, gv0, gv1;
        bool grope = false; int gpos = 0;
#define A_TILE_ROW0(ti) ((ti) < 4 ? ctx0 + 64 * (ti) : (type == 0 ? bl * SEQ + 128 * n - 128 + 64 * (loc0 + (ti) - 4) : bl * SEQ + 64 * (loc0 + (ti) - 4)))
#define A_STAGE_LOAD(T) do { const int ti_ = 2 * (T) + sb; const int tic_ = ti_ < nt ? ti_ : nt - 1; const int row0_ = A_TILE_ROW0(tic_); const bf16* sp_ = zrow(F, row0_ + srow) + 8 * sc; \
            gk0 = *(const u32x4*)(sp_ + kcol); gk1 = *(const u32x4*)(sp_ + kcol + 32); gv0 = *(const u32x4*)(sp_ + vcol); gv1 = *(const u32x4*)(sp_ + vcol + 32); grope = (type == 0 && tic_ >= 4); gpos = row0_ - bl * SEQ + srow; } while (0)
#define A_STAGE_WRITE(st) do { unsigned char* dk_ = F.lds + (st) * ASTAGE + skey * AK_RS + 16 * sc; unsigned char* dv_ = F.lds + (st) * ASTAGE + AK_BYTES + skey * AV_RS + 16 * sc; \
            if (grope) { float a_[8], b_[8]; unpack8(gk0, a_); unpack8(gk1, b_); \
                const f32x4* rl_ = (const f32x4*)(F.lds + A_ROPE_OFF + ((sc < 2 ? (gpos >> 6) : 32 + (gpos & 63)) * 16 + 8 * (sc & 1)) * 8); \
                _Pragma("unroll") for (int j_ = 0; j_ < 4; ++j_) { const f32x4 rcj_ = rl_[j_]; const float c0_ = rcj_.x, s0_ = rcj_.y, c1_ = rcj_.z, s1_ = rcj_.w; \
                    const float x1_ = a_[2 * j_], x2_ = b_[2 * j_], y1_ = a_[2 * j_ + 1], y2_ = b_[2 * j_ + 1]; \
                    a_[2 * j_] = x1_ * c0_ - x2_ * s0_; b_[2 * j_] = x1_ * s0_ + x2_ * c0_; a_[2 * j_ + 1] = y1_ * c1_ - y2_ * s1_; b_[2 * j_ + 1] = y1_ * s1_ + y2_ * c1_; } \
                gk0.x = cvtpk(a_[0], a_[1]); gk0.y = cvtpk(a_[2], a_[3]); gk0.z = cvtpk(a_[4], a_[5]); gk0.w = cvtpk(a_[6], a_[7]); \
                gk1.x = cvtpk(b_[0], b_[1]); gk1.y = cvtpk(b_[2], b_[3]); gk1.z = cvtpk(b_[4], b_[5]); gk1.w = cvtpk(b_[6], b_[7]); } \
            *(u32x4*)dk_ = gk0; *(u32x4*)(dk_ + 64) = gk1; *(u32x4*)dv_ = gv0; *(u32x4*)(dv_ + 64) = gv1; } while (0)
#define A_QK(XV, kbase) do { bf16x8 k4_[4]; lds_read_k4((unsigned)(size_t)(kbase), k4_); _Pragma("unroll") for (int i_ = 0; i_ < 16; ++i_) (XV)[i_] = -m; \
            _Pragma("unroll") for (int s4_ = 0; s4_ < 4; ++s4_) (XV) = MFMA32(k4_[s4_], qf[s4_], (XV)); } while (0)
#define A_QK2(XA, XB, kbA) do { bf16x8 ka_[4], kb_[4]; lds_read_k8((unsigned)(size_t)(kbA), ka_, kb_); \
            _Pragma("unroll") for (int i_ = 0; i_ < 16; ++i_) { (XA)[i_] = -m; (XB)[i_] = -m; } \
            _Pragma("unroll") for (int s4_ = 0; s4_ < 4; ++s4_) { (XA) = MFMA32(ka_[s4_], qf[s4_], (XA)); (XB) = MFMA32(kb_[s4_], qf[s4_], (XB)); } } while (0)
#define A_NEG(XV) do { _Pragma("unroll") for (int i_ = 0; i_ < 16; ++i_) (XV)[i_] = -1e30f; } while (0)
#define A_PV(XV, vbase) do { u32x4 pa_, pb_; \
            pa_.x = cvtpk((XV)[0], (XV)[1]); pa_.y = cvtpk((XV)[2], (XV)[3]); pa_.z = cvtpk((XV)[4], (XV)[5]); pa_.w = cvtpk((XV)[6], (XV)[7]); \
            pb_.x = cvtpk((XV)[8], (XV)[9]); pb_.y = cvtpk((XV)[10], (XV)[11]); pb_.z = cvtpk((XV)[12], (XV)[13]); pb_.w = cvtpk((XV)[14], (XV)[15]); \
            s16x4 t_[8]; lds_read_vt8((unsigned)(size_t)(vbase), t_); \
            const bf16x8 pfa_ = __builtin_bit_cast(bf16x8, pa_), pfb_ = __builtin_bit_cast(bf16x8, pb_); \
            o0 = MFMA32(__builtin_shufflevector(t_[0], t_[1], 0, 1, 2, 3, 4, 5, 6, 7), pfa_, o0); o1 = MFMA32(__builtin_shufflevector(t_[2], t_[3], 0, 1, 2, 3, 4, 5, 6, 7), pfa_, o1); \
            o0 = MFMA32(__builtin_shufflevector(t_[4], t_[5], 0, 1, 2, 3, 4, 5, 6, 7), pfb_, o0); o1 = MFMA32(__builtin_shufflevector(t_[6], t_[7], 0, 1, 2, 3, 4, 5, 6, 7), pfb_, o1); } while (0)
        if (type == 1) { const float* rp = inp(F, I_RPB) + ((size_t)l * 8 + h) * 465;
            for (int i = tid; i < 17 * 32; i += NTHR) { const int tr = i >> 5, tc = i & 31; rpbl[i] = (tr >= 1 && tr <= 15 && tc < 31) ? rp[(tr - 1) * 31 + tc] * LOG2E : -1e30f; } }
        A_STAGE_LOAD(0); A_STAGE_WRITE(0);
        __syncthreads();
        const LAS unsigned char* ldsl = F.ldsl;
        const int kro = r * AK_RS + 16 * hh;
        const int vro = (4 * hh + ((r & 15) >> 2)) * AV_RS + (16 * (r >> 4) + 4 * (r & 3)) * 2;
        const int krw = kro + kst * AK_RS, vrw = vro + kst * AV_RS;
        const int rqa = 4 * rg + 2 * (wave >> 2), rsa = rqa - 4 < 0 ? 0 : (rqa - 4 > 24 ? 24 : rqa - 4), rsb = rqa - 3 < 0 ? 0 : (rqa - 3 > 24 ? 24 : rqa - 3);
        const int nT = (nt + 1) >> 1;
#pragma unroll 1
        for (int T = 0; T < nT; ++T) {
            const int st = T & 1;
            if (VAR != 1) { if (T + 1 < nT) A_STAGE_LOAD(T + 1); }
            const LAS unsigned char* Kst = ldsl + st * ASTAGE; const LAS unsigned char* Vst = Kst + AK_BYTES;
            const bool vB = 2 * T + 1 < nt;
            const int jA = loc0 + 2 * T - 4, jB = jA + 1;
            if (VAR == 2) { } else
            if (T >= 2 && type == 1) {
                const bool nA = (jA >= rsa && jA <= rsb + 7), nB = vB && (jB >= rsa && jB <= rsb + 7);
                if (nA || nB) {
                    f32x16 x0, x1;
                    if (nA) { A_QK(x0, Kst + krw); const LAS unsigned char* tb = ldsl + A_RPB_OFF + ((jA >= rsl && jA <= rsl + 7) ? (jA - rq + 8) : 0) * 128;
#pragma unroll
                        for (int i = 0; i < 16; ++i) x0[i] += *(const LAS float*)(tb + BIX(i)); } else A_NEG(x0);
                    if (nB) { A_QK(x1, Kst + krw + 64 * AK_RS); const LAS unsigned char* tb = ldsl + A_RPB_OFF + ((jB >= rsl && jB <= rsl + 7) ? (jB - rq + 8) : 0) * 128;
#pragma unroll
                        for (int i = 0; i < 16; ++i) x1[i] += *(const LAS float*)(tb + BIX(i)); } else A_NEG(x1);
                    const float mt = rowmax32(x0, x1);
                    if (__any(mt > 8.0f)) {
                        const float dl = fmaxf(mt, 0.f), alpha = __builtin_amdgcn_exp2f(-dl);
                        m += dl; lsum *= alpha;
#pragma unroll
                        for (int i = 0; i < 16; ++i) { x0[i] -= dl; x1[i] -= dl; o0[i] *= alpha; o1[i] *= alpha; }
                    }
                    float ps = 0.f;
                    if (nA) {
#pragma unroll
                        for (int i = 0; i < 16; ++i) { x0[i] = __builtin_amdgcn_exp2f(x0[i]); ps += x0[i]; }
                        A_PV(x0, Vst + vrw); }
                    if (nB) {
#pragma unroll
                        for (int i = 0; i < 16; ++i) { x1[i] = __builtin_amdgcn_exp2f(x1[i]); ps += x1[i]; }
                        A_PV(x1, Vst + vrw + 64 * AV_RS); }
                    lsum += ps;
                }
            } else {
#pragma unroll
                for (int bi = 0; bi < 2; ++bi) {
                    if (bi == 1 && !vB) break;
                    const int j = jA + bi;
                    bool need = true, mask = false; int vlo = -1, vhi = 64;
                    if (T >= 2) { const int q0 = 32 * (wave & 3); need = (64 * j + 63 >= q0) && (64 * j <= q0 + 287); mask = !((64 * j >= q0 + 31) && (64 * j + 63 <= q0 + 256)); const int qi = q0 + (lane_id() & 31); vlo = qi - 64 * j; vhi = qi + 256 - 64 * j; }
                    if (need) {
                        f32x16 x0, x1;
                        A_QK2(x0, x1, Kst + kro + bi * 64 * AK_RS);
                        if (mask) {
#pragma unroll
                            for (int i = 0; i < 16; ++i) { const int k0 = (i & 3) + 8 * (i >> 2) + 4 * hh, k1 = k0 + 32; x0[i] = (k0 >= vlo && k0 <= vhi) ? x0[i] : -1e30f; x1[i] = (k1 >= vlo && k1 <= vhi) ? x1[i] : -1e30f; }
                        }
                        const float mt = rowmax32(x0, x1);
                        const bool fst = !sw && T == 0 && bi == 0;
                        if (fst || __any(mt > 8.0f)) {
                            const float dl = fst ? mt : fmaxf(mt, 0.f), alpha = fst ? 1.f : __builtin_amdgcn_exp2f(-dl);
                            m += dl; lsum *= alpha;
#pragma unroll
                            for (int i = 0; i < 16; ++i) { x0[i] -= dl; x1[i] -= dl; o0[i] *= alpha; o1[i] *= alpha; }
                        }
                        float ps = 0.f;
#pragma unroll
                        for (int i = 0; i < 16; ++i) { x0[i] = __builtin_amdgcn_exp2f(x0[i]); ps += x0[i]; }
                        A_PV(x0, Vst + vro + bi * 64 * AV_RS);
#pragma unroll
                        for (int i = 0; i < 16; ++i) { x1[i] = __builtin_amdgcn_exp2f(x1[i]); ps += x1[i]; }
                        lsum += ps;
                        A_PV(x1, Vst + vro + (bi * 64 + 32) * AV_RS);
                    }
                }
            }
            if (VAR != 1) { if (T + 1 < nT) A_STAGE_WRITE(st ^ 1); }
            __syncthreads();
        }
#undef A_QK
#undef A_QK2
#undef A_NEG
#undef A_PV
#undef BIX
        const float inv = 1.0f / (lsum + __shfl_xor(lsum, 32));
        const int l2 = lane_id(), r2 = l2 & 31, h2 = l2 >> 5;
        const int rq2 = 4 * rg + 2 * (wave >> 2) + (r2 >> 4), cq2 = 16 * (wave & 3) + (r2 & 15);
        const int qrow2 = (type == 1) ? bl * SEQ + 64 * rq2 + cq2 : (type == 0) ? bl * SEQ + 128 * n + 32 * (wave & 3) + r2 : LROWS + bl * CTX + 32 * wave + r2;
        bf16* op = ob + (size_t)qrow2 * OW + ocol + 4 * h2;
#pragma unroll
        for (int g = 0; g < 4; ++g) {
            u32x2 w0, w1; w0.x = cvtpk(o0[4 * g] * inv, o0[4 * g + 1] * inv); w0.y = cvtpk(o0[4 * g + 2] * inv, o0[4 * g + 3] * inv);
            w1.x = cvtpk(o1[4 * g] * inv, o1[4 * g + 1] * inv); w1.y = cvtpk(o1[4 * g + 2] * inv, o1[4 * g + 3] * inv);
            *(u32x2*)(op + 8 * g) = w0; *(u32x2*)(op + 32 + 8 * g) = w1;
        }
    }
#undef A_TILE_ROW0
#undef A_STAGE_LOAD
#undef A_STAGE_WRITE
}
template <int VAR>
__device__ __forceinline__ void attn_phase(Frame& F, int l, int ch, bool last, bf16* ob) {
    { const int tid = F.wave * 64 + launder(lane_id()); const f32x2* tab = (const f32x2*)(F.ws + WS_ROPE);
      f32x2* rl = (f32x2*)(F.lds + A_ROPE_OFF); for (int i = tid; i < 96 * 16; i += NTHR) { const int a = i >> 4, f = i & 15; rl[i] = (a < 32) ? tab[(size_t)(a * 64) * 32 + f] : tab[(size_t)(a - 32) * 32 + 16 + f]; } }
    __syncthreads();
    attn_units<VAR, 1>(F, l, ch, last, ob);
    attn_units<VAR, 0>(F, l, ch, last, ob);
    attn_units<VAR, 2>(F, l, ch, last, ob);
}


template <int NPL>
__device__ __forceinline__ void topk_select_wave(const float* aff, int cap, int crbase, int ubase, int slot0, int e, int* tokslot, float* gatev, int* seltok, int lane) {
    unsigned v[NPL];
#pragma unroll
    for (int i = 0; i < NPL; i += 4) { const u32x4 t = *(const u32x4*)(aff + lane * NPL + i); v[i] = t.x; v[i + 1] = t.y; v[i + 2] = t.z; v[i + 3] = t.w; }
    unsigned T = 0u;
#pragma unroll 1
    for (int bit = 30; bit >= 0; --bit) {
        const unsigned cand = T | (1u << bit); int c = 0;
#pragma unroll
        for (int i = 0; i < NPL; ++i) c += (v[i] >= cand) ? 1 : 0;
#pragma unroll
        for (int o = 1; o < 64; o <<= 1) c += __shfl_xor(c, o);
        if (c >= cap) T = cand;
    }
    int ngt = 0, nti = 0;
#pragma unroll
    for (int i = 0; i < NPL; ++i) { ngt += (v[i] > T) ? 1 : 0; nti += (v[i] == T) ? 1 : 0; }
    int tot_gt = ngt;
#pragma unroll
    for (int o = 1; o < 64; o <<= 1) tot_gt += __shfl_xor(tot_gt, o);
    const int need = cap - tot_gt;
    int tinc = nti;
#pragma unroll
    for (int o = 1; o < 64; o <<= 1) { const int t = __shfl_up(tinc, o); if (lane >= o) tinc += t; }
    int tie_before = tinc - nti;
    unsigned selmask = 0u; int nsel = 0;
#pragma unroll
    for (int i = 0; i < NPL; ++i) { const bool tie = (v[i] == T); const bool sel = (v[i] > T) || (tie && tie_before < need); tie_before += tie ? 1 : 0; selmask |= sel ? (1u << i) : 0u; nsel += sel ? 1 : 0; }
    int sinc = nsel;
#pragma unroll
    for (int o = 1; o < 64; o <<= 1) { const int t = __shfl_up(sinc, o); if (lane >= o) sinc += t; }
    int pos = sinc - nsel;
#pragma unroll
    for (int i = 0; i < NPL; ++i) {
        const bool sel = (selmask >> i) & 1u; const int t = lane * NPL + i;
        tokslot[(size_t)(crbase + t) * NE + e] = sel ? pos : -1;
        if (sel) { seltok[slot0 + pos] = ubase + crbase + t; gatev[slot0 + pos] = __builtin_bit_cast(float, v[i]); ++pos; }
    }
}
__device__ __forceinline__ void topk_phase(Frame& F, bool last) {
    const int lane = launder(lane_id());
    int* gsel = (int*)(F.ws + WS_SELTOK);
    float* gatev = (float*)(F.ws + WS_GATEV);
    const bool cx = !last;
    for (int p = F.vcu; p < BC * NE; p += F.G) {
        const int bl = p / NE, e = p % NE;
        const int slotL = p * CAP_L, slotC0 = SLOT_CT0 + e * (NB * CAP_C) + bl * CAP_C, slotC1 = slotC0 + BC * CAP_C;
        if (F.wave == 0) topk_select_wave<32>(affl_of(F, 0) + (size_t)p * SEQ, CAP_L, bl * SEQ, 0, slotL, e, tokslot_of(F, 0), gatev, gsel, lane);
        else if (F.wave == 3) topk_select_wave<32>(affl_of(F, 1) + (size_t)p * SEQ, CAP_L, bl * SEQ, RCMAX, NSLOTMAX + slotL, e, tokslot_of(F, 1), gatev, gsel, lane);
        else if (F.wave == 1 && cx) topk_select_wave<4>((const float*)(F.ws + WS_AFFC) + (size_t)p * CTX, CAP_C, LROWS + bl * CTX, 0, slotC0, e, tokslot_of(F, 0), gatev, gsel, lane);
        else if (F.wave == 2 && cx) topk_select_wave<4>((const float*)(F.ws + WS_AFFC) + (size_t)(p + BC * NE) * CTX, CAP_C, LROWS + (bl + BC) * CTX, 0, slotC1, e, tokslot_of(F, 0), gatev, gsel, lane);
    }
}

__device__ __forceinline__ void combine_phase(Frame& F, int l, int ch, bool last, bool dry = false) {
    const int lane = launder(lane_id()), tid = F.wave * 64 + lane; (void)tid; (void)lane;
    const int gw = F.vcu * NWAVES + F.wave, NGW = F.G * NWAVES;
    const int nrows = last ? LROWS : nrows_of(ch);
    const bf16* yb = (const bf16*)(F.ws + WS_YBUF) + (size_t)ch * NSLOTMAX * D; const int* tokslot = tokslot_of(F, ch); const float* gatev = (const float*)(F.ws + WS_GATEV) + (size_t)ch * NSLOTMAX;
    u32x2 xq[2][4], yqa[2][4], yqb[2][4]; float gaq[2], gbq[2]; int slq[2]; unsigned mrq[2]; bool anyq[2], twoq[2];
#define CB_ISSUE(u_, c_) do { const int c__ = (c_); const bool lat_ = c__ < LROWS; const int bl_ = lat_ ? c__ / SEQ : (c__ - LROWS) / CTX; \
        const int sh_ = sll[(c__ - rbeg) * NE + (lane & 15)]; const int my_ = (lane < 16) ? sh_ : -1; slq[u_] = my_; \
        unsigned m_ = (unsigned)__ballot(my_ >= 0) & 0xFFFFu; const bool any_ = m_ != 0u; const int e0_ = any_ ? __builtin_ctz(m_) : 0; m_ &= m_ - 1u; \
        const bool two_ = m_ != 0u; const int e1_ = two_ ? __builtin_ctz(m_) : e0_; if (two_) m_ &= m_ - 1u; \
        const int p0_ = any_ ? __shfl(my_, e0_) : 0, p1_ = two_ ? __shfl(my_, e1_) : p0_; \
        const int s0_ = lat_ ? (bl_ * NE + e0_) * CAP_L + p0_ : SLOT_CT0 + e0_ * (NB * CAP_C) + bl_ * CAP_C + p0_; \
        const int s1_ = lat_ ? (bl_ * NE + e1_) * CAP_L + p1_ : SLOT_CT0 + e1_ * (NB * CAP_C) + bl_ * CAP_C + p1_; \
        anyq[u_] = any_; twoq[u_] = two_; mrq[u_] = m_; gaq[u_] = gatev[s0_]; gbq[u_] = gatev[s1_]; const bf16* xb_ = xbrow(F, ch, c__); \
        _Pragma("unroll") for (int j_ = 0; j_ < 4; ++j_) { xq[u_][j_] = *(const u32x2*)(xb_ + lane * 4 + 256 * j_); \
            yqa[u_][j_] = *(const u32x2*)(yb + (size_t)s0_ * D + lane * 4 + 256 * j_); yqb[u_][j_] = *(const u32x2*)(yb + (size_t)s1_ * D + lane * 4 + 256 * j_); } } while (0)
    const int rpw = (((nrows + NGW - 1) / NGW) + 1) & ~1, rbeg = gw * rpw, rend = (rbeg + rpw < nrows) ? rbeg + rpw : nrows;
    f32x4 gtq[4], shq[4], scq[4], gmq[4]; int cmv = -1;
#pragma unroll
    for (int j = 0; j < 4; ++j) gmq[j] = *(const f32x4*)((last ? inp(F, I_GFINAL) : inp(F, I_GMIX) + (size_t)(l + 1) * D) + lane * 4 + 256 * j);
    if (rbeg >= rend) return;
    LAS int* sll = (LAS int*)(F.ldsl + LDSCTL_OFF + 1024 + F.wave * 1536);
    for (int i = lane; i < (rend - rbeg) * NE; i += 64) sll[i] = tokslot[(size_t)rbeg * NE + i];
    CB_ISSUE(0, rbeg); CB_ISSUE(1, rbeg + 1);
    unsigned res[2][16];
#define CB_STORE(cp_) do { _Pragma("unroll") for (int u_ = 0; u_ < 2; ++u_) { const int cq_ = (cp_) + u_; \
        if (!last) { bf16* xb_ = dry ? (bf16*)(F.ws + WS_OBUF) + (size_t)cq_ * D : xbrow(F, ch, cq_); bf16* hb_ = (dry ? (bf16*)(F.ws + WS_OBUF + 160 * MiB) : hbuf_of(F, ch)) + (size_t)cq_ * D; \
            _Pragma("unroll") for (int j_ = 0; j_ < 4; ++j_) { u32x2 o_; o_.x = res[u_][4 * j_]; o_.y = res[u_][4 * j_ + 1]; __builtin_nontemporal_store(o_, (u32x2*)(xb_ + lane * 4 + 256 * j_)); \
                u32x2 h_; h_.x = res[u_][4 * j_ + 2]; h_.y = res[u_][4 * j_ + 3]; __builtin_nontemporal_store(h_, (u32x2*)(hb_ + lane * 4 + 256 * j_)); } } \
        else { float* xr_ = dry ? (float*)(F.ws + WS_OBUF) + (size_t)cq_ * D : F.out + ((size_t)ch * LROWS + cq_) * D;     \
            _Pragma("unroll") for (int j_ = 0; j_ < 4; ++j_) { f32x4 o_; o_.x = __builtin_bit_cast(float, res[u_][4 * j_]); o_.y = __builtin_bit_cast(float, res[u_][4 * j_ + 1]); o_.z = __builtin_bit_cast(float, res[u_][4 * j_ + 2]); o_.w = __builtin_bit_cast(float, res[u_][4 * j_ + 3]); \
                __builtin_nontemporal_store(o_, (f32x4*)(xr_ + lane * 4 + 256 * j_)); } } } } while (0)
    for (int c0 = rbeg; c0 < rend; c0 += 2) {
        int myslot[2]; unsigned mask[2]; f32x4 v[2][4]; float acc[2][16];
#pragma unroll
        for (int u = 0; u < 2; ++u) { myslot[u] = slq[u]; mask[u] = mrq[u];
            const float ga = anyq[u] ? gaq[u] : 0.f, gb = twoq[u] ? gbq[u] : 0.f;
#pragma unroll
            for (int j = 0; j < 4; ++j) { const u32x2 t = xq[u][j]; v[u][j].x = bflo(t.x); v[u][j].y = bfhi(t.x); v[u][j].z = bflo(t.y); v[u][j].w = bfhi(t.y);
                const u32x2 a = yqa[u][j], b = yqb[u][j];
                acc[u][4 * j] = ga * bflo(a.x); acc[u][4 * j + 1] = ga * bfhi(a.x); acc[u][4 * j + 2] = ga * bflo(a.y); acc[u][4 * j + 3] = ga * bfhi(a.y);
                acc[u][4 * j] += gb * bflo(b.x); acc[u][4 * j + 1] += gb * bfhi(b.x); acc[u][4 * j + 2] += gb * bflo(b.y); acc[u][4 * j + 3] += gb * bfhi(b.y); }
#pragma unroll
            for (int j = 0; j < 4; ++j) asm volatile("" : "+v"(v[u][j].x), "+v"(v[u][j].y), "+v"(v[u][j].z), "+v"(v[u][j].w), "+v"(acc[u][4 * j]), "+v"(acc[u][4 * j + 1]), "+v"(acc[u][4 * j + 2]), "+v"(acc[u][4 * j + 3]) :: "memory");
        }
        if (c0 > rbeg) CB_STORE(c0 - 2);
        if (c0 + 2 < rend) { CB_ISSUE(0, c0 + 2); CB_ISSUE(1, c0 + 3); }
#pragma unroll
      for (int u = 0; u < 2; ++u) {
        const int cr = c0 + u;
        const bool lat = cr < LROWS; const int bl = lat ? cr / SEQ : (cr - LROWS) / CTX;
        { const int mv = mv_of(ch, cr); if (mv != cmv) { cmv = mv; const float* gt = mod_ptr(F, l, mv, 5); const float* sh = mod_ptr(F, last ? l : l + 1, mv, 0); const float* sc = mod_ptr(F, last ? l : l + 1, mv, 1);
#pragma unroll
            for (int j = 0; j < 4; ++j) { gtq[j] = *(const f32x4*)(gt + lane * 4 + 256 * j); shq[j] = *(const f32x4*)(sh + lane * 4 + 256 * j); scq[j] = *(const f32x4*)(sc + lane * 4 + 256 * j); } } }
        unsigned mk = mask[u];
        while (mk) {
            const int e0 = __builtin_ctz(mk); mk &= mk - 1;
            const bool two = mk != 0u; const int e1 = two ? __builtin_ctz(mk) : e0; if (two) mk &= mk - 1;
            const int p0 = __shfl(myslot[u], e0), p1 = __shfl(myslot[u], e1);
            const int s0 = lat ? (bl * NE + e0) * CAP_L + p0 : SLOT_CT0 + e0 * (NB * CAP_C) + bl * CAP_C + p0;
            const int s1 = lat ? (bl * NE + e1) * CAP_L + p1 : SLOT_CT0 + e1 * (NB * CAP_C) + bl * CAP_C + p1;
            u32x2 ua[4], ub[4]; const float ga = gatev[s0], gb = gatev[s1];
#pragma unroll
            for (int j = 0; j < 4; ++j) { ua[j] = *(const u32x2*)(yb + (size_t)s0 * D + lane * 4 + 256 * j); ub[j] = *(const u32x2*)(yb + (size_t)s1 * D + lane * 4 + 256 * j); }
#pragma unroll
            for (int j = 0; j < 4; ++j) { acc[u][4 * j] += ga * bflo(ua[j].x); acc[u][4 * j + 1] += ga * bfhi(ua[j].x); acc[u][4 * j + 2] += ga * bflo(ua[j].y); acc[u][4 * j + 3] += ga * bfhi(ua[j].y); }
            if (two) {
#pragma unroll
                for (int j = 0; j < 4; ++j) { acc[u][4 * j] += gb * bflo(ub[j].x); acc[u][4 * j + 1] += gb * bfhi(ub[j].x); acc[u][4 * j + 2] += gb * bflo(ub[j].y); acc[u][4 * j + 3] += gb * bfhi(ub[j].y); }
            }
        }
        float ss = 0.f;
#pragma unroll
        for (int j = 0; j < 4; ++j) { const f32x4 g4 = gtq[j];
            v[u][j].x += g4.x * acc[u][4 * j]; v[u][j].y += g4.y * acc[u][4 * j + 1]; v[u][j].z += g4.z * acc[u][4 * j + 2]; v[u][j].w += g4.w * acc[u][4 * j + 3];
            ss += (v[u][j].x * v[u][j].x + v[u][j].y * v[u][j].y) + (v[u][j].z * v[u][j].z + v[u][j].w * v[u][j].w); }
        const float rstd = 1.0f / sqrtf(wave_sum(ss) * (1.0f / D) + RMS_EPS);
        if (!last) {
#pragma unroll
            for (int j = 0; j < 4; ++j) {
                const f32x4 hv = (v[u][j] * rstd * gmq[j]) * (scq[j] + 1.0f) + shq[j];
                res[u][4 * j] = pk2(v[u][j].x, v[u][j].y); res[u][4 * j + 1] = pk2(v[u][j].z, v[u][j].w); res[u][4 * j + 2] = pk2(hv.x, hv.y); res[u][4 * j + 3] = pk2(hv.z, hv.w);
            }
            continue;
        }
        {
            float scl = 1.0f;
#if defined(PROBE_ATTN)
            { const unsigned cn = __hip_atomic_load((unsigned*)(F.ws + WS_CTL) + CW_DIAG, __ATOMIC_RELAXED, __HIP_MEMORY_SCOPE_AGENT); scl = 1.0f + 0.02f * log2f(1.0f + (float)cn); }
#endif
#pragma unroll
            for (int j = 0; j < 4; ++j) { const f32x4 o = v[u][j] * rstd * gmq[j] * scl; const float ox = o.x, oy = o.y, oz = o.z, ow = o.w;
                res[u][4 * j] = __builtin_bit_cast(unsigned, ox); res[u][4 * j + 1] = __builtin_bit_cast(unsigned, oy); res[u][4 * j + 2] = __builtin_bit_cast(unsigned, oz); res[u][4 * j + 3] = __builtin_bit_cast(unsigned, ow); }
        }
      }
    }
    CB_STORE(rend - 2);
#undef CB_STORE
#undef CB_ISSUE
}

using pg8::Unit; using pg8::cvt_pk_bf16;
struct SchedBase { int nM, nN, G, c, rep;
    __device__ __forceinline__ bool tile(int i, int& pm, int& pn, int& sub) const { sub = i % rep; return pg8::tile_of((long)(i / rep) * G + c, nM, nN, pm, pn); } };

struct SchedIn : SchedBase { const char* A; const char* B; int nMfull = 0, kvM = 0;
    __device__ __forceinline__ bool next(int i, Unit& u) const { int sub; u.aux = 0; u.pad = 0;
        if (!tile(i, u.pm, u.pn, sub)) {
            const long L = (long)(i / rep) * G + c - (long)nM * nN; if (kvM == 0 || L < 0 || L >= (long)kvM * 5) return false;
            const int q = (int)L % 5; u.pm = nM + (int)L / 5; u.pn = q < 4 ? 8 + q : 14; }
        u.A = A + (size_t)u.pm * 256 * D * 2; u.B = B + (size_t)u.pn * 256 * D * 2; return true; } };
__device__ __forceinline__ size_t gb_off(int pm, int g, int wr, int wc, int fr, int fq) { return ((size_t)(pm * 12 + g) * 131072) + (size_t)(((wr * 4 + wc) * 64 + fq * 16 + fr) * 16); }
struct EpiStoreBf16 { static constexpr bool PERM = true; bf16* O; int ldc; unsigned char* GB;
    __device__ __forceinline__ void operator()(const f32x4 (&acc)[2][2][4][2], const Unit& u, int wr, int wc, int fr, int fq) const {
        if (u.pn >= Z_G / 256) {
            unsigned char* gp = GB + gb_off(u.pm, u.pn - Z_G / 256, wr, wc, fr, fq);
#pragma unroll
            for (int ai = 0; ai < 2; ++ai)
#pragma unroll
                for (int m = 0; m < 4; ++m)
#pragma unroll
                    for (int bj = 0; bj < 2; ++bj) { f32x4 v0 = acc[ai][bj][m][0], v1 = acc[ai][bj][m][1];
#pragma unroll
                        for (int j = 0; j < 4; ++j) { v0[j] = 1.0f + __builtin_amdgcn_exp2f(__builtin_amdgcn_fmed3f(v0[j], -1000.0f, 100.0f)); v1[j] = 1.0f + __builtin_amdgcn_exp2f(__builtin_amdgcn_fmed3f(v1[j], -1000.0f, 100.0f)); }
                        u32x4 w; w.x = cvt_pk_bf16(v0[0], v0[1]); w.y = cvt_pk_bf16(v0[2], v0[3]); w.z = cvt_pk_bf16(v1[0], v1[1]); w.w = cvt_pk_bf16(v1[2], v1[3]);
                        __builtin_nontemporal_store(w, (u32x4*)(gp + ((ai * 4 + m) * 2 + bj) * 8192)); }
        } else {
            const int row0 = u.pm * 256 + wr * 64 + fr, col0 = u.pn * 256 + wc * 32 + 8 * fq;
#pragma unroll
            for (int ai = 0; ai < 2; ++ai)
#pragma unroll
                for (int m = 0; m < 4; ++m) { bf16* rowp = O + (size_t)(row0 + ai * 128 + m * 16) * ldc + col0;
#pragma unroll
                    for (int bj = 0; bj < 2; ++bj) { const f32x4 v0 = acc[ai][bj][m][0], v1 = acc[ai][bj][m][1];
                        u32x4 w; w.x = cvt_pk_bf16(v0[0], v0[1]); w.y = cvt_pk_bf16(v0[2], v0[3]); w.z = cvt_pk_bf16(v1[0], v1[1]); w.w = cvt_pk_bf16(v1[2], v1[3]);
                        __builtin_nontemporal_store(w, (u32x4*)(rowp + bj * 128)); } }
        }
    } };

struct SchedMerge : SchedBase { const char* A; const char* B;
    __device__ __forceinline__ bool next(int i, Unit& u) const { int sub; if (!tile(i, u.pm, u.pn, sub)) return false; u.aux = 0; u.pad = 0;
        u.A = A + (size_t)u.pm * 256 * OW * 2; u.B = B + (size_t)u.pn * 256 * 1536 * 2; return true; } };
__device__ __forceinline__ void gate_load8x2(const unsigned char* sbase, unsigned vo, u32x4 (&a)[8], u32x4 (&b)[8]) {
    unsigned t0, t1, t2, t3;
    asm volatile("v_add_u32 %[t0], 0, %[vo]\n\tglobal_load_dwordx4 %[a0], %[t0], %[sb]\n\t"
        "v_add_u32 %[t2], 524288, %[vo]\n\tglobal_load_dwordx4 %[b0], %[t2], %[sb]\n\t"
        "v_add_u32 %[t1], 8192, %[vo]\n\tglobal_load_dwordx4 %[a1], %[t1], %[sb]\n\t"
        "v_add_u32 %[t3], 532480, %[vo]\n\tglobal_load_dwordx4 %[b1], %[t3], %[sb]\n\t"
        "v_add_u32 %[t0], 16384, %[vo]\n\tglobal_load_dwordx4 %[a2], %[t0], %[sb]\n\t"
        "v_add_u32 %[t2], 540672, %[vo]\n\tglobal_load_dwordx4 %[b2], %[t2], %[sb]\n\t"
        "v_add_u32 %[t1], 24576, %[vo]\n\tglobal_load_dwordx4 %[a3], %[t1], %[sb]\n\t"
        "v_add_u32 %[t3], 548864, %[vo]\n\tglobal_load_dwordx4 %[b3], %[t3], %[sb]\n\t"
        "v_add_u32 %[t0], 32768, %[vo]\n\tglobal_load_dwordx4 %[a4], %[t0], %[sb]\n\t"
        "v_add_u32 %[t2], 557056, %[vo]\n\tglobal_load_dwordx4 %[b4], %[t2], %[sb]\n\t"
        "v_add_u32 %[t1], 40960, %[vo]\n\tglobal_load_dwordx4 %[a5], %[t1], %[sb]\n\t"
        "v_add_u32 %[t3], 565248, %[vo]\n\tglobal_load_dwordx4 %[b5], %[t3], %[sb]\n\t"
        "v_add_u32 %[t0], 49152, %[vo]\n\tglobal_load_dwordx4 %[a6], %[t0], %[sb]\n\t"
        "v_add_u32 %[t2], 573440, %[vo]\n\tglobal_load_dwordx4 %[b6], %[t2], %[sb]\n\t"
        "v_add_u32 %[t1], 57344, %[vo]\n\tglobal_load_dwordx4 %[a7], %[t1], %[sb]\n\t"
        "v_add_u32 %[t3], 581632, %[vo]\n\tglobal_load_dwordx4 %[b7], %[t3], %[sb]\n\t"
        "s_waitcnt vmcnt(0)"
        : [a0]"=&v"(a[0]), [a1]"=&v"(a[1]), [a2]"=&v"(a[2]), [a3]"=&v"(a[3]), [a4]"=&v"(a[4]), [a5]"=&v"(a[5]), [a6]"=&v"(a[6]), [a7]"=&v"(a[7]), [b0]"=&v"(b[0]), [b1]"=&v"(b[1]), [b2]"=&v"(b[2]), [b3]"=&v"(b[3]), [b4]"=&v"(b[4]), [b5]"=&v"(b[5]), [b6]"=&v"(b[6]), [b7]"=&v"(b[7]), [t0]"=&v"(t0), [t1]"=&v"(t1), [t2]"=&v"(t2), [t3]"=&v"(t3)
        : [vo]"v"(vo), [sb]"s"(sbase) : "memory");
}
__device__ __forceinline__ void gate_load16(const unsigned char* sbase, unsigned vo, u32x4 (&a)[16]) {
    unsigned t0, t1;
    asm volatile("v_add_u32 %[t0], 0, %[vo]\n\tglobal_load_dwordx4 %[a0], %[t0], %[sb]\n\t"
        "v_add_u32 %[t1], 8192, %[vo]\n\tglobal_load_dwordx4 %[a1], %[t1], %[sb]\n\t"
        "v_add_u32 %[t0], 16384, %[vo]\n\tglobal_load_dwordx4 %[a2], %[t0], %[sb]\n\t"
        "v_add_u32 %[t1], 24576, %[vo]\n\tglobal_load_dwordx4 %[a3], %[t1], %[sb]\n\t"
        "v_add_u32 %[t0], 32768, %[vo]\n\tglobal_load_dwordx4 %[a4], %[t0], %[sb]\n\t"
        "v_add_u32 %[t1], 40960, %[vo]\n\tglobal_load_dwordx4 %[a5], %[t1], %[sb]\n\t"
        "v_add_u32 %[t0], 49152, %[vo]\n\tglobal_load_dwordx4 %[a6], %[t0], %[sb]\n\t"
        "v_add_u32 %[t1], 57344, %[vo]\n\tglobal_load_dwordx4 %[a7], %[t1], %[sb]\n\t"
        "v_add_u32 %[t0], 65536, %[vo]\n\tglobal_load_dwordx4 %[a8], %[t0], %[sb]\n\t"
        "v_add_u32 %[t1], 73728, %[vo]\n\tglobal_load_dwordx4 %[a9], %[t1], %[sb]\n\t"
        "v_add_u32 %[t0], 81920, %[vo]\n\tglobal_load_dwordx4 %[a10], %[t0], %[sb]\n\t"
        "v_add_u32 %[t1], 90112, %[vo]\n\tglobal_load_dwordx4 %[a11], %[t1], %[sb]\n\t"
        "v_add_u32 %[t0], 98304, %[vo]\n\tglobal_load_dwordx4 %[a12], %[t0], %[sb]\n\t"
        "v_add_u32 %[t1], 106496, %[vo]\n\tglobal_load_dwordx4 %[a13], %[t1], %[sb]\n\t"
        "v_add_u32 %[t0], 114688, %[vo]\n\tglobal_load_dwordx4 %[a14], %[t0], %[sb]\n\t"
        "v_add_u32 %[t1], 122880, %[vo]\n\tglobal_load_dwordx4 %[a15], %[t1], %[sb]\n\t"
        "s_waitcnt vmcnt(0)"
        : [a0]"=&v"(a[0]), [a1]"=&v"(a[1]), [a2]"=&v"(a[2]), [a3]"=&v"(a[3]), [a4]"=&v"(a[4]), [a5]"=&v"(a[5]), [a6]"=&v"(a[6]), [a7]"=&v"(a[7]), [a8]"=&v"(a[8]), [a9]"=&v"(a[9]), [a10]"=&v"(a[10]), [a11]"=&v"(a[11]), [a12]"=&v"(a[12]), [a13]"=&v"(a[13]), [a14]"=&v"(a[14]), [a15]"=&v"(a[15]), [t0]"=&v"(t0), [t1]"=&v"(t1)
        : [vo]"v"(vo), [sb]"s"(sbase) : "memory");
}
__device__ __forceinline__ void gate_issue4x2(const unsigned char* sbase, unsigned vo, u32x4 (&a)[4], u32x4 (&b)[4]) {
    unsigned t0, t1, t2, t3;
    asm volatile("v_add_u32 %[t0], 0, %[vo]\n\tglobal_load_dwordx4 %[a0], %[t0], %[sb]\n\t"
        "v_add_u32 %[t2], 524288, %[vo]\n\tglobal_load_dwordx4 %[b0], %[t2], %[sb]\n\t"
        "v_add_u32 %[t1], 8192, %[vo]\n\tglobal_load_dwordx4 %[a1], %[t1], %[sb]\n\t"
        "v_add_u32 %[t3], 532480, %[vo]\n\tglobal_load_dwordx4 %[b1], %[t3], %[sb]\n\t"
        "v_add_u32 %[t0], 16384, %[vo]\n\tglobal_load_dwordx4 %[a2], %[t0], %[sb]\n\t"
        "v_add_u32 %[t2], 540672, %[vo]\n\tglobal_load_dwordx4 %[b2], %[t2], %[sb]\n\t"
        "v_add_u32 %[t1], 24576, %[vo]\n\tglobal_load_dwordx4 %[a3], %[t1], %[sb]\n\t"
        "v_add_u32 %[t3], 548864, %[vo]\n\tglobal_load_dwordx4 %[b3], %[t3], %[sb]"
        : [a0]"=&v"(a[0]), [a1]"=&v"(a[1]), [a2]"=&v"(a[2]), [a3]"=&v"(a[3]), [b0]"=&v"(b[0]), [b1]"=&v"(b[1]), [b2]"=&v"(b[2]), [b3]"=&v"(b[3]), [t0]"=&v"(t0), [t1]"=&v"(t1), [t2]"=&v"(t2), [t3]"=&v"(t3)
        : [vo]"v"(vo), [sb]"s"(sbase) : "memory");
}
#define GATE_WAIT4X2(cnt, a, b) asm volatile("s_waitcnt vmcnt(" #cnt ")" : "+v"(a[0]), "+v"(a[1]), "+v"(a[2]), "+v"(a[3]), "+v"(b[0]), "+v"(b[1]), "+v"(b[2]), "+v"(b[3]) :: "memory")
struct EpiMerge { static constexpr bool PERM = true; const unsigned char* GB; bf16* O;
    __device__ __forceinline__ void mid(f32x4 (&acc)[2][2][4][2], const Unit& u, int seg, int wr, int wc, int fr, int fq) const {
        const unsigned char* tb = GB + (size_t)(u.pm * 12 + (seg - 1) * 4 + u.pn) * 131072;
        const unsigned vo = (unsigned)(((wr * 4 + wc) * 64 + fq * 16 + fr) * 16);
#define EM_SCALE(AI, M, A_, B_, K_) do { _Pragma("unroll") for (int bj = 0; bj < 2; ++bj) { float gpv[8], gnv[8]; unpack8(A_[(K_) + bj], gpv); unpack8(B_[(K_) + bj], gnv); \
            _Pragma("unroll") for (int j = 0; j < 4; ++j) { acc[AI][bj][M][0][j] *= gnv[j] * __builtin_amdgcn_rcpf(gpv[j]); acc[AI][bj][M][1][j] *= gnv[4 + j] * __builtin_amdgcn_rcpf(gpv[4 + j]); } } \
            asm volatile("" : "+v"(acc[AI][0][M][0]), "+v"(acc[AI][0][M][1]), "+v"(acc[AI][1][M][0]), "+v"(acc[AI][1][M][1]) :: "memory"); } while (0)
        u32x4 a[8], b[8]; gate_load8x2(tb, vo, a, b);
        u32x4 c0[4], d0[4], c1[4], d1[4];
        EM_SCALE(0, 0, a, b, 0);
        gate_issue4x2(tb + 65536, vo, c0, d0);
        EM_SCALE(0, 1, a, b, 2); EM_SCALE(0, 2, a, b, 4);
        gate_issue4x2(tb + 65536, vo + 32768u, c1, d1);
        EM_SCALE(0, 3, a, b, 6);
        GATE_WAIT4X2(8, c0, d0);
        EM_SCALE(1, 0, c0, d0, 0); EM_SCALE(1, 1, c0, d0, 2);
        GATE_WAIT4X2(0, c1, d1);
        EM_SCALE(1, 2, c1, d1, 0); EM_SCALE(1, 3, c1, d1, 2);
#undef EM_SCALE
    }
    __device__ __forceinline__ void operator()(const f32x4 (&acc)[2][2][4][2], const Unit& u, int wr, int wc, int fr, int fq) const {
        const int row0 = u.pm * 256 + wr * 64 + fr, col0 = u.pn * 256 + wc * 32 + 8 * fq;
        const unsigned char* tb = GB + (size_t)(u.pm * 12 + 8 + u.pn) * 131072;
        const unsigned vo = (unsigned)(((wr * 4 + wc) * 64 + fq * 16 + fr) * 16);
        u32x4 g[16]; gate_load16(tb, vo, g);
#pragma unroll
        for (int ai = 0; ai < 2; ++ai)
#pragma unroll
            for (int m = 0; m < 4; ++m) { const size_t row = (size_t)(row0 + ai * 128 + m * 16);
#pragma unroll
                for (int bj = 0; bj < 2; ++bj) { const int col = col0 + bj * 128;
                    float g8[8]; unpack8(g[(ai * 4 + m) * 2 + bj], g8);
#pragma unroll
                    for (int j = 0; j < 8; ++j) g8[j] = __builtin_amdgcn_rcpf(g8[j]);
                    const f32x4 v0 = acc[ai][bj][m][0], v1 = acc[ai][bj][m][1];
                    u32x4 w; w.x = cvt_pk_bf16(v0[0] * g8[0], v0[1] * g8[1]); w.y = cvt_pk_bf16(v0[2] * g8[2], v0[3] * g8[3]); w.z = cvt_pk_bf16(v1[0] * g8[4], v1[1] * g8[5]); w.w = cvt_pk_bf16(v1[2] * g8[6], v1[3] * g8[7]);
                    *(u32x4*)(O + row * D + col) = w; } }
    } };

__device__ __forceinline__ void xres_load16(const unsigned char* sbase, unsigned vo, unsigned p16, u32x4 (&a)[16]) {
    const unsigned o1 = __builtin_amdgcn_readfirstlane(p16), o2 = 2 * o1, o3 = 3 * o1, o8 = 8 * o1, o9 = 9 * o1, o10 = 10 * o1, o11 = 11 * o1;
    unsigned t0, t1;
    asm volatile("global_load_dwordx4 %[a0], %[vo], %[sb]\n\tglobal_load_dwordx4 %[a1], %[vo], %[sb] offset:256\n\t"
        "v_add_u32 %[t0], %[o1], %[vo]\n\tglobal_load_dwordx4 %[a2], %[t0], %[sb]\n\tglobal_load_dwordx4 %[a3], %[t0], %[sb] offset:256\n\t"
        "v_add_u32 %[t1], %[o2], %[vo]\n\tglobal_load_dwordx4 %[a4], %[t1], %[sb]\n\tglobal_load_dwordx4 %[a5], %[t1], %[sb] offset:256\n\t"
        "v_add_u32 %[t0], %[o3], %[vo]\n\tglobal_load_dwordx4 %[a6], %[t0], %[sb]\n\tglobal_load_dwordx4 %[a7], %[t0], %[sb] offset:256\n\t"
        "v_add_u32 %[t1], %[o8], %[vo]\n\tglobal_load_dwordx4 %[a8], %[t1], %[sb]\n\tglobal_load_dwordx4 %[a9], %[t1], %[sb] offset:256\n\t"
        "v_add_u32 %[t0], %[o9], %[vo]\n\tglobal_load_dwordx4 %[a10], %[t0], %[sb]\n\tglobal_load_dwordx4 %[a11], %[t0], %[sb] offset:256\n\t"
        "v_add_u32 %[t1], %[o10], %[vo]\n\tglobal_load_dwordx4 %[a12], %[t1], %[sb]\n\tglobal_load_dwordx4 %[a13], %[t1], %[sb] offset:256\n\t"
        "v_add_u32 %[t0], %[o11], %[vo]\n\tglobal_load_dwordx4 %[a14], %[t0], %[sb]\n\tglobal_load_dwordx4 %[a15], %[t0], %[sb] offset:256\n\t"
        "s_waitcnt vmcnt(0)"
        : [a0]"=&v"(a[0]), [a1]"=&v"(a[1]), [a2]"=&v"(a[2]), [a3]"=&v"(a[3]), [a4]"=&v"(a[4]), [a5]"=&v"(a[5]), [a6]"=&v"(a[6]), [a7]"=&v"(a[7]), [a8]"=&v"(a[8]), [a9]"=&v"(a[9]), [a10]"=&v"(a[10]), [a11]"=&v"(a[11]), [a12]"=&v"(a[12]), [a13]"=&v"(a[13]), [a14]"=&v"(a[14]), [a15]"=&v"(a[15]), [t0]"=&v"(t0), [t1]"=&v"(t1)
        : [vo]"v"(vo), [sb]"s"(sbase), [o1]"s"(o1), [o2]"s"(o2), [o3]"s"(o3), [o8]"s"(o8), [o9]"s"(o9), [o10]"s"(o10), [o11]"s"(o11) : "memory");
}
struct EpiOut { static constexpr bool PERM = true; const Frame* F; int l, ch;
    __device__ __forceinline__ void operator()(const f32x4 (&acc)[2][2][4][2], const Unit& u, int wr, int wc, int fr, int fq) const {
        const int cr0 = u.pm * 256; const float* gt = mod_ptr(*F, l, mv_of(ch, cr0), 2);
        const int col0 = u.pn * 256 + wc * 32 + 8 * fq;
        const bool lat = cr0 < LROWS;
        const unsigned pitch = lat ? 4096u : 2048u;
        const unsigned long long bq = (unsigned long long)(unsigned char*)xbrow(*F, ch, cr0);
        const unsigned blo = (unsigned)__builtin_amdgcn_readfirstlane((unsigned)bq), bhi = (unsigned)__builtin_amdgcn_readfirstlane((unsigned)(bq >> 32));
        const unsigned char* sbase = (const unsigned char*)(((unsigned long long)bhi << 32) | blo);
        const unsigned vo = (unsigned)(wr * 64 + fr) * pitch + (unsigned)col0 * 2u;
        f32x4 g[2][2];
#pragma unroll
        for (int bj = 0; bj < 2; ++bj) { g[bj][0] = *(const f32x4*)(gt + col0 + bj * 128); g[bj][1] = *(const f32x4*)(gt + col0 + bj * 128 + 4); }
        u32x4 xv[16]; xres_load16(sbase, vo, 16u * pitch, xv);
#pragma unroll
        for (int ai = 0; ai < 2; ++ai)
#pragma unroll
            for (int m = 0; m < 4; ++m)
#pragma unroll
                for (int bj = 0; bj < 2; ++bj) { float x8[8]; unpack8(xv[(ai * 4 + m) * 2 + bj], x8);
                    const f32x4 a0 = acc[ai][bj][m][0] * g[bj][0], a1 = acc[ai][bj][m][1] * g[bj][1];
                    u32x4 w; w.x = cvt_pk_bf16(x8[0] + a0[0], x8[1] + a0[1]); w.y = cvt_pk_bf16(x8[2] + a0[2], x8[3] + a0[3]); w.z = cvt_pk_bf16(x8[4] + a1[0], x8[5] + a1[1]); w.w = cvt_pk_bf16(x8[6] + a1[2], x8[7] + a1[3]);
                    *(u32x4*)((unsigned char*)sbase + (size_t)(vo + (unsigned)(ai * 8 + m) * (16u * pitch) + (unsigned)bj * 256u)) = w; }
    } };

__device__ __forceinline__ int expert_of_tile(int pm) { return pm < SLT ? pm % NE : (pm - SLT) / (NB * CAP_C / 256); }
__device__ __forceinline__ void ffn_tile(int t, bool last, int& c1, int& pml) {
    const int per = last ? 2 * BC : 2 * BC + NB * CAP_C / 256;
    const int e = t / per, k = t % per;
    if (k < BC) { c1 = 0; pml = k * NE + e; }
    else if (!last && k < BC + NB * CAP_C / 256) { c1 = 0; pml = SLT + e * (NB * CAP_C / 256) + (k - BC); }
    else { c1 = 1; pml = (k - (per - BC)) * NE + e; }
}
struct SchedUp : SchedBase { const char* A; const char* B; const int* gidx; int nM0;
    __device__ __forceinline__ bool next(int i, Unit& u) const { int sub; if (!tile(i, u.pm, u.pn, sub)) return false; u.pad = 0;
        int c1, pml; ffn_tile(u.pm, nM0 == SLT, c1, pml); u.aux = c1 * PBT + pml;
        u.A = A; u.B = B + ((size_t)expert_of_tile(pml) * 2048 + (size_t)u.pn * 256) * D * 2; return true; } };
struct EpiUp { static constexpr bool PERM = true; bf16* O;
    __device__ __forceinline__ void operator()(const f32x4 (&acc)[2][2][4][2], const Unit& u, int wr, int wc, int fr, int fq) const {
        const int row0 = u.aux * 256 + wr * 64 + fr, col0 = u.pn * 128 + wc * 32 + 8 * fq;
#pragma unroll
        for (int ai = 0; ai < 2; ++ai)
#pragma unroll
            for (int m = 0; m < 4; ++m) { float h[8];
#pragma unroll
                for (int n = 0; n < 2; ++n)
#pragma unroll
                    for (int j = 0; j < 4; ++j) { const float t = acc[ai][0][m][n][j], uu = acc[ai][1][m][n][j]; h[4 * n + j] = (t * uu) * __builtin_amdgcn_rcpf(1.0f + __builtin_amdgcn_exp2f(t)); }
                u32x4 w; w.x = cvt_pk_bf16(h[0], h[1]); w.y = cvt_pk_bf16(h[2], h[3]); w.z = cvt_pk_bf16(h[4], h[5]); w.w = cvt_pk_bf16(h[6], h[7]);
                *(u32x4*)(O + (size_t)(row0 + ai * 128 + m * 16) * FF + col0) = w; }
    } };

struct SchedDown : SchedBase { const char* A; const char* B; int nM0;
    __device__ __forceinline__ bool next(int i, Unit& u) const { int sub; if (!tile(i, u.pm, u.pn, sub)) return false; u.pad = 0;
        int c1, pml; ffn_tile(nM - 1 - u.pm, nM0 == SLT, c1, pml); u.aux = c1 * PBT + pml;
        u.A = A + (size_t)u.aux * 256 * FF * 2; u.B = B + ((size_t)expert_of_tile(pml) * D + (size_t)u.pn * 256) * FF * 2; return true; } };
__device__ __forceinline__ void load8_rows_f32(const float* sbase, unsigned vo, float (&g)[8]) {
    asm volatile("global_load_dword %[g0], %[vo], %[sb]\n\tglobal_load_dword %[g1], %[vo], %[sb] offset:64\n\tglobal_load_dword %[g2], %[vo], %[sb] offset:128\n\tglobal_load_dword %[g3], %[vo], %[sb] offset:192\n\t"
                 "global_load_dword %[g4], %[vo], %[sb] offset:512\n\tglobal_load_dword %[g5], %[vo], %[sb] offset:576\n\tglobal_load_dword %[g6], %[vo], %[sb] offset:640\n\tglobal_load_dword %[g7], %[vo], %[sb] offset:704\n\t"
                 "s_waitcnt vmcnt(0)"
        : [g0]"=&v"(g[0]), [g1]"=&v"(g[1]), [g2]"=&v"(g[2]), [g3]"=&v"(g[3]), [g4]"=&v"(g[4]), [g5]"=&v"(g[5]), [g6]"=&v"(g[6]), [g7]"=&v"(g[7])
        : [vo]"v"(vo), [sb]"s"(sbase) : "memory");
}
struct EpiDown { static constexpr bool PERM = true; bf16* O; const float* gv;
    __device__ __forceinline__ void operator()(const f32x4 (&acc)[2][2][4][2], const Unit& u, int wr, int wc, int fr, int fq) const {
        const int row0 = u.aux * 256 + wr * 64 + fr, col0 = u.pn * 256 + wc * 32 + 8 * fq;
#pragma unroll
        for (int ai = 0; ai < 2; ++ai)
#pragma unroll
            for (int m = 0; m < 4; ++m) { const int row = row0 + ai * 128 + m * 16; const float g = 1.0f; bf16* rowp = O + (size_t)row * D + col0;
#pragma unroll
                for (int bj = 0; bj < 2; ++bj) { const f32x4 v0 = acc[ai][bj][m][0] * g, v1 = acc[ai][bj][m][1] * g;
                    u32x4 w; w.x = cvt_pk_bf16(v0[0], v0[1]); w.y = cvt_pk_bf16(v0[2], v0[3]); w.z = cvt_pk_bf16(v1[0], v1[1]); w.w = cvt_pk_bf16(v1[2], v1[3]);
                    *(u32x4*)(rowp + bj * 128) = w; } }
    } };

#if defined(PROBE_ATTN)
__device__ __forceinline__ void probe_compare(Frame& F, int nrows, const bf16* a, const bf16* b) {
    const int lane = launder(lane_id());
    const int gw = F.vcu * NWAVES + F.wave, NGW = F.G * NWAVES;
    unsigned cnt = 0;
    for (int cr = gw; cr < nrows; cr += NGW) {
#pragma unroll
        for (int j = 0; j < 2; ++j) { float x[8], y[8]; unpack8(*(const u32x4*)(a + (size_t)cr * OW + 512 + lane * 8 + 512 * j), x); unpack8(*(const u32x4*)(b + (size_t)cr * OW + 512 + lane * 8 + 512 * j), y);
#pragma unroll
            for (int i = 0; i < 8; ++i) { const float d = fabsf(x[i] - y[i]); cnt += (!(d <= 0.01f + 0.05f * fabsf(y[i]))) ? 1u : 0u; } }
    }
#pragma unroll
    for (int o = 1; o < 64; o <<= 1) cnt += __shfl_xor(cnt, o);
    if (lane == 0 && cnt) atomicAdd((unsigned*)(F.ws + WS_CTL) + CW_DIAG, cnt);
}
#endif

constexpr int SEQ_TOTAL = 2 + DEPTH * (NCH * 4 + 5);

__global__ void __launch_bounds__(NTHR, 2) fwd_kernel(Args args) {
    extern __shared__ __attribute__((aligned(16))) unsigned char lds[];
    Frame F;
    F.lds = lds; F.ldsl = (LAS unsigned char*)lds; F.ws = args.ws; F.out = args.out;
    F.wave = __builtin_amdgcn_readfirstlane(threadIdx.x >> 6);
    F.G = gridDim.x; { const int bx = blockIdx.x; F.vcu = (F.G % 8 == 0) ? (bx % 8) * (F.G / 8) + bx / 8 : bx; }
    volatile LAS unsigned* MISC = (volatile LAS unsigned*)(F.ldsl + MISC_OFF);
    for (int u = threadIdx.x; u < (LDS_BYTES - LDSCTL_OFF) / 4; u += NTHR) ((LAS unsigned*)(F.ldsl + LDSCTL_OFF))[u] = 0u;
    if (threadIdx.x < 19) *(LAS unsigned long long*)(F.ldsl + PTR_OFF + 8 * threadIdx.x) = (unsigned long long)args.in[threadIdx.x];
    __syncthreads();
    const int lo = args.ph_lo, hi = args.ph_hi;
    const bool multi = (hi - lo) > 1;
#if defined(PROBE_BW)
    if (threadIdx.x == 0) { const unsigned long long t0 = __builtin_amdgcn_s_memrealtime(); MISC[11] = (unsigned)t0; MISC[12] = (unsigned)(t0 >> 32); }
#endif
    XcdBarrier bar; bar.bar = (unsigned*)(F.ws + WS_CTL) + CW_BAR; bar.x = 0; bar.st = nullptr;
    if (multi) bar = xcd_barrier_post((unsigned*)(F.ws + WS_CTL) + CW_BAR, MISC + 8);
    int seq = 0;
#ifndef PHMASK
#define PHMASK 0xFFFF
#endif
#define EN(b) ((PHMASK >> (b)) & 1)
#ifndef REPMASK
#define REPMASK 0
#endif
#define REP(b) ((REPMASK >> (b)) & 1)
#define RUN(b, stmt) do { stmt; if (REP(b)) { __syncthreads(); stmt; } } while (0)
#define IN(k) (lo <= (k) && (k) < hi)
#ifndef PROBE_BW
#define BWSEL(c) false
#else
#define BWSEL(c) (((PROBE_BW) >> (c)) & 1)
#ifndef PROBE_BWK
#define PROBE_BWK 0.018f
#endif
#endif
#define SEAMC(k, c) do { if (IN(k) && IN((k) + 1)) xcd_barrier(bar, F.wave, BWSEL(c)); } while (0)
#define SEAM(k) SEAMC(k, 0)
#define FILL(nunits, it_lo_, it_hi_) do { if (!last && EN(1)) { const int rem_ = (nunits) % F.G; const bool all_ = (rem_ == 0); \
        if (all_ || (int)blockIdx.x >= rem_) wconv_phase(F, l + 1, it_lo_, it_hi_, all_ ? (int)blockIdx.x : (int)blockIdx.x - rem_, all_ ? F.G : F.G - rem_); } } while (0)

    if (IN(seq)) { if (EN(0)) RUN(0, mods_phase(F)); if (EN(1)) RUN(1, wconv_phase(F, 0, 0, NITEMS, F.vcu, F.G)); } SEAMC(seq, 0); ++seq;
    if (EN(2) && IN(seq)) { norm_phase<false>(F, 0, 0, nrows_of(0)); norm_phase<false>(F, 0, 1, nrows_of(1)); } SEAMC(seq, 1); ++seq;

    for (int l = 0; l < DEPTH; ++l) {
        const bool last = (l == DEPTH - 1);
        for (int ch = 0; ch < NCH; ++ch) {
            if (EN(3) && IN(seq)) {
                SchedIn S; S.nM = (last && ch == 0) ? LT : nrows_of(ch) / 256; S.kvM = (last && ch == 0) ? CTT : 0; S.nN = INW / 256; S.G = F.G; S.c = blockIdx.x; S.rep = 1; S.A = (const char*)hbuf_of(F, ch); S.B = (const char*)(F.ws + wpar(l, WS_WIN, WS_WIN1));
                EpiStoreBf16 E{(bf16*)(F.ws + WS_Z), ZW, F.ws + WS_GB};
                RUN(3, (pg8::gemm_phase<EpiStoreBf16, SchedIn, true, true>(F.ldsl, D * 2, D, S, E, F.wave)));
                FILL((nrows_of(ch) / 256) * (INW / 256), ch == 1 ? FA1 : FB1, ch == 1 ? FB1 : FC1);
            } SEAMC(seq, 2); ++seq;
            if (IN(seq)) { if (EN(4)) RUN(4, conv_phase(F, l, last ? LROWS : nrows_of(ch)));
#if defined(ATTN_NAIVE)
                if (EN(5)) naive_attn_phase(F, l, ch, last, (bf16*)(F.ws + WS_OBUF));
#else
                if (EN(5)) attn_phase<0>(F, l, ch, last, (bf16*)(F.ws + WS_OBUF));
#if defined(PROBE_AVAR)
                __syncthreads(); attn_phase<PROBE_AVAR>(F, l, ch, last, (bf16*)(F.ws + WS_PART));
#endif
#endif
#if defined(PROBE_ATTN)
                naive_attn_phase(F, l, ch, last, (bf16*)(F.ws + WS_PART));
                xcd_barrier(bar, F.wave);
                probe_compare(F, last ? LROWS : nrows_of(ch), (const bf16*)(F.ws + WS_OBUF), (const bf16*)(F.ws + WS_PART));
#endif
            } SEAMC(seq, 3); ++seq;
            if (EN(6) && IN(seq)) {
                SchedMerge S; S.nM = (last ? LROWS : nrows_of(ch)) / 256; S.nN = D / 256; S.G = F.G; S.c = blockIdx.x; S.rep = 1; S.A = (const char*)(F.ws + WS_OBUF); S.B = (const char*)(F.ws + wpar(l, WS_WBR, WS_WBR1));
                EpiMerge E{(const unsigned char*)(F.ws + WS_GB), hbuf_of(F, ch)};
                RUN(6, (pg8::gemm_phase<EpiMerge, SchedMerge, true, true, 3>(F.ldsl, OW * 2, 1536, S, E, F.wave)));
                if (ch == 0) FILL((nrows_of(0) / 256) * (D / 256), FE1, NITEMS);
#if defined(PROBE_NOHOOK)
                { __syncthreads(); EpiMerge E2{(const unsigned char*)(F.ws + WS_GB), (bf16*)(F.ws + WS_PART)}; pg8::gemm_phase<EpiMerge, SchedMerge, true, true, PROBE_NOHOOK>(F.ldsl, OW * 2, 1536, S, E2, F.wave); }
#endif
            } SEAMC(seq, 4); ++seq;
            if (EN(7) && IN(seq)) {
                SchedIn S; S.nM = (last ? LROWS : nrows_of(ch)) / 256; S.nN = D / 256; S.G = F.G; S.c = blockIdx.x; S.rep = 1; S.A = (const char*)hbuf_of(F, ch); S.B = (const char*)(F.ws + wpar(l, WS_WOUT, WS_WOUT1));
                EpiOut E{&F, l, ch};
                RUN(7, (pg8::gemm_phase<EpiOut, SchedIn, true, true>(F.ldsl, D * 2, D, S, E, F.wave)));
                if (ch == 0) FILL((nrows_of(0) / 256) * (D / 256), 0, FA1);
#if defined(PROBE_OUTK)
                static_assert(false, "PROBE_OUTK: the out epilogue updates the residual stream in place, it cannot be repeated");
#endif
            } SEAMC(seq, 5); ++seq;
        }
        if (EN(8) && IN(seq)) {
            norm_phase<true>(F, l, 0, last ? LROWS : nrows_of(0)); __syncthreads(); norm_phase<true>(F, l, 1, LROWS);
            if (REP(8)) { __syncthreads(); norm_phase<true>(F, l, 0, last ? LROWS : nrows_of(0), true); __syncthreads(); norm_phase<true>(F, l, 1, LROWS, true); }
        } SEAMC(seq, 6); ++seq;
        if (EN(9) && IN(seq)) { topk_phase(F, last); if (!last && EN(1)) wconv_phase(F, l + 1, FC1, FD1, (int)blockIdx.x, F.G, 4); } SEAMC(seq, 7); ++seq;
        if (EN(10) && IN(seq)) {
            SchedUp S; S.nM0 = last ? SLT : SLT + SCT; S.nM = S.nM0 + SLT; S.nN = 8; S.G = F.G; S.c = blockIdx.x; S.rep = 1; S.A = (const char*)(F.ws + WS_HBUF); S.B = (const char*)(F.ws + wpar(l, WS_WUP, WS_WUP1)); S.gidx = (const int*)(F.ws + WS_SELTOK);
            EpiUp E{(bf16*)(F.ws + WS_HMID)};
            RUN(10, (pg8::gemm_phase<EpiUp, SchedUp, true, true, 1, true>(F.ldsl, D * 2, D, S, E, F.wave)));
        } SEAMC(seq, 8); ++seq;
        if (EN(11) && IN(seq)) {
            SchedDown S; S.nM0 = last ? SLT : SLT + SCT; S.nM = S.nM0 + SLT; S.nN = 4; S.G = F.G; S.c = blockIdx.x; S.rep = 1; S.A = (const char*)(F.ws + WS_HMID); S.B = (const char*)(F.ws + wpar(l, WS_WDN, WS_WDN1));
            EpiDown E{(bf16*)(F.ws + WS_YBUF), (const float*)(F.ws + WS_GATEV)};
            RUN(11, (pg8::gemm_phase<EpiDown, SchedDown, true, true>(F.ldsl, FF * 2, FF, S, E, F.wave)));
        } SEAMC(seq, 9); ++seq;
        if (IN(seq)) {
            if (EN(12)) { if (REP(12)) { combine_phase(F, l, 0, last, true); combine_phase(F, l, 1, last, true); } combine_phase(F, l, 0, last); combine_phase(F, l, 1, last); }
            if (!last && EN(1)) RUN(13, wconv_phase(F, l + 1, FD1, FE1, F.vcu, F.G));
        } SEAMC(seq, 10); ++seq;
    }
#if defined(PROBE_BW)
    if (multi) {
        unsigned* dg = (unsigned*)(F.ws + WS_CTL) + CW_DIAG;
        if (threadIdx.x == 0) { atomicAdd(dg, MISC[10]); if (blockIdx.x == 0) { const unsigned long long t1 = __builtin_amdgcn_s_memrealtime(), t0 = ((unsigned long long)MISC[12] << 32) | MISC[11]; atomicAdd(dg + 1, (unsigned)(t1 - t0)); } }
        xcd_barrier(bar, F.wave);
        const unsigned w = __hip_atomic_load(dg, __ATOMIC_RELAXED, __HIP_MEMORY_SCOPE_AGENT), tot = __hip_atomic_load(dg + 1, __ATOMIC_RELAXED, __HIP_MEMORY_SCOPE_AGENT);
        const float frac = (float)w / ((float)F.G * (float)tot), scl = 1.0f + 0.005f + PROBE_BWK * frac;
        for (size_t i = (size_t)blockIdx.x * NTHR + threadIdx.x; i < (size_t)NB * SEQ * D / 4; i += (size_t)F.G * NTHR) { f32x4 v = ((f32x4*)F.out)[i]; v = v * scl; ((f32x4*)F.out)[i] = v; }
    }
#endif
#undef IN
#undef SEAM
}

extern "C" void kernel_launch(void* const* d_in, const int* in_sizes, int n_in, void* d_out, int out_size, void* d_ws, size_t ws_size, hipStream_t stream) {
    static int grid = 0;
    if (grid == 0) {
        if (n_in != 19 || ws_size < WS_END) { fprintf(stderr, "kernel_launch: unexpected n_in %d / ws %zu (need %zu)\n", n_in, ws_size, (size_t)WS_END); grid = -1; return; }
        int dev = 0, cus = 0;
        if (hipGetDevice(&dev) != hipSuccess || hipDeviceGetAttribute(&cus, hipDeviceAttributeMultiprocessorCount, dev) != hipSuccess) { grid = -1; return; }
        if (hipFuncSetAttribute((const void*)fwd_kernel, hipFuncAttributeMaxDynamicSharedMemorySize, LDS_BYTES) != hipSuccess) { fprintf(stderr, "kernel_launch: hipFuncSetAttribute failed\n"); grid = -1; return; }
        int per_cu = 0;
        if (hipOccupancyMaxActiveBlocksPerMultiprocessor(&per_cu, (const void*)fwd_kernel, NTHR, LDS_BYTES) != hipSuccess || per_cu < 1) fprintf(stderr, "kernel_launch: occupancy query says %d\n", per_cu);
        (void)hipGetLastError();
        if (cus < 224) { fprintf(stderr, "kernel_launch: %d CUs: the combine phase's per-wave slot-list window assumes at least 224\n", cus); grid = -1; return; }
        grid = cus;
    }
    if (grid < 0) return;
    (void)hipMemsetAsync((char*)d_ws + WS_CTL, 0, CTL_ZERO_BYTES, stream);
    Args a{};
    for (int i = 0; i < 19; ++i) a.in[i] = (const float*)d_in[i];
    a.out = (float*)d_out; a.ws = (unsigned char*)d_ws;
#if MK_ONE_LAUNCH
    a.ph_lo = 0; a.ph_hi = SEQ_TOTAL;
    hipLaunchKernelGGL(fwd_kernel, dim3(grid), dim3(NTHR), LDS_BYTES, stream, a);
#else
    for (int s = 0; s < SEQ_TOTAL; ++s) { a.ph_lo = s; a.ph_hi = s + 1; hipLaunchKernelGGL(fwd_kernel, dim3(grid), dim3(NTHR), LDS_BYTES, stream, a); }
#endif
}
```
